# Optimizing an MI355X kernel written in HIP

```python
import jax, jax.numpy as jnp
from jax import lax
import numpy as np

D_MODEL = 1024
BATCH = 32
SEQ = 2048
DEPTH = 1

CHUNK = 64
Q_BLOCK = 128
EPS = 1e-6
MLA_HEADS = 8
Q_LORA = 384
KV_LORA = 256
QK_NOPE = 64
QK_ROPE = 32
V_DIM = 64
QK_DIM = QK_NOPE + QK_ROPE
ROPE_THETA = 10000.0
SB_HEADS = 8
SB_DIM = 64
N_EXPERTS = 32
TOP_K = 4
D_EXPERT = D_MODEL
SWIGLU_LIMIT = 7.0
SWIGLU_ALPHA = 1.702
EXPERT_BLOCK = 256
SPLIT_WIDTHS = (Q_LORA, KV_LORA, QK_ROPE, 3 * SB_HEADS * SB_DIM, D_MODEL, D_MODEL)
SPLIT_POINTS = tuple(int(v) for v in np.cumsum(SPLIT_WIDTHS)[:-1])
D_IN = int(sum(SPLIT_WIDTHS))

kernel_name = 'hybrid_mla_stickbreaking_moe_block'


def rmsnorm(x, g):
    xf = x.astype(jnp.float32)
    y = xf * lax.rsqrt(jnp.mean(xf * xf, axis=-1, keepdims=True) + EPS)
    return (y * g.astype(jnp.float32)).astype(x.dtype)


def modulate(h, shift, scale):
    return h * (1 + scale[:, None, :]) + shift[:, None, :]


def rope_tables(positions):
    inv_freq = 1.0 / (ROPE_THETA ** (jnp.arange(0, QK_ROPE, 2, dtype=jnp.float32) / QK_ROPE))
    ang = positions.astype(jnp.float32)[..., None] * inv_freq
    return jnp.cos(ang)[:, :, None, :], jnp.sin(ang)[:, :, None, :]


def apply_rope(x, cos, sin):
    xf = x.astype(jnp.float32)
    x1, x2 = xf[..., :QK_ROPE // 2], xf[..., QK_ROPE // 2:]
    return jnp.concatenate([x1 * cos - x2 * sin, x2 * cos + x1 * sin], axis=-1).astype(x.dtype)


def mla_attention(q, k, v):
    S = q.shape[2]
    scale = QK_DIM ** -0.5
    outs = []
    for i in range(S // Q_BLOCK):
        s0, s1 = i * Q_BLOCK, (i + 1) * Q_BLOCK
        sc = jnp.einsum('bhqd,bhkd->bhqk', q[:, :, s0:s1], k[:, :, :s1]).astype(jnp.float32) * scale
        q_chunk = (s0 + jnp.arange(Q_BLOCK)) // CHUNK
        k_chunk = jnp.arange(s1) // CHUNK
        mask = k_chunk[None, :] <= q_chunk[:, None]
        p = jax.nn.softmax(jnp.where(mask, sc, -jnp.inf), axis=-1)
        outs.append(jnp.einsum('bhqk,bhkd->bhqd', p.astype(v.dtype), v[:, :, :s1]))
    return jnp.concatenate(outs, axis=2)


def stick_breaking_attention(q, k, v):
    S = q.shape[2]
    scale = SB_DIM ** -0.5
    outs = []
    for i in range(S // Q_BLOCK):
        s0, s1 = i * Q_BLOCK, (i + 1) * Q_BLOCK
        z = jnp.einsum('bhqd,bhkd->bhqk', q[:, :, s0:s1], k[:, :, :s1]).astype(jnp.float32) * scale
        q_pos = s0 + jnp.arange(Q_BLOCK)
        k_pos = jnp.arange(s1)
        mask = k_pos[None, :] < q_pos[:, None]
        log_keep = jnp.where(mask, jax.nn.log_sigmoid(-z), 0.0)
        suffix = lax.cumsum(log_keep, axis=3, reverse=True)
        log_a = jax.nn.log_sigmoid(z) + suffix - log_keep
        a = jnp.where(mask, jnp.exp(log_a), 0.0)
        outs.append(jnp.einsum('bhqk,bhkd->bhqd', a.astype(v.dtype), v[:, :, :s1]))
    return jnp.concatenate(outs, axis=2)


def moe_ffn(h, w_router, b_router, w_gate_up, b_gate_up, w_down, b_down):
    B, S, D = h.shape
    T = B * S
    xf = h.reshape(T, D)
    logits = (xf @ w_router).astype(jnp.float32) + b_router.astype(jnp.float32)
    top_val, top_idx = lax.top_k(logits, TOP_K)
    top_w = jax.nn.softmax(top_val, axis=-1)
    n_assign = T * TOP_K
    flat_e = top_idx.reshape(-1).astype(jnp.int32)
    flat_tok = jnp.repeat(jnp.arange(T, dtype=jnp.int32), TOP_K)
    flat_w = top_w.reshape(-1)
    order = jnp.argsort(flat_e)
    sorted_e = flat_e[order]
    counts = jnp.bincount(flat_e, length=N_EXPERTS).astype(jnp.int32)
    padded = (counts + EXPERT_BLOCK - 1) // EXPERT_BLOCK * EXPERT_BLOCK
    start = jnp.cumsum(counts) - counts
    pend = jnp.cumsum(padded)
    pstart = pend - padded
    dest = pstart[sorted_e] + (jnp.arange(n_assign, dtype=jnp.int32) - start[sorted_e])
    P = ((n_assign + EXPERT_BLOCK - 1) // EXPERT_BLOCK) * EXPERT_BLOCK + N_EXPERTS * EXPERT_BLOCK
    NB = P // EXPERT_BLOCK
    buf_tok = jnp.full((P,), T, dtype=jnp.int32).at[dest].set(flat_tok[order])
    buf_w = jnp.zeros((P,), jnp.float32).at[dest].set(flat_w[order])
    block_e = jnp.minimum(
        jnp.searchsorted(pend, jnp.arange(NB, dtype=jnp.int32) * EXPERT_BLOCK, side='right'),
        N_EXPERTS - 1).astype(jnp.int32)
    xpad = jnp.concatenate([xf, jnp.zeros((1, D), xf.dtype)], axis=0)

    def expert_block(args):
        tok, e, wgt = args
        xb = xpad[tok]
        gu = xb @ w_gate_up[e] + b_gate_up[e]
        gate = jnp.minimum(gu[:, :D_EXPERT], SWIGLU_LIMIT)
        up = jnp.clip(gu[:, D_EXPERT:], -SWIGLU_LIMIT, SWIGLU_LIMIT)
        hid = (up + 1) * (gate * jax.nn.sigmoid(SWIGLU_ALPHA * gate))
        yb = hid @ w_down[e] + b_down[e]
        return yb.astype(jnp.float32) * wgt[:, None]

    ys = lax.map(expert_block, (buf_tok.reshape(NB, EXPERT_BLOCK), block_e,
                                buf_w.reshape(NB, EXPERT_BLOCK)))
    out = jnp.zeros((T + 1, D), jnp.float32).at[buf_tok].add(ys.reshape(P, D))
    return out[:T].reshape(B, S, D).astype(h.dtype)


def hybrid_layer(x, c, cos, sin, w_ada, b_ada, g_norm1, w_in, g_q_lat, w_uq, g_kv_lat, w_ukv,
                 g_qk_q, g_qk_k, w_o_mla, w_o_sb, w_out, g_norm2, w_router, b_router,
                 w_gate_up, b_gate_up, w_down, b_down):
    B, S, _ = x.shape
    mod = jax.nn.silu(c) @ w_ada + b_ada
    sh1, sc1, ga1, sh2, sc2, ga2 = jnp.split(mod, 6, axis=-1)

    h = modulate(rmsnorm(x, g_norm1), sh1, sc1)
    proj = h @ w_in
    q_lat, kv_lat, k_pe, sb_qkv, gate_a, gate_b = jnp.split(proj, SPLIT_POINTS, axis=-1)

    q = (rmsnorm(q_lat, g_q_lat) @ w_uq).reshape(B, S, MLA_HEADS, QK_DIM)
    kv = (rmsnorm(kv_lat, g_kv_lat) @ w_ukv).reshape(B, S, MLA_HEADS, QK_NOPE + V_DIM)
    k_nope, v = kv[..., :QK_NOPE], kv[..., QK_NOPE:]
    k = jnp.concatenate(
        [k_nope, jnp.broadcast_to(k_pe[:, :, None, :], (B, S, MLA_HEADS, QK_ROPE))], axis=-1)
    q = rmsnorm(q, g_qk_q)
    k = rmsnorm(k, g_qk_k)
    q = jnp.concatenate([q[..., :QK_NOPE], apply_rope(q[..., QK_NOPE:], cos, sin)], axis=-1)
    k = jnp.concatenate([k[..., :QK_NOPE], apply_rope(k[..., QK_NOPE:], cos, sin)], axis=-1)
    o_mla = mla_attention(q.transpose(0, 2, 1, 3), k.transpose(0, 2, 1, 3), v.transpose(0, 2, 1, 3))
    o_mla = o_mla.transpose(0, 2, 1, 3).reshape(B, S, MLA_HEADS * V_DIM)

    sb = sb_qkv.reshape(B, S, 3, SB_HEADS, SB_DIM).transpose(2, 0, 3, 1, 4)
    o_sb = stick_breaking_attention(sb[0], sb[1], sb[2])
    o_sb = o_sb.transpose(0, 2, 1, 3).reshape(B, S, SB_HEADS * SB_DIM)

    merged = jax.nn.sigmoid(gate_a) * (o_mla @ w_o_mla) + jax.nn.sigmoid(gate_b) * (o_sb @ w_o_sb)
    x = x + ga1[:, None, :] * (merged @ w_out)

    h2 = modulate(rmsnorm(x, g_norm2), sh2, sc2)
    x = x + ga2[:, None, :] * moe_ffn(h2, w_router, b_router, w_gate_up, b_gate_up, w_down, b_down)
    return x


def setup_inputs(seed: int = 0) -> dict:
    key = jax.random.key(seed)
    ks = jax.random.split(key, 26)
    f32 = jnp.float32
    L = DEPTH

    def nrm(k, shape, scale):
        return jax.random.normal(k, shape, f32) * scale

    def gain(k, shape):
        return 1.0 + 0.02 * jax.random.normal(k, shape, f32)

    x = jax.random.normal(ks[0], (BATCH, SEQ, D_MODEL), f32)
    c = jax.random.normal(ks[1], (BATCH, D_MODEL), f32)
    offset = jax.random.randint(ks[2], (BATCH, 1), 0, 8192, dtype=jnp.int32)
    positions = offset + jnp.arange(SEQ, dtype=jnp.int32)[None, :]
    return {
        'x': x,
        'c': c,
        'positions': positions,
        'w_ada': nrm(ks[3], (L, D_MODEL, 6 * D_MODEL), 0.5 * D_MODEL ** -0.5),
        'b_ada': nrm(ks[4], (L, 6 * D_MODEL), 0.02),
        'g_norm1': gain(ks[5], (L, D_MODEL)),
        'w_in': nrm(ks[6], (L, D_MODEL, D_IN), D_MODEL ** -0.5),
        'g_q_lat': gain(ks[7], (L, Q_LORA)),
        'w_uq': nrm(ks[8], (L, Q_LORA, MLA_HEADS * QK_DIM), Q_LORA ** -0.5),
        'g_kv_lat': gain(ks[9], (L, KV_LORA)),
        'w_ukv': nrm(ks[10], (L, KV_LORA, MLA_HEADS * (QK_NOPE + V_DIM)), KV_LORA ** -0.5),
        'g_qk_q': gain(ks[11], (L, QK_DIM)),
        'g_qk_k': gain(ks[12], (L, QK_DIM)),
        'w_o_mla': nrm(ks[13], (L, MLA_HEADS * V_DIM, D_MODEL), (MLA_HEADS * V_DIM) ** -0.5),
        'w_o_sb': nrm(ks[14], (L, SB_HEADS * SB_DIM, D_MODEL), (SB_HEADS * SB_DIM) ** -0.5),
        'w_out': nrm(ks[15], (L, D_MODEL, D_MODEL), D_MODEL ** -0.5),
        'g_norm2': gain(ks[16], (L, D_MODEL)),
        'w_router': nrm(ks[17], (L, D_MODEL, N_EXPERTS), D_MODEL ** -0.5),
        'b_router': nrm(ks[18], (L, N_EXPERTS), 0.01),
        'w_gate_up': nrm(ks[19], (L, N_EXPERTS, D_MODEL, 2 * D_EXPERT), D_MODEL ** -0.5),
        'b_gate_up': nrm(ks[20], (L, N_EXPERTS, 2 * D_EXPERT), 0.02),
        'w_down': nrm(ks[21], (L, N_EXPERTS, D_EXPERT, D_MODEL), D_EXPERT ** -0.5),
        'b_down': nrm(ks[22], (L, N_EXPERTS, D_MODEL), 0.02),
    }


def reference(x, c, positions, w_ada, b_ada, g_norm1, w_in, g_q_lat, w_uq, g_kv_lat, w_ukv,
              g_qk_q, g_qk_k, w_o_mla, w_o_sb, w_out, g_norm2, w_router, b_router,
              w_gate_up, b_gate_up, w_down, b_down):
    cos, sin = rope_tables(positions)
    for l in range(DEPTH):
        x = hybrid_layer(x, c, cos, sin, w_ada[l], b_ada[l], g_norm1[l], w_in[l], g_q_lat[l],
                         w_uq[l], g_kv_lat[l], w_ukv[l], g_qk_q[l], g_qk_k[l], w_o_mla[l],
                         w_o_sb[l], w_out[l], g_norm2[l], w_router[l], b_router[l],
                         w_gate_up[l], b_gate_up[l], w_down[l], b_down[l])
    return x
```

```cpp
#include <hip/hip_runtime.h>
#include <cstdio>
#include <cstdint>

#define LAS __attribute__((address_space(3)))
#define GAS __attribute__((address_space(1)))
typedef unsigned short bf16_t;
typedef short bf16x8 __attribute__((ext_vector_type(8)));
typedef short s16x4 __attribute__((ext_vector_type(4)));
typedef float f32x2 __attribute__((ext_vector_type(2)));
typedef float f32x4 __attribute__((ext_vector_type(4)));
typedef float f32x16 __attribute__((ext_vector_type(16)));
typedef unsigned u32x2 __attribute__((ext_vector_type(2)));
typedef unsigned u32x4 __attribute__((ext_vector_type(4)));

constexpr int NB = 32, SEQ = 2048, DM = 1024, NTOK = NB * SEQ;
constexpr int QLORA = 384, KVLORA = 256, ROPE = 32, NOPE = 64, VD = 64, QKD = 96, NH = 8;
constexpr int SBD = 64;
constexpr int NE = 32, TOPK = 4, DE = 1024;
constexpr int DIN = 4256, DINP = 4352;
constexpr float EPS = 1e-6f;
constexpr float LOG2E = 1.4426950408889634f;
constexpr int LISTCAP = NTOK;
constexpr int MAXTILES = NTOK / 256 + NE;

constexpr size_t MiB = 1u << 20;
constexpr size_t WS_CTL = 0, CTL_ZERO_BYTES = 1 * MiB;
constexpr size_t WS_WIN = 1 * MiB;
constexpr size_t WS_WUQ = 10 * MiB;
constexpr size_t WS_WUKV = 11 * MiB;
constexpr size_t WS_WOM = 12 * MiB;
constexpr size_t WS_WOS = 13 * MiB;
constexpr size_t WS_WOUT = 14 * MiB;
constexpr size_t WS_MOD = 16 * MiB;
constexpr size_t WS_H = 32 * MiB;
constexpr size_t WS_KVRAW = WS_H, WS_MERGED = WS_H;
constexpr size_t WS_SGA = 160 * MiB;
constexpr size_t WS_H2 = WS_SGA;
constexpr size_t WS_SGB = 288 * MiB;
constexpr size_t WS_WGU = WS_SGB;
constexpr size_t WS_SB = 416 * MiB;
constexpr size_t WS_WDN = 416 * MiB;
constexpr size_t WS_TOKL = 480 * MiB;
constexpr size_t WS_WL = 512 * MiB;
constexpr size_t WS_HID = 544 * MiB;
constexpr size_t WS_QL = 608 * MiB;
constexpr size_t WS_KVL = 656 * MiB;
constexpr size_t WS_KPE = 688 * MiB;
constexpr size_t WS_Q = 692 * MiB;
constexpr size_t WS_K = 788 * MiB;
constexpr size_t WS_OMLA = 884 * MiB;
constexpr size_t WS_OSB = 948 * MiB;
constexpr size_t WS_END = 1012 * MiB;
static_assert(WS_HID + (size_t)MAXTILES * 256 * 1024 * 2 <= 692 * MiB, "hid fits below Q (dead by then anyway)");
constexpr int CW_BAR = 4096;
constexpr int CW_CNT = 16384;

constexpr int RING_BYTES = 131072;
constexpr int LDSCTL_OFF = RING_BYTES;
constexpr int LC_BARST = 0;
constexpr int LC_TBASE = 64;
constexpr int LC_NE = 256;
constexpr int LC_TILEE = 512;
constexpr int LDS_BYTES = 147456;
static_assert(LC_TILEE + MAXTILES * 4 <= LDS_BYTES - LDSCTL_OFF, "lds ctl");

__device__ __forceinline__ unsigned cvt_pk_bf16(float lo, float hi) { unsigned r; asm volatile("v_cvt_pk_bf16_f32 %0, %1, %2" : "=v"(r) : "v"(lo), "v"(hi)); return r; }
__device__ __forceinline__ float bf_lo(unsigned u) { return __builtin_bit_cast(float, u << 16); }
__device__ __forceinline__ float bf_hi(unsigned u) { return __builtin_bit_cast(float, u & 0xffff0000u); }
__device__ __forceinline__ float fast_sigmoid(float x) { return __builtin_amdgcn_rcpf(1.f + __builtin_amdgcn_exp2f(-x * LOG2E)); }

namespace pg8 {
constexpr int BM = 256, BK = 64, HALF = 128, HTB = HALF * BK * 2, STAGE_BYTES = 8 * HTB, NXCD = 8, WGM = 8;
__host__ __device__ __forceinline__ int lds_byte(int r, int c) { const int st = (r >> 4) * 2 + (c >> 5), rr = r & 15, cc = c & 31, ob = rr * 64 + cc * 2; return st * 1024 + (ob ^ (((ob >> 9) & 1) << 5)); }
__host__ __device__ __forceinline__ void stage_rc(int b, int& R, int& C) { const int st = b / 1024, sb = b % 1024, swz = sb ^ (((sb >> 9) & 1) << 5); R = (st >> 1) * 16 + swz / 64; C = (st & 1) * 32 + (swz % 64) / 2; }
__host__ __device__ __forceinline__ int perm32(int rho) { const int n = rho >> 4, i = rho & 15; return 8 * (i >> 2) + 4 * n + (i & 3); }

struct Unit { int pm, pn, e, j0, ne; };

struct DenseOrder {
    const char* A; const char* Bt; int K; int nM, nN, nwg, G, c;
    __device__ void init(const void* A_, const void* Bt_, int M, int N, int K_, int G_, int c_) { A = (const char*)A_; Bt = (const char*)Bt_; K = K_; nM = M / BM; nN = N / BM; nwg = nM * nN; G = G_; c = c_; }
    __device__ __forceinline__ bool next(int i, Unit& u) const {
        const long L = (long)i * G + c; if (L >= nwg) return false;
        int wgid = (int)L; { const int q = nwg / NXCD, r = nwg % NXCD, xcd = wgid % NXCD, off = wgid / NXCD; wgid = (xcd < r ? xcd * (q + 1) : r * (q + 1) + (xcd - r) * q) + off; }
        const int nig = WGM * nN, gid = wgid / nig, fm = gid * WGM, gsz = (nM - fm) < WGM ? (nM - fm) : WGM;
        u.pm = fm + ((wgid % nig) % gsz); u.pn = (wgid % nig) / gsz; u.e = 0; u.j0 = 0; u.ne = 0; return true;
    }
    __device__ __forceinline__ const char* a_base(const Unit& u) const { return A + (size_t)u.pm * (size_t)(BM * 2) * K; }
    __device__ __forceinline__ const char* b_base(const Unit& u) const { return Bt + (size_t)u.pn * (size_t)(BM * 2) * K; }
    __device__ __forceinline__ unsigned row_of(const Unit&, int) const { return 0u; }
};

template <bool GATHER, class Epi, class Sched>
__device__ __forceinline__ void gemm_phase(LAS unsigned char* lds, const int K, const Sched& S, const Epi& E) {
    int tid_ = threadIdx.x; asm volatile("" : "+v"(tid_));
    const int tid = tid_, wid = __builtin_amdgcn_readfirstlane(tid >> 6), lane = tid & 63, wr = wid >> 2, wc = wid & 3, fr = lane & 15, fq = lane >> 4;
    const int nt = K / BK;
    int RA[2]; unsigned cofA[2], voffB[2];
#pragma unroll
    for (int i = 0; i < 2; ++i) { int R, C; stage_rc(tid * 16 + i * 8192, R, C); const int Rb = (R & ~31) + perm32(R & 31);
        RA[i] = R; cofA[i] = (unsigned)C * 2u; voffB[i] = (unsigned)(Rb * K + C) * 2u; }
    const size_t kstep = (size_t)(BK * 2);
    const size_t hstep = (size_t)HALF * K * 2;
    const unsigned ldsw = (unsigned)wid * 1024u;
    const int aoff = lds_byte(wr * 64 + fr, fq * 8), boff = lds_byte(wc * 32 + fr, fq * 8);
#define PG8_SA(b, h) (((b) * 2 + (h)) * HTB)
#define PG8_SB(b, h) ((4 + (b) * 2 + (h)) * HTB)
#define PG8_STAGE(bufoff, gbase, voff) do { _Pragma("unroll") for (int _i = 0; _i < 2; ++_i) \
        __builtin_amdgcn_global_load_lds((const unsigned*)((const char*)(gbase) + (voff)[_i]), (LAS unsigned*)(lds + (bufoff) + ldsw + _i * 8192), 16, 0, 0); } while (0)
#define PG8_LDA(dst, b, h) do { _Pragma("unroll") for (int m = 0; m < 4; ++m) _Pragma("unroll") for (int k = 0; k < 2; ++k) dst[m][k] = *(const LAS bf16x8*)(lds + PG8_SA(b, h) + aoff + m * 2048 + k * 1024); } while (0)
#define PG8_LDB(dst, b, h) do { _Pragma("unroll") for (int n = 0; n < 2; ++n) _Pragma("unroll") for (int k = 0; k < 2; ++k) dst[n][k] = *(const LAS bf16x8*)(lds + PG8_SB(b, h) + boff + n * 2048 + k * 1024); } while (0)
#define PG8_MMA(ai, bj, At, Bt) do { __builtin_amdgcn_s_setprio(1); _Pragma("unroll") for (int m = 0; m < 4; ++m) _Pragma("unroll") for (int n = 0; n < 2; ++n) _Pragma("unroll") for (int k = 0; k < 2; ++k) \
        acc[ai][bj][m][n] = __builtin_amdgcn_mfma_f32_16x16x32_bf16(Bt[n][k], At[m][k], acc[ai][bj][m][n], 0, 0, 0); __builtin_amdgcn_s_setprio(0); } while (0)
#define PG8_WAIT_V(n) asm volatile("s_waitcnt vmcnt(" #n ")" ::: "memory")
#define PG8_WAIT_L(n) asm volatile("s_waitcnt lgkmcnt(" #n ")" ::: "memory")
#define PG8_BAR __builtin_amdgcn_s_barrier()
#define PG8_SCHED __builtin_amdgcn_sched_barrier(0)
#define PG8_AOFFS(dst, u) do { _Pragma("unroll") for (int _h = 0; _h < 2; ++_h) _Pragma("unroll") for (int _i = 0; _i < 2; ++_i) { \
        const unsigned _row = GATHER ? S.row_of(u, _h * HALF + RA[_i]) : (unsigned)(_h * HALF + RA[_i]); dst[_h][_i] = _row * (unsigned)(K * 2) + cofA[_i]; } } while (0)
    Unit cur, nxt; int ui = 0;
    if (!S.next(0, cur)) return;
    f32x4 acc[2][2][4][2];
#pragma unroll
    for (int a = 0; a < 2; ++a)
#pragma unroll
        for (int b = 0; b < 2; ++b)
#pragma unroll
            for (int m = 0; m < 4; ++m)
#pragma unroll
                for (int n = 0; n < 2; ++n) acc[a][b][m][n] = (f32x4){0.f, 0.f, 0.f, 0.f};
    bf16x8 At[4][2], B0[2][2], B1[2][2];
    unsigned oc[2][2], on[2][2];
    PG8_AOFFS(oc, cur);
    const char* cA = S.a_base(cur); const char* cB = S.b_base(cur);
    PG8_STAGE(PG8_SB(0, 0), cB, voffB); PG8_STAGE(PG8_SB(0, 1), cB + hstep, voffB); PG8_STAGE(PG8_SA(0, 0), cA, oc[0]); PG8_STAGE(PG8_SA(0, 1), cA, oc[1]);
    if (wr == 1) PG8_BAR;
    PG8_WAIT_V(2); PG8_BAR;
    PG8_STAGE(PG8_SB(1, 0), cB + kstep, voffB); PG8_STAGE(PG8_SA(1, 0), cA + kstep, oc[0]); PG8_STAGE(PG8_SB(1, 1), cB + hstep + kstep, voffB);
    PG8_WAIT_V(6); PG8_BAR;
    for (;;) {
        const bool has_next = S.next(ui + 1, nxt);
        const char* nA = has_next ? S.a_base(nxt) : cA; const char* nB = has_next ? S.b_base(nxt) : cB;
        if constexpr (GATHER) { if (has_next) { PG8_AOFFS(on, nxt); } else {
#pragma unroll
            for (int _h = 0; _h < 2; ++_h)
#pragma unroll
                for (int _i = 0; _i < 2; ++_i) on[_h][_i] = oc[_h][_i]; } }
        for (int t = 0; t < nt; t += 2) {
            const bool last = (t == nt - 2);
            const char* a1 = cA + (size_t)(t + 1) * kstep;
            const char* a2 = last ? nA : cA + (size_t)(t + 2) * kstep; const char* b2 = last ? nB : cB + (size_t)(t + 2) * kstep;
            const char* a3 = a2 + kstep; const char* b3 = b2 + kstep;
            unsigned o2[2][2];
#pragma unroll
            for (int _h = 0; _h < 2; ++_h)
#pragma unroll
                for (int _i = 0; _i < 2; ++_i) o2[_h][_i] = (GATHER && last) ? on[_h][_i] : oc[_h][_i];
            PG8_LDB(B0, 0, 0); PG8_LDB(B1, 0, 1); PG8_SCHED; PG8_LDA(At, 0, 0); PG8_STAGE(PG8_SA(1, 1), a1, oc[1]);
            PG8_WAIT_V(8); PG8_WAIT_L(0); PG8_BAR; PG8_MMA(0, 0, At, B0); PG8_MMA(0, 1, At, B1); PG8_BAR; PG8_SCHED;
            PG8_LDA(At, 0, 1); PG8_STAGE(PG8_SB(0, 0), b2, voffB); PG8_STAGE(PG8_SB(0, 1), b2 + hstep, voffB); PG8_STAGE(PG8_SA(0, 0), a2, o2[0]);
            PG8_WAIT_V(8); PG8_WAIT_L(0); PG8_BAR; PG8_MMA(1, 0, At, B0); PG8_MMA(1, 1, At, B1); PG8_BAR; PG8_SCHED;
            PG8_LDB(B0, 1, 0); PG8_LDB(B1, 1, 1); PG8_SCHED; PG8_LDA(At, 1, 0); PG8_STAGE(PG8_SA(0, 1), a2, o2[1]);
            PG8_WAIT_V(8); PG8_WAIT_L(0); PG8_BAR; PG8_MMA(0, 0, At, B0); PG8_MMA(0, 1, At, B1); PG8_BAR; PG8_SCHED;
            PG8_LDA(At, 1, 1); PG8_STAGE(PG8_SB(1, 0), b3, voffB); PG8_STAGE(PG8_SB(1, 1), b3 + hstep, voffB); PG8_STAGE(PG8_SA(1, 0), a3, o2[0]);
            PG8_WAIT_V(8); PG8_WAIT_L(0); PG8_BAR; PG8_MMA(1, 0, At, B0); PG8_MMA(1, 1, At, B1); PG8_BAR; PG8_SCHED;
        }
        if (wr == 0) PG8_BAR;
        E(acc, cur, wr, wc, fr, fq);
        if (!has_next) break;
#pragma unroll
        for (int a = 0; a < 2; ++a)
#pragma unroll
            for (int b = 0; b < 2; ++b)
#pragma unroll
                for (int m = 0; m < 4; ++m)
#pragma unroll
                    for (int n = 0; n < 2; ++n) acc[a][b][m][n] = (f32x4){0.f, 0.f, 0.f, 0.f};
        cur = nxt; cA = nA; cB = nB; ++ui;
        if constexpr (GATHER) {
#pragma unroll
        for (int _h = 0; _h < 2; ++_h)
#pragma unroll
            for (int _i = 0; _i < 2; ++_i) oc[_h][_i] = on[_h][_i]; }
        if (wr == 1) PG8_BAR;
    }
    PG8_WAIT_V(0);
    PG8_BAR;
#undef PG8_SA
#undef PG8_SB
#undef PG8_STAGE
#undef PG8_LDA
#undef PG8_LDB
#undef PG8_MMA
#undef PG8_WAIT_V
#undef PG8_WAIT_L
#undef PG8_BAR
#undef PG8_SCHED
#undef PG8_AOFFS
}
}
#define XB_TMO      128
#define XB_XCNT(j)  (256  + 64 * (j))
#define XB_XSUB(j)  (1280 + 64 * (j))
#define XB_XGEN(j)  (2304 + 64 * (j))
#define XB_TOP      3328
#define XB_TOPGEN   3392
#define XCD_BAR_WORDS 3456
#define XB_SPIN_CAP (1u << 18)

__device__ __forceinline__ unsigned xb_ld(unsigned* p)              { return __hip_atomic_load(p, __ATOMIC_RELAXED, __HIP_MEMORY_SCOPE_AGENT); }
__device__ __forceinline__ unsigned xb_add(unsigned* p, unsigned v) { return __hip_atomic_fetch_add(p, v, __ATOMIC_RELAXED, __HIP_MEMORY_SCOPE_AGENT); }
__device__ __forceinline__ unsigned xb_xcc_id() { return (unsigned)__builtin_amdgcn_s_getreg((3 << 11) | 20) & 0xFu; }
#define XB_SPIN(cond, bar) do { unsigned _sp = 0; while (cond) { __builtin_amdgcn_s_sleep(1); \
    if ((++_sp & 255u) == 0u) { if (xb_ld(&(bar)[XB_TMO])) break; if (_sp > XB_SPIN_CAP) { atomicAdd(&(bar)[XB_TMO], 1u); break; } } } } while (0)

struct XcdBarrier {
    unsigned* bar; unsigned x;
    volatile LAS unsigned* st;
};

__device__ __forceinline__ XcdBarrier xcd_barrier_post(unsigned* bar, volatile LAS unsigned* st) {
    XcdBarrier b; b.bar = bar; b.x = xb_xcc_id(); b.st = st;
    if (threadIdx.x == 0) (void)xb_add(&bar[XB_XCNT(b.x)], 1u);
    return b;
}
__device__ __forceinline__ void xcd_barrier_complete(unsigned* bar, unsigned x, unsigned& nloc, unsigned& nx) {
    const unsigned G = gridDim.x * gridDim.y * gridDim.z;
    unsigned sum, cnt, mine, sp = 0u;
    for (;;) {
        sum = 0u; cnt = 0u; mine = 0u;
#pragma unroll
        for (unsigned j = 0; j < 16; ++j) { const unsigned c = xb_ld(&bar[XB_XCNT(j)]); sum += c; cnt += (c > 0u) ? 1u : 0u; mine = (j == x) ? c : mine; }
        if (sum == G) break;
        __builtin_amdgcn_s_sleep(1);
        if ((++sp & 255u) == 0u) { if (xb_ld(&bar[XB_TMO])) break; if (sp > XB_SPIN_CAP) { atomicAdd(&bar[XB_TMO], 1u); break; } }
    }
    nloc = mine > 0u ? mine : 1u; nx = cnt > 0u ? cnt : 1u;
}

__device__ __forceinline__ void xcd_barrier(const XcdBarrier& b) {
    asm volatile("s_waitcnt vmcnt(0)" ::: "memory");
    __syncthreads();
    if (threadIdx.x == 0) {
        unsigned* bar = b.bar;
        __builtin_amdgcn_s_waitcnt(0);
        unsigned nloc = b.st[0], nx = b.st[1];
        if (nloc == 0u) { xcd_barrier_complete(bar, b.x, nloc, nx); b.st[0] = nloc; b.st[1] = nx; }
        const unsigned old = xb_add(&bar[XB_XSUB(b.x)], 1u);
        const unsigned gen = old / nloc;
        if (old + 1u == (gen + 1u) * nloc) {
            __builtin_amdgcn_fence(__ATOMIC_RELEASE, "agent");
            asm volatile("s_waitcnt vmcnt(0)" ::: "memory");
            const unsigned og = xb_add(&bar[XB_TOP], 1u);
            const unsigned tg = og / nx;
            if (og + 1u == (tg + 1u) * nx) xb_add(&bar[XB_TOPGEN], 1u);
            else XB_SPIN(xb_ld(&bar[XB_TOPGEN]) == tg, bar);
            __builtin_amdgcn_fence(__ATOMIC_ACQUIRE, "agent");
            xb_add(&bar[XB_XGEN(b.x)], 1u);
            asm volatile("s_waitcnt vmcnt(0)" ::: "memory");
        } else {
            XB_SPIN(xb_ld(&bar[XB_XGEN(b.x)]) == gen, bar);
            __builtin_amdgcn_fence(__ATOMIC_ACQUIRE, "agent");
            asm volatile("s_waitcnt vmcnt(0)" ::: "memory");
        }
    }
    __syncthreads();
}

#define LDS_WAIT() asm volatile("s_waitcnt lgkmcnt(0)" ::: "memory")
#define VM_WAIT() asm volatile("s_waitcnt vmcnt(0)" ::: "memory")
#define MFMA32(a, b, c) __builtin_amdgcn_mfma_f32_32x32x16_bf16((a), (b), (c), 0, 0, 0)
__device__ __forceinline__ float wave_sum(float v) {
#pragma unroll
    for (int o = 1; o < 64; o <<= 1) v += __shfl_xor(v, o);
    return v;
}
__device__ __forceinline__ int crow(int i, int hh) { return (i & 3) + 8 * (i >> 2) + 4 * hh; }
__device__ __forceinline__ bf16x8 pack8(float a0, float a1, float a2, float a3, float a4, float a5, float a6, float a7) {
    u32x4 p; p.x = cvt_pk_bf16(a0, a1); p.y = cvt_pk_bf16(a2, a3); p.z = cvt_pk_bf16(a4, a5); p.w = cvt_pk_bf16(a6, a7);
    return __builtin_bit_cast(bf16x8, p);
}

struct Ctx {
    LAS unsigned char* lds;
    int tid, lane, wave, vcu, G;
};

__device__ __forceinline__ void transpose_item(const float* W, int K, int N, bf16_t* WT, int k0, int n0, int drow0, LAS float* scr, int lane) {
#pragma unroll 8
    for (int i = 0; i < 32; ++i) { const int kk = 2 * i + (lane >> 5); scr[kk * 33 + (lane & 31)] = W[(size_t)(k0 + kk) * N + n0 + (lane & 31)]; }
    LDS_WAIT(); asm volatile("" ::: "memory");
    const int c = lane & 7;
#pragma unroll
    for (int j = 0; j < 4; ++j) { const int n = (lane >> 3) + 8 * j; const LAS float* s = scr + (8 * c) * 33 + n;
        u32x4 o; o.x = cvt_pk_bf16(s[0 * 33], s[1 * 33]); o.y = cvt_pk_bf16(s[2 * 33], s[3 * 33]); o.z = cvt_pk_bf16(s[4 * 33], s[5 * 33]); o.w = cvt_pk_bf16(s[6 * 33], s[7 * 33]);
        *(GAS u32x4*)(WT + (size_t)(drow0 + n) * K + k0 + 8 * c) = o; }
    LDS_WAIT(); asm volatile("" ::: "memory");
}

typedef const f32x4 (&AccRef)[2][2][4][2];

struct EpiStore {
    bf16_t* O; int ldc;
    __device__ __forceinline__ void operator()(AccRef acc, const pg8::Unit& u, int wr, int wc, int fr, int fq) const {
        const int row0 = u.pm * 256 + wr * 64 + fr, col0 = u.pn * 256 + wc * 32 + 8 * fq;
#pragma unroll
        for (int ai = 0; ai < 2; ++ai)
#pragma unroll
            for (int m = 0; m < 4; ++m) { bf16_t* rowp = O + (size_t)(row0 + ai * 128 + m * 16) * ldc + col0;
#pragma unroll
                for (int bj = 0; bj < 2; ++bj) { const f32x4 v0 = acc[ai][bj][m][0], v1 = acc[ai][bj][m][1];
                    u32x4 w; w.x = cvt_pk_bf16(v0[0], v0[1]); w.y = cvt_pk_bf16(v0[2], v0[3]); w.z = cvt_pk_bf16(v1[0], v1[1]); w.w = cvt_pk_bf16(v1[2], v1[3]);
                    *(u32x4*)(rowp + bj * 128) = w; } }
    }
};

struct EpiProj {
    bf16_t *QL, *KVL, *KPE, *SB, *SGA, *SGB;
    __device__ __forceinline__ void operator()(AccRef acc, const pg8::Unit& u, int wr, int wc, int fr, int fq) const {
        const int row0 = u.pm * 256 + wr * 64 + fr;
#pragma unroll
        for (int bj = 0; bj < 2; ++bj) {
            const int cg = u.pn * 256 + bj * 128 + wc * 32;
            bf16_t* base; int ld, co; bool sig = false;
            if (cg < 384) { base = QL; ld = 384; co = cg; }
            else if (cg < 640) { base = KVL; ld = 256; co = cg - 384; }
            else if (cg < 672) { base = KPE; ld = 32; co = cg - 640; }
            else if (cg < 768) { continue; }
            else if (cg < 2304) { base = SB; ld = 1536; co = cg - 768; }
            else if (cg < 3328) { base = SGA; ld = 1024; co = cg - 2304; sig = true; }
            else { base = SGB; ld = 1024; co = cg - 3328; sig = true; }
#pragma unroll
            for (int ai = 0; ai < 2; ++ai)
#pragma unroll
                for (int m = 0; m < 4; ++m) { f32x4 v0 = acc[ai][bj][m][0], v1 = acc[ai][bj][m][1];
                    if (sig) {
#pragma unroll
                        for (int j = 0; j < 4; ++j) { v0[j] = fast_sigmoid(v0[j]); v1[j] = fast_sigmoid(v1[j]); } }
                    u32x4 w; w.x = cvt_pk_bf16(v0[0], v0[1]); w.y = cvt_pk_bf16(v0[2], v0[3]); w.z = cvt_pk_bf16(v1[0], v1[1]); w.w = cvt_pk_bf16(v1[2], v1[3]);
                    *(u32x4*)(base + (size_t)(row0 + ai * 128 + m * 16) * ld + co + 8 * fq) = w; }
        }
    }
};

template <bool SECOND> struct EpiMerge {
    bf16_t* MG; const bf16_t* SG;
    __device__ __forceinline__ void operator()(AccRef acc, const pg8::Unit& u, int wr, int wc, int fr, int fq) const {
        const int row0 = u.pm * 256 + wr * 64 + fr, col0 = u.pn * 256 + wc * 32 + 8 * fq;
#pragma unroll
        for (int ai = 0; ai < 2; ++ai)
#pragma unroll
            for (int m = 0; m < 4; ++m) { const size_t ro = (size_t)(row0 + ai * 128 + m * 16) * 1024 + col0;
#pragma unroll
                for (int bj = 0; bj < 2; ++bj) { const f32x4 v0 = acc[ai][bj][m][0], v1 = acc[ai][bj][m][1];
                    const u32x4 g = *(const u32x4*)(SG + ro + bj * 128);
                    float r0 = bf_lo(g.x) * v0[0], r1 = bf_hi(g.x) * v0[1], r2 = bf_lo(g.y) * v0[2], r3 = bf_hi(g.y) * v0[3];
                    float r4 = bf_lo(g.z) * v1[0], r5 = bf_hi(g.z) * v1[1], r6 = bf_lo(g.w) * v1[2], r7 = bf_hi(g.w) * v1[3];
                    if (SECOND) { const u32x4 p = *(const u32x4*)(MG + ro + bj * 128);
                        r0 += bf_lo(p.x); r1 += bf_hi(p.x); r2 += bf_lo(p.y); r3 += bf_hi(p.y); r4 += bf_lo(p.z); r5 += bf_hi(p.z); r6 += bf_lo(p.w); r7 += bf_hi(p.w); }
                    u32x4 w; w.x = cvt_pk_bf16(r0, r1); w.y = cvt_pk_bf16(r2, r3); w.z = cvt_pk_bf16(r4, r5); w.w = cvt_pk_bf16(r6, r7);
                    *(u32x4*)(MG + ro + bj * 128) = w; } }
    }
};

struct EpiWout {
    const float* X; float* OUT; const float* MOD;
    __device__ __forceinline__ void operator()(AccRef acc, const pg8::Unit& u, int wr, int wc, int fr, int fq) const {
        const int row0 = u.pm * 256 + wr * 64 + fr, col0 = u.pn * 256 + wc * 32 + 8 * fq;
        const float* ga = MOD + (size_t)(u.pm >> 3) * 6144 + 2048 + col0;
        f32x4 g[2][2];
#pragma unroll
        for (int bj = 0; bj < 2; ++bj)
#pragma unroll
            for (int n = 0; n < 2; ++n) g[bj][n] = *(const f32x4*)(ga + bj * 128 + 4 * n);
#pragma unroll
        for (int ai = 0; ai < 2; ++ai)
#pragma unroll
            for (int m = 0; m < 4; ++m) { const size_t ro = (size_t)(row0 + ai * 128 + m * 16) * 1024 + col0;
#pragma unroll
                for (int bj = 0; bj < 2; ++bj)
#pragma unroll
                    for (int n = 0; n < 2; ++n) { const f32x4 xv = *(const f32x4*)(X + ro + bj * 128 + 4 * n);
                        *(f32x4*)(OUT + ro + bj * 128 + 4 * n) = xv + g[bj][n] * acc[ai][bj][m][n]; } }
    }
};

struct EpiGateUp {
    bf16_t* HID; const float* BGU;
    __device__ __forceinline__ void operator()(AccRef acc, const pg8::Unit& u, int wr, int wc, int fr, int fq) const {
        const int row0 = u.pm * 256 + wr * 64 + fr, hc = u.pn * 128 + wc * 32 + 8 * fq;
        const float* bg = BGU + (size_t)u.e * 2048 + hc;
        f32x4 bgate[2], bup[2];
#pragma unroll
        for (int n = 0; n < 2; ++n) { bgate[n] = *(const f32x4*)(bg + 4 * n); bup[n] = *(const f32x4*)(bg + 1024 + 4 * n); }
#pragma unroll
        for (int ai = 0; ai < 2; ++ai)
#pragma unroll
            for (int m = 0; m < 4; ++m) { float r[8];
#pragma unroll
                for (int n = 0; n < 2; ++n) { const f32x4 gv = acc[ai][0][m][n] + bgate[n], uv = acc[ai][1][m][n] + bup[n];
#pragma unroll
                    for (int j = 0; j < 4; ++j) { const float g = __builtin_fminf(gv[j], 7.f); const float up = __builtin_fminf(__builtin_fmaxf(uv[j], -7.f), 7.f);
                        r[4 * n + j] = (up + 1.f) * (g * fast_sigmoid(1.702f * g)); } }
                u32x4 w; w.x = cvt_pk_bf16(r[0], r[1]); w.y = cvt_pk_bf16(r[2], r[3]); w.z = cvt_pk_bf16(r[4], r[5]); w.w = cvt_pk_bf16(r[6], r[7]);
                *(u32x4*)(HID + (size_t)(row0 + ai * 128 + m * 16) * 1024 + hc) = w; asm volatile("" ::: "memory"); }
    }
};

struct EpiDown {
    float* OUT; const float* BDN; const float* MOD; const int* TOKL; const float* WL;
    __device__ __forceinline__ void operator()(AccRef acc, const pg8::Unit& u, int wr, int wc, int fr, int fq) const {
        const int col0 = u.pn * 256 + wc * 32 + 8 * fq;
        const float* bd = BDN + (size_t)u.e * 1024 + col0;
        f32x4 b4[2][2];
#pragma unroll
        for (int bj = 0; bj < 2; ++bj)
#pragma unroll
            for (int n = 0; n < 2; ++n) b4[bj][n] = *(const f32x4*)(bd + bj * 128 + 4 * n);
        const int* tl = TOKL + (size_t)u.e * LISTCAP; const float* wl = WL + (size_t)u.e * LISTCAP;
#pragma unroll
        for (int ai = 0; ai < 2; ++ai)
#pragma unroll
            for (int m = 0; m < 4; ++m) { const int slot = u.j0 + ai * 128 + wr * 64 + m * 16 + fr;
                if (slot < u.ne) { const int tok = tl[slot]; const float wgt = wl[slot];
                    const float* ga = MOD + (size_t)(tok >> 11) * 6144 + 5120 + col0; float* op = OUT + (size_t)tok * 1024 + col0;
#pragma unroll
                    for (int bj = 0; bj < 2; ++bj)
#pragma unroll
                        for (int n = 0; n < 2; ++n) { const f32x4 g = *(const f32x4*)(ga + bj * 128 + 4 * n); const f32x4 o = *(const f32x4*)(op + bj * 128 + 4 * n);
                            *(f32x4*)(op + bj * 128 + 4 * n) = o + g * ((acc[ai][bj][m][n] + b4[bj][n]) * wgt); } }
                asm volatile("" ::: "memory"); }
    }
};

template <int NPN, bool GATHER> struct MoeOrder {
    const char* A; const char* Bt; size_t estride; const int* lists; int G, c; const LAS int* tbase; const LAS int* nearr; const LAS int* tilee;
    __device__ __forceinline__ bool next(int i, pg8::Unit& u) const {
        const int L = i * G + c, T = L / NPN; const int total = __builtin_amdgcn_readfirstlane(tbase[NE]);
        if (T >= total) return false;
        const int e = __builtin_amdgcn_readfirstlane(tilee[T]);
        u.pm = T; u.pn = L % NPN; u.e = e; u.j0 = (T - __builtin_amdgcn_readfirstlane(tbase[e])) * 256; u.ne = __builtin_amdgcn_readfirstlane(nearr[e]); return true;
    }
    __device__ __forceinline__ const char* a_base(const pg8::Unit& u) const { return GATHER ? A : A + (size_t)u.pm * (size_t)(256 * 1024 * 2); }
    __device__ __forceinline__ const char* b_base(const pg8::Unit& u) const { return Bt + (size_t)u.e * estride + (size_t)u.pn * (size_t)(256 * 1024 * 2); }
    __device__ __forceinline__ unsigned row_of(const pg8::Unit& u, int r) const { const int slot = u.j0 + r; return slot < u.ne ? (unsigned)lists[(size_t)u.e * LISTCAP + slot] : 0u; }
};

constexpr int ATT_KBYTES = 12 * 1024;
constexpr int ATT_VPITCH = 136;
constexpr int ATT_VBYTES = 64 * ATT_VPITCH;
constexpr int ATT_BUF = ATT_KBYTES + ATT_VBYTES;
constexpr int ATT_WS = 2 * ATT_BUF;
static_assert(ATT_WS + 8 * 256 <= RING_BYTES, "attention LDS");

__device__ __forceinline__ void mla_unit(LAS unsigned char* lds, const bf16_t* Q, const bf16_t* Kb, const bf16_t* KV, bf16_t* O, int b, int h, int qb) {
    const int tid = threadIdx.x, lane = tid & 63, r = lane & 31, hh = lane >> 5; const int wid = __builtin_amdgcn_readfirstlane(tid >> 6);
    const size_t rowbase = (size_t)b * SEQ; const int q0 = qb * 256, qw = q0 + 32 * wid;
    const int cq = qw >> 6, NT = (q0 >> 6) + 4;
    LAS float* wsf = (LAS float*)(lds + ATT_WS) + wid * 64;
    bf16x8 qf[6];
    { const bf16_t* qp = Q + (rowbase + qw + r) * 768 + h * 96 + hh * 8;
#pragma unroll
      for (int s = 0; s < 6; ++s) qf[s] = *(const bf16x8*)(qp + 16 * s); }
    const int lkv = tid & 63, lc = tid >> 6;
    const bf16_t* kg0 = Kb + (rowbase + lkv) * 768 + h * 96 + lc * 8;
    const bf16_t* vg = KV + (rowbase + lkv) * 1024 + h * 128 + 64 + lc * 8;
    u32x4 kr0, kr1 = (u32x4){0u, 0u, 0u, 0u}, vr;
#define ATT_LOAD(t) do { kr0 = *(const u32x4*)(kg0 + (size_t)(t) * 64 * 768); if (tid < 256) kr1 = *(const u32x4*)(kg0 + (size_t)(t) * 64 * 768 + 64); vr = *(const u32x4*)(vg + (size_t)(t) * 64 * 1024); } while (0)
#define ATT_STORE(bufi) do { LAS unsigned char* kb_ = lds + (bufi) * ATT_BUF; *(LAS u32x4*)(kb_ + tid * 16) = kr0; if (tid < 256) *(LAS u32x4*)(kb_ + 8192 + tid * 16) = kr1; \
        LAS unsigned char* vb_ = kb_ + ATT_KBYTES + (lc * 8) * ATT_VPITCH + lkv * 2; \
        _Pragma("unroll") for (int j_ = 0; j_ < 8; ++j_) *(LAS unsigned short*)(vb_ + j_ * ATT_VPITCH) = (unsigned short)(vr[j_ >> 1] >> (16 * (j_ & 1))); } while (0)
    ATT_LOAD(0); ATT_STORE(0); __syncthreads();
    float m_run = -INFINITY, l_run = 0.f;
    f32x16 o0, o1;
#pragma unroll
    for (int i = 0; i < 16; ++i) { o0[i] = 0.f; o1[i] = 0.f; }
    for (int t = 0; t < NT; ++t) {
        const int buf = t & 1;
        if (t + 1 < NT) ATT_LOAD(t + 1);
        if (t <= cq) {
            const LAS unsigned char* kb = lds + buf * ATT_BUF; const LAS unsigned char* vb = kb + ATT_KBYTES;
            f32x16 p0, p1;
#pragma unroll
            for (int i = 0; i < 16; ++i) { p0[i] = 0.f; p1[i] = 0.f; }
#pragma unroll
            for (int s = 0; s < 6; ++s) { const bf16x8 a0 = *(const LAS bf16x8*)(kb + (2 * s + hh) * 1024 + r * 16), a1 = *(const LAS bf16x8*)(kb + (2 * s + hh) * 1024 + (r + 32) * 16);
                p0 = MFMA32(a0, qf[s], p0); p1 = MFMA32(a1, qf[s], p1); }
            float mx = p0[0];
#pragma unroll
            for (int i = 0; i < 16; ++i) { mx = __builtin_fmaxf(mx, p0[i]); mx = __builtin_fmaxf(mx, p1[i]); }
            mx = __builtin_fmaxf(mx, __shfl_xor(mx, 32));
            const float m_new = __builtin_fmaxf(m_run, mx), alpha = __builtin_amdgcn_exp2f(m_run - m_new); m_run = m_new;
            float rs = 0.f;
#pragma unroll
            for (int i = 0; i < 16; ++i) { p0[i] = __builtin_amdgcn_exp2f(p0[i] - m_new); p1[i] = __builtin_amdgcn_exp2f(p1[i] - m_new); rs += p0[i] + p1[i]; }
            l_run = l_run * alpha + rs;
            if (hh == 0) wsf[r] = alpha;
            LDS_WAIT();
#pragma unroll
            for (int g = 0; g < 4; ++g) { const f32x4 al = *(const LAS f32x4*)(wsf + 8 * g + 4 * hh);
#pragma unroll
                for (int e = 0; e < 4; ++e) { o0[4 * g + e] *= al[e]; o1[4 * g + e] *= al[e]; } }
#pragma unroll
            for (int half = 0; half < 2; ++half)
#pragma unroll
                for (int s2 = 0; s2 < 2; ++s2) {
                    const f32x16& P = half ? p1 : p0;
                    const bf16x8 pa = pack8(P[8 * s2], P[8 * s2 + 1], P[8 * s2 + 2], P[8 * s2 + 3], P[8 * s2 + 4], P[8 * s2 + 5], P[8 * s2 + 6], P[8 * s2 + 7]);
                    const int kvo = (32 * half + 16 * s2 + 4 * hh) * 2;
                    { const s16x4 lo = *(const LAS s16x4*)(vb + r * ATT_VPITCH + kvo), hi = *(const LAS s16x4*)(vb + r * ATT_VPITCH + kvo + 16);
                      const bf16x8 vf = __builtin_shufflevector(lo, hi, 0, 1, 2, 3, 4, 5, 6, 7); o0 = MFMA32(pa, vf, o0); }
                    { const s16x4 lo = *(const LAS s16x4*)(vb + (r + 32) * ATT_VPITCH + kvo), hi = *(const LAS s16x4*)(vb + (r + 32) * ATT_VPITCH + kvo + 16);
                      const bf16x8 vf = __builtin_shufflevector(lo, hi, 0, 1, 2, 3, 4, 5, 6, 7); o1 = MFMA32(pa, vf, o1); }
                }
        }
        if (t + 1 < NT) ATT_STORE(buf ^ 1);
        __syncthreads();
    }
    const float l_tot = l_run + __shfl_xor(l_run, 32);
    if (hh == 0) wsf[r] = 1.f / l_tot;
    LDS_WAIT();
#pragma unroll
    for (int g = 0; g < 4; ++g) { const f32x4 rl = *(const LAS f32x4*)(wsf + 8 * g + 4 * hh);
#pragma unroll
        for (int e = 0; e < 4; ++e) { const int i = 4 * g + e; bf16_t* op = O + (rowbase + qw + crow(i, hh)) * 512 + h * 64 + r;
            op[0] = (bf16_t)(cvt_pk_bf16(o0[i] * rl[e], 0.f) & 0xffffu); op[32] = (bf16_t)(cvt_pk_bf16(o1[i] * rl[e], 0.f) & 0xffffu); } }
    LDS_WAIT();
#undef ATT_LOAD
#undef ATT_STORE
}

__device__ __forceinline__ void sb_unit(LAS unsigned char* lds, const bf16_t* SBQ, bf16_t* O, int b, int h, int qb) {
    const int tid = threadIdx.x, lane = tid & 63, r = lane & 31, hh = lane >> 5; const int wid = __builtin_amdgcn_readfirstlane(tid >> 6);
    const size_t rowbase = (size_t)b * SEQ; const int q0 = qb * 256, qw = q0 + 32 * wid;
    const int NT = (q0 >> 6) + 4;
    constexpr float C2 = 0.125f * LOG2E;
    bf16x8 qf[4];
    { const bf16_t* qp = SBQ + (rowbase + qw + r) * 1536 + h * 64 + hh * 8;
#pragma unroll
      for (int s = 0; s < 4; ++s) qf[s] = *(const bf16x8*)(qp + 16 * s); }
    const int lkv = tid & 63, lc = tid >> 6;
    const bf16_t* kg0 = SBQ + (rowbase + lkv) * 1536 + 512 + h * 64 + lc * 8;
    const bf16_t* vg = SBQ + (rowbase + lkv) * 1536 + 1024 + h * 64 + lc * 8;
    u32x4 kr0, vr;
#define ATT_LOAD(t) do { kr0 = *(const u32x4*)(kg0 + (size_t)(t) * 64 * 1536); vr = *(const u32x4*)(vg + (size_t)(t) * 64 * 1536); } while (0)
#define ATT_STORE(bufi) do { LAS unsigned char* kb_ = lds + (bufi) * ATT_BUF; *(LAS u32x4*)(kb_ + tid * 16) = kr0; \
        LAS unsigned char* vb_ = kb_ + ATT_KBYTES + (lc * 8) * ATT_VPITCH + lkv * 2; \
        _Pragma("unroll") for (int j_ = 0; j_ < 8; ++j_) *(LAS unsigned short*)(vb_ + j_ * ATT_VPITCH) = (unsigned short)(vr[j_ >> 1] >> (16 * (j_ & 1))); } while (0)
    ATT_LOAD(NT - 1); ATT_STORE(0); __syncthreads();
    float carry = 0.f;
    f32x16 o0, o1;
#pragma unroll
    for (int i = 0; i < 16; ++i) { o0[i] = 0.f; o1[i] = 0.f; }
#define SB_SUB(X, kvh0, kvl) do { const bool diag_ = ((kvh0) == qw); float lk_[16], z_[16]; \
        _Pragma("unroll") for (int i = 0; i < 16; ++i) { const float z2 = X[i] * C2; const float ex = __builtin_amdgcn_exp2f(z2); float sp = __builtin_amdgcn_logf(1.f + ex); sp = z2 > 64.f ? z2 : sp; \
            const bool valid = !diag_ || (crow(i, hh) < r); lk_[i] = valid ? -sp : 0.f; z_[i] = z2; } \
        float G_[4], Gp_[4]; \
        _Pragma("unroll") for (int g = 0; g < 4; ++g) { G_[g] = (lk_[4 * g] + lk_[4 * g + 1]) + (lk_[4 * g + 2] + lk_[4 * g + 3]); Gp_[g] = __shfl_xor(G_[g], 32); } \
        float tail_[4]; tail_[3] = 0.f; tail_[2] = G_[3] + Gp_[3]; tail_[1] = tail_[2] + (G_[2] + Gp_[2]); tail_[0] = tail_[1] + (G_[1] + Gp_[1]); const float total_ = tail_[0] + (G_[0] + Gp_[0]); \
        float a_[16]; \
        _Pragma("unroll") for (int g = 0; g < 4; ++g) { const float base_ = carry + tail_[g] + (hh == 0 ? Gp_[g] : 0.f); \
            const float s3 = base_ + lk_[4 * g + 3], s2_ = s3 + lk_[4 * g + 2], s1 = s2_ + lk_[4 * g + 1], s0 = s1 + lk_[4 * g]; \
            a_[4 * g + 3] = __builtin_amdgcn_exp2f(z_[4 * g + 3] + s3); a_[4 * g + 2] = __builtin_amdgcn_exp2f(z_[4 * g + 2] + s2_); a_[4 * g + 1] = __builtin_amdgcn_exp2f(z_[4 * g + 1] + s1); a_[4 * g] = __builtin_amdgcn_exp2f(z_[4 * g] + s0); } \
        if (diag_) { _Pragma("unroll") for (int i = 0; i < 16; ++i) a_[i] = (crow(i, hh) < r) ? a_[i] : 0.f; } \
        carry += total_; \
        _Pragma("unroll") for (int s2 = 0; s2 < 2; ++s2) { \
            const bf16x8 pa = pack8(a_[8 * s2], a_[8 * s2 + 1], a_[8 * s2 + 2], a_[8 * s2 + 3], a_[8 * s2 + 4], a_[8 * s2 + 5], a_[8 * s2 + 6], a_[8 * s2 + 7]); \
            const int kvo = ((kvl) + 16 * s2 + 4 * hh) * 2; \
            { const s16x4 lo = *(const LAS s16x4*)(vb + r * ATT_VPITCH + kvo), hi = *(const LAS s16x4*)(vb + r * ATT_VPITCH + kvo + 16); \
              const bf16x8 vf = __builtin_shufflevector(lo, hi, 0, 1, 2, 3, 4, 5, 6, 7); o0 = MFMA32(pa, vf, o0); } \
            { const s16x4 lo = *(const LAS s16x4*)(vb + (r + 32) * ATT_VPITCH + kvo), hi = *(const LAS s16x4*)(vb + (r + 32) * ATT_VPITCH + kvo + 16); \
              const bf16x8 vf = __builtin_shufflevector(lo, hi, 0, 1, 2, 3, 4, 5, 6, 7); o1 = MFMA32(pa, vf, o1); } } } while (0)
    for (int it = 0; it < NT; ++it) {
        const int t = NT - 1 - it, buf = it & 1, kv0 = 64 * t;
        if (t > 0) ATT_LOAD(t - 1);
        if (kv0 <= qw) {
            const LAS unsigned char* kb = lds + buf * ATT_BUF; const LAS unsigned char* vb = kb + ATT_KBYTES;
            const bool upper = (kv0 + 32 <= qw);
            f32x16 p0, p1;
#pragma unroll
            for (int i = 0; i < 16; ++i) { p0[i] = 0.f; p1[i] = 0.f; }
#pragma unroll
            for (int s = 0; s < 4; ++s) { const bf16x8 a0 = *(const LAS bf16x8*)(kb + (2 * s + hh) * 1024 + r * 16); p0 = MFMA32(a0, qf[s], p0); }
            if (upper) {
#pragma unroll
                for (int s = 0; s < 4; ++s) { const bf16x8 a1 = *(const LAS bf16x8*)(kb + (2 * s + hh) * 1024 + (r + 32) * 16); p1 = MFMA32(a1, qf[s], p1); }
                SB_SUB(p1, kv0 + 32, 32);
            }
            SB_SUB(p0, kv0, 0);
        }
        if (t > 0) ATT_STORE(buf ^ 1);
        __syncthreads();
    }
#pragma unroll
    for (int i = 0; i < 16; ++i) { bf16_t* op = O + (rowbase + qw + crow(i, hh)) * 512 + h * 64 + r;
        op[0] = (bf16_t)(cvt_pk_bf16(o0[i], 0.f) & 0xffffu); op[32] = (bf16_t)(cvt_pk_bf16(o1[i], 0.f) & 0xffffu); }
#undef SB_SUB
#undef ATT_LOAD
#undef ATT_STORE
}

#ifndef PHMASK
#define PHMASK 0xFFFF
#endif
#define PH(n) ((PHMASK >> (n)) & 1)
struct Args { const void* in[23]; float* out; unsigned char* ws; };

__global__ void __launch_bounds__(512, 2) fwd_kernel(Args args) {
    extern __shared__ __attribute__((aligned(16))) unsigned char lds_raw[];
    LAS unsigned char* lds = (LAS unsigned char*)lds_raw;
    const int tid = threadIdx.x, lane = tid & 63, wave = __builtin_amdgcn_readfirstlane(tid >> 6);
    const int G = gridDim.x; const int bx = blockIdx.x; const int vcu = (G % 8 == 0) ? (bx % 8) * (G / 8) + bx / 8 : bx;
    const int gw = vcu * 8 + wave, NGW = G * 8;
    unsigned char* ws = args.ws;
    unsigned* ctl = (unsigned*)(ws + WS_CTL);
    const float* x = (const float*)args.in[0]; const float* cvec = (const float*)args.in[1]; const int* positions = (const int*)args.in[2];
    const float* w_ada = (const float*)args.in[3]; const float* b_ada = (const float*)args.in[4]; const float* g_norm1 = (const float*)args.in[5];
    const float* w_in = (const float*)args.in[6]; const float* g_q_lat = (const float*)args.in[7]; const float* w_uq = (const float*)args.in[8];
    const float* g_kv_lat = (const float*)args.in[9]; const float* w_ukv = (const float*)args.in[10]; const float* g_qk_q = (const float*)args.in[11];
    const float* g_qk_k = (const float*)args.in[12]; const float* w_o_mla = (const float*)args.in[13]; const float* w_o_sb = (const float*)args.in[14];
    const float* w_out = (const float*)args.in[15]; const float* g_norm2 = (const float*)args.in[16]; const float* w_router = (const float*)args.in[17];
    const float* b_router = (const float*)args.in[18]; const float* w_gate_up = (const float*)args.in[19]; const float* b_gate_up = (const float*)args.in[20];
    const float* w_down = (const float*)args.in[21]; const float* b_down = (const float*)args.in[22];
    float* out = args.out;
    bf16_t* WIN = (bf16_t*)(ws + WS_WIN); bf16_t* WUQ = (bf16_t*)(ws + WS_WUQ); bf16_t* WUKV = (bf16_t*)(ws + WS_WUKV); bf16_t* WOM = (bf16_t*)(ws + WS_WOM);
    bf16_t* WOS = (bf16_t*)(ws + WS_WOS); bf16_t* WOUT = (bf16_t*)(ws + WS_WOUT); float* MOD = (float*)(ws + WS_MOD);
    bf16_t* HB = (bf16_t*)(ws + WS_H); bf16_t* KVRAW = (bf16_t*)(ws + WS_KVRAW); bf16_t* MERGED = (bf16_t*)(ws + WS_MERGED);
    bf16_t* SGA = (bf16_t*)(ws + WS_SGA); bf16_t* SGB = (bf16_t*)(ws + WS_SGB); bf16_t* H2 = (bf16_t*)(ws + WS_H2);
    bf16_t* WGU = (bf16_t*)(ws + WS_WGU); bf16_t* WDN = (bf16_t*)(ws + WS_WDN); bf16_t* SBQ = (bf16_t*)(ws + WS_SB);
    int* TOKL = (int*)(ws + WS_TOKL); float* WLST = (float*)(ws + WS_WL); bf16_t* HID = (bf16_t*)(ws + WS_HID);
    bf16_t* QL = (bf16_t*)(ws + WS_QL); bf16_t* KVL = (bf16_t*)(ws + WS_KVL); bf16_t* KPE = (bf16_t*)(ws + WS_KPE);
    bf16_t* QB = (bf16_t*)(ws + WS_Q); bf16_t* KB = (bf16_t*)(ws + WS_K); bf16_t* OMLA = (bf16_t*)(ws + WS_OMLA); bf16_t* OSB = (bf16_t*)(ws + WS_OSB);

    for (int u = tid; u < (LDS_BYTES - LDSCTL_OFF) / 4; u += 512) ((LAS unsigned*)(lds + LDSCTL_OFF))[u] = 0u;
    __syncthreads();
    XcdBarrier bar = xcd_barrier_post(ctl + CW_BAR, (volatile LAS unsigned*)(lds + LDSCTL_OFF + LC_BARST));
    LAS float* scr = (LAS float*)(lds + wave * 16384);

#if PH(0)
    {
        constexpr int I_IN = 16 * 133, I_UQ = 6 * 24, I_UKV = 4 * 32, I_OM = 8 * 32, I_OS = 8 * 32, I_OUT = 16 * 32;
        constexpr int NIT = I_IN + I_UQ + I_UKV + I_OM + I_OS + I_OUT;
        for (int it = gw; it < NIT; it += NGW) {
            int q = it;
            if (q < I_IN) { const int kb = q / 133, nb = q % 133, n0 = 32 * nb; transpose_item(w_in, 1024, DIN, WIN, 64 * kb, n0, n0 < 672 ? n0 : n0 + 96, scr, lane); continue; } q -= I_IN;
            if (q < I_UQ) { const int kb = q / 24, nb = q % 24; transpose_item(w_uq, 384, 768, WUQ, 64 * kb, 32 * nb, 32 * nb, scr, lane); continue; } q -= I_UQ;
            if (q < I_UKV) { const int kb = q / 32, nb = q % 32; transpose_item(w_ukv, 256, 1024, WUKV, 64 * kb, 32 * nb, 32 * nb, scr, lane); continue; } q -= I_UKV;
            if (q < I_OM) { const int kb = q / 32, nb = q % 32; transpose_item(w_o_mla, 512, 1024, WOM, 64 * kb, 32 * nb, 32 * nb, scr, lane); continue; } q -= I_OM;
            if (q < I_OS) { const int kb = q / 32, nb = q % 32; transpose_item(w_o_sb, 512, 1024, WOS, 64 * kb, 32 * nb, 32 * nb, scr, lane); continue; } q -= I_OS;
            { const int kb = q / 32, nb = q % 32; transpose_item(w_out, 1024, 1024, WOUT, 64 * kb, 32 * nb, 32 * nb, scr, lane); }
        }
        for (int i = vcu * 512 + tid; i < 96 * 1024 * 2 / 16; i += G * 512) ((u32x4*)(WIN + 672 * 1024))[i] = (u32x4){0u, 0u, 0u, 0u};
        __syncthreads();
        for (int it = vcu; it < 6144 / 64; it += G) {
            for (int idx = lane; idx < 32 * 128; idx += 64) { const int b = idx >> 7, kk = idx & 127; const float cv = cvec[b * 1024 + 128 * wave + kk]; scr[idx] = cv / (1.f + __expf(-cv)); }
            LDS_WAIT(); asm volatile("" ::: "memory");
            float acc[32];
#pragma unroll
            for (int b = 0; b < 32; ++b) acc[b] = 0.f;
            const float* wp = w_ada + (size_t)(128 * wave) * 6144 + 64 * it + lane;
            for (int k4 = 0; k4 < 32; ++k4) {
                const float w0 = wp[(size_t)(4 * k4) * 6144], w1 = wp[(size_t)(4 * k4 + 1) * 6144], w2 = wp[(size_t)(4 * k4 + 2) * 6144], w3 = wp[(size_t)(4 * k4 + 3) * 6144];
#pragma unroll
                for (int b = 0; b < 32; ++b) { const f32x4 s = *(const LAS f32x4*)(scr + b * 128 + 4 * k4); acc[b] += s.x * w0 + s.y * w1 + s.z * w2 + s.w * w3; }
            }
            LDS_WAIT(); asm volatile("" ::: "memory");
#pragma unroll
            for (int b = 0; b < 32; ++b) scr[b * 64 + lane] = acc[b];
            __syncthreads();
#pragma unroll
            for (int bb = 0; bb < 4; ++bb) { const int b = 4 * wave + bb; float s = 0.f;
#pragma unroll
                for (int w2 = 0; w2 < 8; ++w2) s += ((const LAS float*)(lds + w2 * 16384))[b * 64 + lane];
                MOD[b * 6144 + 64 * it + lane] = s + b_ada[64 * it + lane]; }
            __syncthreads();
        }
    }
#endif
    xcd_barrier(bar);

#if PH(1)
    for (int m = gw; m < NTOK; m += NGW) {
        const int b = m >> 11;
        const f32x4* xr = (const f32x4*)(x + (size_t)m * 1024) + lane;
        f32x4 v[4]; float ss = 0.f;
#pragma unroll
        for (int j = 0; j < 4; ++j) { v[j] = xr[64 * j]; ss += (v[j].x * v[j].x + v[j].y * v[j].y) + (v[j].z * v[j].z + v[j].w * v[j].w); }
        const float rstd = rsqrtf(wave_sum(ss) * (1.f / 1024.f) + EPS);
        const float* mb = MOD + (size_t)b * 6144;
#pragma unroll
        for (int j = 0; j < 4; ++j) { const int col = 4 * lane + 256 * j;
            const f32x4 g = *(const f32x4*)(g_norm1 + col), sh = *(const f32x4*)(mb + col), sc = *(const f32x4*)(mb + 1024 + col);
            const f32x4 y = (v[j] * rstd) * g * (sc + 1.f) + sh;
            u32x2 o; o.x = cvt_pk_bf16(y.x, y.y); o.y = cvt_pk_bf16(y.z, y.w);
            *(u32x2*)(HB + (size_t)m * 1024 + col) = o; }
    }
#endif
    xcd_barrier(bar);

#if PH(2)
    { pg8::DenseOrder S; S.init(HB, WIN, NTOK, DINP, 1024, G, bx);
      EpiProj E{QL, KVL, KPE, SBQ, SGA, SGB};
      pg8::gemm_phase<false>(lds, 1024, S, E); }
#endif
    xcd_barrier(bar);

#if PH(3)
    for (int m = gw; m < NTOK; m += NGW) {
        { u32x4 v = (u32x4){0u, 0u, 0u, 0u}; bf16_t* p = QL + (size_t)m * 384 + lane * 8; if (lane < 48) v = *(const u32x4*)p;
          float f[8] = {bf_lo(v.x), bf_hi(v.x), bf_lo(v.y), bf_hi(v.y), bf_lo(v.z), bf_hi(v.z), bf_lo(v.w), bf_hi(v.w)}; float ss = 0.f;
#pragma unroll
          for (int j = 0; j < 8; ++j) ss += f[j] * f[j];
          const float rstd = rsqrtf(wave_sum(ss) * (1.f / 384.f) + EPS);
          if (lane < 48) { const f32x4 g0 = *(const f32x4*)(g_q_lat + lane * 8), g1 = *(const f32x4*)(g_q_lat + lane * 8 + 4);
              u32x4 o; o.x = cvt_pk_bf16(f[0] * rstd * g0.x, f[1] * rstd * g0.y); o.y = cvt_pk_bf16(f[2] * rstd * g0.z, f[3] * rstd * g0.w);
              o.z = cvt_pk_bf16(f[4] * rstd * g1.x, f[5] * rstd * g1.y); o.w = cvt_pk_bf16(f[6] * rstd * g1.z, f[7] * rstd * g1.w); *(u32x4*)p = o; } }
        { u32x4 v = (u32x4){0u, 0u, 0u, 0u}; bf16_t* p = KVL + (size_t)m * 256 + lane * 8; if (lane < 32) v = *(const u32x4*)p;
          float f[8] = {bf_lo(v.x), bf_hi(v.x), bf_lo(v.y), bf_hi(v.y), bf_lo(v.z), bf_hi(v.z), bf_lo(v.w), bf_hi(v.w)}; float ss = 0.f;
#pragma unroll
          for (int j = 0; j < 8; ++j) ss += f[j] * f[j];
          const float rstd = rsqrtf(wave_sum(ss) * (1.f / 256.f) + EPS);
          if (lane < 32) { const f32x4 g0 = *(const f32x4*)(g_kv_lat + lane * 8), g1 = *(const f32x4*)(g_kv_lat + lane * 8 + 4);
              u32x4 o; o.x = cvt_pk_bf16(f[0] * rstd * g0.x, f[1] * rstd * g0.y); o.y = cvt_pk_bf16(f[2] * rstd * g0.z, f[3] * rstd * g0.w);
              o.z = cvt_pk_bf16(f[4] * rstd * g1.x, f[5] * rstd * g1.y); o.w = cvt_pk_bf16(f[6] * rstd * g1.z, f[7] * rstd * g1.w); *(u32x4*)p = o; } }
    }
#endif
    xcd_barrier(bar);

#if PH(4)
    { pg8::DenseOrder S; S.init(QL, WUQ, NTOK, 768, 384, G, bx); EpiStore E{QB, 768}; pg8::gemm_phase<false>(lds, 384, S, E); }
    { pg8::DenseOrder S; S.init(KVL, WUKV, NTOK, 1024, 256, G, bx); EpiStore E{KVRAW, 1024}; pg8::gemm_phase<false>(lds, 256, S, E); }
#endif
    xcd_barrier(bar);

#if PH(5)
    {
        const int hd = lane >> 3, sub = lane & 7;
        const float QSC = 0.10206207261596575f * LOG2E;
        const float if0 = exp2f(-(float)(2 * sub) * (13.287712379549449f / 16.f)), if1 = exp2f(-(float)(2 * sub + 1) * (13.287712379549449f / 16.f));
        f32x4 gq0 = *(const f32x4*)(g_qk_q + sub * 8), gq1 = *(const f32x4*)(g_qk_q + sub * 8 + 4); const f32x2 gqa = *(const f32x2*)(g_qk_q + 64 + 2 * sub), gqb = *(const f32x2*)(g_qk_q + 80 + 2 * sub);
        f32x4 gk0 = *(const f32x4*)(g_qk_k + sub * 8), gk1 = *(const f32x4*)(g_qk_k + sub * 8 + 4); const f32x2 gka = *(const f32x2*)(g_qk_k + 64 + 2 * sub), gkb = *(const f32x2*)(g_qk_k + 80 + 2 * sub);
        for (int m = gw; m < NTOK; m += NGW) {
            const float pos = (float)positions[m];
            float cs[2], sn[2];
            { const float a0 = pos * if0, a1 = pos * if1;
              double r0 = (double)a0 * 0.15915494309189535, r1 = (double)a1 * 0.15915494309189535; r0 -= __builtin_rint(r0); r1 -= __builtin_rint(r1);
              cs[0] = __builtin_amdgcn_cosf((float)r0); sn[0] = __builtin_amdgcn_sinf((float)r0); cs[1] = __builtin_amdgcn_cosf((float)r1); sn[1] = __builtin_amdgcn_sinf((float)r1); }
#pragma unroll
            for (int which = 0; which < 2; ++which) {
                u32x4 A; unsigned B1, B2; bf16_t* dst;
                if (which == 0) { bf16_t* qp = QB + (size_t)m * 768 + hd * 96; A = *(const u32x4*)(qp + sub * 8); B1 = *(const unsigned*)(qp + 64 + 2 * sub); B2 = *(const unsigned*)(qp + 80 + 2 * sub); dst = qp; }
                else { A = *(const u32x4*)(KVRAW + (size_t)m * 1024 + hd * 128 + sub * 8); B1 = *(const unsigned*)(KPE + (size_t)m * 32 + 2 * sub); B2 = *(const unsigned*)(KPE + (size_t)m * 32 + 16 + 2 * sub); dst = KB + (size_t)m * 768 + hd * 96; }
                float f[8] = {bf_lo(A.x), bf_hi(A.x), bf_lo(A.y), bf_hi(A.y), bf_lo(A.z), bf_hi(A.z), bf_lo(A.w), bf_hi(A.w)};
                float x1[2] = {bf_lo(B1), bf_hi(B1)}, x2[2] = {bf_lo(B2), bf_hi(B2)};
                float ss = x1[0] * x1[0] + x1[1] * x1[1] + x2[0] * x2[0] + x2[1] * x2[1];
#pragma unroll
                for (int j = 0; j < 8; ++j) ss += f[j] * f[j];
                ss += __shfl_xor(ss, 1); ss += __shfl_xor(ss, 2); ss += __shfl_xor(ss, 4);
                const float rstd = rsqrtf(ss * (1.f / 96.f) + EPS);
                const f32x4 g0 = which ? gk0 : gq0, g1 = which ? gk1 : gq1; const f32x2 ga = which ? gka : gqa, gb = which ? gkb : gqb;
                const float sc = which ? 1.f : QSC;
                float y[8] = {f[0] * rstd * g0.x, f[1] * rstd * g0.y, f[2] * rstd * g0.z, f[3] * rstd * g0.w, f[4] * rstd * g1.x, f[5] * rstd * g1.y, f[6] * rstd * g1.z, f[7] * rstd * g1.w};
                const float y1a = x1[0] * rstd * ga.x, y1b = x1[1] * rstd * ga.y, y2a = x2[0] * rstd * gb.x, y2b = x2[1] * rstd * gb.y;
                const float o1a = y1a * cs[0] - y2a * sn[0], o1b = y1b * cs[1] - y2b * sn[1], o2a = y2a * cs[0] + y1a * sn[0], o2b = y2b * cs[1] + y1b * sn[1];
                u32x4 o; o.x = cvt_pk_bf16(y[0] * sc, y[1] * sc); o.y = cvt_pk_bf16(y[2] * sc, y[3] * sc); o.z = cvt_pk_bf16(y[4] * sc, y[5] * sc); o.w = cvt_pk_bf16(y[6] * sc, y[7] * sc);
                *(u32x4*)(dst + sub * 8) = o; *(unsigned*)(dst + 64 + 2 * sub) = cvt_pk_bf16(o1a * sc, o1b * sc); *(unsigned*)(dst + 80 + 2 * sub) = cvt_pk_bf16(o2a * sc, o2b * sc);
            }
        }
    }
#endif
    xcd_barrier(bar);

#if PH(6)
    for (int bh = vcu; bh < NB * NH; bh += G) {
        for (int qb = 0; qb < 8; ++qb) mla_unit(lds, QB, KB, KVRAW, OMLA, bh >> 3, bh & 7, qb);
        for (int qb = 0; qb < 8; ++qb) sb_unit(lds, SBQ, OSB, bh >> 3, bh & 7, qb);
    }
#endif
    xcd_barrier(bar);

#if PH(8)
    { pg8::DenseOrder S; S.init(OMLA, WOM, NTOK, 1024, 512, G, bx); EpiMerge<false> E{MERGED, SGA}; pg8::gemm_phase<false>(lds, 512, S, E); }
    { pg8::DenseOrder S; S.init(OSB, WOS, NTOK, 1024, 512, G, bx); EpiMerge<true> E{MERGED, SGB}; pg8::gemm_phase<false>(lds, 512, S, E); }
#endif
    xcd_barrier(bar);

#if PH(9)
    { pg8::DenseOrder S; S.init(MERGED, WOUT, NTOK, 1024, 1024, G, bx); EpiWout E{x, out, MOD}; pg8::gemm_phase<false>(lds, 1024, S, E); }
#endif
    xcd_barrier(bar);

#if PH(10)
    {
        constexpr int I_GU = 16 * 64, I_DN = 16 * 32;
        for (int it = gw; it < NE * (I_GU + I_DN); it += NGW) {
            if (it < NE * I_GU) { const int e = it / I_GU, q = it % I_GU, kb = q / 64, nb = q % 64, n0 = 32 * nb; const int g = n0 >> 10, jj = n0 & 1023;
                transpose_item(w_gate_up + (size_t)e * 1024 * 2048, 1024, 2048, WGU + (size_t)e * 2048 * 1024, 64 * kb, n0, 256 * (jj >> 7) + 128 * g + (jj & 127), scr, lane); }
            else { const int r2 = it - NE * I_GU, e = r2 / I_DN, q = r2 % I_DN, kb = q / 32, nb = q % 32;
                transpose_item(w_down + (size_t)e * 1024 * 1024, 1024, 1024, WDN + (size_t)e * 1024 * 1024, 64 * kb, 32 * nb, 32 * nb, scr, lane); }
        }
        const int e = lane & 31, half = lane >> 5;
        const float br = b_router[e];
        for (int gi = gw; gi < NTOK / 4; gi += NGW) {
#pragma unroll
            for (int rr = 0; rr < 4; ++rr) { const int m = 4 * gi + rr, b = m >> 11;
                const f32x4* xr = (const f32x4*)(out + (size_t)m * 1024) + lane;
                f32x4 v[4]; float ss = 0.f;
#pragma unroll
                for (int j = 0; j < 4; ++j) { v[j] = xr[64 * j]; ss += (v[j].x * v[j].x + v[j].y * v[j].y) + (v[j].z * v[j].z + v[j].w * v[j].w); }
                const float rstd = rsqrtf(wave_sum(ss) * (1.f / 1024.f) + EPS);
                const float* mb = MOD + (size_t)b * 6144;
#pragma unroll
                for (int j = 0; j < 4; ++j) { const int col = 4 * lane + 256 * j;
                    const f32x4 g = *(const f32x4*)(g_norm2 + col), sh = *(const f32x4*)(mb + 3072 + col), sc = *(const f32x4*)(mb + 4096 + col);
                    const f32x4 y = (v[j] * rstd) * g * (sc + 1.f) + sh;
                    u32x2 o; o.x = cvt_pk_bf16(y.x, y.y); o.y = cvt_pk_bf16(y.z, y.w);
                    *(u32x2*)(H2 + (size_t)m * 1024 + col) = o;
                    *(LAS f32x4*)(scr + rr * 1024 + col) = y; } }
            LDS_WAIT(); asm volatile("" ::: "memory");
            float acc[4] = {0.f, 0.f, 0.f, 0.f};
            const float* wp = w_router + (size_t)(512 * half) * 32 + e;
            for (int c4 = 0; c4 < 512; c4 += 4) {
                const float w0 = wp[(c4 + 0) * 32], w1 = wp[(c4 + 1) * 32], w2 = wp[(c4 + 2) * 32], w3 = wp[(c4 + 3) * 32];
#pragma unroll
                for (int rr = 0; rr < 4; ++rr) { const f32x4 hv = *(const LAS f32x4*)(scr + rr * 1024 + 512 * half + c4); acc[rr] += hv.x * w0 + hv.y * w1 + hv.z * w2 + hv.w * w3; }
            }
            LDS_WAIT(); asm volatile("" ::: "memory");
#pragma unroll
            for (int rr = 0; rr < 4; ++rr) {
                float v = acc[rr] + __shfl_xor(acc[rr], 32) + br;
                float tv[4]; int te[4];
#pragma unroll
                for (int k = 0; k < 4; ++k) { float bv = v; int bi = e;
#pragma unroll
                    for (int off = 16; off >= 1; off >>= 1) { const float ov = __shfl_xor(bv, off); const int oi = __shfl_xor(bi, off); if (ov > bv || (ov == bv && oi < bi)) { bv = ov; bi = oi; } }
                    tv[k] = bv; te[k] = bi; if (e == bi) v = -INFINITY; }
                const float e1 = __expf(tv[1] - tv[0]), e2 = __expf(tv[2] - tv[0]), e3 = __expf(tv[3] - tv[0]); const float inv = 1.f / (1.f + e1 + e2 + e3);
                if (lane < 4) { const int k = lane; const int ek = k == 0 ? te[0] : k == 1 ? te[1] : k == 2 ? te[2] : te[3]; const float wk = (k == 0 ? 1.f : k == 1 ? e1 : k == 2 ? e2 : e3) * inv;
                    const unsigned slot = atomicAdd(ctl + CW_CNT + (k * 32 + ek) * 16, 1u);
                    TOKL[(size_t)(k * 32 + ek) * LISTCAP + slot] = 4 * gi + rr; WLST[(size_t)(k * 32 + ek) * LISTCAP + slot] = wk; }
            }
        }
    }
#endif
    xcd_barrier(bar);

#if PH(11)
    LAS int* tbase = (LAS int*)(lds + LDSCTL_OFF + LC_TBASE); LAS int* nearr = (LAS int*)(lds + LDSCTL_OFF + LC_NE); LAS int* tilee = (LAS int*)(lds + LDSCTL_OFF + LC_TILEE);
    for (int k = 0; k < TOPK; ++k) {
        __syncthreads();
        if (tid < NE) nearr[tid] = (int)ctl[CW_CNT + (k * 32 + tid) * 16];
        __syncthreads();
        if (tid == 0) { int a = 0;
#pragma nounroll
            for (int e = 0; e < NE; ++e) { tbase[e] = a; a += (nearr[e] + 255) >> 8; } tbase[NE] = a; }
        __syncthreads();
        { const int total = tbase[NE];
          for (int T = tid; T < total; T += 512) { int e = 0;
#pragma nounroll
              while (e < NE - 1 && tbase[e + 1] <= T) ++e;
              tilee[T] = e; } }
        __syncthreads();
#ifndef NO_GU
        { MoeOrder<8, true> S{(const char*)H2, (const char*)WGU, (size_t)2048 * 1024 * 2, TOKL + (size_t)k * NE * LISTCAP, G, vcu, tbase, nearr, tilee};
          EpiGateUp E{HID, b_gate_up};
          pg8::gemm_phase<true>(lds, 1024, S, E); }
#endif
        xcd_barrier(bar);
#ifndef NO_DN
        { MoeOrder<4, false> S{(const char*)HID, (const char*)WDN, (size_t)1024 * 1024 * 2, TOKL + (size_t)k * NE * LISTCAP, G, vcu, tbase, nearr, tilee};
          EpiDown E{out, b_down, MOD, TOKL + (size_t)k * NE * LISTCAP, WLST + (size_t)k * NE * LISTCAP};
          pg8::gemm_phase<false>(lds, 1024, S, E); }
#endif
        if (k + 1 < TOPK) xcd_barrier(bar);
    }
#endif
}

extern "C" void kernel_launch(void* const* d_in, const int* in_sizes, int n_in, void* d_out, int out_size, void* d_ws, size_t ws_size, hipStream_t stream) {
    static int grid = 0;
    if (grid == 0) {
        if (n_in != 23 || in_sizes[0] != NTOK * DM || out_size != NTOK * DM || ws_size < WS_END) { fprintf(stderr, "kernel_launch: unexpected shapes (n_in %d, in0 %d, out %d, ws %zu); nothing launched\n", n_in, n_in > 0 ? in_sizes[0] : -1, out_size, ws_size); grid = -1; return; }
        int dev = 0, cus = 0, per_cu = 0;
        if (hipGetDevice(&dev) != hipSuccess || hipDeviceGetAttribute(&cus, hipDeviceAttributeMultiprocessorCount, dev) != hipSuccess) { grid = -1; return; }
        if (hipFuncSetAttribute((const void*)fwd_kernel, hipFuncAttributeMaxDynamicSharedMemorySize, LDS_BYTES) != hipSuccess) { fprintf(stderr, "kernel_launch: hipFuncSetAttribute failed\n"); grid = -1; return; }
        if (hipOccupancyMaxActiveBlocksPerMultiprocessor(&per_cu, (const void*)fwd_kernel, 512, LDS_BYTES) != hipSuccess || per_cu < 1) fprintf(stderr, "kernel_launch: occupancy query reports %d\n", per_cu);
        (void)hipGetLastError();
        grid = cus;
    }
    if (grid < 0) return;
    if (hipMemsetAsync((char*)d_ws + WS_CTL, 0, CTL_ZERO_BYTES, stream) != hipSuccess) return;
    Args a{};
    for (int i = 0; i < 23; ++i) a.in[i] = d_in[i];
    a.out = (float*)d_out; a.ws = (unsigned char*)d_ws;
    hipLaunchKernelGGL(fwd_kernel, dim3(grid), dim3(512), LDS_BYTES, stream, a);
}
```

```cpp
#include <hip/hip_runtime.h>
#include <cstdio>
#include <cstdint>

#define LAS __attribute__((address_space(3)))
#define GAS __attribute__((address_space(1)))
typedef unsigned short bf16_t;
typedef short bf16x8 __attribute__((ext_vector_type(8)));
typedef short s16x4 __attribute__((ext_vector_type(4)));
typedef float f32x2 __attribute__((ext_vector_type(2)));
typedef float f32x4 __attribute__((ext_vector_type(4)));
typedef float f32x16 __attribute__((ext_vector_type(16)));
typedef unsigned u32x2 __attribute__((ext_vector_type(2)));
typedef unsigned u32x4 __attribute__((ext_vector_type(4)));

constexpr int NB = 32, SEQ = 2048, DM = 1024, NTOK = NB * SEQ;
constexpr int QLORA = 384, KVLORA = 256, ROPE = 32, NOPE = 64, VD = 64, QKD = 96, NH = 8;
constexpr int SBD = 64;
constexpr int NE = 32, TOPK = 4, DE = 1024;
constexpr int DIN = 4256, DINP = 4352;
constexpr float EPS = 1e-6f;
constexpr float LOG2E = 1.4426950408889634f;
constexpr int LISTCAP = NTOK;
constexpr int MAXTILES = NTOK / 256 + NE;

constexpr size_t MiB = 1u << 20;
constexpr size_t WS_CTL = 0, CTL_ZERO_BYTES = 1 * MiB;
constexpr size_t WS_WIN = 1 * MiB;
constexpr size_t WS_WUQ = 10 * MiB;
constexpr size_t WS_WUKV = 11 * MiB;
constexpr size_t WS_WOM = 12 * MiB;
constexpr size_t WS_WOS = 13 * MiB;
constexpr size_t WS_WOUT = 14 * MiB;
constexpr size_t WS_MOD = 16 * MiB;
constexpr size_t WS_H = 32 * MiB;
constexpr size_t WS_KVRAW = WS_H, WS_MERGED = WS_H;
constexpr size_t WS_SGA = 160 * MiB;
constexpr size_t WS_H2 = WS_SGA;
constexpr size_t WS_SGB = 288 * MiB;
constexpr size_t WS_WGU = WS_SGB;
constexpr size_t WS_SB = 416 * MiB;
constexpr size_t WS_WDN = 416 * MiB;
constexpr size_t WS_TOKL = 480 * MiB;
constexpr size_t WS_WL = 512 * MiB;
constexpr size_t WS_HID = 544 * MiB;
constexpr size_t WS_QL = 608 * MiB;
constexpr size_t WS_KVL = 656 * MiB;
constexpr size_t WS_KPE = 688 * MiB;
constexpr size_t WS_Q = 692 * MiB;
constexpr size_t WS_K = 788 * MiB;
constexpr size_t WS_OMLA = 884 * MiB;
constexpr size_t WS_OSB = 948 * MiB;
constexpr size_t WS_END = 1012 * MiB;
static_assert(WS_HID + (size_t)MAXTILES * 256 * 1024 * 2 <= 692 * MiB, "hid fits below Q (dead by then anyway)");
constexpr int CW_BAR = 4096;
constexpr int CW_CNT = 16384;

constexpr int RING_BYTES = 131072;
constexpr int LDSCTL_OFF = RING_BYTES + 1024;
constexpr int LC_BARST = 0;
constexpr int LC_TBASE = 64;
constexpr int LC_NE = 256;
constexpr int LC_TILEE = 512;
constexpr int LDS_BYTES = 147456;
static_assert(LC_TILEE + MAXTILES * 4 <= LDS_BYTES - LDSCTL_OFF, "lds ctl");

__device__ __forceinline__ unsigned cvt_pk_bf16(float lo, float hi) { unsigned r; asm volatile("v_cvt_pk_bf16_f32 %0, %1, %2" : "=v"(r) : "v"(lo), "v"(hi)); return r; }
__device__ __forceinline__ float bf_lo(unsigned u) { return __builtin_bit_cast(float, u << 16); }
__device__ __forceinline__ float bf_hi(unsigned u) { return __builtin_bit_cast(float, u & 0xffff0000u); }
__device__ __forceinline__ float fast_sigmoid(float x) { return __builtin_amdgcn_rcpf(1.f + __builtin_amdgcn_exp2f(-x * LOG2E)); }

namespace pg8 {
constexpr int BM = 256, BK = 64, HALF = 128, HTB = HALF * BK * 2, STAGE_BYTES = 8 * HTB, NXCD = 8, WGM = 8;
__host__ __device__ __forceinline__ int lds_byte(int r, int c) { const int st = (r >> 4) * 2 + (c >> 5), rr = r & 15, cc = c & 31, ob = rr * 64 + cc * 2; return st * 1024 + (ob ^ (((ob >> 9) & 1) << 5)); }
__host__ __device__ __forceinline__ void stage_rc(int b, int& R, int& C) { const int st = b / 1024, sb = b % 1024, swz = sb ^ (((sb >> 9) & 1) << 5); R = (st >> 1) * 16 + swz / 64; C = (st & 1) * 32 + (swz % 64) / 2; }
__host__ __device__ __forceinline__ int perm32(int rho) { const int n = rho >> 4, i = rho & 15; return 8 * (i >> 2) + 4 * n + (i & 3); }

struct Unit { int pm, pn, e, j0, ne; };

struct DenseOrder {
    const char* A; const char* Bt; int K; int nM, nN, nwg, G, c;
    __device__ void init(const void* A_, const void* Bt_, int M, int N, int K_, int G_, int c_) { A = (const char*)A_; Bt = (const char*)Bt_; K = K_; nM = M / BM; nN = N / BM; nwg = nM * nN; G = G_; c = c_; }
    __device__ __forceinline__ bool next(int i, Unit& u) const {
        const long L = (long)i * G + c; if (L >= nwg) return false;
        int wgid = (int)L; { const int q = nwg / NXCD, r = nwg % NXCD, xcd = wgid % NXCD, off = wgid / NXCD; wgid = (xcd < r ? xcd * (q + 1) : r * (q + 1) + (xcd - r) * q) + off; }
        const int nig = WGM * nN, gid = wgid / nig, fm = gid * WGM, gsz = (nM - fm) < WGM ? (nM - fm) : WGM;
        u.pm = fm + ((wgid % nig) % gsz); u.pn = (wgid % nig) / gsz; u.e = 0; u.j0 = 0; u.ne = 0; return true;
    }
    __device__ __forceinline__ const char* a_base(const Unit& u) const { return A + (size_t)u.pm * (size_t)(BM * 2) * K; }
    __device__ __forceinline__ const char* b_base(const Unit& u) const { return Bt + (size_t)u.pn * (size_t)(BM * 2) * K; }
    __device__ __forceinline__ unsigned row_of(const Unit&, int) const { return 0u; }
};

template <bool GATHER, class Epi, class Sched>
__device__ __forceinline__ void gemm_phase(LAS unsigned char* lds, const int K, const Sched& S, const Epi& E) {
    int tid_ = threadIdx.x; asm volatile("" : "+v"(tid_));
    const int tid = tid_, wid = __builtin_amdgcn_readfirstlane(tid >> 6), lane = tid & 63, wr = wid >> 2, wc = wid & 3, fr = lane & 15, fq = lane >> 4;
    const int nt = K / BK;
    int RA[2]; unsigned cofA[2], voffB[2];
#pragma unroll
    for (int i = 0; i < 2; ++i) { int R, C; stage_rc(tid * 16 + i * 8192, R, C); const int Rb = (R & ~31) + perm32(R & 31);
        RA[i] = R; cofA[i] = (unsigned)C * 2u; voffB[i] = (unsigned)(Rb * K + C) * 2u; }
    const size_t kstep = (size_t)(BK * 2);
    const size_t hstep = (size_t)HALF * K * 2;
    const unsigned ldsw = (unsigned)wid * 1024u;
    const int aoff = lds_byte(wr * 64 + fr, fq * 8), boff = lds_byte(wc * 32 + fr, fq * 8);
#define PG8_SA(b, h) (((b) * 2 + (h)) * HTB)
#define PG8_SB(b, h) ((4 + (b) * 2 + (h)) * HTB)
#define PG8_STAGE(bufoff, gbase, voff) do { _Pragma("unroll") for (int _i = 0; _i < 2; ++_i) \
        __builtin_amdgcn_global_load_lds((const unsigned*)((const char*)(gbase) + (voff)[_i]), (LAS unsigned*)(lds + (bufoff) + ldsw + _i * 8192), 16, 0, 0); } while (0)
#define PG8_LDA(dst, b, h) do { _Pragma("unroll") for (int m = 0; m < 4; ++m) _Pragma("unroll") for (int k = 0; k < 2; ++k) dst[m][k] = *(const LAS bf16x8*)(lds + PG8_SA(b, h) + aoff + m * 2048 + k * 1024); } while (0)
#define PG8_LDB(dst, b, h) do { _Pragma("unroll") for (int n = 0; n < 2; ++n) _Pragma("unroll") for (int k = 0; k < 2; ++k) dst[n][k] = *(const LAS bf16x8*)(lds + PG8_SB(b, h) + boff + n * 2048 + k * 1024); } while (0)
#define PG8_MMA(ai, bj, At, Bt) do { __builtin_amdgcn_s_setprio(1); _Pragma("unroll") for (int m = 0; m < 4; ++m) _Pragma("unroll") for (int n = 0; n < 2; ++n) _Pragma("unroll") for (int k = 0; k < 2; ++k) \
        acc[ai][bj][m][n] = __builtin_amdgcn_mfma_f32_16x16x32_bf16(Bt[n][k], At[m][k], acc[ai][bj][m][n], 0, 0, 0); __builtin_amdgcn_s_setprio(0); } while (0)
#define PG8_WAIT_V(n) asm volatile("s_waitcnt vmcnt(" #n ")" ::: "memory")
#define PG8_WAIT_L(n) asm volatile("s_waitcnt lgkmcnt(" #n ")" ::: "memory")
#define PG8_BAR __builtin_amdgcn_s_barrier()
#define PG8_SCHED __builtin_amdgcn_sched_barrier(0)
#define PG8_AOFFS(dst, u) do { _Pragma("unroll") for (int _h = 0; _h < 2; ++_h) _Pragma("unroll") for (int _i = 0; _i < 2; ++_i) { \
        const unsigned _row = GATHER ? S.row_of(u, _h * HALF + RA[_i]) : (unsigned)(_h * HALF + RA[_i]); dst[_h][_i] = _row * (unsigned)(K * 2) + cofA[_i]; } } while (0)
    Unit cur, nxt; int ui = 0;
    if (!S.next(0, cur)) return;
    f32x4 acc[2][2][4][2];
#pragma unroll
    for (int a = 0; a < 2; ++a)
#pragma unroll
        for (int b = 0; b < 2; ++b)
#pragma unroll
            for (int m = 0; m < 4; ++m)
#pragma unroll
                for (int n = 0; n < 2; ++n) acc[a][b][m][n] = (f32x4){0.f, 0.f, 0.f, 0.f};
    bf16x8 At[4][2], B0[2][2], B1[2][2];
    unsigned oc[2][2], on[2][2];
    PG8_AOFFS(oc, cur);
    const char* cA = S.a_base(cur); const char* cB = S.b_base(cur);
    PG8_STAGE(PG8_SB(0, 0), cB, voffB); PG8_STAGE(PG8_SB(0, 1), cB + hstep, voffB); PG8_STAGE(PG8_SA(0, 0), cA, oc[0]); PG8_STAGE(PG8_SA(0, 1), cA, oc[1]);
    if (wr == 1) PG8_BAR;
    PG8_WAIT_V(2); PG8_BAR;
    PG8_STAGE(PG8_SB(1, 0), cB + kstep, voffB); PG8_STAGE(PG8_SA(1, 0), cA + kstep, oc[0]); PG8_STAGE(PG8_SB(1, 1), cB + hstep + kstep, voffB);
    PG8_WAIT_V(6); PG8_BAR;
    for (;;) {
        const bool has_next = S.next(ui + 1, nxt);
        const char* nA = has_next ? S.a_base(nxt) : cA; const char* nB = has_next ? S.b_base(nxt) : cB;
        if constexpr (GATHER) { if (has_next) { PG8_AOFFS(on, nxt); } else {
#pragma unroll
            for (int _h = 0; _h < 2; ++_h)
#pragma unroll
                for (int _i = 0; _i < 2; ++_i) on[_h][_i] = oc[_h][_i]; } }
        for (int t = 0; t < nt; t += 2) {
            const bool last = (t == nt - 2);
            const char* a1 = cA + (size_t)(t + 1) * kstep;
            const char* a2 = last ? nA : cA + (size_t)(t + 2) * kstep; const char* b2 = last ? nB : cB + (size_t)(t + 2) * kstep;
            const char* a3 = a2 + kstep; const char* b3 = b2 + kstep;
            unsigned o2[2][2];
#pragma unroll
            for (int _h = 0; _h < 2; ++_h)
#pragma unroll
                for (int _i = 0; _i < 2; ++_i) o2[_h][_i] = (GATHER && last) ? on[_h][_i] : oc[_h][_i];
            PG8_LDB(B0, 0, 0); PG8_LDB(B1, 0, 1); PG8_SCHED; PG8_LDA(At, 0, 0); PG8_STAGE(PG8_SA(1, 1), a1, oc[1]);
            PG8_WAIT_V(8); PG8_WAIT_L(0); PG8_BAR; PG8_MMA(0, 0, At, B0); PG8_MMA(0, 1, At, B1); PG8_BAR; PG8_SCHED;
            PG8_LDA(At, 0, 1); PG8_STAGE(PG8_SB(0, 0), b2, voffB); PG8_STAGE(PG8_SB(0, 1), b2 + hstep, voffB); PG8_STAGE(PG8_SA(0, 0), a2, o2[0]);
            PG8_WAIT_V(8); PG8_WAIT_L(0); PG8_BAR; PG8_MMA(1, 0, At, B0); PG8_MMA(1, 1, At, B1); PG8_BAR; PG8_SCHED;
            PG8_LDB(B0, 1, 0); PG8_LDB(B1, 1, 1); PG8_SCHED; PG8_LDA(At, 1, 0); PG8_STAGE(PG8_SA(0, 1), a2, o2[1]);
            PG8_WAIT_V(8); PG8_WAIT_L(0); PG8_BAR; PG8_MMA(0, 0, At, B0); PG8_MMA(0, 1, At, B1); PG8_BAR; PG8_SCHED;
            PG8_LDA(At, 1, 1); PG8_STAGE(PG8_SB(1, 0), b3, voffB); PG8_STAGE(PG8_SB(1, 1), b3 + hstep, voffB); PG8_STAGE(PG8_SA(1, 0), a3, o2[0]);
            PG8_WAIT_V(8); PG8_WAIT_L(0); PG8_BAR; PG8_MMA(1, 0, At, B0); PG8_MMA(1, 1, At, B1); PG8_BAR; PG8_SCHED;
        }
        if (wr == 0) PG8_BAR;
        E(acc, cur, wr, wc, fr, fq);
        if (!has_next) break;
#pragma unroll
        for (int a = 0; a < 2; ++a)
#pragma unroll
            for (int b = 0; b < 2; ++b)
#pragma unroll
                for (int m = 0; m < 4; ++m)
#pragma unroll
                    for (int n = 0; n < 2; ++n) acc[a][b][m][n] = (f32x4){0.f, 0.f, 0.f, 0.f};
        cur = nxt; cA = nA; cB = nB; ++ui;
        if constexpr (GATHER) {
#pragma unroll
        for (int _h = 0; _h < 2; ++_h)
#pragma unroll
            for (int _i = 0; _i < 2; ++_i) oc[_h][_i] = on[_h][_i]; }
        if (wr == 1) PG8_BAR;
    }
    PG8_WAIT_V(0);
    PG8_BAR;
#undef PG8_SA
#undef PG8_SB
#undef PG8_STAGE
#undef PG8_LDA
#undef PG8_LDB
#undef PG8_MMA
#undef PG8_WAIT_V
#undef PG8_WAIT_L
#undef PG8_BAR
#undef PG8_SCHED
#undef PG8_AOFFS
}
}
#define XB_TMO      128
#define XB_XCNT(j)  (256  + 64 * (j))
#define XB_XSUB(j)  (1280 + 64 * (j))
#define XB_XGEN(j)  (2304 + 64 * (j))
#define XB_TOP      3328
#define XB_TOPGEN   3392
#define XCD_BAR_WORDS 3456
#define XB_SPIN_CAP (1u << 18)

__device__ __forceinline__ unsigned xb_ld(unsigned* p)              { return __hip_atomic_load(p, __ATOMIC_RELAXED, __HIP_MEMORY_SCOPE_AGENT); }
__device__ __forceinline__ unsigned xb_add(unsigned* p, unsigned v) { return __hip_atomic_fetch_add(p, v, __ATOMIC_RELAXED, __HIP_MEMORY_SCOPE_AGENT); }
__device__ __forceinline__ unsigned xb_xcc_id() { return (unsigned)__builtin_amdgcn_s_getreg((3 << 11) | 20) & 0xFu; }
#define XB_SPIN(cond, bar) do { unsigned _sp = 0; while (cond) { __builtin_amdgcn_s_sleep(1); \
    if ((++_sp & 255u) == 0u) { if (xb_ld(&(bar)[XB_TMO])) break; if (_sp > XB_SPIN_CAP) { atomicAdd(&(bar)[XB_TMO], 1u); break; } } } } while (0)

struct XcdBarrier {
    unsigned* bar; unsigned x;
    volatile LAS unsigned* st;
};

__device__ __forceinline__ XcdBarrier xcd_barrier_post(unsigned* bar, volatile LAS unsigned* st) {
    XcdBarrier b; b.bar = bar; b.x = xb_xcc_id(); b.st = st;
    if (threadIdx.x == 0) (void)xb_add(&bar[XB_XCNT(b.x)], 1u);
    return b;
}
__device__ __forceinline__ void xcd_barrier_complete(unsigned* bar, unsigned x, unsigned& nloc, unsigned& nx) {
    const unsigned G = gridDim.x * gridDim.y * gridDim.z;
    unsigned sum, cnt, mine, sp = 0u;
    for (;;) {
        sum = 0u; cnt = 0u; mine = 0u;
#pragma unroll
        for (unsigned j = 0; j < 16; ++j) { const unsigned c = xb_ld(&bar[XB_XCNT(j)]); sum += c; cnt += (c > 0u) ? 1u : 0u; mine = (j == x) ? c : mine; }
        if (sum == G) break;
        __builtin_amdgcn_s_sleep(1);
        if ((++sp & 255u) == 0u) { if (xb_ld(&bar[XB_TMO])) break; if (sp > XB_SPIN_CAP) { atomicAdd(&bar[XB_TMO], 1u); break; } }
    }
    nloc = mine > 0u ? mine : 1u; nx = cnt > 0u ? cnt : 1u;
}

__device__ __forceinline__ void xcd_barrier(const XcdBarrier& b) {
    asm volatile("s_waitcnt vmcnt(0)" ::: "memory");
    __syncthreads();
    if (threadIdx.x == 0) {
        unsigned* bar = b.bar;
        __builtin_amdgcn_s_waitcnt(0);
        unsigned nloc = b.st[0], nx = b.st[1];
        if (nloc == 0u) { xcd_barrier_complete(bar, b.x, nloc, nx); b.st[0] = nloc; b.st[1] = nx; }
        const unsigned old = xb_add(&bar[XB_XSUB(b.x)], 1u);
        const unsigned gen = old / nloc;
        if (old + 1u == (gen + 1u) * nloc) {
            __builtin_amdgcn_fence(__ATOMIC_RELEASE, "agent");
            asm volatile("s_waitcnt vmcnt(0)" ::: "memory");
            const unsigned og = xb_add(&bar[XB_TOP], 1u);
            const unsigned tg = og / nx;
            if (og + 1u == (tg + 1u) * nx) xb_add(&bar[XB_TOPGEN], 1u);
            else XB_SPIN(xb_ld(&bar[XB_TOPGEN]) == tg, bar);
            __builtin_amdgcn_fence(__ATOMIC_ACQUIRE, "agent");
            xb_add(&bar[XB_XGEN(b.x)], 1u);
            asm volatile("s_waitcnt vmcnt(0)" ::: "memory");
        } else {
            XB_SPIN(xb_ld(&bar[XB_XGEN(b.x)]) == gen, bar);
            __builtin_amdgcn_fence(__ATOMIC_ACQUIRE, "agent");
            asm volatile("s_waitcnt vmcnt(0)" ::: "memory");
        }
    }
    __syncthreads();
}

#define LDS_WAIT() asm volatile("s_waitcnt lgkmcnt(0)" ::: "memory")
#define VM_WAIT() asm volatile("s_waitcnt vmcnt(0)" ::: "memory")
#define MFMA32(a, b, c) __builtin_amdgcn_mfma_f32_32x32x16_bf16((a), (b), (c), 0, 0, 0)
__device__ __forceinline__ float wave_sum(float v) {
#pragma unroll
    for (int o = 1; o < 64; o <<= 1) v += __shfl_xor(v, o);
    return v;
}
__device__ __forceinline__ int crow(int i, int hh) { return (i & 3) + 8 * (i >> 2) + 4 * hh; }
__device__ __forceinline__ bf16x8 pack8(float a0, float a1, float a2, float a3, float a4, float a5, float a6, float a7) {
    u32x4 p; p.x = cvt_pk_bf16(a0, a1); p.y = cvt_pk_bf16(a2, a3); p.z = cvt_pk_bf16(a4, a5); p.w = cvt_pk_bf16(a6, a7);
    return __builtin_bit_cast(bf16x8, p);
}

struct Ctx {
    LAS unsigned char* lds;
    int tid, lane, wave, vcu, G;
};

__device__ __forceinline__ void transpose_item(const float* W, int K, int N, bf16_t* WT, int k0, int n0, int drow0, LAS float* scr, int lane) {
#pragma unroll 8
    for (int i = 0; i < 32; ++i) { const int kk = 2 * i + (lane >> 5); scr[kk * 33 + (lane & 31)] = W[(size_t)(k0 + kk) * N + n0 + (lane & 31)]; }
    LDS_WAIT(); asm volatile("" ::: "memory");
    const int c = lane & 7;
#pragma unroll
    for (int j = 0; j < 4; ++j) { const int n = (lane >> 3) + 8 * j; const LAS float* s = scr + (8 * c) * 33 + n;
        u32x4 o; o.x = cvt_pk_bf16(s[0 * 33], s[1 * 33]); o.y = cvt_pk_bf16(s[2 * 33], s[3 * 33]); o.z = cvt_pk_bf16(s[4 * 33], s[5 * 33]); o.w = cvt_pk_bf16(s[6 * 33], s[7 * 33]);
        *(GAS u32x4*)(WT + (size_t)(drow0 + n) * K + k0 + 8 * c) = o; }
    LDS_WAIT(); asm volatile("" ::: "memory");
}

typedef const f32x4 (&AccRef)[2][2][4][2];

struct EpiNull { __device__ __forceinline__ void operator()(AccRef acc, const pg8::Unit& u, int wr, int wc, int fr, int fq) const {
        float s = 0.f;
#pragma unroll
        for (int ai = 0; ai < 2; ++ai)
#pragma unroll
            for (int bj = 0; bj < 2; ++bj)
#pragma unroll
                for (int m = 0; m < 4; ++m)
#pragma unroll
                    for (int n = 0; n < 2; ++n) s += acc[ai][bj][m][n][0] + acc[ai][bj][m][n][1] + acc[ai][bj][m][n][2] + acc[ai][bj][m][n][3];
        asm volatile("" :: "v"(s)); } };
struct EpiStore {
    bf16_t* O; int ldc;
    __device__ __forceinline__ void operator()(AccRef acc, const pg8::Unit& u, int wr, int wc, int fr, int fq) const {
        const int row0 = u.pm * 256 + wr * 64 + fr, col0 = u.pn * 256 + wc * 32 + 8 * fq;
#pragma unroll
        for (int ai = 0; ai < 2; ++ai)
#pragma unroll
            for (int m = 0; m < 4; ++m) { bf16_t* rowp = O + (size_t)(row0 + ai * 128 + m * 16) * ldc + col0;
#pragma unroll
                for (int bj = 0; bj < 2; ++bj) { const f32x4 v0 = acc[ai][bj][m][0], v1 = acc[ai][bj][m][1];
                    u32x4 w; w.x = cvt_pk_bf16(v0[0], v0[1]); w.y = cvt_pk_bf16(v0[2], v0[3]); w.z = cvt_pk_bf16(v1[0], v1[1]); w.w = cvt_pk_bf16(v1[2], v1[3]);
                    *(u32x4*)(rowp + bj * 128) = w; } }
    }
};

struct EpiProj {
    bf16_t *QL, *KVL, *KPE, *SB, *SGA, *SGB;
    __device__ __forceinline__ void operator()(AccRef acc, const pg8::Unit& u, int wr, int wc, int fr, int fq) const {
        const int row0 = u.pm * 256 + wr * 64 + fr;
#pragma unroll
        for (int bj = 0; bj < 2; ++bj) {
            const int cg = u.pn * 256 + bj * 128 + wc * 32;
            bf16_t* base; int ld, co; bool sig = false;
            if (cg < 384) { base = QL; ld = 384; co = cg; }
            else if (cg < 640) { base = KVL; ld = 256; co = cg - 384; }
            else if (cg < 672) { base = KPE; ld = 32; co = cg - 640; }
            else if (cg < 768) { continue; }
            else if (cg < 2304) { base = SB; ld = 1536; co = cg - 768; }
            else if (cg < 3328) { base = SGA; ld = 1024; co = cg - 2304; sig = true; }
            else { base = SGB; ld = 1024; co = cg - 3328; sig = true; }
#pragma unroll
            for (int ai = 0; ai < 2; ++ai)
#pragma unroll
                for (int m = 0; m < 4; ++m) { f32x4 v0 = acc[ai][bj][m][0], v1 = acc[ai][bj][m][1];
                    if (sig) {
#pragma unroll
                        for (int j = 0; j < 4; ++j) { v0[j] = fast_sigmoid(v0[j]); v1[j] = fast_sigmoid(v1[j]); } }
                    u32x4 w; w.x = cvt_pk_bf16(v0[0], v0[1]); w.y = cvt_pk_bf16(v0[2], v0[3]); w.z = cvt_pk_bf16(v1[0], v1[1]); w.w = cvt_pk_bf16(v1[2], v1[3]);
                    *(u32x4*)(base + (size_t)(row0 + ai * 128 + m * 16) * ld + co + 8 * fq) = w; }
        }
    }
};

template <bool SECOND> struct EpiMerge {
    bf16_t* MG; const bf16_t* SG;
    __device__ __forceinline__ void operator()(AccRef acc, const pg8::Unit& u, int wr, int wc, int fr, int fq) const {
        const int row0 = u.pm * 256 + wr * 64 + fr, col0 = u.pn * 256 + wc * 32 + 8 * fq;
#pragma unroll
        for (int ai = 0; ai < 2; ++ai)
#pragma unroll
            for (int m = 0; m < 4; ++m) { const size_t ro = (size_t)(row0 + ai * 128 + m * 16) * 1024 + col0;
#pragma unroll
                for (int bj = 0; bj < 2; ++bj) { const f32x4 v0 = acc[ai][bj][m][0], v1 = acc[ai][bj][m][1];
                    const u32x4 g = *(const u32x4*)(SG + ro + bj * 128);
                    float r0 = bf_lo(g.x) * v0[0], r1 = bf_hi(g.x) * v0[1], r2 = bf_lo(g.y) * v0[2], r3 = bf_hi(g.y) * v0[3];
                    float r4 = bf_lo(g.z) * v1[0], r5 = bf_hi(g.z) * v1[1], r6 = bf_lo(g.w) * v1[2], r7 = bf_hi(g.w) * v1[3];
                    if (SECOND) { const u32x4 p = *(const u32x4*)(MG + ro + bj * 128);
                        r0 += bf_lo(p.x); r1 += bf_hi(p.x); r2 += bf_lo(p.y); r3 += bf_hi(p.y); r4 += bf_lo(p.z); r5 += bf_hi(p.z); r6 += bf_lo(p.w); r7 += bf_hi(p.w); }
                    u32x4 w; w.x = cvt_pk_bf16(r0, r1); w.y = cvt_pk_bf16(r2, r3); w.z = cvt_pk_bf16(r4, r5); w.w = cvt_pk_bf16(r6, r7);
                    *(u32x4*)(MG + ro + bj * 128) = w; } }
    }
};

struct EpiWout {
    const float* X; float* OUT; const float* MOD;
    __device__ __forceinline__ void operator()(AccRef acc, const pg8::Unit& u, int wr, int wc, int fr, int fq) const {
        const int row0 = u.pm * 256 + wr * 64 + fr, col0 = u.pn * 256 + wc * 32 + 8 * fq;
        const float* ga = MOD + (size_t)(u.pm >> 3) * 6144 + 2048 + col0;
        f32x4 g[2][2];
#pragma unroll
        for (int bj = 0; bj < 2; ++bj)
#pragma unroll
            for (int n = 0; n < 2; ++n) g[bj][n] = *(const f32x4*)(ga + bj * 128 + 4 * n);
#pragma unroll
        for (int ai = 0; ai < 2; ++ai)
#pragma unroll
            for (int m = 0; m < 4; ++m) { const size_t ro = (size_t)(row0 + ai * 128 + m * 16) * 1024 + col0;
#pragma unroll
                for (int bj = 0; bj < 2; ++bj)
#pragma unroll
                    for (int n = 0; n < 2; ++n) { const f32x4 xv = *(const f32x4*)(X + ro + bj * 128 + 4 * n);
                        *(f32x4*)(OUT + ro + bj * 128 + 4 * n) = xv + g[bj][n] * acc[ai][bj][m][n]; } }
    }
};

struct EpiGateUp {
    bf16_t* HID; const float* BGU;
    __device__ __forceinline__ void operator()(AccRef acc, const pg8::Unit& u, int wr, int wc, int fr, int fq) const {
        const int row0 = u.pm * 256 + wr * 64 + fr, hc = u.pn * 128 + wc * 32 + 8 * fq;
        const float* bg = BGU + (size_t)u.e * 2048 + hc;
        f32x4 bgate[2], bup[2];
#pragma unroll
        for (int n = 0; n < 2; ++n) { bgate[n] = *(const f32x4*)(bg + 4 * n); bup[n] = *(const f32x4*)(bg + 1024 + 4 * n); }
#pragma unroll
        for (int ai = 0; ai < 2; ++ai)
#pragma unroll
            for (int m = 0; m < 4; ++m) { float r[8];
#pragma unroll
                for (int n = 0; n < 2; ++n) { const f32x4 gv = acc[ai][0][m][n] + bgate[n], uv = acc[ai][1][m][n] + bup[n];
#pragma unroll
                    for (int j = 0; j < 4; ++j) { const float g = __builtin_fminf(gv[j], 7.f); const float up = __builtin_fminf(__builtin_fmaxf(uv[j], -7.f), 7.f);
                        r[4 * n + j] = (up + 1.f) * (g * fast_sigmoid(1.702f * g)); } }
                u32x4 w; w.x = cvt_pk_bf16(r[0], r[1]); w.y = cvt_pk_bf16(r[2], r[3]); w.z = cvt_pk_bf16(r[4], r[5]); w.w = cvt_pk_bf16(r[6], r[7]);
                *(u32x4*)(HID + (size_t)(row0 + ai * 128 + m * 16) * 1024 + hc) = w; asm volatile("" ::: "memory"); }
    }
};

struct EpiDown {
    float* OUT; const float* BDN; const float* MOD; const int* TOKL; const float* WL;
    __device__ __forceinline__ void operator()(AccRef acc, const pg8::Unit& u, int wr, int wc, int fr, int fq) const {
        const int col0 = u.pn * 256 + wc * 32 + 8 * fq;
        const float* bd = BDN + (size_t)u.e * 1024 + col0;
        f32x4 b4[2][2];
#pragma unroll
        for (int bj = 0; bj < 2; ++bj)
#pragma unroll
            for (int n = 0; n < 2; ++n) b4[bj][n] = *(const f32x4*)(bd + bj * 128 + 4 * n);
        const int* tl = TOKL + (size_t)u.e * LISTCAP; const float* wl = WL + (size_t)u.e * LISTCAP;
#pragma unroll
        for (int ai = 0; ai < 2; ++ai)
#pragma unroll
            for (int m = 0; m < 4; ++m) { const int slot = u.j0 + ai * 128 + wr * 64 + m * 16 + fr;
                if (slot < u.ne) { const int tok = tl[slot]; const float wgt = wl[slot];
                    const float* ga = MOD + (size_t)(tok >> 11) * 6144 + 5120 + col0; float* op = OUT + (size_t)tok * 1024 + col0;
#pragma unroll
                    for (int bj = 0; bj < 2; ++bj)
#pragma unroll
                        for (int n = 0; n < 2; ++n) { const f32x4 g = *(const f32x4*)(ga + bj * 128 + 4 * n); const f32x4 o = *(const f32x4*)(op + bj * 128 + 4 * n);
                            *(f32x4*)(op + bj * 128 + 4 * n) = o + g * ((acc[ai][bj][m][n] + b4[bj][n]) * wgt); } }
                asm volatile("" ::: "memory"); }
    }
};

template <int NPN, bool GATHER> struct MoeOrder {
    const char* A; const char* Bt; size_t estride; const int* lists; int G, c; const LAS int* tbase; const LAS int* nearr; const LAS int* tilee;
    __device__ __forceinline__ bool next(int i, pg8::Unit& u) const {
        const int L = i * G + c, T = L / NPN; const int total = __builtin_amdgcn_readfirstlane(tbase[NE]);
        if (T >= total) return false;
        const int e = __builtin_amdgcn_readfirstlane(tilee[T]);
        u.pm = T; u.pn = L % NPN; u.e = e; u.j0 = (T - __builtin_amdgcn_readfirstlane(tbase[e])) * 256; u.ne = __builtin_amdgcn_readfirstlane(nearr[e]); return true;
    }
    __device__ __forceinline__ const char* a_base(const pg8::Unit& u) const { return GATHER ? A : A + (size_t)u.pm * (size_t)(256 * 1024 * 2); }
    __device__ __forceinline__ const char* b_base(const pg8::Unit& u) const { return Bt + (size_t)u.e * estride + (size_t)u.pn * (size_t)(256 * 1024 * 2); }
    __device__ __forceinline__ unsigned row_of(const pg8::Unit& u, int r) const { const int slot = u.j0 + r; return slot < u.ne ? (unsigned)lists[(size_t)u.e * LISTCAP + slot] : 0u; }
};

constexpr int ATT_KBYTES = 12 * 1024;
constexpr int ATT_VPITCH = 136;
constexpr int ATT_VBYTES = 64 * ATT_VPITCH;
constexpr int ATT_BUF = ATT_KBYTES + ATT_VBYTES;
constexpr int ATT_WS = 2 * ATT_BUF;
static_assert(ATT_WS + 8 * 256 + 64 <= RING_BYTES, "attention LDS");

__device__ __forceinline__ void mla_unit(LAS unsigned char* lds, const bf16_t* Q, const bf16_t* Kb, const bf16_t* KV, bf16_t* O, int b, int h, int qb) {
    const int tid = threadIdx.x, lane = tid & 63, r = lane & 31, hh = lane >> 5; const int wid = __builtin_amdgcn_readfirstlane(tid >> 6);
    const size_t rowbase = (size_t)b * SEQ; const int q0 = qb * 256, qw = q0 + 32 * wid;
    const int cq = qw >> 6, NT = (q0 >> 6) + 4;
    LAS float* wsf = (LAS float*)(lds + ATT_WS) + wid * 64;
    bf16x8 qf[6];
    { const bf16_t* qp = Q + (rowbase + qw + r) * 768 + h * 96 + hh * 8;
#pragma unroll
      for (int s = 0; s < 6; ++s) qf[s] = *(const bf16x8*)(qp + 16 * s); }
    const int lkv = tid & 63, lc = tid >> 6;
    const bf16_t* kg0 = Kb + (rowbase + lkv) * 768 + h * 96 + lc * 8;
    const bf16_t* vg = KV + (rowbase + lkv) * 1024 + h * 128 + 64 + lc * 8;
    u32x4 kr0, kr1 = (u32x4){0u, 0u, 0u, 0u}, vr;
#define ATT_LOAD(t) do { kr0 = *(const u32x4*)(kg0 + (size_t)(t) * 64 * 768); if (tid < 256) kr1 = *(const u32x4*)(kg0 + (size_t)(t) * 64 * 768 + 64); vr = *(const u32x4*)(vg + (size_t)(t) * 64 * 1024); } while (0)
#define ATT_STORE(bufi) do { LAS unsigned char* kb_ = lds + (bufi) * ATT_BUF; *(LAS u32x4*)(kb_ + tid * 16) = kr0; if (tid < 256) *(LAS u32x4*)(kb_ + 8192 + tid * 16) = kr1; \
        LAS unsigned char* vb_ = kb_ + ATT_KBYTES + (lc * 8) * ATT_VPITCH + lkv * 2; \
        _Pragma("unroll") for (int j_ = 0; j_ < 8; ++j_) *(LAS unsigned short*)(vb_ + j_ * ATT_VPITCH) = (unsigned short)(vr[j_ >> 1] >> (16 * (j_ & 1))); } while (0)
    ATT_LOAD(0); ATT_STORE(0); __syncthreads();
    float m_run = -INFINITY, l_run = 0.f;
    f32x16 o0, o1;
#pragma unroll
    for (int i = 0; i < 16; ++i) { o0[i] = 0.f; o1[i] = 0.f; }
    for (int t = 0; t < NT; ++t) {
        const int buf = t & 1;
        if (t + 1 < NT) ATT_LOAD(t + 1);
        if (t <= cq) {
            const LAS unsigned char* kb = lds + buf * ATT_BUF; const LAS unsigned char* vb = kb + ATT_KBYTES;
            f32x16 p0, p1;
#pragma unroll
            for (int i = 0; i < 16; ++i) { p0[i] = 0.f; p1[i] = 0.f; }
#pragma unroll
            for (int s = 0; s < 6; ++s) { const bf16x8 a0 = *(const LAS bf16x8*)(kb + (2 * s + hh) * 1024 + r * 16), a1 = *(const LAS bf16x8*)(kb + (2 * s + hh) * 1024 + (r + 32) * 16);
                p0 = MFMA32(a0, qf[s], p0); p1 = MFMA32(a1, qf[s], p1); }
            float mx = p0[0];
#pragma unroll
            for (int i = 0; i < 16; ++i) { mx = __builtin_fmaxf(mx, p0[i]); mx = __builtin_fmaxf(mx, p1[i]); }
            mx = __builtin_fmaxf(mx, __shfl_xor(mx, 32));
            const float m_new = __builtin_fmaxf(m_run, mx), alpha = __builtin_amdgcn_exp2f(m_run - m_new); m_run = m_new;
            float rs = 0.f;
#pragma unroll
            for (int i = 0; i < 16; ++i) { p0[i] = __builtin_amdgcn_exp2f(p0[i] - m_new); p1[i] = __builtin_amdgcn_exp2f(p1[i] - m_new); rs += p0[i] + p1[i]; }
            l_run = l_run * alpha + rs;
            if (hh == 0) wsf[r] = alpha;
            LDS_WAIT();
#pragma unroll
            for (int g = 0; g < 4; ++g) { const f32x4 al = *(const LAS f32x4*)(wsf + 8 * g + 4 * hh);
#pragma unroll
                for (int e = 0; e < 4; ++e) { o0[4 * g + e] *= al[e]; o1[4 * g + e] *= al[e]; } }
#pragma unroll
            for (int half = 0; half < 2; ++half)
#pragma unroll
                for (int s2 = 0; s2 < 2; ++s2) {
                    const f32x16& P = half ? p1 : p0;
                    const bf16x8 pa = pack8(P[8 * s2], P[8 * s2 + 1], P[8 * s2 + 2], P[8 * s2 + 3], P[8 * s2 + 4], P[8 * s2 + 5], P[8 * s2 + 6], P[8 * s2 + 7]);
                    const int kvo = (32 * half + 16 * s2 + 4 * hh) * 2;
                    { const s16x4 lo = *(const LAS s16x4*)(vb + r * ATT_VPITCH + kvo), hi = *(const LAS s16x4*)(vb + r * ATT_VPITCH + kvo + 16);
                      const bf16x8 vf = __builtin_shufflevector(lo, hi, 0, 1, 2, 3, 4, 5, 6, 7); o0 = MFMA32(pa, vf, o0); }
                    { const s16x4 lo = *(const LAS s16x4*)(vb + (r + 32) * ATT_VPITCH + kvo), hi = *(const LAS s16x4*)(vb + (r + 32) * ATT_VPITCH + kvo + 16);
                      const bf16x8 vf = __builtin_shufflevector(lo, hi, 0, 1, 2, 3, 4, 5, 6, 7); o1 = MFMA32(pa, vf, o1); }
                }
        }
        if (t + 1 < NT) ATT_STORE(buf ^ 1);
        __syncthreads();
    }
    const float l_tot = l_run + __shfl_xor(l_run, 32);
    if (hh == 0) wsf[r] = 1.f / l_tot;
    LDS_WAIT();
#pragma unroll
    for (int g = 0; g < 4; ++g) { const f32x4 rl = *(const LAS f32x4*)(wsf + 8 * g + 4 * hh);
#pragma unroll
        for (int e = 0; e < 4; ++e) { const int i = 4 * g + e; bf16_t* op = O + (rowbase + qw + crow(i, hh)) * 512 + h * 64 + r;
            op[0] = (bf16_t)(cvt_pk_bf16(o0[i] * rl[e], 0.f) & 0xffffu); op[32] = (bf16_t)(cvt_pk_bf16(o1[i] * rl[e], 0.f) & 0xffffu); } }
    LDS_WAIT();
#undef ATT_LOAD
#undef ATT_STORE
}

__device__ __forceinline__ void sb_unit(LAS unsigned char* lds, const bf16_t* SBQ, bf16_t* O, int b, int h, int qb) {
    const int tid = threadIdx.x, lane = tid & 63, r = lane & 31, hh = lane >> 5; const int wid = __builtin_amdgcn_readfirstlane(tid >> 6);
    const size_t rowbase = (size_t)b * SEQ; const int q0 = qb * 256, qw = q0 + 32 * wid;
    const int NT = (q0 >> 6) + 4;
    constexpr float C2 = 0.125f * LOG2E;
    bf16x8 qf[4];
    { const bf16_t* qp = SBQ + (rowbase + qw + r) * 1536 + h * 64 + hh * 8;
#pragma unroll
      for (int s = 0; s < 4; ++s) qf[s] = *(const bf16x8*)(qp + 16 * s); }
    const int lkv = tid & 63, lc = tid >> 6;
    const bf16_t* kg0 = SBQ + (rowbase + lkv) * 1536 + 512 + h * 64 + lc * 8;
    const bf16_t* vg = SBQ + (rowbase + lkv) * 1536 + 1024 + h * 64 + lc * 8;
    u32x4 kr0, vr;
#define ATT_LOAD(t) do { kr0 = *(const u32x4*)(kg0 + (size_t)(t) * 64 * 1536); vr = *(const u32x4*)(vg + (size_t)(t) * 64 * 1536); } while (0)
#define ATT_STORE(bufi) do { LAS unsigned char* kb_ = lds + (bufi) * ATT_BUF; *(LAS u32x4*)(kb_ + tid * 16) = kr0; \
        LAS unsigned char* vb_ = kb_ + ATT_KBYTES + (lc * 8) * ATT_VPITCH + lkv * 2; \
        _Pragma("unroll") for (int j_ = 0; j_ < 8; ++j_) *(LAS unsigned short*)(vb_ + j_ * ATT_VPITCH) = (unsigned short)(vr[j_ >> 1] >> (16 * (j_ & 1))); } while (0)
    LAS unsigned* dflag = (LAS unsigned*)(lds + ATT_WS + 8 * 256);
    ATT_LOAD(NT - 1); ATT_STORE(0); __syncthreads();
    float carry = 0.f; bool wdone = false;
    f32x16 o0, o1;
#pragma unroll
    for (int i = 0; i < 16; ++i) { o0[i] = 0.f; o1[i] = 0.f; }
#define SB_SUB(X, kvh0, kvl) do { const bool diag_ = ((kvh0) == qw); float lk_[16], z_[16]; \
        _Pragma("unroll") for (int i = 0; i < 16; ++i) { const float z2 = X[i] * C2; const float ex = __builtin_amdgcn_exp2f(z2); float sp = __builtin_amdgcn_logf(1.f + ex); sp = z2 > 64.f ? z2 : sp; \
            const bool valid = !diag_ || (crow(i, hh) < r); lk_[i] = valid ? -sp : 0.f; z_[i] = z2; } \
        float G_[4], Gp_[4]; \
        _Pragma("unroll") for (int g = 0; g < 4; ++g) { G_[g] = (lk_[4 * g] + lk_[4 * g + 1]) + (lk_[4 * g + 2] + lk_[4 * g + 3]); Gp_[g] = __shfl_xor(G_[g], 32); } \
        float tail_[4]; tail_[3] = 0.f; tail_[2] = G_[3] + Gp_[3]; tail_[1] = tail_[2] + (G_[2] + Gp_[2]); tail_[0] = tail_[1] + (G_[1] + Gp_[1]); const float total_ = tail_[0] + (G_[0] + Gp_[0]); \
        float a_[16]; \
        _Pragma("unroll") for (int g = 0; g < 4; ++g) { const float base_ = carry + tail_[g] + (hh == 0 ? Gp_[g] : 0.f); \
            const float s3 = base_ + lk_[4 * g + 3], s2_ = s3 + lk_[4 * g + 2], s1 = s2_ + lk_[4 * g + 1], s0 = s1 + lk_[4 * g]; \
            a_[4 * g + 3] = __builtin_amdgcn_exp2f(z_[4 * g + 3] + s3); a_[4 * g + 2] = __builtin_amdgcn_exp2f(z_[4 * g + 2] + s2_); a_[4 * g + 1] = __builtin_amdgcn_exp2f(z_[4 * g + 1] + s1); a_[4 * g] = __builtin_amdgcn_exp2f(z_[4 * g] + s0); } \
        if (diag_) { _Pragma("unroll") for (int i = 0; i < 16; ++i) a_[i] = (crow(i, hh) < r) ? a_[i] : 0.f; } \
        carry += total_; \
        _Pragma("unroll") for (int s2 = 0; s2 < 2; ++s2) { \
            const bf16x8 pa = pack8(a_[8 * s2], a_[8 * s2 + 1], a_[8 * s2 + 2], a_[8 * s2 + 3], a_[8 * s2 + 4], a_[8 * s2 + 5], a_[8 * s2 + 6], a_[8 * s2 + 7]); \
            const int kvo = ((kvl) + 16 * s2 + 4 * hh) * 2; \
            { const s16x4 lo = *(const LAS s16x4*)(vb + r * ATT_VPITCH + kvo), hi = *(const LAS s16x4*)(vb + r * ATT_VPITCH + kvo + 16); \
              const bf16x8 vf = __builtin_shufflevector(lo, hi, 0, 1, 2, 3, 4, 5, 6, 7); o0 = MFMA32(pa, vf, o0); } \
            { const s16x4 lo = *(const LAS s16x4*)(vb + (r + 32) * ATT_VPITCH + kvo), hi = *(const LAS s16x4*)(vb + (r + 32) * ATT_VPITCH + kvo + 16); \
              const bf16x8 vf = __builtin_shufflevector(lo, hi, 0, 1, 2, 3, 4, 5, 6, 7); o1 = MFMA32(pa, vf, o1); } } } while (0)
    for (int it = 0; it < NT; ++it) {
        const int t = NT - 1 - it, buf = it & 1, kv0 = 64 * t;
        if (t > 0) ATT_LOAD(t - 1);
        if (kv0 <= qw && !wdone) {
            const LAS unsigned char* kb = lds + buf * ATT_BUF; const LAS unsigned char* vb = kb + ATT_KBYTES;
            const bool upper = (kv0 + 32 <= qw);
            f32x16 p0, p1;
#pragma unroll
            for (int i = 0; i < 16; ++i) { p0[i] = 0.f; p1[i] = 0.f; }
#pragma unroll
            for (int s = 0; s < 4; ++s) { const bf16x8 a0 = *(const LAS bf16x8*)(kb + (2 * s + hh) * 1024 + r * 16); p0 = MFMA32(a0, qf[s], p0); }
            if (upper) {
#pragma unroll
                for (int s = 0; s < 4; ++s) { const bf16x8 a1 = *(const LAS bf16x8*)(kb + (2 * s + hh) * 1024 + (r + 32) * 16); p1 = MFMA32(a1, qf[s], p1); }
                SB_SUB(p1, kv0 + 32, 32);
            }
            SB_SUB(p0, kv0, 0);
            wdone = __all(carry < -170.f) != 0;
        }
        if (lane == 0) dflag[(it & 1) * 8 + wid] = wdone ? 1u : 0u;
        if (t > 0) ATT_STORE(buf ^ 1);
        __syncthreads();
        { const u32x4 f0 = *(const LAS u32x4*)(dflag + (it & 1) * 8), f1 = *(const LAS u32x4*)(dflag + (it & 1) * 8 + 4);
          if ((f0.x & f0.y & f0.z & f0.w & f1.x & f1.y & f1.z & f1.w) != 0u) break; }
    }
    __syncthreads();
#pragma unroll
    for (int i = 0; i < 16; ++i) { bf16_t* op = O + (rowbase + qw + crow(i, hh)) * 512 + h * 64 + r;
        op[0] = (bf16_t)(cvt_pk_bf16(o0[i], 0.f) & 0xffffu); op[32] = (bf16_t)(cvt_pk_bf16(o1[i], 0.f) & 0xffffu); }
#undef SB_SUB
#undef ATT_LOAD
#undef ATT_STORE
}

#ifndef PHMASK
#define PHMASK 0xFFFF
#endif
#define PH(n) ((PHMASK >> (n)) & 1)
#ifndef DUPMASK
#define DUPMASK 0
#endif
#define DUP(n) (1 + ((DUPMASK >> (n)) & 1))
struct Args { const void* in[23]; float* out; unsigned char* ws; };

__global__ void __launch_bounds__(512, 2) fwd_kernel(Args args) {
    extern __shared__ __attribute__((aligned(16))) unsigned char lds_raw[];
    LAS unsigned char* lds = (LAS unsigned char*)lds_raw;
    const int tid = threadIdx.x, lane = tid & 63, wave = __builtin_amdgcn_readfirstlane(tid >> 6);
    const int G = gridDim.x; const int bx = blockIdx.x; const int vcu = (G % 8 == 0) ? (bx % 8) * (G / 8) + bx / 8 : bx;
    const int gw = vcu * 8 + wave, NGW = G * 8;
    unsigned char* ws = args.ws;
    unsigned* ctl = (unsigned*)(ws + WS_CTL);
    const float* x = (const float*)args.in[0]; const float* cvec = (const float*)args.in[1]; const int* positions = (const int*)args.in[2];
    const float* w_ada = (const float*)args.in[3]; const float* b_ada = (const float*)args.in[4]; const float* g_norm1 = (const float*)args.in[5];
    const float* w_in = (const float*)args.in[6]; const float* g_q_lat = (const float*)args.in[7]; const float* w_uq = (const float*)args.in[8];
    const float* g_kv_lat = (const float*)args.in[9]; const float* w_ukv = (const float*)args.in[10]; const float* g_qk_q = (const float*)args.in[11];
    const float* g_qk_k = (const float*)args.in[12]; const float* w_o_mla = (const float*)args.in[13]; const float* w_o_sb = (const float*)args.in[14];
    const float* w_out = (const float*)args.in[15]; const float* g_norm2 = (const float*)args.in[16]; const float* w_router = (const float*)args.in[17];
    const float* b_router = (const float*)args.in[18]; const float* w_gate_up = (const float*)args.in[19]; const float* b_gate_up = (const float*)args.in[20];
    const float* w_down = (const float*)args.in[21]; const float* b_down = (const float*)args.in[22];
    float* out = args.out;
    bf16_t* WIN = (bf16_t*)(ws + WS_WIN); bf16_t* WUQ = (bf16_t*)(ws + WS_WUQ); bf16_t* WUKV = (bf16_t*)(ws + WS_WUKV); bf16_t* WOM = (bf16_t*)(ws + WS_WOM);
    bf16_t* WOS = (bf16_t*)(ws + WS_WOS); bf16_t* WOUT = (bf16_t*)(ws + WS_WOUT); float* MOD = (float*)(ws + WS_MOD);
    bf16_t* HB = (bf16_t*)(ws + WS_H); bf16_t* KVRAW = (bf16_t*)(ws + WS_KVRAW); bf16_t* MERGED = (bf16_t*)(ws + WS_MERGED);
    bf16_t* SGA = (bf16_t*)(ws + WS_SGA); bf16_t* SGB = (bf16_t*)(ws + WS_SGB); bf16_t* H2 = (bf16_t*)(ws + WS_H2);
    bf16_t* WGU = (bf16_t*)(ws + WS_WGU); bf16_t* WDN = (bf16_t*)(ws + WS_WDN); bf16_t* SBQ = (bf16_t*)(ws + WS_SB);
    int* TOKL = (int*)(ws + WS_TOKL); float* WLST = (float*)(ws + WS_WL); bf16_t* HID = (bf16_t*)(ws + WS_HID);
    bf16_t* QL = (bf16_t*)(ws + WS_QL); bf16_t* KVL = (bf16_t*)(ws + WS_KVL); bf16_t* KPE = (bf16_t*)(ws + WS_KPE);
    bf16_t* QB = (bf16_t*)(ws + WS_Q); bf16_t* KB = (bf16_t*)(ws + WS_K); bf16_t* OMLA = (bf16_t*)(ws + WS_OMLA); bf16_t* OSB = (bf16_t*)(ws + WS_OSB);

    for (int u = tid; u < (LDS_BYTES - LDSCTL_OFF) / 4; u += 512) ((LAS unsigned*)(lds + LDSCTL_OFF))[u] = 0u;
    __syncthreads();
    XcdBarrier bar = xcd_barrier_post(ctl + CW_BAR, (volatile LAS unsigned*)(lds + LDSCTL_OFF + LC_BARST));
    LAS float* scr = (LAS float*)(lds + wave * 16384);

#if PH(0)
    {
        constexpr int I_IN = 16 * 133, I_UQ = 6 * 24, I_UKV = 4 * 32, I_OM = 8 * 32, I_OS = 8 * 32, I_OUT = 16 * 32;
        constexpr int NIT = I_IN + I_UQ + I_UKV + I_OM + I_OS + I_OUT;
        for (int it = gw; it < NIT; it += NGW) {
            int q = it;
            if (q < I_IN) { const int kb = q / 133, nb = q % 133, n0 = 32 * nb; transpose_item(w_in, 1024, DIN, WIN, 64 * kb, n0, n0 < 672 ? n0 : n0 + 96, scr, lane); continue; } q -= I_IN;
            if (q < I_UQ) { const int kb = q / 24, nb = q % 24; transpose_item(w_uq, 384, 768, WUQ, 64 * kb, 32 * nb, 32 * nb, scr, lane); continue; } q -= I_UQ;
            if (q < I_UKV) { const int kb = q / 32, nb = q % 32; transpose_item(w_ukv, 256, 1024, WUKV, 64 * kb, 32 * nb, 32 * nb, scr, lane); continue; } q -= I_UKV;
            if (q < I_OM) { const int kb = q / 32, nb = q % 32; transpose_item(w_o_mla, 512, 1024, WOM, 64 * kb, 32 * nb, 32 * nb, scr, lane); continue; } q -= I_OM;
            if (q < I_OS) { const int kb = q / 32, nb = q % 32; transpose_item(w_o_sb, 512, 1024, WOS, 64 * kb, 32 * nb, 32 * nb, scr, lane); continue; } q -= I_OS;
            { const int kb = q / 32, nb = q % 32; transpose_item(w_out, 1024, 1024, WOUT, 64 * kb, 32 * nb, 32 * nb, scr, lane); }
        }
        for (int i = vcu * 512 + tid; i < 96 * 1024 * 2 / 16; i += G * 512) ((u32x4*)(WIN + 672 * 1024))[i] = (u32x4){0u, 0u, 0u, 0u};
        __syncthreads();
        for (int it = vcu; it < 6144 / 64; it += G) {
            for (int idx = lane; idx < 32 * 128; idx += 64) { const int b = idx >> 7, kk = idx & 127; const float cv = cvec[b * 1024 + 128 * wave + kk]; scr[idx] = cv / (1.f + __expf(-cv)); }
            LDS_WAIT(); asm volatile("" ::: "memory");
            float acc[32];
#pragma unroll
            for (int b = 0; b < 32; ++b) acc[b] = 0.f;
            const float* wp = w_ada + (size_t)(128 * wave) * 6144 + 64 * it + lane;
            for (int k4 = 0; k4 < 32; ++k4) {
                const float w0 = wp[(size_t)(4 * k4) * 6144], w1 = wp[(size_t)(4 * k4 + 1) * 6144], w2 = wp[(size_t)(4 * k4 + 2) * 6144], w3 = wp[(size_t)(4 * k4 + 3) * 6144];
#pragma unroll
                for (int b = 0; b < 32; ++b) { const f32x4 s = *(const LAS f32x4*)(scr + b * 128 + 4 * k4); acc[b] += s.x * w0 + s.y * w1 + s.z * w2 + s.w * w3; }
            }
            LDS_WAIT(); asm volatile("" ::: "memory");
#pragma unroll
            for (int b = 0; b < 32; ++b) scr[b * 64 + lane] = acc[b];
            __syncthreads();
#pragma unroll
            for (int bb = 0; bb < 4; ++bb) { const int b = 4 * wave + bb; float s = 0.f;
#pragma unroll
                for (int w2 = 0; w2 < 8; ++w2) s += ((const LAS float*)(lds + w2 * 16384))[b * 64 + lane];
                MOD[b * 6144 + 64 * it + lane] = s + b_ada[64 * it + lane]; }
            __syncthreads();
        }
    }
#endif
    xcd_barrier(bar);

#if PH(1)
    for (int gi = gw; gi < NTOK / 4; gi += NGW) {
        f32x4 v[4][4];
#pragma unroll
        for (int rr = 0; rr < 4; ++rr) { const f32x4* xr = (const f32x4*)(x + (size_t)(4 * gi + rr) * 1024) + lane;
#pragma unroll
            for (int j = 0; j < 4; ++j) v[rr][j] = xr[64 * j]; }
        const int b = (4 * gi) >> 11;
        const float* mb = MOD + (size_t)b * 6144;
        f32x4 gsc[4], shv[4];
#pragma unroll
        for (int j = 0; j < 4; ++j) { const int col = 4 * lane + 256 * j; gsc[j] = *(const f32x4*)(g_norm1 + col) * (*(const f32x4*)(mb + 1024 + col) + 1.f); shv[j] = *(const f32x4*)(mb + col); }
#pragma unroll
        for (int rr = 0; rr < 4; ++rr) { float ss = 0.f;
#pragma unroll
            for (int j = 0; j < 4; ++j) ss += (v[rr][j].x * v[rr][j].x + v[rr][j].y * v[rr][j].y) + (v[rr][j].z * v[rr][j].z + v[rr][j].w * v[rr][j].w);
            const float rstd = rsqrtf(wave_sum(ss) * (1.f / 1024.f) + EPS);
#pragma unroll
            for (int j = 0; j < 4; ++j) { const int col = 4 * lane + 256 * j; const f32x4 y = (v[rr][j] * rstd) * gsc[j] + shv[j];
                u32x2 o; o.x = cvt_pk_bf16(y.x, y.y); o.y = cvt_pk_bf16(y.z, y.w);
                *(u32x2*)(HB + (size_t)(4 * gi + rr) * 1024 + col) = o; } }
    }
#endif
    xcd_barrier(bar);

#if PH(2)
    {
#ifdef CLKPROBE
      const unsigned long long c0 = __builtin_amdgcn_s_memtime(), r0 = __builtin_amdgcn_s_memrealtime();
#endif
      pg8::DenseOrder S; S.init(HB, WIN, NTOK, DINP, 1024, G, bx);
      EpiProj E{QL, KVL, KPE, SBQ, SGA, SGB};
      for (int rep = 0; rep < DUP(4); ++rep) pg8::gemm_phase<false>(lds, 1024, S, E);
#ifdef CLKPROBE
      { const unsigned long long c1 = __builtin_amdgcn_s_memtime(), r1 = __builtin_amdgcn_s_memrealtime(); const unsigned long long spin = (c1 - c0) / CLKPROBE;
        while (__builtin_amdgcn_s_memrealtime() - r1 < spin) __builtin_amdgcn_s_sleep(8); (void)r0; }
#endif
#ifdef NULLK
      { EpiNull EN; pg8::DenseOrder S2; S2.init(HB, WIN, NTOK, DINP, NULLK, G, bx); pg8::gemm_phase<false>(lds, NULLK, S2, EN); }
#endif
      }
#endif
    xcd_barrier(bar);

#if PH(3)
    {
        f32x4 gq0 = (f32x4){0.f, 0.f, 0.f, 0.f}, gq1 = gq0, gk0 = gq0, gk1 = gq0;
        if (lane < 48) { gq0 = *(const f32x4*)(g_q_lat + lane * 8); gq1 = *(const f32x4*)(g_q_lat + lane * 8 + 4); }
        if (lane < 32) { gk0 = *(const f32x4*)(g_kv_lat + lane * 8); gk1 = *(const f32x4*)(g_kv_lat + lane * 8 + 4); }
        for (int gi = gw; gi < NTOK / 4; gi += NGW) {
            u32x4 vq[4], vk[4];
#pragma unroll
            for (int rr = 0; rr < 4; ++rr) { vq[rr] = (u32x4){0u, 0u, 0u, 0u}; vk[rr] = vq[rr];
                if (lane < 48) vq[rr] = *(const u32x4*)(QL + (size_t)(4 * gi + rr) * 384 + lane * 8);
                if (lane < 32) vk[rr] = *(const u32x4*)(KVL + (size_t)(4 * gi + rr) * 256 + lane * 8); }
#pragma unroll
            for (int rr = 0; rr < 4; ++rr) {
                { const u32x4 v = vq[rr]; float f[8] = {bf_lo(v.x), bf_hi(v.x), bf_lo(v.y), bf_hi(v.y), bf_lo(v.z), bf_hi(v.z), bf_lo(v.w), bf_hi(v.w)}; float ss = 0.f;
#pragma unroll
                  for (int j = 0; j < 8; ++j) ss += f[j] * f[j];
                  const float rstd = rsqrtf(wave_sum(ss) * (1.f / 384.f) + EPS);
                  if (lane < 48) { u32x4 o; o.x = cvt_pk_bf16(f[0] * rstd * gq0.x, f[1] * rstd * gq0.y); o.y = cvt_pk_bf16(f[2] * rstd * gq0.z, f[3] * rstd * gq0.w);
                      o.z = cvt_pk_bf16(f[4] * rstd * gq1.x, f[5] * rstd * gq1.y); o.w = cvt_pk_bf16(f[6] * rstd * gq1.z, f[7] * rstd * gq1.w); *(u32x4*)(QL + (size_t)(4 * gi + rr) * 384 + lane * 8) = o; } }
                { const u32x4 v = vk[rr]; float f[8] = {bf_lo(v.x), bf_hi(v.x), bf_lo(v.y), bf_hi(v.y), bf_lo(v.z), bf_hi(v.z), bf_lo(v.w), bf_hi(v.w)}; float ss = 0.f;
#pragma unroll
                  for (int j = 0; j < 8; ++j) ss += f[j] * f[j];
                  const float rstd = rsqrtf(wave_sum(ss) * (1.f / 256.f) + EPS);
                  if (lane < 32) { u32x4 o; o.x = cvt_pk_bf16(f[0] * rstd * gk0.x, f[1] * rstd * gk0.y); o.y = cvt_pk_bf16(f[2] * rstd * gk0.z, f[3] * rstd * gk0.w);
                      o.z = cvt_pk_bf16(f[4] * rstd * gk1.x, f[5] * rstd * gk1.y); o.w = cvt_pk_bf16(f[6] * rstd * gk1.z, f[7] * rstd * gk1.w); *(u32x4*)(KVL + (size_t)(4 * gi + rr) * 256 + lane * 8) = o; } }
            }
        }
    }
#endif
    xcd_barrier(bar);

#if PH(4)
    for (int rep = 0; rep < DUP(5); ++rep) {
    { pg8::DenseOrder S; S.init(QL, WUQ, NTOK, 768, 384, G, bx); EpiStore E{QB, 768}; pg8::gemm_phase<false>(lds, 384, S, E); }
    { pg8::DenseOrder S; S.init(KVL, WUKV, NTOK, 1024, 256, G, bx); EpiStore E{KVRAW, 1024}; pg8::gemm_phase<false>(lds, 256, S, E); } }
#endif
    xcd_barrier(bar);

#if PH(5)
    {
        const int hd = lane >> 3, sub = lane & 7;
        const float QSC = 0.10206207261596575f * LOG2E;
        const float if0 = exp2f(-(float)(2 * sub) * (13.287712379549449f / 16.f)), if1 = exp2f(-(float)(2 * sub + 1) * (13.287712379549449f / 16.f));
        f32x4 gq0 = *(const f32x4*)(g_qk_q + sub * 8), gq1 = *(const f32x4*)(g_qk_q + sub * 8 + 4); const f32x2 gqa = *(const f32x2*)(g_qk_q + 64 + 2 * sub), gqb = *(const f32x2*)(g_qk_q + 80 + 2 * sub);
        f32x4 gk0 = *(const f32x4*)(g_qk_k + sub * 8), gk1 = *(const f32x4*)(g_qk_k + sub * 8 + 4); const f32x2 gka = *(const f32x2*)(g_qk_k + 64 + 2 * sub), gkb = *(const f32x2*)(g_qk_k + 80 + 2 * sub);
        for (int gi = gw; gi < NTOK / 4; gi += NGW) {
            u32x4 A[4][2]; unsigned B1[4][2], B2[4][2]; float posf[4];
#pragma unroll
            for (int t = 0; t < 4; ++t) { const int m = 4 * gi + t; posf[t] = (float)positions[m];
                const bf16_t* qp = QB + (size_t)m * 768 + hd * 96; A[t][0] = *(const u32x4*)(qp + sub * 8); B1[t][0] = *(const unsigned*)(qp + 64 + 2 * sub); B2[t][0] = *(const unsigned*)(qp + 80 + 2 * sub);
                A[t][1] = *(const u32x4*)(KVRAW + (size_t)m * 1024 + hd * 128 + sub * 8); B1[t][1] = *(const unsigned*)(KPE + (size_t)m * 32 + 2 * sub); B2[t][1] = *(const unsigned*)(KPE + (size_t)m * 32 + 16 + 2 * sub); }
#pragma unroll
            for (int t = 0; t < 4; ++t) { const int m = 4 * gi + t;
                float cs[2], sn[2];
                { const float a0 = posf[t] * if0, a1 = posf[t] * if1;
                  double r0 = (double)a0 * 0.15915494309189535, r1 = (double)a1 * 0.15915494309189535; r0 -= __builtin_rint(r0); r1 -= __builtin_rint(r1);
                  cs[0] = __builtin_amdgcn_cosf((float)r0); sn[0] = __builtin_amdgcn_sinf((float)r0); cs[1] = __builtin_amdgcn_cosf((float)r1); sn[1] = __builtin_amdgcn_sinf((float)r1); }
#pragma unroll
                for (int which = 0; which < 2; ++which) {
                    const u32x4 Av = A[t][which]; const unsigned b1 = B1[t][which], b2 = B2[t][which];
                    bf16_t* dst = which ? KB + (size_t)m * 768 + hd * 96 : QB + (size_t)m * 768 + hd * 96;
                    float f[8] = {bf_lo(Av.x), bf_hi(Av.x), bf_lo(Av.y), bf_hi(Av.y), bf_lo(Av.z), bf_hi(Av.z), bf_lo(Av.w), bf_hi(Av.w)};
                    float x1[2] = {bf_lo(b1), bf_hi(b1)}, x2[2] = {bf_lo(b2), bf_hi(b2)};
                    float ss = x1[0] * x1[0] + x1[1] * x1[1] + x2[0] * x2[0] + x2[1] * x2[1];
#pragma unroll
                    for (int j = 0; j < 8; ++j) ss += f[j] * f[j];
                    ss += __shfl_xor(ss, 1); ss += __shfl_xor(ss, 2); ss += __shfl_xor(ss, 4);
                    const float rstd = rsqrtf(ss * (1.f / 96.f) + EPS);
                    const f32x4 g0 = which ? gk0 : gq0, g1 = which ? gk1 : gq1; const f32x2 ga = which ? gka : gqa, gb = which ? gkb : gqb;
                    const float sc = which ? 1.f : QSC;
                    float y[8] = {f[0] * rstd * g0.x, f[1] * rstd * g0.y, f[2] * rstd * g0.z, f[3] * rstd * g0.w, f[4] * rstd * g1.x, f[5] * rstd * g1.y, f[6] * rstd * g1.z, f[7] * rstd * g1.w};
                    const float y1a = x1[0] * rstd * ga.x, y1b = x1[1] * rstd * ga.y, y2a = x2[0] * rstd * gb.x, y2b = x2[1] * rstd * gb.y;
                    const float o1a = y1a * cs[0] - y2a * sn[0], o1b = y1b * cs[1] - y2b * sn[1], o2a = y2a * cs[0] + y1a * sn[0], o2b = y2b * cs[1] + y1b * sn[1];
                    u32x4 o; o.x = cvt_pk_bf16(y[0] * sc, y[1] * sc); o.y = cvt_pk_bf16(y[2] * sc, y[3] * sc); o.z = cvt_pk_bf16(y[4] * sc, y[5] * sc); o.w = cvt_pk_bf16(y[6] * sc, y[7] * sc);
                    *(u32x4*)(dst + sub * 8) = o; *(unsigned*)(dst + 64 + 2 * sub) = cvt_pk_bf16(o1a * sc, o1b * sc); *(unsigned*)(dst + 80 + 2 * sub) = cvt_pk_bf16(o2a * sc, o2b * sc);
                }
            }
        }
    }
#endif
    xcd_barrier(bar);

#if PH(6)
    for (int bh = vcu; bh < NB * NH; bh += G) {
        for (int rep = 0; rep < DUP(0); ++rep) for (int qb = 0; qb < 8; ++qb) mla_unit(lds, QB, KB, KVRAW, OMLA, bh >> 3, bh & 7, qb);
        for (int rep = 0; rep < DUP(1); ++rep) for (int qb = 0; qb < 8; ++qb) sb_unit(lds, SBQ, OSB, bh >> 3, bh & 7, qb);
    }
#endif
    xcd_barrier(bar);

#if PH(8)
    for (int rep = 0; rep < DUP(6); ++rep) {
    { pg8::DenseOrder S; S.init(OMLA, WOM, NTOK, 1024, 512, G, bx); EpiMerge<false> E{MERGED, SGA}; pg8::gemm_phase<false>(lds, 512, S, E); }
    { pg8::DenseOrder S; S.init(OSB, WOS, NTOK, 1024, 512, G, bx); EpiMerge<true> E{MERGED, SGB}; pg8::gemm_phase<false>(lds, 512, S, E); } }
#endif
    xcd_barrier(bar);

#if PH(9)
    { pg8::DenseOrder S; S.init(MERGED, WOUT, NTOK, 1024, 1024, G, bx); EpiWout E{x, out, MOD}; for (int rep = 0; rep < DUP(7); ++rep) pg8::gemm_phase<false>(lds, 1024, S, E); }
#endif
    xcd_barrier(bar);

#if PH(10)
    {
        constexpr int I_GU = 16 * 64, I_DN = 16 * 32;
        for (int rep = 0; rep < DUP(2); ++rep) for (int it = gw; it < NE * (I_GU + I_DN); it += NGW) {
            if (it < NE * I_GU) { const int e = it / I_GU, q = it % I_GU, kb = q / 64, nb = q % 64, n0 = 32 * nb; const int g = n0 >> 10, jj = n0 & 1023;
                transpose_item(w_gate_up + (size_t)e * 1024 * 2048, 1024, 2048, WGU + (size_t)e * 2048 * 1024, 64 * kb, n0, 256 * (jj >> 7) + 128 * g + (jj & 127), scr, lane); }
            else { const int r2 = it - NE * I_GU, e = r2 / I_DN, q = r2 % I_DN, kb = q / 32, nb = q % 32;
                transpose_item(w_down + (size_t)e * 1024 * 1024, 1024, 1024, WDN + (size_t)e * 1024 * 1024, 64 * kb, 32 * nb, 32 * nb, scr, lane); }
        }
        __syncthreads();
        {
            const int r = lane & 31, hh = lane >> 5;
            constexpr int TP = 1026;
            LAS float* tile = (LAS float*)lds;
            float areg[64];
#pragma unroll
            for (int mm = 0; mm < 64; ++mm) areg[mm] = w_router[(size_t)(128 * wave + 4 * (mm >> 1) + 2 * hh + (mm & 1)) * 32 + r];
            const float br = b_router[r];
            for (int tt = vcu; tt < NTOK / 32; tt += G) {
                { f32x4 v[4][4];
#pragma unroll
                  for (int rr = 0; rr < 4; ++rr) { const f32x4* xr = (const f32x4*)(out + (size_t)(32 * tt + 4 * wave + rr) * 1024) + lane;
#pragma unroll
                      for (int j = 0; j < 4; ++j) v[rr][j] = xr[64 * j]; }
                  const float* mb = MOD + (size_t)((32 * tt) >> 11) * 6144;
                  f32x4 gsc[4], shv[4];
#pragma unroll
                  for (int j = 0; j < 4; ++j) { const int col = 4 * lane + 256 * j; gsc[j] = *(const f32x4*)(g_norm2 + col) * (*(const f32x4*)(mb + 4096 + col) + 1.f); shv[j] = *(const f32x4*)(mb + 3072 + col); }
#pragma unroll
                  for (int rr = 0; rr < 4; ++rr) { float ss = 0.f; const int row = 4 * wave + rr;
#pragma unroll
                      for (int j = 0; j < 4; ++j) ss += (v[rr][j].x * v[rr][j].x + v[rr][j].y * v[rr][j].y) + (v[rr][j].z * v[rr][j].z + v[rr][j].w * v[rr][j].w);
                      const float rstd = rsqrtf(wave_sum(ss) * (1.f / 1024.f) + EPS);
#pragma unroll
                      for (int j = 0; j < 4; ++j) { const int col = 4 * lane + 256 * j; const f32x4 y = (v[rr][j] * rstd) * gsc[j] + shv[j];
                          u32x2 o; o.x = cvt_pk_bf16(y.x, y.y); o.y = cvt_pk_bf16(y.z, y.w);
                          *(u32x2*)(H2 + (size_t)(32 * tt + row) * 1024 + col) = o;
                          *(LAS f32x2*)(tile + row * TP + col) = (f32x2){y.x, y.y}; *(LAS f32x2*)(tile + row * TP + col + 2) = (f32x2){y.z, y.w}; } } }
                __syncthreads();
                f32x16 acc;
#pragma unroll
                for (int i = 0; i < 16; ++i) acc[i] = 0.f;
#pragma unroll
                for (int sg = 0; sg < 32; ++sg) { const f32x2 hv = *(const LAS f32x2*)(tile + r * TP + 128 * wave + 4 * sg + 2 * hh);
                    acc = __builtin_amdgcn_mfma_f32_32x32x2f32(areg[2 * sg], hv.x, acc, 0, 0, 0); acc = __builtin_amdgcn_mfma_f32_32x32x2f32(areg[2 * sg + 1], hv.y, acc, 0, 0, 0); }
                __syncthreads();
#pragma unroll
                for (int i = 0; i < 16; ++i) tile[wave * 1024 + i * 64 + lane] = acc[i];
                __syncthreads();
                { const int e = r, he = (e >> 2) & 1, ie = (e & 3) + 4 * (e >> 3);
#pragma unroll
                  for (int rr = 0; rr < 4; ++rr) { const int row = 4 * wave + rr; float v = br;
#pragma unroll
                      for (int w2 = 0; w2 < 8; ++w2) v += tile[w2 * 1024 + ie * 64 + row + 32 * he];
                      float tv[4]; int te[4];
#pragma unroll
                      for (int k = 0; k < 4; ++k) { float bv = v; int bi = e;
#pragma unroll
                          for (int off = 16; off >= 1; off >>= 1) { const float ov = __shfl_xor(bv, off); const int oi = __shfl_xor(bi, off); if (ov > bv || (ov == bv && oi < bi)) { bv = ov; bi = oi; } }
                          tv[k] = bv; te[k] = bi; if (e == bi) v = -INFINITY; }
                      const float e1 = __expf(tv[1] - tv[0]), e2 = __expf(tv[2] - tv[0]), e3 = __expf(tv[3] - tv[0]); const float inv = 1.f / (1.f + e1 + e2 + e3);
                      if (lane < 4) { const int k = lane; const int ek = k == 0 ? te[0] : k == 1 ? te[1] : k == 2 ? te[2] : te[3]; const float wk = (k == 0 ? 1.f : k == 1 ? e1 : k == 2 ? e2 : e3) * inv;
                          const unsigned slot = atomicAdd(ctl + CW_CNT + (k * 32 + ek) * 16, 1u);
                          TOKL[(size_t)(k * 32 + ek) * LISTCAP + slot] = 32 * tt + row; WLST[(size_t)(k * 32 + ek) * LISTCAP + slot] = wk; } } }
                __syncthreads();
            }
        }
    }
#endif
    xcd_barrier(bar);

#if PH(11)
    LAS int* tbase = (LAS int*)(lds + LDSCTL_OFF + LC_TBASE); LAS int* nearr = (LAS int*)(lds + LDSCTL_OFF + LC_NE); LAS int* tilee = (LAS int*)(lds + LDSCTL_OFF + LC_TILEE);
    for (int k = 0; k < TOPK; ++k) {
        __syncthreads();
        if (tid < NE) nearr[tid] = (int)ctl[CW_CNT + (k * 32 + tid) * 16];
        __syncthreads();
        if (tid == 0) { int a = 0;
#pragma nounroll
            for (int e = 0; e < NE; ++e) { tbase[e] = a; a += (nearr[e] + 255) >> 8; } tbase[NE] = a; }
        __syncthreads();
        { const int total = tbase[NE];
          for (int T = tid; T < total; T += 512) { int e = 0;
#pragma nounroll
              while (e < NE - 1 && tbase[e + 1] <= T) ++e;
              tilee[T] = e; } }
        __syncthreads();
#ifndef NO_GU
        { MoeOrder<8, true> S{(const char*)H2, (const char*)WGU, (size_t)2048 * 1024 * 2, TOKL + (size_t)k * NE * LISTCAP, G, vcu, tbase, nearr, tilee};
          EpiGateUp E{HID, b_gate_up};
          for (int rep = 0; rep < DUP(3); ++rep) pg8::gemm_phase<true>(lds, 1024, S, E); }
#endif
        xcd_barrier(bar);
#ifndef NO_DN
        { MoeOrder<4, false> S{(const char*)HID, (const char*)WDN, (size_t)1024 * 1024 * 2, TOKL + (size_t)k * NE * LISTCAP, G, vcu, tbase, nearr, tilee};
          EpiDown E{out, b_down, MOD, TOKL + (size_t)k * NE * LISTCAP, WLST + (size_t)k * NE * LISTCAP};
          pg8::gemm_phase<false>(lds, 1024, S, E); }
#endif
        if (k + 1 < TOPK) xcd_barrier(bar);
    }
#endif
}

extern "C" void kernel_launch(void* const* d_in, const int* in_sizes, int n_in, void* d_out, int out_size, void* d_ws, size_t ws_size, hipStream_t stream) {
    static int grid = 0;
    if (grid == 0) {
        if (n_in != 23 || in_sizes[0] != NTOK * DM || out_size != NTOK * DM || ws_size < WS_END) { fprintf(stderr, "kernel_launch: unexpected shapes (n_in %d, in0 %d, out %d, ws %zu); nothing launched\n", n_in, n_in > 0 ? in_sizes[0] : -1, out_size, ws_size); grid = -1; return; }
        int dev = 0, cus = 0, per_cu = 0;
        if (hipGetDevice(&dev) != hipSuccess || hipDeviceGetAttribute(&cus, hipDeviceAttributeMultiprocessorCount, dev) != hipSuccess) { grid = -1; return; }
        if (hipFuncSetAttribute((const void*)fwd_kernel, hipFuncAttributeMaxDynamicSharedMemorySize, LDS_BYTES) != hipSuccess) { fprintf(stderr, "kernel_launch: hipFuncSetAttribute failed\n"); grid = -1; return; }
        if (hipOccupancyMaxActiveBlocksPerMultiprocessor(&per_cu, (const void*)fwd_kernel, 512, LDS_BYTES) != hipSuccess || per_cu < 1) fprintf(stderr, "kernel_launch: occupancy query reports %d\n", per_cu);
        (void)hipGetLastError();
        grid = cus;
    }
    if (grid < 0) return;
    if (hipMemsetAsync((char*)d_ws + WS_CTL, 0, CTL_ZERO_BYTES, stream) != hipSuccess) return;
    Args a{};
    for (int i = 0; i < 23; ++i) a.in[i] = d_in[i];
    a.out = (float*)d_out; a.ws = (unsigned char*)d_ws;
    hipLaunchKernelGGL(fwd_kernel, dim3(grid), dim3(512), LDS_BYTES, stream, a);
}
```

```cpp
#include <hip/hip_runtime.h>
#include <cstdio>
#include <cstdint>

#define LAS __attribute__((address_space(3)))
#define GAS __attribute__((address_space(1)))
typedef unsigned short bf16_t;
typedef short bf16x8 __attribute__((ext_vector_type(8)));
typedef short s16x4 __attribute__((ext_vector_type(4)));
typedef float f32x2 __attribute__((ext_vector_type(2)));
typedef float f32x4 __attribute__((ext_vector_type(4)));
typedef float f32x16 __attribute__((ext_vector_type(16)));
typedef unsigned u32x2 __attribute__((ext_vector_type(2)));
typedef unsigned u32x4 __attribute__((ext_vector_type(4)));
typedef int v8i __attribute__((ext_vector_type(8)));
typedef unsigned u32x8 __attribute__((ext_vector_type(8)));

constexpr int NB = 32, SEQ = 2048, DM = 1024, NTOK = NB * SEQ;
constexpr int QLORA = 384, KVLORA = 256, ROPE = 32, NOPE = 64, VD = 64, QKD = 96, NH = 8;
constexpr int SBD = 64;
constexpr int NE = 32, TOPK = 4, DE = 1024;
constexpr int DIN = 4256, DINP = 4352;
constexpr float EPS = 1e-6f;
constexpr float LOG2E = 1.4426950408889634f;
constexpr int LISTCAP = NTOK;
constexpr int MAXTILES = NTOK / 256 + NE;

constexpr size_t MiB = 1u << 20;
constexpr size_t WS_CTL = 0, CTL_ZERO_BYTES = 1 * MiB;
constexpr size_t WS_WIN = 1 * MiB;
constexpr size_t WS_WUQ = 10 * MiB;
constexpr size_t WS_WUKV = 11 * MiB;
constexpr size_t WS_WOM = 12 * MiB;
constexpr size_t WS_WOS = 13 * MiB;
constexpr size_t WS_WOUT = 14 * MiB;
constexpr size_t WS_MOD = 16 * MiB;
constexpr size_t WS_H = 32 * MiB;
constexpr size_t WS_KVRAW = WS_H, WS_MERGED = WS_H;
constexpr size_t WS_SGA = 160 * MiB;
constexpr size_t WS_H2 = WS_SGA;
constexpr size_t WS_SGB = 288 * MiB;
constexpr size_t WS_WGU = WS_SGB;
constexpr size_t WS_SB = 416 * MiB;
constexpr size_t WS_WDN = 416 * MiB;
constexpr size_t WS_TOKL = 480 * MiB;
constexpr size_t WS_WL = 512 * MiB;
constexpr size_t WS_HID = 544 * MiB;
constexpr size_t WS_QL = 608 * MiB;
constexpr size_t WS_KVL = 656 * MiB;
constexpr size_t WS_KPE = 688 * MiB;
constexpr size_t WS_Q = 692 * MiB;
constexpr size_t WS_K = 788 * MiB;
constexpr size_t WS_OMLA = 884 * MiB;
constexpr size_t WS_OSB = 948 * MiB;
constexpr size_t WS_END = 1012 * MiB;
static_assert(WS_HID + (size_t)MAXTILES * 256 * 1024 * 2 <= 692 * MiB, "hid fits below Q (dead by then anyway)");
constexpr int CW_BAR = 4096;
constexpr int CW_CNT = 16384;

constexpr int RING_BYTES = 131072;
constexpr int LDSCTL_OFF = RING_BYTES + 1024;
constexpr int LC_BARST = 0;
constexpr int LC_TBASE = 64;
constexpr int LC_NE = 256;
constexpr int LC_TILEE = 512;
constexpr int LDS_BYTES = 147456;
static_assert(LC_TILEE + MAXTILES * 4 <= LDS_BYTES - LDSCTL_OFF, "lds ctl");

__device__ __forceinline__ unsigned cvt_pk_bf16(float lo, float hi) { unsigned r; asm volatile("v_cvt_pk_bf16_f32 %0, %1, %2" : "=v"(r) : "v"(lo), "v"(hi)); return r; }
__device__ __forceinline__ float bf_lo(unsigned u) { return __builtin_bit_cast(float, u << 16); }
__device__ __forceinline__ float bf_hi(unsigned u) { return __builtin_bit_cast(float, u & 0xffff0000u); }
__device__ __forceinline__ float fast_sigmoid(float x) { return __builtin_amdgcn_rcpf(1.f + __builtin_amdgcn_exp2f(-x * LOG2E)); }

namespace pg8 {
constexpr int BM = 256, BK = 64, HALF = 128, HTB = HALF * BK * 2, STAGE_BYTES = 8 * HTB, NXCD = 8, WGM = 8;
__host__ __device__ __forceinline__ int lds_byte(int r, int c) { const int st = (r >> 4) * 2 + (c >> 5), rr = r & 15, cc = c & 31, ob = rr * 64 + cc * 2; return st * 1024 + (ob ^ (((ob >> 9) & 1) << 5)); }
__host__ __device__ __forceinline__ void stage_rc(int b, int& R, int& C) { const int st = b / 1024, sb = b % 1024, swz = sb ^ (((sb >> 9) & 1) << 5); R = (st >> 1) * 16 + swz / 64; C = (st & 1) * 32 + (swz % 64) / 2; }
__host__ __device__ __forceinline__ int perm32(int rho) { const int n = rho >> 4, i = rho & 15; return 8 * (i >> 2) + 4 * n + (i & 3); }

struct Unit { int pm, pn, e, j0, ne; };

struct DenseOrder {
    const char* A; const char* Bt; int K; int nM, nN, nwg, G, c;
    __device__ void init(const void* A_, const void* Bt_, int M, int N, int K_, int G_, int c_) { A = (const char*)A_; Bt = (const char*)Bt_; K = K_; nM = M / BM; nN = N / BM; nwg = nM * nN; G = G_; c = c_; }
    __device__ __forceinline__ bool next(int i, Unit& u) const {
        const long L = (long)i * G + c; if (L >= nwg) return false;
        int wgid = (int)L; { const int q = nwg / NXCD, r = nwg % NXCD, xcd = wgid % NXCD, off = wgid / NXCD; wgid = (xcd < r ? xcd * (q + 1) : r * (q + 1) + (xcd - r) * q) + off; }
        const int nig = WGM * nN, gid = wgid / nig, fm = gid * WGM, gsz = (nM - fm) < WGM ? (nM - fm) : WGM;
        u.pm = fm + ((wgid % nig) % gsz); u.pn = (wgid % nig) / gsz; u.e = 0; u.j0 = 0; u.ne = 0; return true;
    }
    __device__ __forceinline__ const char* a_base(const Unit& u) const { return A + (size_t)u.pm * (size_t)(BM * 2) * K; }
    __device__ __forceinline__ const char* b_base(const Unit& u) const { return Bt + (size_t)u.pn * (size_t)(BM * 2) * K; }
    __device__ __forceinline__ unsigned row_of(const Unit&, int) const { return 0u; }
};

template <bool GATHER, class Epi, class Sched>
__device__ __forceinline__ void gemm_phase(LAS unsigned char* lds, const int K, const Sched& S, const Epi& E) {
    int tid_ = threadIdx.x; asm volatile("" : "+v"(tid_));
    const int tid = tid_, wid = __builtin_amdgcn_readfirstlane(tid >> 6), lane = tid & 63, wr = wid >> 2, wc = wid & 3, fr = lane & 15, fq = lane >> 4;
    const int nt = K / BK;
    int RA[2]; unsigned cofA[2], voffB[2];
#pragma unroll
    for (int i = 0; i < 2; ++i) { int R, C; stage_rc(tid * 16 + i * 8192, R, C); const int Rb = (R & ~31) + perm32(R & 31);
        RA[i] = R; cofA[i] = (unsigned)C * 2u; voffB[i] = (unsigned)(Rb * K + C) * 2u; }
    const size_t kstep = (size_t)(BK * 2);
    const size_t hstep = (size_t)HALF * K * 2;
    const unsigned ldsw = (unsigned)wid * 1024u;
    const int aoff = lds_byte(wr * 64 + fr, fq * 8), boff = lds_byte(wc * 32 + fr, fq * 8);
#define PG8_SA(b, h) (((b) * 2 + (h)) * HTB)
#define PG8_SB(b, h) ((4 + (b) * 2 + (h)) * HTB)
#define PG8_STAGE(bufoff, gbase, voff) do { _Pragma("unroll") for (int _i = 0; _i < 2; ++_i) \
        __builtin_amdgcn_global_load_lds((const unsigned*)((const char*)(gbase) + (voff)[_i]), (LAS unsigned*)(lds + (bufoff) + ldsw + _i * 8192), 16, 0, 0); } while (0)
#define PG8_LDA(dst, b, h) do { _Pragma("unroll") for (int m = 0; m < 4; ++m) _Pragma("unroll") for (int k = 0; k < 2; ++k) dst[m][k] = *(const LAS bf16x8*)(lds + PG8_SA(b, h) + aoff + m * 2048 + k * 1024); } while (0)
#define PG8_LDB(dst, b, h) do { _Pragma("unroll") for (int n = 0; n < 2; ++n) _Pragma("unroll") for (int k = 0; k < 2; ++k) dst[n][k] = *(const LAS bf16x8*)(lds + PG8_SB(b, h) + boff + n * 2048 + k * 1024); } while (0)
#define PG8_MMA(ai, bj, At, Bt) do { __builtin_amdgcn_s_setprio(1); _Pragma("unroll") for (int m = 0; m < 4; ++m) _Pragma("unroll") for (int n = 0; n < 2; ++n) _Pragma("unroll") for (int k = 0; k < 2; ++k) \
        acc[ai][bj][m][n] = __builtin_amdgcn_mfma_f32_16x16x32_bf16(Bt[n][k], At[m][k], acc[ai][bj][m][n], 0, 0, 0); __builtin_amdgcn_s_setprio(0); } while (0)
#define PG8_WAIT_V(n) asm volatile("s_waitcnt vmcnt(" #n ")" ::: "memory")
#define PG8_WAIT_L(n) asm volatile("s_waitcnt lgkmcnt(" #n ")" ::: "memory")
#define PG8_BAR __builtin_amdgcn_s_barrier()
#define PG8_SCHED __builtin_amdgcn_sched_barrier(0)
#define PG8_AOFFS(dst, u) do { _Pragma("unroll") for (int _h = 0; _h < 2; ++_h) _Pragma("unroll") for (int _i = 0; _i < 2; ++_i) { \
        const unsigned _row = GATHER ? S.row_of(u, _h * HALF + RA[_i]) : (unsigned)(_h * HALF + RA[_i]); dst[_h][_i] = _row * (unsigned)(K * 2) + cofA[_i]; } } while (0)
    Unit cur, nxt; int ui = 0;
    if (!S.next(0, cur)) return;
    f32x4 acc[2][2][4][2];
#pragma unroll
    for (int a = 0; a < 2; ++a)
#pragma unroll
        for (int b = 0; b < 2; ++b)
#pragma unroll
            for (int m = 0; m < 4; ++m)
#pragma unroll
                for (int n = 0; n < 2; ++n) acc[a][b][m][n] = (f32x4){0.f, 0.f, 0.f, 0.f};
    bf16x8 At[4][2], B0[2][2], B1[2][2];
    unsigned oc[2][2], on[2][2];
    PG8_AOFFS(oc, cur);
    const char* cA = S.a_base(cur); const char* cB = S.b_base(cur);
    PG8_STAGE(PG8_SB(0, 0), cB, voffB); PG8_STAGE(PG8_SB(0, 1), cB + hstep, voffB); PG8_STAGE(PG8_SA(0, 0), cA, oc[0]); PG8_STAGE(PG8_SA(0, 1), cA, oc[1]);
    if (wr == 1) PG8_BAR;
    PG8_WAIT_V(2); PG8_BAR;
    PG8_STAGE(PG8_SB(1, 0), cB + kstep, voffB); PG8_STAGE(PG8_SA(1, 0), cA + kstep, oc[0]); PG8_STAGE(PG8_SB(1, 1), cB + hstep + kstep, voffB);
    PG8_WAIT_V(6); PG8_BAR;
    for (;;) {
        const bool has_next = S.next(ui + 1, nxt);
        const char* nA = has_next ? S.a_base(nxt) : cA; const char* nB = has_next ? S.b_base(nxt) : cB;
        if constexpr (GATHER) { if (has_next) { PG8_AOFFS(on, nxt);
            _Pragma("unroll") for (int _h = 0; _h < 2; ++_h) _Pragma("unroll") for (int _i = 0; _i < 2; ++_i) asm volatile("" : "+v"(on[_h][_i]));
          } else {
#pragma unroll
            for (int _h = 0; _h < 2; ++_h)
#pragma unroll
                for (int _i = 0; _i < 2; ++_i) on[_h][_i] = oc[_h][_i]; } }
#pragma nounroll
        for (int t = 0; t < nt; t += 2) {
            const bool last = (t == nt - 2);
            const char* a1 = cA + (size_t)(t + 1) * kstep;
            const char* a2 = last ? nA : cA + (size_t)(t + 2) * kstep; const char* b2 = last ? nB : cB + (size_t)(t + 2) * kstep;
            const char* a3 = a2 + kstep; const char* b3 = b2 + kstep;
            unsigned o2[2][2];
#pragma unroll
            for (int _h = 0; _h < 2; ++_h)
#pragma unroll
                for (int _i = 0; _i < 2; ++_i) o2[_h][_i] = (GATHER && last) ? on[_h][_i] : oc[_h][_i];
            PG8_LDB(B0, 0, 0); PG8_LDB(B1, 0, 1); PG8_SCHED; PG8_LDA(At, 0, 0); PG8_STAGE(PG8_SA(1, 1), a1, oc[1]);
            PG8_WAIT_V(8); PG8_WAIT_L(0); PG8_BAR; PG8_MMA(0, 0, At, B0); PG8_MMA(0, 1, At, B1); PG8_BAR; PG8_SCHED;
            PG8_LDA(At, 0, 1); PG8_STAGE(PG8_SB(0, 0), b2, voffB); PG8_STAGE(PG8_SB(0, 1), b2 + hstep, voffB); PG8_STAGE(PG8_SA(0, 0), a2, o2[0]);
            PG8_WAIT_V(8); PG8_WAIT_L(0); PG8_BAR; PG8_MMA(1, 0, At, B0); PG8_MMA(1, 1, At, B1); PG8_BAR; PG8_SCHED;
            PG8_LDB(B0, 1, 0); PG8_LDB(B1, 1, 1); PG8_SCHED; PG8_LDA(At, 1, 0); PG8_STAGE(PG8_SA(0, 1), a2, o2[1]);
            PG8_WAIT_V(8); PG8_WAIT_L(0); PG8_BAR; PG8_MMA(0, 0, At, B0); PG8_MMA(0, 1, At, B1); PG8_BAR; PG8_SCHED;
            PG8_LDA(At, 1, 1); PG8_STAGE(PG8_SB(1, 0), b3, voffB); PG8_STAGE(PG8_SB(1, 1), b3 + hstep, voffB); PG8_STAGE(PG8_SA(1, 0), a3, o2[0]);
            PG8_WAIT_V(8); PG8_WAIT_L(0); PG8_BAR; PG8_MMA(1, 0, At, B0); PG8_MMA(1, 1, At, B1); PG8_BAR; PG8_SCHED;
        }
        if (wr == 0) PG8_BAR;
        E(acc, cur, wr, wc, fr, fq);
        if (!has_next) break;
#pragma unroll
        for (int a = 0; a < 2; ++a)
#pragma unroll
            for (int b = 0; b < 2; ++b)
#pragma unroll
                for (int m = 0; m < 4; ++m)
#pragma unroll
                    for (int n = 0; n < 2; ++n) acc[a][b][m][n] = (f32x4){0.f, 0.f, 0.f, 0.f};
        cur = nxt; cA = nA; cB = nB; ++ui;
        if constexpr (GATHER) {
#pragma unroll
        for (int _h = 0; _h < 2; ++_h)
#pragma unroll
            for (int _i = 0; _i < 2; ++_i) oc[_h][_i] = on[_h][_i]; }
        if (wr == 1) PG8_BAR;
    }
    PG8_WAIT_V(0);
    PG8_BAR;
#undef PG8_SA
#undef PG8_SB
#undef PG8_STAGE
#undef PG8_LDA
#undef PG8_LDB
#undef PG8_MMA
#undef PG8_WAIT_V
#undef PG8_WAIT_L
#undef PG8_BAR
#undef PG8_SCHED
#undef PG8_AOFFS
}
template <bool GATHER, class Epi, class Sched>
__device__ __forceinline__ void gemm_phase_f8(LAS unsigned char* lds, const int K, const Sched& S, const Epi& E) {
    int tid_ = threadIdx.x; asm volatile("" : "+v"(tid_));
    const int tid = tid_, wid = __builtin_amdgcn_readfirstlane(tid >> 6), lane = tid & 63, wr = wid >> 2, wc = wid & 3, fr = lane & 15, fq = lane >> 4;
    const int nt = K / BK;
    int RA[2]; unsigned cofA[2], voffB[2];
#pragma unroll
    for (int i = 0; i < 2; ++i) { int R, C; stage_rc(tid * 16 + i * 8192, R, C); const int Rb = (R & ~31) + perm32(R & 31);
        RA[i] = R; cofA[i] = (unsigned)C * 2u; voffB[i] = (unsigned)(Rb * K + C) * 2u; }
    const size_t kstep = (size_t)(BK * 2);
    const size_t hstep = (size_t)HALF * K * 2;
    const unsigned ldsw = (unsigned)wid * 1024u;
    const int aoff = lds_byte(wr * 64 + fr, 16 * (fq & 1)) + (fq >> 1) * 1024, boff = lds_byte(wc * 32 + fr, 16 * (fq & 1)) + (fq >> 1) * 1024;
#define PG8_SA(b, h) (((b) * 2 + (h)) * HTB)
#define PG8_SB(b, h) ((4 + (b) * 2 + (h)) * HTB)
#define PG8_STAGE(bufoff, gbase, voff) do { _Pragma("unroll") for (int _i = 0; _i < 2; ++_i) \
        __builtin_amdgcn_global_load_lds((const unsigned*)((const char*)(gbase) + (voff)[_i]), (LAS unsigned*)(lds + (bufoff) + ldsw + _i * 8192), 16, 0, 0); } while (0)
#define PG8_LD32(p_) __builtin_shufflevector(*(const LAS u32x4*)(p_), *(const LAS u32x4*)((p_) + 16), 0, 1, 2, 3, 4, 5, 6, 7)
#define PG8_LDA(dst, b, h) do { _Pragma("unroll") for (int m = 0; m < 4; ++m) dst[m] = PG8_LD32(lds + PG8_SA(b, h) + aoff + m * 2048); } while (0)
#define PG8_LDB(dst, b, h) do { _Pragma("unroll") for (int n = 0; n < 2; ++n) dst[n] = PG8_LD32(lds + PG8_SB(b, h) + boff + n * 2048); } while (0)
#define PG8_F8(fr_) ((v8i){(int)fr_[0][0], (int)fr_[0][1], (int)fr_[0][2], (int)fr_[0][3], (int)fr_[1][0], (int)fr_[1][1], (int)fr_[1][2], (int)fr_[1][3]})
#define PG8_MMA(ai, bj, At, Bt) do { __builtin_amdgcn_s_setprio(1); _Pragma("unroll") for (int m = 0; m < 4; ++m) _Pragma("unroll") for (int n = 0; n < 2; ++n) \
        asm volatile("v_mfma_scale_f32_16x16x128_f8f6f4 %0, %1, %2, %0, %3, %3 op_sel_hi:[0,0,0]" : "+v"(acc[ai][bj][m][n]) : "v"(Bt[n]), "v"(At[m]), "v"(one_scale)); __builtin_amdgcn_s_setprio(0); } while (0)
#define PG8_WAIT_V(n) asm volatile("s_waitcnt vmcnt(" #n ")" ::: "memory")
#define PG8_WAIT_L(n) asm volatile("s_waitcnt lgkmcnt(" #n ")" ::: "memory")
#define PG8_BAR __builtin_amdgcn_s_barrier()
#define PG8_SCHED __builtin_amdgcn_sched_barrier(0)
#define PG8_AOFFS(dst, u) do { _Pragma("unroll") for (int _h = 0; _h < 2; ++_h) _Pragma("unroll") for (int _i = 0; _i < 2; ++_i) { \
        const unsigned _row = GATHER ? S.row_of(u, _h * HALF + RA[_i]) : (unsigned)(_h * HALF + RA[_i]); dst[_h][_i] = _row * (unsigned)(K * 2) + cofA[_i]; } } while (0)
    Unit cur, nxt; int ui = 0;
    if (!S.next(0, cur)) return;
    f32x4 acc[2][2][4][2];
#pragma unroll
    for (int a = 0; a < 2; ++a)
#pragma unroll
        for (int b = 0; b < 2; ++b)
#pragma unroll
            for (int m = 0; m < 4; ++m)
#pragma unroll
                for (int n = 0; n < 2; ++n) { acc[a][b][m][n] = (f32x4){0.f, 0.f, 0.f, 0.f}; asm volatile("" : "+v"(acc[a][b][m][n])); }
    u32x8 At[4], B0[2], B1[2];
    int one_scale = 0x7f7f7f7f; asm volatile("" : "+v"(one_scale));
    unsigned oc[2][2], on[2][2];
    PG8_AOFFS(oc, cur);
    const char* cA = S.a_base(cur); const char* cB = S.b_base(cur);
    PG8_STAGE(PG8_SB(0, 0), cB, voffB); PG8_STAGE(PG8_SB(0, 1), cB + hstep, voffB); PG8_STAGE(PG8_SA(0, 0), cA, oc[0]); PG8_STAGE(PG8_SA(0, 1), cA, oc[1]);
    if (wr == 1) PG8_BAR;
    PG8_WAIT_V(2); PG8_BAR;
    PG8_STAGE(PG8_SB(1, 0), cB + kstep, voffB); PG8_STAGE(PG8_SA(1, 0), cA + kstep, oc[0]); PG8_STAGE(PG8_SB(1, 1), cB + hstep + kstep, voffB);
    PG8_WAIT_V(6); PG8_BAR;
    for (;;) {
        const bool has_next = S.next(ui + 1, nxt);
        const char* nA = has_next ? S.a_base(nxt) : cA; const char* nB = has_next ? S.b_base(nxt) : cB;
        if constexpr (GATHER) { if (has_next) { PG8_AOFFS(on, nxt);
            _Pragma("unroll") for (int _h = 0; _h < 2; ++_h) _Pragma("unroll") for (int _i = 0; _i < 2; ++_i) asm volatile("" : "+v"(on[_h][_i]));
          } else {
#pragma unroll
            for (int _h = 0; _h < 2; ++_h)
#pragma unroll
                for (int _i = 0; _i < 2; ++_i) on[_h][_i] = oc[_h][_i]; } }
#pragma nounroll
        for (int t = 0; t < nt; t += 2) {
            const bool last = (t == nt - 2);
            const char* a1 = cA + (size_t)(t + 1) * kstep;
            const char* a2 = last ? nA : cA + (size_t)(t + 2) * kstep; const char* b2 = last ? nB : cB + (size_t)(t + 2) * kstep;
            const char* a3 = a2 + kstep; const char* b3 = b2 + kstep;
            unsigned o2[2][2];
#pragma unroll
            for (int _h = 0; _h < 2; ++_h)
#pragma unroll
                for (int _i = 0; _i < 2; ++_i) o2[_h][_i] = (GATHER && last) ? on[_h][_i] : oc[_h][_i];
            PG8_LDB(B0, 0, 0); PG8_LDB(B1, 0, 1); PG8_SCHED; PG8_LDA(At, 0, 0); PG8_STAGE(PG8_SA(1, 1), a1, oc[1]);
            PG8_WAIT_V(8); PG8_WAIT_L(0); PG8_BAR; PG8_MMA(0, 0, At, B0); PG8_MMA(0, 1, At, B1); PG8_BAR; PG8_SCHED;
            PG8_LDA(At, 0, 1); PG8_STAGE(PG8_SB(0, 0), b2, voffB); PG8_STAGE(PG8_SB(0, 1), b2 + hstep, voffB); PG8_STAGE(PG8_SA(0, 0), a2, o2[0]);
            PG8_WAIT_V(8); PG8_WAIT_L(0); PG8_BAR; PG8_MMA(1, 0, At, B0); PG8_MMA(1, 1, At, B1); PG8_BAR; PG8_SCHED;
            PG8_LDB(B0, 1, 0); PG8_LDB(B1, 1, 1); PG8_SCHED; PG8_LDA(At, 1, 0); PG8_STAGE(PG8_SA(0, 1), a2, o2[1]);
            PG8_WAIT_V(8); PG8_WAIT_L(0); PG8_BAR; PG8_MMA(0, 0, At, B0); PG8_MMA(0, 1, At, B1); PG8_BAR; PG8_SCHED;
            PG8_LDA(At, 1, 1); PG8_STAGE(PG8_SB(1, 0), b3, voffB); PG8_STAGE(PG8_SB(1, 1), b3 + hstep, voffB); PG8_STAGE(PG8_SA(1, 0), a3, o2[0]);
            PG8_WAIT_V(8); PG8_WAIT_L(0); PG8_BAR; PG8_MMA(1, 0, At, B0); PG8_MMA(1, 1, At, B1); PG8_BAR; PG8_SCHED;
        }
        asm volatile("s_nop 15\n\ts_nop 15" ::: "memory");
        if (wr == 0) PG8_BAR;
        E(acc, cur, wr, wc, fr, fq);
        if (!has_next) break;
#pragma unroll
        for (int a = 0; a < 2; ++a)
#pragma unroll
            for (int b = 0; b < 2; ++b)
#pragma unroll
                for (int m = 0; m < 4; ++m)
#pragma unroll
                    for (int n = 0; n < 2; ++n) { acc[a][b][m][n] = (f32x4){0.f, 0.f, 0.f, 0.f}; asm volatile("" : "+v"(acc[a][b][m][n])); }
        cur = nxt; cA = nA; cB = nB; ++ui;
        if constexpr (GATHER) {
#pragma unroll
        for (int _h = 0; _h < 2; ++_h)
#pragma unroll
            for (int _i = 0; _i < 2; ++_i) oc[_h][_i] = on[_h][_i]; }
        if (wr == 1) PG8_BAR;
    }
    PG8_WAIT_V(0);
    PG8_BAR;
#undef PG8_SA
#undef PG8_SB
#undef PG8_STAGE
#undef PG8_LDA
#undef PG8_LDB
#undef PG8_MMA
#undef PG8_WAIT_V
#undef PG8_WAIT_L
#undef PG8_BAR
#undef PG8_SCHED
#undef PG8_AOFFS
#undef PG8_F8
}
}
#define XB_TMO      128
#define XB_XCNT(j)  (256  + 64 * (j))
#define XB_XSUB(j)  (1280 + 64 * (j))
#define XB_XGEN(j)  (2304 + 64 * (j))
#define XB_TOP      3328
#define XB_TOPGEN   3392
#define XCD_BAR_WORDS 3456
#define XB_SPIN_CAP (1u << 18)

__device__ __forceinline__ unsigned xb_ld(unsigned* p)              { return __hip_atomic_load(p, __ATOMIC_RELAXED, __HIP_MEMORY_SCOPE_AGENT); }
__device__ __forceinline__ unsigned xb_add(unsigned* p, unsigned v) { return __hip_atomic_fetch_add(p, v, __ATOMIC_RELAXED, __HIP_MEMORY_SCOPE_AGENT); }
__device__ __forceinline__ unsigned xb_xcc_id() { return (unsigned)__builtin_amdgcn_s_getreg((3 << 11) | 20) & 0xFu; }
#define XB_SPIN(cond, bar) do { unsigned _sp = 0; while (cond) { __builtin_amdgcn_s_sleep(1); \
    if ((++_sp & 255u) == 0u) { if (xb_ld(&(bar)[XB_TMO])) break; if (_sp > XB_SPIN_CAP) { atomicAdd(&(bar)[XB_TMO], 1u); break; } } } } while (0)

struct XcdBarrier {
    unsigned* bar; unsigned x;
    volatile LAS unsigned* st;
};

__device__ __forceinline__ XcdBarrier xcd_barrier_post(unsigned* bar, volatile LAS unsigned* st) {
    XcdBarrier b; b.bar = bar; b.x = xb_xcc_id(); b.st = st;
    if (threadIdx.x == 0) (void)xb_add(&bar[XB_XCNT(b.x)], 1u);
    return b;
}
__device__ __forceinline__ void xcd_barrier_complete(unsigned* bar, unsigned x, unsigned& nloc, unsigned& nx) {
    const unsigned G = gridDim.x * gridDim.y * gridDim.z;
    unsigned sum, cnt, mine, sp = 0u;
    for (;;) {
        sum = 0u; cnt = 0u; mine = 0u;
#pragma unroll
        for (unsigned j = 0; j < 16; ++j) { const unsigned c = xb_ld(&bar[XB_XCNT(j)]); sum += c; cnt += (c > 0u) ? 1u : 0u; mine = (j == x) ? c : mine; }
        if (sum == G) break;
        __builtin_amdgcn_s_sleep(1);
        if ((++sp & 255u) == 0u) { if (xb_ld(&bar[XB_TMO])) break; if (sp > XB_SPIN_CAP) { atomicAdd(&bar[XB_TMO], 1u); break; } }
    }
    nloc = mine > 0u ? mine : 1u; nx = cnt > 0u ? cnt : 1u;
}

__device__ __forceinline__ void xcd_barrier(const XcdBarrier& b) {
    asm volatile("s_waitcnt vmcnt(0)" ::: "memory");
    __syncthreads();
    if (threadIdx.x == 0) {
        unsigned* bar = b.bar;
        __builtin_amdgcn_s_waitcnt(0);
        unsigned nloc = b.st[0], nx = b.st[1];
        if (nloc == 0u) { xcd_barrier_complete(bar, b.x, nloc, nx); b.st[0] = nloc; b.st[1] = nx; }
        const unsigned old = xb_add(&bar[XB_XSUB(b.x)], 1u);
        const unsigned gen = old / nloc;
        if (old + 1u == (gen + 1u) * nloc) {
            __builtin_amdgcn_fence(__ATOMIC_RELEASE, "agent");
            asm volatile("s_waitcnt vmcnt(0)" ::: "memory");
            const unsigned og = xb_add(&bar[XB_TOP], 1u);
            const unsigned tg = og / nx;
            if (og + 1u == (tg + 1u) * nx) xb_add(&bar[XB_TOPGEN], 1u);
            else XB_SPIN(xb_ld(&bar[XB_TOPGEN]) == tg, bar);
            __builtin_amdgcn_fence(__ATOMIC_ACQUIRE, "agent");
            xb_add(&bar[XB_XGEN(b.x)], 1u);
            asm volatile("s_waitcnt vmcnt(0)" ::: "memory");
        } else {
            XB_SPIN(xb_ld(&bar[XB_XGEN(b.x)]) == gen, bar);
            __builtin_amdgcn_fence(__ATOMIC_ACQUIRE, "agent");
            asm volatile("s_waitcnt vmcnt(0)" ::: "memory");
        }
    }
    __syncthreads();
}

#define LDS_WAIT() asm volatile("s_waitcnt lgkmcnt(0)" ::: "memory")
#define VM_WAIT() asm volatile("s_waitcnt vmcnt(0)" ::: "memory")
#define MFMA32(a, b, c) __builtin_amdgcn_mfma_f32_32x32x16_bf16((a), (b), (c), 0, 0, 0)
__device__ __forceinline__ float wave_sum(float v) {
#pragma unroll
    for (int o = 1; o < 64; o <<= 1) v += __shfl_xor(v, o);
    return v;
}
__device__ __forceinline__ int crow(int i, int hh) { return (i & 3) + 8 * (i >> 2) + 4 * hh; }
__device__ __forceinline__ bf16x8 pack8(float a0, float a1, float a2, float a3, float a4, float a5, float a6, float a7) {
    u32x4 p; p.x = cvt_pk_bf16(a0, a1); p.y = cvt_pk_bf16(a2, a3); p.z = cvt_pk_bf16(a4, a5); p.w = cvt_pk_bf16(a6, a7);
    return __builtin_bit_cast(bf16x8, p);
}

struct Ctx {
    LAS unsigned char* lds;
    int tid, lane, wave, vcu, G;
};

__device__ __forceinline__ void transpose_item(const float* W, int K, int N, bf16_t* WT, int k0, int n0, int drow0, LAS float* scr, int lane) {
#pragma unroll 8
    for (int i = 0; i < 32; ++i) { const int kk = 2 * i + (lane >> 5); scr[kk * 33 + (lane & 31)] = W[(size_t)(k0 + kk) * N + n0 + (lane & 31)]; }
    LDS_WAIT(); asm volatile("" ::: "memory");
    const int c = lane & 7;
#pragma unroll
    for (int j = 0; j < 4; ++j) { const int n = (lane >> 3) + 8 * j; const LAS float* s = scr + (8 * c) * 33 + n;
        u32x4 o; o.x = cvt_pk_bf16(s[0 * 33], s[1 * 33]); o.y = cvt_pk_bf16(s[2 * 33], s[3 * 33]); o.z = cvt_pk_bf16(s[4 * 33], s[5 * 33]); o.w = cvt_pk_bf16(s[6 * 33], s[7 * 33]);
        *(GAS u32x4*)(WT + (size_t)(drow0 + n) * K + k0 + 8 * c) = o; }
    LDS_WAIT(); asm volatile("" ::: "memory");
}

__device__ __forceinline__ unsigned pk4_fp8(float a, float b, float c, float d) { int p = __builtin_amdgcn_cvt_pk_fp8_f32(a, b, 0, false); p = __builtin_amdgcn_cvt_pk_fp8_f32(c, d, p, true); return (unsigned)p; }
__device__ __forceinline__ void transpose_item_f8(const float* W, int K, int N, unsigned char* WT, int k0, int n0, int drow0, float scl, LAS float* scr, int lane) {
#pragma unroll 8
    for (int i = 0; i < 32; ++i) { const int kk = 2 * i + (lane >> 5); scr[kk * 33 + (lane & 31)] = W[(size_t)(k0 + kk) * N + n0 + (lane & 31)]; }
    LDS_WAIT(); asm volatile("" ::: "memory");
    const int c = lane & 7;
#pragma unroll
    for (int j = 0; j < 4; ++j) { const int n = (lane >> 3) + 8 * j; const LAS float* s = scr + (8 * c) * 33 + n;
        u32x2 o; o.x = pk4_fp8(s[0 * 33] * scl, s[1 * 33] * scl, s[2 * 33] * scl, s[3 * 33] * scl); o.y = pk4_fp8(s[4 * 33] * scl, s[5 * 33] * scl, s[6 * 33] * scl, s[7 * 33] * scl);
        *(GAS u32x2*)(WT + (size_t)(drow0 + n) * K + k0 + 8 * c) = o; }
    LDS_WAIT(); asm volatile("" ::: "memory");
}

typedef const f32x4 (&AccRef)[2][2][4][2];

struct EpiNull { __device__ __forceinline__ void operator()(AccRef acc, const pg8::Unit& u, int wr, int wc, int fr, int fq) const {
        float s = 0.f;
#pragma unroll
        for (int ai = 0; ai < 2; ++ai)
#pragma unroll
            for (int bj = 0; bj < 2; ++bj)
#pragma unroll
                for (int m = 0; m < 4; ++m)
#pragma unroll
                    for (int n = 0; n < 2; ++n) s += acc[ai][bj][m][n][0] + acc[ai][bj][m][n][1] + acc[ai][bj][m][n][2] + acc[ai][bj][m][n][3];
        asm volatile("" :: "v"(s)); } };
struct EpiStore {
    bf16_t* O; int ldc;
    __device__ __forceinline__ void operator()(AccRef acc, const pg8::Unit& u, int wr, int wc, int fr, int fq) const {
        const int row0 = u.pm * 256 + wr * 64 + fr, col0 = u.pn * 256 + wc * 32 + 8 * fq;
#pragma unroll
        for (int ai = 0; ai < 2; ++ai)
#pragma unroll
            for (int m = 0; m < 4; ++m) { bf16_t* rowp = O + (size_t)(row0 + ai * 128 + m * 16) * ldc + col0;
#pragma unroll
                for (int bj = 0; bj < 2; ++bj) { const f32x4 v0 = acc[ai][bj][m][0], v1 = acc[ai][bj][m][1];
                    u32x4 w; w.x = cvt_pk_bf16(v0[0], v0[1]); w.y = cvt_pk_bf16(v0[2], v0[3]); w.z = cvt_pk_bf16(v1[0], v1[1]); w.w = cvt_pk_bf16(v1[2], v1[3]);
                    *(u32x4*)(rowp + bj * 128) = w; } }
    }
};

struct EpiProj {
    bf16_t *QL, *KVL, *KPE, *SB, *SGA, *SGB;
    __device__ __forceinline__ void operator()(AccRef acc, const pg8::Unit& u, int wr, int wc, int fr, int fq) const {
        const int row0 = u.pm * 256 + wr * 64 + fr;
#pragma unroll
        for (int bj = 0; bj < 2; ++bj) {
            const int cg = u.pn * 256 + bj * 128 + wc * 32;
            bf16_t* base; int ld, co; bool sig = false;
            if (cg < 384) { base = QL; ld = 384; co = cg; }
            else if (cg < 640) { base = KVL; ld = 256; co = cg - 384; }
            else if (cg < 672) { base = KPE; ld = 32; co = cg - 640; }
            else if (cg < 768) { continue; }
            else if (cg < 2304) { base = SB; ld = 1536; co = cg - 768; }
            else if (cg < 3328) { base = SGA; ld = 1024; co = cg - 2304; sig = true; }
            else { base = SGB; ld = 1024; co = cg - 3328; sig = true; }
#pragma unroll
            for (int ai = 0; ai < 2; ++ai)
#pragma unroll
                for (int m = 0; m < 4; ++m) { f32x4 v0 = acc[ai][bj][m][0], v1 = acc[ai][bj][m][1];
                    if (sig) {
#pragma unroll
                        for (int j = 0; j < 4; ++j) { v0[j] = fast_sigmoid(v0[j]); v1[j] = fast_sigmoid(v1[j]); } }
                    u32x4 w; w.x = cvt_pk_bf16(v0[0], v0[1]); w.y = cvt_pk_bf16(v0[2], v0[3]); w.z = cvt_pk_bf16(v1[0], v1[1]); w.w = cvt_pk_bf16(v1[2], v1[3]);
                    *(u32x4*)(base + (size_t)(row0 + ai * 128 + m * 16) * ld + co + 8 * fq) = w; }
        }
    }
};

template <bool SECOND> struct EpiMerge {
    bf16_t* MG; const bf16_t* SG;
    __device__ __forceinline__ void operator()(AccRef acc, const pg8::Unit& u, int wr, int wc, int fr, int fq) const {
        const int row0 = u.pm * 256 + wr * 64 + fr, col0 = u.pn * 256 + wc * 32 + 8 * fq;
#pragma unroll
        for (int ai = 0; ai < 2; ++ai)
#pragma unroll
            for (int m = 0; m < 4; ++m) { const size_t ro = (size_t)(row0 + ai * 128 + m * 16) * 1024 + col0;
#pragma unroll
                for (int bj = 0; bj < 2; ++bj) { const f32x4 v0 = acc[ai][bj][m][0], v1 = acc[ai][bj][m][1];
                    const u32x4 g = *(const u32x4*)(SG + ro + bj * 128);
                    float r0 = bf_lo(g.x) * v0[0], r1 = bf_hi(g.x) * v0[1], r2 = bf_lo(g.y) * v0[2], r3 = bf_hi(g.y) * v0[3];
                    float r4 = bf_lo(g.z) * v1[0], r5 = bf_hi(g.z) * v1[1], r6 = bf_lo(g.w) * v1[2], r7 = bf_hi(g.w) * v1[3];
                    if (SECOND) { const u32x4 p = *(const u32x4*)(MG + ro + bj * 128);
                        r0 += bf_lo(p.x); r1 += bf_hi(p.x); r2 += bf_lo(p.y); r3 += bf_hi(p.y); r4 += bf_lo(p.z); r5 += bf_hi(p.z); r6 += bf_lo(p.w); r7 += bf_hi(p.w); }
                    u32x4 w; w.x = cvt_pk_bf16(r0, r1); w.y = cvt_pk_bf16(r2, r3); w.z = cvt_pk_bf16(r4, r5); w.w = cvt_pk_bf16(r6, r7);
                    *(u32x4*)(MG + ro + bj * 128) = w; } }
    }
};

struct EpiWout {
    const float* X; float* OUT; const float* MOD;
    __device__ __forceinline__ void operator()(AccRef acc, const pg8::Unit& u, int wr, int wc, int fr, int fq) const {
        const int row0 = u.pm * 256 + wr * 64 + fr, col0 = u.pn * 256 + wc * 32 + 8 * fq;
        const float* ga = MOD + (size_t)(u.pm >> 3) * 6144 + 2048 + col0;
        f32x4 g[2][2];
#pragma unroll
        for (int bj = 0; bj < 2; ++bj)
#pragma unroll
            for (int n = 0; n < 2; ++n) g[bj][n] = *(const f32x4*)(ga + bj * 128 + 4 * n);
#pragma unroll
        for (int ai = 0; ai < 2; ++ai)
#pragma unroll
            for (int m = 0; m < 4; ++m) { const size_t ro = (size_t)(row0 + ai * 128 + m * 16) * 1024 + col0;
#pragma unroll
                for (int bj = 0; bj < 2; ++bj)
#pragma unroll
                    for (int n = 0; n < 2; ++n) { const f32x4 xv = *(const f32x4*)(X + ro + bj * 128 + 4 * n);
                        *(f32x4*)(OUT + ro + bj * 128 + 4 * n) = xv + g[bj][n] * acc[ai][bj][m][n]; } }
    }
};

constexpr float WSCALE = 32.f, WDESCALE = 1.f / 32.f;
struct EpiGateUp {
    unsigned char* HID; const float* BGU;
    __device__ __forceinline__ void operator()(AccRef acc, const pg8::Unit& u, int wr, int wc, int fr, int fq) const {
        const int row0 = u.pm * 256 + wr * 64 + fr, hc = u.pn * 128 + wc * 32 + 8 * fq;
        const float* bg = BGU + (size_t)u.e * 2048 + hc;
        f32x4 bgate[2], bup[2];
#pragma unroll
        for (int n = 0; n < 2; ++n) { bgate[n] = *(const f32x4*)(bg + 4 * n); bup[n] = *(const f32x4*)(bg + 1024 + 4 * n); }
#pragma unroll
        for (int ai = 0; ai < 2; ++ai)
#pragma unroll
            for (int m = 0; m < 4; ++m) { float r[8];
#pragma unroll
                for (int n = 0; n < 2; ++n) { const f32x4 gv = acc[ai][0][m][n] * WDESCALE + bgate[n], uv = acc[ai][1][m][n] * WDESCALE + bup[n];
#pragma unroll
                    for (int j = 0; j < 4; ++j) { const float g = __builtin_fminf(gv[j], 7.f); const float up = __builtin_fminf(__builtin_fmaxf(uv[j], -7.f), 7.f);
                        r[4 * n + j] = (up + 1.f) * (g * fast_sigmoid(1.702f * g)); } }
                u32x2 w; w.x = pk4_fp8(r[0], r[1], r[2], r[3]); w.y = pk4_fp8(r[4], r[5], r[6], r[7]);
                *(u32x2*)(HID + (size_t)(row0 + ai * 128 + m * 16) * 1024 + hc) = w; asm volatile("" ::: "memory"); }
    }
};

struct EpiDown {
    float* OUT; const float* BDN; const float* MOD; const int* TOKL; const float* WL;
    __device__ __forceinline__ void operator()(AccRef acc, const pg8::Unit& u, int wr, int wc, int fr, int fq) const {
        const int col0 = u.pn * 256 + wc * 32 + 8 * fq;
        const float* bd = BDN + (size_t)u.e * 1024 + col0;
        f32x4 b4[2][2];
#pragma unroll
        for (int bj = 0; bj < 2; ++bj)
#pragma unroll
            for (int n = 0; n < 2; ++n) b4[bj][n] = *(const f32x4*)(bd + bj * 128 + 4 * n);
        const int* tl = TOKL + (size_t)u.e * LISTCAP; const float* wl = WL + (size_t)u.e * LISTCAP;
#pragma unroll
        for (int ai = 0; ai < 2; ++ai)
#pragma unroll
            for (int m = 0; m < 4; ++m) { const int slot = u.j0 + ai * 128 + wr * 64 + m * 16 + fr;
                if (slot < u.ne) { const int tok = tl[slot]; const float wgt = wl[slot];
                    const float* ga = MOD + (size_t)(tok >> 11) * 6144 + 5120 + col0; float* op = OUT + (size_t)tok * 1024 + col0;
#pragma unroll
                    for (int bj = 0; bj < 2; ++bj)
#pragma unroll
                        for (int n = 0; n < 2; ++n) { const f32x4 g = *(const f32x4*)(ga + bj * 128 + 4 * n); const f32x4 o = *(const f32x4*)(op + bj * 128 + 4 * n);
                            *(f32x4*)(op + bj * 128 + 4 * n) = o + g * ((acc[ai][bj][m][n] * WDESCALE + b4[bj][n]) * wgt); } }
                asm volatile("" ::: "memory"); }
    }
};

template <int NPN, bool GATHER> struct MoeOrder {
    const char* A; const char* Bt; size_t estride; const int* lists; int G, c; const LAS int* tbase; const LAS int* nearr; const LAS int* tilee;
    __device__ __forceinline__ bool next(int i, pg8::Unit& u) const {
        const int L = i * G + c, T = L / NPN; const int total = __builtin_amdgcn_readfirstlane(tbase[NE]);
        if (T >= total) return false;
        const int e = __builtin_amdgcn_readfirstlane(tilee[T]);
        u.pm = T; u.pn = L % NPN; u.e = e; u.j0 = (T - __builtin_amdgcn_readfirstlane(tbase[e])) * 256; u.ne = __builtin_amdgcn_readfirstlane(nearr[e]); return true;
    }
    __device__ __forceinline__ const char* a_base(const pg8::Unit& u) const { return GATHER ? A : A + (size_t)u.pm * (size_t)(256 * 1024); }
    __device__ __forceinline__ const char* b_base(const pg8::Unit& u) const { return Bt + (size_t)u.e * estride + (size_t)u.pn * (size_t)(256 * 1024); }
    __device__ __forceinline__ unsigned row_of(const pg8::Unit& u, int r) const { const int slot = u.j0 + r; return slot < u.ne ? (unsigned)lists[(size_t)u.e * LISTCAP + slot] : 0u; }
};

constexpr int ATT_KBYTES = 12 * 1024;
constexpr int ATT_VPITCH = 136;
constexpr int ATT_VBYTES = 64 * ATT_VPITCH;
constexpr int ATT_BUF = ATT_KBYTES + ATT_VBYTES;
constexpr int ATT_WS = 2 * ATT_BUF;
static_assert(ATT_WS + 8 * 256 + 64 <= RING_BYTES, "attention LDS");

__device__ __forceinline__ void mla_unit(LAS unsigned char* lds, const bf16_t* Q, const bf16_t* Kb, const bf16_t* KV, bf16_t* O, int b, int h, int qb) {
    const int tid = threadIdx.x, lane = tid & 63, r = lane & 31, hh = lane >> 5; const int wid = __builtin_amdgcn_readfirstlane(tid >> 6);
    const size_t rowbase = (size_t)b * SEQ; const int q0 = qb * 256, qw = q0 + 32 * wid;
    const int cq = qw >> 6, NT = (q0 >> 6) + 4;
    LAS float* wsf = (LAS float*)(lds + ATT_WS) + wid * 64;
    bf16x8 qf[6];
    { const bf16_t* qp = Q + (rowbase + qw + r) * 768 + h * 96 + hh * 8;
#pragma unroll
      for (int s = 0; s < 6; ++s) qf[s] = *(const bf16x8*)(qp + 16 * s); }
    const int lkv = tid & 63, lc = tid >> 6;
    const bf16_t* kg0 = Kb + (rowbase + lkv) * 768 + h * 96 + lc * 8;
    const bf16_t* vg = KV + (rowbase + lkv) * 1024 + h * 128 + 64 + lc * 8;
    u32x4 kr0, kr1 = (u32x4){0u, 0u, 0u, 0u}, vr;
#define ATT_LOAD(t) do { kr0 = *(const u32x4*)(kg0 + (size_t)(t) * 64 * 768); if (tid < 256) kr1 = *(const u32x4*)(kg0 + (size_t)(t) * 64 * 768 + 64); vr = *(const u32x4*)(vg + (size_t)(t) * 64 * 1024); } while (0)
#define ATT_STORE(bufi) do { LAS unsigned char* kb_ = lds + (bufi) * ATT_BUF; *(LAS u32x4*)(kb_ + tid * 16) = kr0; if (tid < 256) *(LAS u32x4*)(kb_ + 8192 + tid * 16) = kr1; \
        LAS unsigned char* vb_ = kb_ + ATT_KBYTES + (lc * 8) * ATT_VPITCH + lkv * 2; \
        _Pragma("unroll") for (int j_ = 0; j_ < 8; ++j_) *(LAS unsigned short*)(vb_ + j_ * ATT_VPITCH) = (unsigned short)(vr[j_ >> 1] >> (16 * (j_ & 1))); } while (0)
    ATT_LOAD(0); ATT_STORE(0); __syncthreads();
    float m_run = -INFINITY, l_run = 0.f;
    f32x16 o0, o1;
#pragma unroll
    for (int i = 0; i < 16; ++i) { o0[i] = 0.f; o1[i] = 0.f; }
    for (int t = 0; t < NT; ++t) {
        const int buf = t & 1;
        if (t + 1 < NT) ATT_LOAD(t + 1);
        if (t <= cq) {
            const LAS unsigned char* kb = lds + buf * ATT_BUF; const LAS unsigned char* vb = kb + ATT_KBYTES;
            f32x16 p0, p1;
#pragma unroll
            for (int i = 0; i < 16; ++i) { p0[i] = 0.f; p1[i] = 0.f; }
#pragma unroll
            for (int s = 0; s < 6; ++s) { const bf16x8 a0 = *(const LAS bf16x8*)(kb + (2 * s + hh) * 1024 + r * 16), a1 = *(const LAS bf16x8*)(kb + (2 * s + hh) * 1024 + (r + 32) * 16);
                p0 = MFMA32(a0, qf[s], p0); p1 = MFMA32(a1, qf[s], p1); }
            float mx = p0[0];
#pragma unroll
            for (int i = 0; i < 16; ++i) { mx = __builtin_fmaxf(mx, p0[i]); mx = __builtin_fmaxf(mx, p1[i]); }
            mx = __builtin_fmaxf(mx, __shfl_xor(mx, 32));
            const float m_new = __builtin_fmaxf(m_run, mx), alpha = __builtin_amdgcn_exp2f(m_run - m_new); m_run = m_new;
            float rs = 0.f;
#pragma unroll
            for (int i = 0; i < 16; ++i) { p0[i] = __builtin_amdgcn_exp2f(p0[i] - m_new); p1[i] = __builtin_amdgcn_exp2f(p1[i] - m_new); rs += p0[i] + p1[i]; }
            l_run = l_run * alpha + rs;
            if (hh == 0) wsf[r] = alpha;
            LDS_WAIT();
#pragma unroll
            for (int g = 0; g < 4; ++g) { const f32x4 al = *(const LAS f32x4*)(wsf + 8 * g + 4 * hh);
#pragma unroll
                for (int e = 0; e < 4; ++e) { o0[4 * g + e] *= al[e]; o1[4 * g + e] *= al[e]; } }
#pragma unroll
            for (int half = 0; half < 2; ++half)
#pragma unroll
                for (int s2 = 0; s2 < 2; ++s2) {
                    const f32x16& P = half ? p1 : p0;
                    const bf16x8 pa = pack8(P[8 * s2], P[8 * s2 + 1], P[8 * s2 + 2], P[8 * s2 + 3], P[8 * s2 + 4], P[8 * s2 + 5], P[8 * s2 + 6], P[8 * s2 + 7]);
                    const int kvo = (32 * half + 16 * s2 + 4 * hh) * 2;
                    { const s16x4 lo = *(const LAS s16x4*)(vb + r * ATT_VPITCH + kvo), hi = *(const LAS s16x4*)(vb + r * ATT_VPITCH + kvo + 16);
                      const bf16x8 vf = __builtin_shufflevector(lo, hi, 0, 1, 2, 3, 4, 5, 6, 7); o0 = MFMA32(pa, vf, o0); }
                    { const s16x4 lo = *(const LAS s16x4*)(vb + (r + 32) * ATT_VPITCH + kvo), hi = *(const LAS s16x4*)(vb + (r + 32) * ATT_VPITCH + kvo + 16);
                      const bf16x8 vf = __builtin_shufflevector(lo, hi, 0, 1, 2, 3, 4, 5, 6, 7); o1 = MFMA32(pa, vf, o1); }
                }
        }
        if (t + 1 < NT) ATT_STORE(buf ^ 1);
        __syncthreads();
    }
    const float l_tot = l_run + __shfl_xor(l_run, 32);
    if (hh == 0) wsf[r] = 1.f / l_tot;
    LDS_WAIT();
#pragma unroll
    for (int g = 0; g < 4; ++g) { const f32x4 rl = *(const LAS f32x4*)(wsf + 8 * g + 4 * hh);
#pragma unroll
        for (int e = 0; e < 4; ++e) { const int i = 4 * g + e; bf16_t* op = O + (rowbase + qw + crow(i, hh)) * 512 + h * 64 + r;
            op[0] = (bf16_t)(cvt_pk_bf16(o0[i] * rl[e], 0.f) & 0xffffu); op[32] = (bf16_t)(cvt_pk_bf16(o1[i] * rl[e], 0.f) & 0xffffu); } }
    LDS_WAIT();
#undef ATT_LOAD
#undef ATT_STORE
}

__device__ __forceinline__ void sb_unit(LAS unsigned char* lds, const bf16_t* SBQ, bf16_t* O, int b, int h, int qb) {
    const int tid = threadIdx.x, lane = tid & 63, r = lane & 31, hh = lane >> 5; const int wid = __builtin_amdgcn_readfirstlane(tid >> 6);
    const size_t rowbase = (size_t)b * SEQ; const int q0 = qb * 256, qw = q0 + 32 * wid;
    const int NT = (q0 >> 6) + 4;
    constexpr float C2 = 0.125f * LOG2E;
    bf16x8 qf[4];
    { const bf16_t* qp = SBQ + (rowbase + qw + r) * 1536 + h * 64 + hh * 8;
#pragma unroll
      for (int s = 0; s < 4; ++s) qf[s] = *(const bf16x8*)(qp + 16 * s); }
    const int lkv = tid & 63, lc = tid >> 6;
    const bf16_t* kg0 = SBQ + (rowbase + lkv) * 1536 + 512 + h * 64 + lc * 8;
    const bf16_t* vg = SBQ + (rowbase + lkv) * 1536 + 1024 + h * 64 + lc * 8;
    u32x4 kr0, vr;
#define ATT_LOAD(t) do { kr0 = *(const u32x4*)(kg0 + (size_t)(t) * 64 * 1536); vr = *(const u32x4*)(vg + (size_t)(t) * 64 * 1536); } while (0)
#define ATT_STORE(bufi) do { LAS unsigned char* kb_ = lds + (bufi) * ATT_BUF; *(LAS u32x4*)(kb_ + tid * 16) = kr0; \
        LAS unsigned char* vb_ = kb_ + ATT_KBYTES + (lc * 8) * ATT_VPITCH + lkv * 2; \
        _Pragma("unroll") for (int j_ = 0; j_ < 8; ++j_) *(LAS unsigned short*)(vb_ + j_ * ATT_VPITCH) = (unsigned short)(vr[j_ >> 1] >> (16 * (j_ & 1))); } while (0)
    LAS unsigned* dflag = (LAS unsigned*)(lds + ATT_WS + 8 * 256);
    ATT_LOAD(NT - 1); ATT_STORE(0); __syncthreads();
    float carry = 0.f; bool wdone = false;
    f32x16 o0, o1;
#pragma unroll
    for (int i = 0; i < 16; ++i) { o0[i] = 0.f; o1[i] = 0.f; }
#define SB_SUB(X, kvh0, kvl) do { const bool diag_ = ((kvh0) == qw); float lk_[16], z_[16]; \
        _Pragma("unroll") for (int i = 0; i < 16; ++i) { const float z2 = X[i] * C2; const float ex = __builtin_amdgcn_exp2f(z2); float sp = __builtin_amdgcn_logf(1.f + ex); sp = z2 > 64.f ? z2 : sp; \
            const bool valid = !diag_ || (crow(i, hh) < r); lk_[i] = valid ? -sp : 0.f; z_[i] = z2; } \
        float G_[4], Gp_[4]; \
        _Pragma("unroll") for (int g = 0; g < 4; ++g) { G_[g] = (lk_[4 * g] + lk_[4 * g + 1]) + (lk_[4 * g + 2] + lk_[4 * g + 3]); Gp_[g] = __shfl_xor(G_[g], 32); } \
        float tail_[4]; tail_[3] = 0.f; tail_[2] = G_[3] + Gp_[3]; tail_[1] = tail_[2] + (G_[2] + Gp_[2]); tail_[0] = tail_[1] + (G_[1] + Gp_[1]); const float total_ = tail_[0] + (G_[0] + Gp_[0]); \
        float a_[16]; \
        _Pragma("unroll") for (int g = 0; g < 4; ++g) { const float base_ = carry + tail_[g] + (hh == 0 ? Gp_[g] : 0.f); \
            const float s3 = base_ + lk_[4 * g + 3], s2_ = s3 + lk_[4 * g + 2], s1 = s2_ + lk_[4 * g + 1], s0 = s1 + lk_[4 * g]; \
            a_[4 * g + 3] = __builtin_amdgcn_exp2f(z_[4 * g + 3] + s3); a_[4 * g + 2] = __builtin_amdgcn_exp2f(z_[4 * g + 2] + s2_); a_[4 * g + 1] = __builtin_amdgcn_exp2f(z_[4 * g + 1] + s1); a_[4 * g] = __builtin_amdgcn_exp2f(z_[4 * g] + s0); } \
        if (diag_) { _Pragma("unroll") for (int i = 0; i < 16; ++i) a_[i] = (crow(i, hh) < r) ? a_[i] : 0.f; } \
        carry += total_; \
        _Pragma("unroll") for (int s2 = 0; s2 < 2; ++s2) { \
            const bf16x8 pa = pack8(a_[8 * s2], a_[8 * s2 + 1], a_[8 * s2 + 2], a_[8 * s2 + 3], a_[8 * s2 + 4], a_[8 * s2 + 5], a_[8 * s2 + 6], a_[8 * s2 + 7]); \
            const int kvo = ((kvl) + 16 * s2 + 4 * hh) * 2; \
            { const s16x4 lo = *(const LAS s16x4*)(vb + r * ATT_VPITCH + kvo), hi = *(const LAS s16x4*)(vb + r * ATT_VPITCH + kvo + 16); \
              const bf16x8 vf = __builtin_shufflevector(lo, hi, 0, 1, 2, 3, 4, 5, 6, 7); o0 = MFMA32(pa, vf, o0); } \
            { const s16x4 lo = *(const LAS s16x4*)(vb + (r + 32) * ATT_VPITCH + kvo), hi = *(const LAS s16x4*)(vb + (r + 32) * ATT_VPITCH + kvo + 16); \
              const bf16x8 vf = __builtin_shufflevector(lo, hi, 0, 1, 2, 3, 4, 5, 6, 7); o1 = MFMA32(pa, vf, o1); } } } while (0)
    for (int it = 0; it < NT; ++it) {
        const int t = NT - 1 - it, buf = it & 1, kv0 = 64 * t;
        if (t > 0) ATT_LOAD(t - 1);
        if (kv0 <= qw && !wdone) {
            const LAS unsigned char* kb = lds + buf * ATT_BUF; const LAS unsigned char* vb = kb + ATT_KBYTES;
            const bool upper = (kv0 + 32 <= qw);
            f32x16 p0, p1;
#pragma unroll
            for (int i = 0; i < 16; ++i) { p0[i] = 0.f; p1[i] = 0.f; }
#pragma unroll
            for (int s = 0; s < 4; ++s) { const bf16x8 a0 = *(const LAS bf16x8*)(kb + (2 * s + hh) * 1024 + r * 16); p0 = MFMA32(a0, qf[s], p0); }
            if (upper) {
#pragma unroll
                for (int s = 0; s < 4; ++s) { const bf16x8 a1 = *(const LAS bf16x8*)(kb + (2 * s + hh) * 1024 + (r + 32) * 16); p1 = MFMA32(a1, qf[s], p1); }
                SB_SUB(p1, kv0 + 32, 32);
            }
            SB_SUB(p0, kv0, 0);
            wdone = __all(carry < -170.f) != 0;
        }
        if (lane == 0) dflag[(it & 1) * 8 + wid] = wdone ? 1u : 0u;
        if (t > 0) ATT_STORE(buf ^ 1);
        __syncthreads();
        { const u32x4 f0 = *(const LAS u32x4*)(dflag + (it & 1) * 8), f1 = *(const LAS u32x4*)(dflag + (it & 1) * 8 + 4);
          if ((f0.x & f0.y & f0.z & f0.w & f1.x & f1.y & f1.z & f1.w) != 0u) break; }
    }
    __syncthreads();
#pragma unroll
    for (int i = 0; i < 16; ++i) { bf16_t* op = O + (rowbase + qw + crow(i, hh)) * 512 + h * 64 + r;
        op[0] = (bf16_t)(cvt_pk_bf16(o0[i], 0.f) & 0xffffu); op[32] = (bf16_t)(cvt_pk_bf16(o1[i], 0.f) & 0xffffu); }
#undef SB_SUB
#undef ATT_LOAD
#undef ATT_STORE
}

#ifndef PHMASK
#define PHMASK 0xFFFF
#endif
#define PH(n) ((PHMASK >> (n)) & 1)
#ifndef DUPMASK
#define DUPMASK 0
#endif
#define DUP(n) (1 + ((DUPMASK >> (n)) & 1))
struct Args { const void* in[23]; float* out; unsigned char* ws; };

__global__ void __launch_bounds__(512, 2) fwd_kernel(Args args) {
    extern __shared__ __attribute__((aligned(16))) unsigned char lds_raw[];
    LAS unsigned char* lds = (LAS unsigned char*)lds_raw;
    const int tid = threadIdx.x, lane = tid & 63, wave = __builtin_amdgcn_readfirstlane(tid >> 6);
    const int G = gridDim.x; const int bx = blockIdx.x; const int vcu = (G % 8 == 0) ? (bx % 8) * (G / 8) + bx / 8 : bx;
    const int gw = vcu * 8 + wave, NGW = G * 8;
    unsigned char* ws = args.ws;
    unsigned* ctl = (unsigned*)(ws + WS_CTL);
    const float* x = (const float*)args.in[0]; const float* cvec = (const float*)args.in[1]; const int* positions = (const int*)args.in[2];
    const float* w_ada = (const float*)args.in[3]; const float* b_ada = (const float*)args.in[4]; const float* g_norm1 = (const float*)args.in[5];
    const float* w_in = (const float*)args.in[6]; const float* g_q_lat = (const float*)args.in[7]; const float* w_uq = (const float*)args.in[8];
    const float* g_kv_lat = (const float*)args.in[9]; const float* w_ukv = (const float*)args.in[10]; const float* g_qk_q = (const float*)args.in[11];
    const float* g_qk_k = (const float*)args.in[12]; const float* w_o_mla = (const float*)args.in[13]; const float* w_o_sb = (const float*)args.in[14];
    const float* w_out = (const float*)args.in[15]; const float* g_norm2 = (const float*)args.in[16]; const float* w_router = (const float*)args.in[17];
    const float* b_router = (const float*)args.in[18]; const float* w_gate_up = (const float*)args.in[19]; const float* b_gate_up = (const float*)args.in[20];
    const float* w_down = (const float*)args.in[21]; const float* b_down = (const float*)args.in[22];
    float* out = args.out;
    bf16_t* WIN = (bf16_t*)(ws + WS_WIN); bf16_t* WUQ = (bf16_t*)(ws + WS_WUQ); bf16_t* WUKV = (bf16_t*)(ws + WS_WUKV); bf16_t* WOM = (bf16_t*)(ws + WS_WOM);
    bf16_t* WOS = (bf16_t*)(ws + WS_WOS); bf16_t* WOUT = (bf16_t*)(ws + WS_WOUT); float* MOD = (float*)(ws + WS_MOD);
    bf16_t* HB = (bf16_t*)(ws + WS_H); bf16_t* KVRAW = (bf16_t*)(ws + WS_KVRAW); bf16_t* MERGED = (bf16_t*)(ws + WS_MERGED);
    bf16_t* SGA = (bf16_t*)(ws + WS_SGA); bf16_t* SGB = (bf16_t*)(ws + WS_SGB); unsigned char* H2 = ws + WS_H2;
    unsigned char* WGU = ws + WS_WGU; unsigned char* WDN = ws + WS_WDN; bf16_t* SBQ = (bf16_t*)(ws + WS_SB);
    int* TOKL = (int*)(ws + WS_TOKL); float* WLST = (float*)(ws + WS_WL); unsigned char* HID = ws + WS_HID;
    bf16_t* QL = (bf16_t*)(ws + WS_QL); bf16_t* KVL = (bf16_t*)(ws + WS_KVL); bf16_t* KPE = (bf16_t*)(ws + WS_KPE);
    bf16_t* QB = (bf16_t*)(ws + WS_Q); bf16_t* KB = (bf16_t*)(ws + WS_K); bf16_t* OMLA = (bf16_t*)(ws + WS_OMLA); bf16_t* OSB = (bf16_t*)(ws + WS_OSB);

    for (int u = tid; u < (LDS_BYTES - LDSCTL_OFF) / 4; u += 512) ((LAS unsigned*)(lds + LDSCTL_OFF))[u] = 0u;
    __syncthreads();
    XcdBarrier bar = xcd_barrier_post(ctl + CW_BAR, (volatile LAS unsigned*)(lds + LDSCTL_OFF + LC_BARST));
    LAS float* scr = (LAS float*)(lds + wave * 16384);

#if PH(0)
    {
        constexpr int I_IN = 16 * 133, I_UQ = 6 * 24, I_UKV = 4 * 32, I_OM = 8 * 32, I_OS = 8 * 32, I_OUT = 16 * 32;
        constexpr int NIT = I_IN + I_UQ + I_UKV + I_OM + I_OS + I_OUT;
        for (int it = gw; it < NIT; it += NGW) {
            int q = it;
            if (q < I_IN) { const int kb = q / 133, nb = q % 133, n0 = 32 * nb; transpose_item(w_in, 1024, DIN, WIN, 64 * kb, n0, n0 < 672 ? n0 : n0 + 96, scr, lane); continue; } q -= I_IN;
            if (q < I_UQ) { const int kb = q / 24, nb = q % 24; transpose_item(w_uq, 384, 768, WUQ, 64 * kb, 32 * nb, 32 * nb, scr, lane); continue; } q -= I_UQ;
            if (q < I_UKV) { const int kb = q / 32, nb = q % 32; transpose_item(w_ukv, 256, 1024, WUKV, 64 * kb, 32 * nb, 32 * nb, scr, lane); continue; } q -= I_UKV;
            if (q < I_OM) { const int kb = q / 32, nb = q % 32; transpose_item(w_o_mla, 512, 1024, WOM, 64 * kb, 32 * nb, 32 * nb, scr, lane); continue; } q -= I_OM;
            if (q < I_OS) { const int kb = q / 32, nb = q % 32; transpose_item(w_o_sb, 512, 1024, WOS, 64 * kb, 32 * nb, 32 * nb, scr, lane); continue; } q -= I_OS;
            { const int kb = q / 32, nb = q % 32; transpose_item(w_out, 1024, 1024, WOUT, 64 * kb, 32 * nb, 32 * nb, scr, lane); }
        }
        for (int i = vcu * 512 + tid; i < 96 * 1024 * 2 / 16; i += G * 512) ((u32x4*)(WIN + 672 * 1024))[i] = (u32x4){0u, 0u, 0u, 0u};
        __syncthreads();
        for (int it = vcu; it < 6144 / 64; it += G) {
            for (int idx = lane; idx < 32 * 128; idx += 64) { const int b = idx >> 7, kk = idx & 127; const float cv = cvec[b * 1024 + 128 * wave + kk]; scr[idx] = cv / (1.f + __expf(-cv)); }
            LDS_WAIT(); asm volatile("" ::: "memory");
            float acc[32];
#pragma unroll
            for (int b = 0; b < 32; ++b) acc[b] = 0.f;
            const float* wp = w_ada + (size_t)(128 * wave) * 6144 + 64 * it + lane;
            for (int k4 = 0; k4 < 32; ++k4) {
                const float w0 = wp[(size_t)(4 * k4) * 6144], w1 = wp[(size_t)(4 * k4 + 1) * 6144], w2 = wp[(size_t)(4 * k4 + 2) * 6144], w3 = wp[(size_t)(4 * k4 + 3) * 6144];
#pragma unroll
                for (int b = 0; b < 32; ++b) { const f32x4 s = *(const LAS f32x4*)(scr + b * 128 + 4 * k4); acc[b] += s.x * w0 + s.y * w1 + s.z * w2 + s.w * w3; }
            }
            LDS_WAIT(); asm volatile("" ::: "memory");
#pragma unroll
            for (int b = 0; b < 32; ++b) scr[b * 64 + lane] = acc[b];
            __syncthreads();
#pragma unroll
            for (int bb = 0; bb < 4; ++bb) { const int b = 4 * wave + bb; float s = 0.f;
#pragma unroll
                for (int w2 = 0; w2 < 8; ++w2) s += ((const LAS float*)(lds + w2 * 16384))[b * 64 + lane];
                MOD[b * 6144 + 64 * it + lane] = s + b_ada[64 * it + lane]; }
            __syncthreads();
        }
    }
#endif
    xcd_barrier(bar);

#if PH(1)
    for (int gi = gw; gi < NTOK / 4; gi += NGW) {
        f32x4 v[4][4];
#pragma unroll
        for (int rr = 0; rr < 4; ++rr) { const f32x4* xr = (const f32x4*)(x + (size_t)(4 * gi + rr) * 1024) + lane;
#pragma unroll
            for (int j = 0; j < 4; ++j) v[rr][j] = xr[64 * j]; }
        const int b = (4 * gi) >> 11;
        const float* mb = MOD + (size_t)b * 6144;
        f32x4 gsc[4], shv[4];
#pragma unroll
        for (int j = 0; j < 4; ++j) { const int col = 4 * lane + 256 * j; gsc[j] = *(const f32x4*)(g_norm1 + col) * (*(const f32x4*)(mb + 1024 + col) + 1.f); shv[j] = *(const f32x4*)(mb + col); }
#pragma unroll
        for (int rr = 0; rr < 4; ++rr) { float ss = 0.f;
#pragma unroll
            for (int j = 0; j < 4; ++j) ss += (v[rr][j].x * v[rr][j].x + v[rr][j].y * v[rr][j].y) + (v[rr][j].z * v[rr][j].z + v[rr][j].w * v[rr][j].w);
            const float rstd = rsqrtf(wave_sum(ss) * (1.f / 1024.f) + EPS);
#pragma unroll
            for (int j = 0; j < 4; ++j) { const int col = 4 * lane + 256 * j; const f32x4 y = (v[rr][j] * rstd) * gsc[j] + shv[j];
                u32x2 o; o.x = cvt_pk_bf16(y.x, y.y); o.y = cvt_pk_bf16(y.z, y.w);
                *(u32x2*)(HB + (size_t)(4 * gi + rr) * 1024 + col) = o; } }
    }
#endif
    xcd_barrier(bar);

#if PH(2)
    {
#ifdef CLKPROBE
      const unsigned long long c0 = __builtin_amdgcn_s_memtime(), r0 = __builtin_amdgcn_s_memrealtime();
#endif
      pg8::DenseOrder S; S.init(HB, WIN, NTOK, DINP, 1024, G, bx);
      EpiProj E{QL, KVL, KPE, SBQ, SGA, SGB};
      for (int rep = 0; rep < DUP(4); ++rep) pg8::gemm_phase<false>(lds, 1024, S, E);
#ifdef CLKPROBE
      { const unsigned long long c1 = __builtin_amdgcn_s_memtime(), r1 = __builtin_amdgcn_s_memrealtime(); const unsigned long long spin = (c1 - c0) / CLKPROBE;
        while (__builtin_amdgcn_s_memrealtime() - r1 < spin) __builtin_amdgcn_s_sleep(8); (void)r0; }
#endif
#ifdef NULLK
      { EpiNull EN; pg8::DenseOrder S2; S2.init(HB, WIN, NTOK, DINP, NULLK, G, bx); pg8::gemm_phase<false>(lds, NULLK, S2, EN); }
#endif
      }
#endif
    xcd_barrier(bar);

#if PH(3)
    {
        f32x4 gq0 = (f32x4){0.f, 0.f, 0.f, 0.f}, gq1 = gq0, gk0 = gq0, gk1 = gq0;
        if (lane < 48) { gq0 = *(const f32x4*)(g_q_lat + lane * 8); gq1 = *(const f32x4*)(g_q_lat + lane * 8 + 4); }
        if (lane < 32) { gk0 = *(const f32x4*)(g_kv_lat + lane * 8); gk1 = *(const f32x4*)(g_kv_lat + lane * 8 + 4); }
        for (int gi = gw; gi < NTOK / 4; gi += NGW) {
            u32x4 vq[4], vk[4];
#pragma unroll
            for (int rr = 0; rr < 4; ++rr) { vq[rr] = (u32x4){0u, 0u, 0u, 0u}; vk[rr] = vq[rr];
                if (lane < 48) vq[rr] = *(const u32x4*)(QL + (size_t)(4 * gi + rr) * 384 + lane * 8);
                if (lane < 32) vk[rr] = *(const u32x4*)(KVL + (size_t)(4 * gi + rr) * 256 + lane * 8); }
#pragma unroll
            for (int rr = 0; rr < 4; ++rr) {
                { const u32x4 v = vq[rr]; float f[8] = {bf_lo(v.x), bf_hi(v.x), bf_lo(v.y), bf_hi(v.y), bf_lo(v.z), bf_hi(v.z), bf_lo(v.w), bf_hi(v.w)}; float ss = 0.f;
#pragma unroll
                  for (int j = 0; j < 8; ++j) ss += f[j] * f[j];
                  const float rstd = rsqrtf(wave_sum(ss) * (1.f / 384.f) + EPS);
                  if (lane < 48) { u32x4 o; o.x = cvt_pk_bf16(f[0] * rstd * gq0.x, f[1] * rstd * gq0.y); o.y = cvt_pk_bf16(f[2] * rstd * gq0.z, f[3] * rstd * gq0.w);
                      o.z = cvt_pk_bf16(f[4] * rstd * gq1.x, f[5] * rstd * gq1.y); o.w = cvt_pk_bf16(f[6] * rstd * gq1.z, f[7] * rstd * gq1.w); *(u32x4*)(QL + (size_t)(4 * gi + rr) * 384 + lane * 8) = o; } }
                { const u32x4 v = vk[rr]; float f[8] = {bf_lo(v.x), bf_hi(v.x), bf_lo(v.y), bf_hi(v.y), bf_lo(v.z), bf_hi(v.z), bf_lo(v.w), bf_hi(v.w)}; float ss = 0.f;
#pragma unroll
                  for (int j = 0; j < 8; ++j) ss += f[j] * f[j];
                  const float rstd = rsqrtf(wave_sum(ss) * (1.f / 256.f) + EPS);
                  if (lane < 32) { u32x4 o; o.x = cvt_pk_bf16(f[0] * rstd * gk0.x, f[1] * rstd * gk0.y); o.y = cvt_pk_bf16(f[2] * rstd * gk0.z, f[3] * rstd * gk0.w);
                      o.z = cvt_pk_bf16(f[4] * rstd * gk1.x, f[5] * rstd * gk1.y); o.w = cvt_pk_bf16(f[6] * rstd * gk1.z, f[7] * rstd * gk1.w); *(u32x4*)(KVL + (size_t)(4 * gi + rr) * 256 + lane * 8) = o; } }
            }
        }
    }
#endif
    xcd_barrier(bar);

#if PH(4)
    for (int rep = 0; rep < DUP(5); ++rep) {
    { pg8::DenseOrder S; S.init(QL, WUQ, NTOK, 768, 384, G, bx); EpiStore E{QB, 768}; pg8::gemm_phase<false>(lds, 384, S, E); }
    { pg8::DenseOrder S; S.init(KVL, WUKV, NTOK, 1024, 256, G, bx); EpiStore E{KVRAW, 1024}; pg8::gemm_phase<false>(lds, 256, S, E); } }
#endif
    xcd_barrier(bar);

#if PH(5)
    {
        const int hd = lane >> 3, sub = lane & 7;
        const float QSC = 0.10206207261596575f * LOG2E;
        const float if0 = exp2f(-(float)(2 * sub) * (13.287712379549449f / 16.f)), if1 = exp2f(-(float)(2 * sub + 1) * (13.287712379549449f / 16.f));
        f32x4 gq0 = *(const f32x4*)(g_qk_q + sub * 8), gq1 = *(const f32x4*)(g_qk_q + sub * 8 + 4); const f32x2 gqa = *(const f32x2*)(g_qk_q + 64 + 2 * sub), gqb = *(const f32x2*)(g_qk_q + 80 + 2 * sub);
        f32x4 gk0 = *(const f32x4*)(g_qk_k + sub * 8), gk1 = *(const f32x4*)(g_qk_k + sub * 8 + 4); const f32x2 gka = *(const f32x2*)(g_qk_k + 64 + 2 * sub), gkb = *(const f32x2*)(g_qk_k + 80 + 2 * sub);
        for (int gi = gw; gi < NTOK / 4; gi += NGW) {
            u32x4 A[4][2]; unsigned B1[4][2], B2[4][2]; float posf[4];
#pragma unroll
            for (int t = 0; t < 4; ++t) { const int m = 4 * gi + t; posf[t] = (float)positions[m];
                const bf16_t* qp = QB + (size_t)m * 768 + hd * 96; A[t][0] = *(const u32x4*)(qp + sub * 8); B1[t][0] = *(const unsigned*)(qp + 64 + 2 * sub); B2[t][0] = *(const unsigned*)(qp + 80 + 2 * sub);
                A[t][1] = *(const u32x4*)(KVRAW + (size_t)m * 1024 + hd * 128 + sub * 8); B1[t][1] = *(const unsigned*)(KPE + (size_t)m * 32 + 2 * sub); B2[t][1] = *(const unsigned*)(KPE + (size_t)m * 32 + 16 + 2 * sub); }
#pragma unroll
            for (int t = 0; t < 4; ++t) { const int m = 4 * gi + t;
                float cs[2], sn[2];
                { const float a0 = posf[t] * if0, a1 = posf[t] * if1;
                  double r0 = (double)a0 * 0.15915494309189535, r1 = (double)a1 * 0.15915494309189535; r0 -= __builtin_rint(r0); r1 -= __builtin_rint(r1);
                  cs[0] = __builtin_amdgcn_cosf((float)r0); sn[0] = __builtin_amdgcn_sinf((float)r0); cs[1] = __builtin_amdgcn_cosf((float)r1); sn[1] = __builtin_amdgcn_sinf((float)r1); }
#pragma unroll
                for (int which = 0; which < 2; ++which) {
                    const u32x4 Av = A[t][which]; const unsigned b1 = B1[t][which], b2 = B2[t][which];
                    bf16_t* dst = which ? KB + (size_t)m * 768 + hd * 96 : QB + (size_t)m * 768 + hd * 96;
                    float f[8] = {bf_lo(Av.x), bf_hi(Av.x), bf_lo(Av.y), bf_hi(Av.y), bf_lo(Av.z), bf_hi(Av.z), bf_lo(Av.w), bf_hi(Av.w)};
                    float x1[2] = {bf_lo(b1), bf_hi(b1)}, x2[2] = {bf_lo(b2), bf_hi(b2)};
                    float ss = x1[0] * x1[0] + x1[1] * x1[1] + x2[0] * x2[0] + x2[1] * x2[1];
#pragma unroll
                    for (int j = 0; j < 8; ++j) ss += f[j] * f[j];
                    ss += __shfl_xor(ss, 1); ss += __shfl_xor(ss, 2); ss += __shfl_xor(ss, 4);
                    const float rstd = rsqrtf(ss * (1.f / 96.f) + EPS);
                    const f32x4 g0 = which ? gk0 : gq0, g1 = which ? gk1 : gq1; const f32x2 ga = which ? gka : gqa, gb = which ? gkb : gqb;
                    const float sc = which ? 1.f : QSC;
                    float y[8] = {f[0] * rstd * g0.x, f[1] * rstd * g0.y, f[2] * rstd * g0.z, f[3] * rstd * g0.w, f[4] * rstd * g1.x, f[5] * rstd * g1.y, f[6] * rstd * g1.z, f[7] * rstd * g1.w};
                    const float y1a = x1[0] * rstd * ga.x, y1b = x1[1] * rstd * ga.y, y2a = x2[0] * rstd * gb.x, y2b = x2[1] * rstd * gb.y;
                    const float o1a = y1a * cs[0] - y2a * sn[0], o1b = y1b * cs[1] - y2b * sn[1], o2a = y2a * cs[0] + y1a * sn[0], o2b = y2b * cs[1] + y1b * sn[1];
                    u32x4 o; o.x = cvt_pk_bf16(y[0] * sc, y[1] * sc); o.y = cvt_pk_bf16(y[2] * sc, y[3] * sc); o.z = cvt_pk_bf16(y[4] * sc, y[5] * sc); o.w = cvt_pk_bf16(y[6] * sc, y[7] * sc);
                    *(u32x4*)(dst + sub * 8) = o; *(unsigned*)(dst + 64 + 2 * sub) = cvt_pk_bf16(o1a * sc, o1b * sc); *(unsigned*)(dst + 80 + 2 * sub) = cvt_pk_bf16(o2a * sc, o2b * sc);
                }
            }
        }
    }
#endif
    xcd_barrier(bar);

#if PH(6)
    for (int bh = vcu; bh < NB * NH; bh += G) {
        for (int rep = 0; rep < DUP(0); ++rep) for (int qb = 0; qb < 8; ++qb) mla_unit(lds, QB, KB, KVRAW, OMLA, bh >> 3, bh & 7, qb);
        for (int rep = 0; rep < DUP(1); ++rep) for (int qb = 0; qb < 8; ++qb) sb_unit(lds, SBQ, OSB, bh >> 3, bh & 7, qb);
    }
#endif
    xcd_barrier(bar);

#if PH(8)
    for (int rep = 0; rep < DUP(6); ++rep) {
    { pg8::DenseOrder S; S.init(OMLA, WOM, NTOK, 1024, 512, G, bx); EpiMerge<false> E{MERGED, SGA}; pg8::gemm_phase<false>(lds, 512, S, E); }
    { pg8::DenseOrder S; S.init(OSB, WOS, NTOK, 1024, 512, G, bx); EpiMerge<true> E{MERGED, SGB}; pg8::gemm_phase<false>(lds, 512, S, E); } }
#endif
    xcd_barrier(bar);

#if PH(9)
    { pg8::DenseOrder S; S.init(MERGED, WOUT, NTOK, 1024, 1024, G, bx); EpiWout E{x, out, MOD}; for (int rep = 0; rep < DUP(7); ++rep) pg8::gemm_phase<false>(lds, 1024, S, E); }
#endif
    xcd_barrier(bar);

#if PH(10)
    {
        constexpr int I_GU = 16 * 64, I_DN = 16 * 32;
        for (int rep = 0; rep < DUP(2); ++rep) for (int it = gw; it < NE * (I_GU + I_DN); it += NGW) {
            if (it < NE * I_GU) { const int e = it / I_GU, q = it % I_GU, kb = q / 64, nb = q % 64, n0 = 32 * nb; const int g = n0 >> 10, jj = n0 & 1023;
                transpose_item_f8(w_gate_up + (size_t)e * 1024 * 2048, 1024, 2048, WGU + (size_t)e * 2048 * 1024, 64 * kb, n0, 256 * (jj >> 7) + 128 * g + (jj & 127), WSCALE, scr, lane); }
            else { const int r2 = it - NE * I_GU, e = r2 / I_DN, q = r2 % I_DN, kb = q / 32, nb = q % 32;
                transpose_item_f8(w_down + (size_t)e * 1024 * 1024, 1024, 1024, WDN + (size_t)e * 1024 * 1024, 64 * kb, 32 * nb, 32 * nb, WSCALE, scr, lane); }
        }
        __syncthreads();
        {
            const int r = lane & 31, hh = lane >> 5;
            constexpr int TP = 1026;
            LAS float* tile = (LAS float*)lds;
            float areg[64];
#pragma unroll
            for (int mm = 0; mm < 64; ++mm) areg[mm] = w_router[(size_t)(128 * wave + 4 * (mm >> 1) + 2 * hh + (mm & 1)) * 32 + r];
            const float br = b_router[r];
            for (int tt = vcu; tt < NTOK / 32; tt += G) {
                { f32x4 v[4][4];
#pragma unroll
                  for (int rr = 0; rr < 4; ++rr) { const f32x4* xr = (const f32x4*)(out + (size_t)(32 * tt + 4 * wave + rr) * 1024) + lane;
#pragma unroll
                      for (int j = 0; j < 4; ++j) v[rr][j] = xr[64 * j]; }
                  const float* mb = MOD + (size_t)((32 * tt) >> 11) * 6144;
                  f32x4 gsc[4], shv[4];
#pragma unroll
                  for (int j = 0; j < 4; ++j) { const int col = 4 * lane + 256 * j; gsc[j] = *(const f32x4*)(g_norm2 + col) * (*(const f32x4*)(mb + 4096 + col) + 1.f); shv[j] = *(const f32x4*)(mb + 3072 + col); }
#pragma unroll
                  for (int rr = 0; rr < 4; ++rr) { float ss = 0.f; const int row = 4 * wave + rr;
#pragma unroll
                      for (int j = 0; j < 4; ++j) ss += (v[rr][j].x * v[rr][j].x + v[rr][j].y * v[rr][j].y) + (v[rr][j].z * v[rr][j].z + v[rr][j].w * v[rr][j].w);
                      const float rstd = rsqrtf(wave_sum(ss) * (1.f / 1024.f) + EPS);
#pragma unroll
                      for (int j = 0; j < 4; ++j) { const int col = 4 * lane + 256 * j; const f32x4 y = (v[rr][j] * rstd) * gsc[j] + shv[j];
                          *(unsigned*)(H2 + (size_t)(32 * tt + row) * 1024 + col) = pk4_fp8(y.x, y.y, y.z, y.w);
                          *(LAS f32x2*)(tile + row * TP + col) = (f32x2){y.x, y.y}; *(LAS f32x2*)(tile + row * TP + col + 2) = (f32x2){y.z, y.w}; } } }
                __syncthreads();
                f32x16 acc;
#pragma unroll
                for (int i = 0; i < 16; ++i) acc[i] = 0.f;
#pragma unroll
                for (int sg = 0; sg < 32; ++sg) { const f32x2 hv = *(const LAS f32x2*)(tile + r * TP + 128 * wave + 4 * sg + 2 * hh);
                    acc = __builtin_amdgcn_mfma_f32_32x32x2f32(areg[2 * sg], hv.x, acc, 0, 0, 0); acc = __builtin_amdgcn_mfma_f32_32x32x2f32(areg[2 * sg + 1], hv.y, acc, 0, 0, 0); }
                __syncthreads();
#pragma unroll
                for (int i = 0; i < 16; ++i) tile[wave * 1024 + i * 64 + lane] = acc[i];
                __syncthreads();
                { const int e = r, he = (e >> 2) & 1, ie = (e & 3) + 4 * (e >> 3);
#pragma unroll
                  for (int rr = 0; rr < 4; ++rr) { const int row = 4 * wave + rr; float v = br;
#pragma unroll
                      for (int w2 = 0; w2 < 8; ++w2) v += tile[w2 * 1024 + ie * 64 + row + 32 * he];
                      float tv[4]; int te[4];
#pragma unroll
                      for (int k = 0; k < 4; ++k) { float bv = v; int bi = e;
#pragma unroll
                          for (int off = 16; off >= 1; off >>= 1) { const float ov = __shfl_xor(bv, off); const int oi = __shfl_xor(bi, off); if (ov > bv || (ov == bv && oi < bi)) { bv = ov; bi = oi; } }
                          tv[k] = bv; te[k] = bi; if (e == bi) v = -INFINITY; }
                      const float e1 = __expf(tv[1] - tv[0]), e2 = __expf(tv[2] - tv[0]), e3 = __expf(tv[3] - tv[0]); const float inv = 1.f / (1.f + e1 + e2 + e3);
                      if (lane < 4) { const int k = lane; const int ek = k == 0 ? te[0] : k == 1 ? te[1] : k == 2 ? te[2] : te[3]; const float wk = (k == 0 ? 1.f : k == 1 ? e1 : k == 2 ? e2 : e3) * inv;
                          const unsigned slot = atomicAdd(ctl + CW_CNT + (k * 32 + ek) * 16, 1u);
                          TOKL[(size_t)(k * 32 + ek) * LISTCAP + slot] = 32 * tt + row; WLST[(size_t)(k * 32 + ek) * LISTCAP + slot] = wk; } } }
                __syncthreads();
            }
        }
    }
#endif
    xcd_barrier(bar);

#if PH(11)
    LAS int* tbase = (LAS int*)(lds + LDSCTL_OFF + LC_TBASE); LAS int* nearr = (LAS int*)(lds + LDSCTL_OFF + LC_NE); LAS int* tilee = (LAS int*)(lds + LDSCTL_OFF + LC_TILEE);
    for (int k = 0; k < TOPK; ++k) {
        int tid = threadIdx.x; asm volatile("" : "+v"(tid));
        __syncthreads();
        if (tid < NE) nearr[tid] = (int)ctl[CW_CNT + (k * 32 + tid) * 16];
        __syncthreads();
        if (tid == 0) { int a = 0;
#pragma nounroll
            for (int e = 0; e < NE; ++e) { tbase[e] = a; a += (nearr[e] + 255) >> 8; } tbase[NE] = a; }
        __syncthreads();
        { const int total = tbase[NE];
          for (int T = tid; T < total; T += 512) { int e = 0;
#pragma nounroll
              while (e < NE - 1 && tbase[e + 1] <= T) ++e;
              tilee[T] = e; } }
        __syncthreads();
#ifndef NO_GU
        { MoeOrder<8, true> S{(const char*)H2, (const char*)WGU, (size_t)2048 * 1024, TOKL + (size_t)k * NE * LISTCAP, G, vcu, tbase, nearr, tilee};
          EpiGateUp E{HID, b_gate_up};
          pg8::gemm_phase_f8<true>(lds, 512, S, E); }
#endif
        xcd_barrier(bar);
#ifndef NO_DN
        { MoeOrder<4, false> S{(const char*)HID, (const char*)WDN, (size_t)1024 * 1024, TOKL + (size_t)k * NE * LISTCAP, G, vcu, tbase, nearr, tilee};
          EpiDown E{out, b_down, MOD, TOKL + (size_t)k * NE * LISTCAP, WLST + (size_t)k * NE * LISTCAP};
          pg8::gemm_phase_f8<false>(lds, 512, S, E); }
#endif
        if (k + 1 < TOPK) xcd_barrier(bar);
    }
#endif
}

extern "C" void kernel_launch(void* const* d_in, const int* in_sizes, int n_in, void* d_out, int out_size, void* d_ws, size_t ws_size, hipStream_t stream) {
    static int grid = 0;
    if (grid == 0) {
        if (n_in != 23 || in_sizes[0] != NTOK * DM || out_size != NTOK * DM || ws_size < WS_END) { fprintf(stderr, "kernel_launch: unexpected shapes (n_in %d, in0 %d, out %d, ws %zu); nothing launched\n", n_in, n_in > 0 ? in_sizes[0] : -1, out_size, ws_size); grid = -1; return; }
        int dev = 0, cus = 0, per_cu = 0;
        if (hipGetDevice(&dev) != hipSuccess || hipDeviceGetAttribute(&cus, hipDeviceAttributeMultiprocessorCount, dev) != hipSuccess) { grid = -1; return; }
        if (hipFuncSetAttribute((const void*)fwd_kernel, hipFuncAttributeMaxDynamicSharedMemorySize, LDS_BYTES) != hipSuccess) { fprintf(stderr, "kernel_launch: hipFuncSetAttribute failed\n"); grid = -1; return; }
        if (hipOccupancyMaxActiveBlocksPerMultiprocessor(&per_cu, (const void*)fwd_kernel, 512, LDS_BYTES) != hipSuccess || per_cu < 1) fprintf(stderr, "kernel_launch: occupancy query reports %d\n", per_cu);
        (void)hipGetLastError();
        grid = cus;
    }
    if (grid < 0) return;
    if (hipMemsetAsync((char*)d_ws + WS_CTL, 0, CTL_ZERO_BYTES, stream) != hipSuccess) return;
    Args a{};
    for (int i = 0; i < 23; ++i) a.in[i] = d_in[i];
    a.out = (float*)d_out; a.ws = (unsigned char*)d_ws;
    hipLaunchKernelGGL(fwd_kernel, dim3(grid), dim3(512), LDS_BYTES, stream, a);
}
```

```cpp
#include <hip/hip_runtime.h>
#include <cstdio>
#include <cstdint>

#define LAS __attribute__((address_space(3)))
#define GAS __attribute__((address_space(1)))
typedef unsigned short bf16_t;
typedef short bf16x8 __attribute__((ext_vector_type(8)));
typedef short s16x4 __attribute__((ext_vector_type(4)));
typedef float f32x2 __attribute__((ext_vector_type(2)));
typedef float f32x4 __attribute__((ext_vector_type(4)));
typedef float f32x16 __attribute__((ext_vector_type(16)));
typedef unsigned u32x2 __attribute__((ext_vector_type(2)));
typedef unsigned u32x4 __attribute__((ext_vector_type(4)));
typedef int v8i __attribute__((ext_vector_type(8)));
typedef unsigned u32x8 __attribute__((ext_vector_type(8)));

constexpr int NB = 32, SEQ = 2048, DM = 1024, NTOK = NB * SEQ;
constexpr int QLORA = 384, KVLORA = 256, ROPE = 32, NOPE = 64, VD = 64, QKD = 96, NH = 8;
constexpr int SBD = 64;
constexpr int NE = 32, TOPK = 4, DE = 1024;
constexpr int DIN = 4256, DINP = 4352;
constexpr float EPS = 1e-6f;
constexpr float LOG2E = 1.4426950408889634f;
constexpr int LISTCAP = NTOK;
constexpr int MAXTILES = NTOK / 256 + NE;

constexpr size_t MiB = 1u << 20;
constexpr size_t WS_CTL = 0, CTL_ZERO_BYTES = 1 * MiB;
constexpr size_t WS_WIN = 1 * MiB;
constexpr size_t WS_WUQ = 10 * MiB;
constexpr size_t WS_WUKV = 11 * MiB;
constexpr size_t WS_WOM = 12 * MiB;
constexpr size_t WS_WOS = 13 * MiB;
constexpr size_t WS_WOUT = 14 * MiB;
constexpr size_t WS_MOD = 16 * MiB;
constexpr size_t WS_WIN8 = 18 * MiB;
constexpr size_t WS_H = 32 * MiB;
constexpr size_t WS_KVRAW = WS_H, WS_MERGED = WS_H;
constexpr size_t WS_SGA = 160 * MiB;
constexpr size_t WS_H2 = WS_SGA;
constexpr size_t WS_SGB = 288 * MiB;
constexpr size_t WS_WGU = WS_SGB;
constexpr size_t WS_SB = 416 * MiB;
constexpr size_t WS_WDN = 416 * MiB;
constexpr size_t WS_TOKL = 480 * MiB;
constexpr size_t WS_WL = 512 * MiB;
constexpr size_t WS_HID = 544 * MiB;
constexpr size_t WS_QL = 608 * MiB;
constexpr size_t WS_KVL = 656 * MiB;
constexpr size_t WS_KPE = 688 * MiB;
constexpr size_t WS_Q = 692 * MiB;
constexpr size_t WS_K = 788 * MiB;
constexpr size_t WS_OMLA = 884 * MiB;
constexpr size_t WS_H8 = WS_OMLA;
constexpr size_t WS_OSB = 948 * MiB;
constexpr size_t WS_END = 1012 * MiB;
static_assert(WS_HID + (size_t)MAXTILES * 256 * 1024 * 2 <= 692 * MiB, "hid fits below Q (dead by then anyway)");
constexpr int CW_BAR = 4096;
constexpr int CW_CNT = 16384;

constexpr int RING_BYTES = 131072;
constexpr int LDSCTL_OFF = RING_BYTES + 1024;
constexpr int LC_BARST = 0;
constexpr int LC_TBASE = 64;
constexpr int LC_NE = 256;
constexpr int LC_TILEE = 512;
constexpr int LDS_BYTES = 147456;
static_assert(LC_TILEE + MAXTILES * 4 <= LDS_BYTES - LDSCTL_OFF, "lds ctl");

__device__ __forceinline__ unsigned cvt_pk_bf16(float lo, float hi) { unsigned r; asm volatile("v_cvt_pk_bf16_f32 %0, %1, %2" : "=v"(r) : "v"(lo), "v"(hi)); return r; }
__device__ __forceinline__ float bf_lo(unsigned u) { return __builtin_bit_cast(float, u << 16); }
__device__ __forceinline__ float bf_hi(unsigned u) { return __builtin_bit_cast(float, u & 0xffff0000u); }
__device__ __forceinline__ float fast_sigmoid(float x) { return __builtin_amdgcn_rcpf(1.f + __builtin_amdgcn_exp2f(-x * LOG2E)); }

namespace pg8 {
constexpr int BM = 256, BK = 64, HALF = 128, HTB = HALF * BK * 2, STAGE_BYTES = 8 * HTB, NXCD = 8, WGM = 8;
__host__ __device__ __forceinline__ int lds_byte(int r, int c) { const int st = (r >> 4) * 2 + (c >> 5), rr = r & 15, cc = c & 31, ob = rr * 64 + cc * 2; return st * 1024 + (ob ^ (((ob >> 9) & 1) << 5)); }
__host__ __device__ __forceinline__ void stage_rc(int b, int& R, int& C) { const int st = b / 1024, sb = b % 1024, swz = sb ^ (((sb >> 9) & 1) << 5); R = (st >> 1) * 16 + swz / 64; C = (st & 1) * 32 + (swz % 64) / 2; }
__host__ __device__ __forceinline__ int perm32(int rho) { const int n = rho >> 4, i = rho & 15; return 8 * (i >> 2) + 4 * n + (i & 3); }

struct Unit { int pm, pn, e, j0, ne; };

struct DenseOrder {
    const char* A; const char* Bt; int K; int nM, nN, nwg, G, c;
    __device__ void init(const void* A_, const void* Bt_, int M, int N, int K_, int G_, int c_) { A = (const char*)A_; Bt = (const char*)Bt_; K = K_; nM = M / BM; nN = N / BM; nwg = nM * nN; G = G_; c = c_; }
    __device__ __forceinline__ bool next(int i, Unit& u) const {
        const long L = (long)i * G + c; if (L >= nwg) return false;
        int wgid = (int)L; { const int q = nwg / NXCD, r = nwg % NXCD, xcd = wgid % NXCD, off = wgid / NXCD; wgid = (xcd < r ? xcd * (q + 1) : r * (q + 1) + (xcd - r) * q) + off; }
        const int nig = WGM * nN, gid = wgid / nig, fm = gid * WGM, gsz = (nM - fm) < WGM ? (nM - fm) : WGM;
        u.pm = fm + ((wgid % nig) % gsz); u.pn = (wgid % nig) / gsz; u.e = 0; u.j0 = 0; u.ne = 0; return true;
    }
    __device__ __forceinline__ const char* a_base(const Unit& u) const { return A + (size_t)u.pm * (size_t)(BM * 2) * K; }
    __device__ __forceinline__ const char* b_base(const Unit& u) const { return Bt + (size_t)u.pn * (size_t)(BM * 2) * K; }
    __device__ __forceinline__ unsigned row_of(const Unit&, int) const { return 0u; }
};

template <bool GATHER, class Epi, class Sched>
__device__ __forceinline__ void gemm_phase(LAS unsigned char* lds, const int K, const Sched& S, const Epi& E) {
    int tid_ = threadIdx.x; asm volatile("" : "+v"(tid_));
    const int tid = tid_, wid = __builtin_amdgcn_readfirstlane(tid >> 6), lane = tid & 63, wr = wid >> 2, wc = wid & 3, fr = lane & 15, fq = lane >> 4;
    const int nt = K / BK;
    int RA[2]; unsigned cofA[2], voffB[2];
#pragma unroll
    for (int i = 0; i < 2; ++i) { int R, C; stage_rc(tid * 16 + i * 8192, R, C); const int Rb = (R & ~31) + perm32(R & 31);
        RA[i] = R; cofA[i] = (unsigned)C * 2u; voffB[i] = (unsigned)(Rb * K + C) * 2u; }
    const size_t kstep = (size_t)(BK * 2);
    const size_t hstep = (size_t)HALF * K * 2;
    const unsigned ldsw = (unsigned)wid * 1024u;
    const int aoff = lds_byte(wr * 64 + fr, fq * 8), boff = lds_byte(wc * 32 + fr, fq * 8);
#define PG8_SA(b, h) (((b) * 2 + (h)) * HTB)
#define PG8_SB(b, h) ((4 + (b) * 2 + (h)) * HTB)
#define PG8_STAGE(bufoff, gbase, voff) do { _Pragma("unroll") for (int _i = 0; _i < 2; ++_i) \
        __builtin_amdgcn_global_load_lds((const unsigned*)((const char*)(gbase) + (voff)[_i]), (LAS unsigned*)(lds + (bufoff) + ldsw + _i * 8192), 16, 0, 0); } while (0)
#define PG8_LDA(dst, b, h) do { _Pragma("unroll") for (int m = 0; m < 4; ++m) _Pragma("unroll") for (int k = 0; k < 2; ++k) dst[m][k] = *(const LAS bf16x8*)(lds + PG8_SA(b, h) + aoff + m * 2048 + k * 1024); } while (0)
#define PG8_LDB(dst, b, h) do { _Pragma("unroll") for (int n = 0; n < 2; ++n) _Pragma("unroll") for (int k = 0; k < 2; ++k) dst[n][k] = *(const LAS bf16x8*)(lds + PG8_SB(b, h) + boff + n * 2048 + k * 1024); } while (0)
#define PG8_MMA(ai, bj, At, Bt) do { __builtin_amdgcn_s_setprio(1); _Pragma("unroll") for (int m = 0; m < 4; ++m) _Pragma("unroll") for (int n = 0; n < 2; ++n) _Pragma("unroll") for (int k = 0; k < 2; ++k) \
        acc[ai][bj][m][n] = __builtin_amdgcn_mfma_f32_16x16x32_bf16(Bt[n][k], At[m][k], acc[ai][bj][m][n], 0, 0, 0); __builtin_amdgcn_s_setprio(0); } while (0)
#define PG8_WAIT_V(n) asm volatile("s_waitcnt vmcnt(" #n ")" ::: "memory")
#define PG8_WAIT_L(n) asm volatile("s_waitcnt lgkmcnt(" #n ")" ::: "memory")
#define PG8_BAR __builtin_amdgcn_s_barrier()
#define PG8_SCHED __builtin_amdgcn_sched_barrier(0)
#define PG8_AOFFS(dst, u) do { _Pragma("unroll") for (int _h = 0; _h < 2; ++_h) _Pragma("unroll") for (int _i = 0; _i < 2; ++_i) { \
        const unsigned _row = GATHER ? S.row_of(u, _h * HALF + RA[_i]) : (unsigned)(_h * HALF + RA[_i]); dst[_h][_i] = _row * (unsigned)(K * 2) + cofA[_i]; } } while (0)
    Unit cur, nxt; int ui = 0;
    if (!S.next(0, cur)) return;
    f32x4 acc[2][2][4][2];
#pragma unroll
    for (int a = 0; a < 2; ++a)
#pragma unroll
        for (int b = 0; b < 2; ++b)
#pragma unroll
            for (int m = 0; m < 4; ++m)
#pragma unroll
                for (int n = 0; n < 2; ++n) acc[a][b][m][n] = (f32x4){0.f, 0.f, 0.f, 0.f};
    bf16x8 At[4][2], B0[2][2], B1[2][2];
    unsigned oc[2][2], on[2][2];
    PG8_AOFFS(oc, cur);
    const char* cA = S.a_base(cur); const char* cB = S.b_base(cur);
    PG8_STAGE(PG8_SB(0, 0), cB, voffB); PG8_STAGE(PG8_SB(0, 1), cB + hstep, voffB); PG8_STAGE(PG8_SA(0, 0), cA, oc[0]); PG8_STAGE(PG8_SA(0, 1), cA, oc[1]);
    if (wr == 1) PG8_BAR;
    PG8_WAIT_V(2); PG8_BAR;
    PG8_STAGE(PG8_SB(1, 0), cB + kstep, voffB); PG8_STAGE(PG8_SA(1, 0), cA + kstep, oc[0]); PG8_STAGE(PG8_SB(1, 1), cB + hstep + kstep, voffB);
    PG8_WAIT_V(6); PG8_BAR;
    for (;;) {
        const bool has_next = S.next(ui + 1, nxt);
        const char* nA = has_next ? S.a_base(nxt) : cA; const char* nB = has_next ? S.b_base(nxt) : cB;
        if constexpr (GATHER) { if (has_next) { PG8_AOFFS(on, nxt);
            _Pragma("unroll") for (int _h = 0; _h < 2; ++_h) _Pragma("unroll") for (int _i = 0; _i < 2; ++_i) asm volatile("" : "+v"(on[_h][_i]));
          } else {
#pragma unroll
            for (int _h = 0; _h < 2; ++_h)
#pragma unroll
                for (int _i = 0; _i < 2; ++_i) on[_h][_i] = oc[_h][_i]; } }
#pragma nounroll
        for (int t = 0; t < nt; t += 2) {
            const bool last = (t == nt - 2);
            const char* a1 = cA + (size_t)(t + 1) * kstep;
            const char* a2 = last ? nA : cA + (size_t)(t + 2) * kstep; const char* b2 = last ? nB : cB + (size_t)(t + 2) * kstep;
            const char* a3 = a2 + kstep; const char* b3 = b2 + kstep;
            unsigned o2[2][2];
#pragma unroll
            for (int _h = 0; _h < 2; ++_h)
#pragma unroll
                for (int _i = 0; _i < 2; ++_i) o2[_h][_i] = (GATHER && last) ? on[_h][_i] : oc[_h][_i];
            PG8_LDB(B0, 0, 0); PG8_LDB(B1, 0, 1); PG8_SCHED; PG8_LDA(At, 0, 0); PG8_STAGE(PG8_SA(1, 1), a1, oc[1]);
            PG8_WAIT_V(8); PG8_WAIT_L(0); PG8_BAR; PG8_MMA(0, 0, At, B0); PG8_MMA(0, 1, At, B1); PG8_BAR; PG8_SCHED;
            PG8_LDA(At, 0, 1); PG8_STAGE(PG8_SB(0, 0), b2, voffB); PG8_STAGE(PG8_SB(0, 1), b2 + hstep, voffB); PG8_STAGE(PG8_SA(0, 0), a2, o2[0]);
            PG8_WAIT_V(8); PG8_WAIT_L(0); PG8_BAR; PG8_MMA(1, 0, At, B0); PG8_MMA(1, 1, At, B1); PG8_BAR; PG8_SCHED;
            PG8_LDB(B0, 1, 0); PG8_LDB(B1, 1, 1); PG8_SCHED; PG8_LDA(At, 1, 0); PG8_STAGE(PG8_SA(0, 1), a2, o2[1]);
            PG8_WAIT_V(8); PG8_WAIT_L(0); PG8_BAR; PG8_MMA(0, 0, At, B0); PG8_MMA(0, 1, At, B1); PG8_BAR; PG8_SCHED;
            PG8_LDA(At, 1, 1); PG8_STAGE(PG8_SB(1, 0), b3, voffB); PG8_STAGE(PG8_SB(1, 1), b3 + hstep, voffB); PG8_STAGE(PG8_SA(1, 0), a3, o2[0]);
            PG8_WAIT_V(8); PG8_WAIT_L(0); PG8_BAR; PG8_MMA(1, 0, At, B0); PG8_MMA(1, 1, At, B1); PG8_BAR; PG8_SCHED;
        }
        if (wr == 0) PG8_BAR;
        E(acc, cur, wr, wc, fr, fq);
        if (!has_next) break;
#pragma unroll
        for (int a = 0; a < 2; ++a)
#pragma unroll
            for (int b = 0; b < 2; ++b)
#pragma unroll
                for (int m = 0; m < 4; ++m)
#pragma unroll
                    for (int n = 0; n < 2; ++n) acc[a][b][m][n] = (f32x4){0.f, 0.f, 0.f, 0.f};
        cur = nxt; cA = nA; cB = nB; ++ui;
        if constexpr (GATHER) {
#pragma unroll
        for (int _h = 0; _h < 2; ++_h)
#pragma unroll
            for (int _i = 0; _i < 2; ++_i) oc[_h][_i] = on[_h][_i]; }
        if (wr == 1) PG8_BAR;
    }
    PG8_WAIT_V(0);
    PG8_BAR;
#undef PG8_SA
#undef PG8_SB
#undef PG8_STAGE
#undef PG8_LDA
#undef PG8_LDB
#undef PG8_MMA
#undef PG8_WAIT_V
#undef PG8_WAIT_L
#undef PG8_BAR
#undef PG8_SCHED
#undef PG8_AOFFS
}
template <bool GATHER, class Epi, class Sched>
__device__ __forceinline__ void gemm_phase_f8(LAS unsigned char* lds, const int K, const Sched& S, const Epi& E) {
    int tid_ = threadIdx.x; asm volatile("" : "+v"(tid_));
    const int tid = tid_, wid = __builtin_amdgcn_readfirstlane(tid >> 6), lane = tid & 63, wr = wid >> 2, wc = wid & 3, fr = lane & 15, fq = lane >> 4;
    const int nt = K / BK;
    int RA[2]; unsigned cofA[2], voffB[2];
#pragma unroll
    for (int i = 0; i < 2; ++i) { int R, C; stage_rc(tid * 16 + i * 8192, R, C); const int Rb = (R & ~31) + perm32(R & 31);
        RA[i] = R; cofA[i] = (unsigned)C * 2u; voffB[i] = (unsigned)(Rb * K + C) * 2u; }
    const size_t kstep = (size_t)(BK * 2);
    const size_t hstep = (size_t)HALF * K * 2;
    const unsigned ldsw = (unsigned)wid * 1024u;
    const int aoff = lds_byte(wr * 64 + fr, 16 * (fq & 1)) + (fq >> 1) * 1024, boff = lds_byte(wc * 32 + fr, 16 * (fq & 1)) + (fq >> 1) * 1024;
#define PG8_SA(b, h) (((b) * 2 + (h)) * HTB)
#define PG8_SB(b, h) ((4 + (b) * 2 + (h)) * HTB)
#define PG8_STAGE(bufoff, gbase, voff) do { _Pragma("unroll") for (int _i = 0; _i < 2; ++_i) \
        __builtin_amdgcn_global_load_lds((const unsigned*)((const char*)(gbase) + (voff)[_i]), (LAS unsigned*)(lds + (bufoff) + ldsw + _i * 8192), 16, 0, 0); } while (0)
#define PG8_LD32(p_) __builtin_shufflevector(*(const LAS u32x4*)(p_), *(const LAS u32x4*)((p_) + 16), 0, 1, 2, 3, 4, 5, 6, 7)
#define PG8_LDA(dst, b, h) do { _Pragma("unroll") for (int m = 0; m < 4; ++m) dst[m] = PG8_LD32(lds + PG8_SA(b, h) + aoff + m * 2048); } while (0)
#define PG8_LDB(dst, b, h) do { _Pragma("unroll") for (int n = 0; n < 2; ++n) dst[n] = PG8_LD32(lds + PG8_SB(b, h) + boff + n * 2048); } while (0)
#define PG8_F8(fr_) ((v8i){(int)fr_[0][0], (int)fr_[0][1], (int)fr_[0][2], (int)fr_[0][3], (int)fr_[1][0], (int)fr_[1][1], (int)fr_[1][2], (int)fr_[1][3]})
#define PG8_MMA(ai, bj, At, Bt) do { __builtin_amdgcn_s_setprio(1); _Pragma("unroll") for (int m = 0; m < 4; ++m) _Pragma("unroll") for (int n = 0; n < 2; ++n) \
        asm volatile("v_mfma_scale_f32_16x16x128_f8f6f4 %0, %1, %2, %0, %3, %3 op_sel_hi:[0,0,0]" : "+v"(acc[ai][bj][m][n]) : "v"(Bt[n]), "v"(At[m]), "v"(one_scale)); __builtin_amdgcn_s_setprio(0); } while (0)
#define PG8_WAIT_V(n) asm volatile("s_waitcnt vmcnt(" #n ")" ::: "memory")
#define PG8_WAIT_L(n) asm volatile("s_waitcnt lgkmcnt(" #n ")" ::: "memory")
#define PG8_BAR __builtin_amdgcn_s_barrier()
#define PG8_SCHED __builtin_amdgcn_sched_barrier(0)
#define PG8_AOFFS(dst, u) do { _Pragma("unroll") for (int _h = 0; _h < 2; ++_h) _Pragma("unroll") for (int _i = 0; _i < 2; ++_i) { \
        const unsigned _row = GATHER ? S.row_of(u, _h * HALF + RA[_i]) : (unsigned)(_h * HALF + RA[_i]); dst[_h][_i] = _row * (unsigned)(K * 2) + cofA[_i]; } } while (0)
    Unit cur, nxt; int ui = 0;
    if (!S.next(0, cur)) return;
    f32x4 acc[2][2][4][2];
#pragma unroll
    for (int a = 0; a < 2; ++a)
#pragma unroll
        for (int b = 0; b < 2; ++b)
#pragma unroll
            for (int m = 0; m < 4; ++m)
#pragma unroll
                for (int n = 0; n < 2; ++n) { acc[a][b][m][n] = (f32x4){0.f, 0.f, 0.f, 0.f}; asm volatile("" : "+v"(acc[a][b][m][n])); }
    u32x8 At[4], B0[2], B1[2];
    int one_scale = 0x7f7f7f7f; asm volatile("" : "+v"(one_scale));
    unsigned oc[2][2], on[2][2];
    PG8_AOFFS(oc, cur);
    const char* cA = S.a_base(cur); const char* cB = S.b_base(cur);
    PG8_STAGE(PG8_SB(0, 0), cB, voffB); PG8_STAGE(PG8_SB(0, 1), cB + hstep, voffB); PG8_STAGE(PG8_SA(0, 0), cA, oc[0]); PG8_STAGE(PG8_SA(0, 1), cA, oc[1]);
    if (wr == 1) PG8_BAR;
    PG8_WAIT_V(2); PG8_BAR;
    PG8_STAGE(PG8_SB(1, 0), cB + kstep, voffB); PG8_STAGE(PG8_SA(1, 0), cA + kstep, oc[0]); PG8_STAGE(PG8_SB(1, 1), cB + hstep + kstep, voffB);
    PG8_WAIT_V(6); PG8_BAR;
    for (;;) {
        const bool has_next = S.next(ui + 1, nxt);
        const char* nA = has_next ? S.a_base(nxt) : cA; const char* nB = has_next ? S.b_base(nxt) : cB;
        if constexpr (GATHER) { if (has_next) { PG8_AOFFS(on, nxt);
            _Pragma("unroll") for (int _h = 0; _h < 2; ++_h) _Pragma("unroll") for (int _i = 0; _i < 2; ++_i) asm volatile("" : "+v"(on[_h][_i]));
          } else {
#pragma unroll
            for (int _h = 0; _h < 2; ++_h)
#pragma unroll
                for (int _i = 0; _i < 2; ++_i) on[_h][_i] = oc[_h][_i]; } }
#pragma nounroll
        for (int t = 0; t < nt; t += 2) {
            const bool last = (t == nt - 2);
            const char* a1 = cA + (size_t)(t + 1) * kstep;
            const char* a2 = last ? nA : cA + (size_t)(t + 2) * kstep; const char* b2 = last ? nB : cB + (size_t)(t + 2) * kstep;
            const char* a3 = a2 + kstep; const char* b3 = b2 + kstep;
            unsigned o2[2][2];
#pragma unroll
            for (int _h = 0; _h < 2; ++_h)
#pragma unroll
                for (int _i = 0; _i < 2; ++_i) o2[_h][_i] = (GATHER && last) ? on[_h][_i] : oc[_h][_i];
            PG8_LDB(B0, 0, 0); PG8_LDB(B1, 0, 1); PG8_SCHED; PG8_LDA(At, 0, 0); PG8_STAGE(PG8_SA(1, 1), a1, oc[1]);
            PG8_WAIT_V(8); PG8_WAIT_L(0); PG8_BAR; PG8_MMA(0, 0, At, B0); PG8_MMA(0, 1, At, B1); PG8_BAR; PG8_SCHED;
            PG8_LDA(At, 0, 1); PG8_STAGE(PG8_SB(0, 0), b2, voffB); PG8_STAGE(PG8_SB(0, 1), b2 + hstep, voffB); PG8_STAGE(PG8_SA(0, 0), a2, o2[0]);
            PG8_WAIT_V(8); PG8_WAIT_L(0); PG8_BAR; PG8_MMA(1, 0, At, B0); PG8_MMA(1, 1, At, B1); PG8_BAR; PG8_SCHED;
            PG8_LDB(B0, 1, 0); PG8_LDB(B1, 1, 1); PG8_SCHED; PG8_LDA(At, 1, 0); PG8_STAGE(PG8_SA(0, 1), a2, o2[1]);
            PG8_WAIT_V(8); PG8_WAIT_L(0); PG8_BAR; PG8_MMA(0, 0, At, B0); PG8_MMA(0, 1, At, B1); PG8_BAR; PG8_SCHED;
            PG8_LDA(At, 1, 1); PG8_STAGE(PG8_SB(1, 0), b3, voffB); PG8_STAGE(PG8_SB(1, 1), b3 + hstep, voffB); PG8_STAGE(PG8_SA(1, 0), a3, o2[0]);
            PG8_WAIT_V(8); PG8_WAIT_L(0); PG8_BAR; PG8_MMA(1, 0, At, B0); PG8_MMA(1, 1, At, B1); PG8_BAR; PG8_SCHED;
        }
        asm volatile("s_nop 15\n\ts_nop 15" ::: "memory");
        if (wr == 0) PG8_BAR;
        E(acc, cur, wr, wc, fr, fq);
        if (!has_next) break;
#pragma unroll
        for (int a = 0; a < 2; ++a)
#pragma unroll
            for (int b = 0; b < 2; ++b)
#pragma unroll
                for (int m = 0; m < 4; ++m)
#pragma unroll
                    for (int n = 0; n < 2; ++n) { acc[a][b][m][n] = (f32x4){0.f, 0.f, 0.f, 0.f}; asm volatile("" : "+v"(acc[a][b][m][n])); }
        cur = nxt; cA = nA; cB = nB; ++ui;
        if constexpr (GATHER) {
#pragma unroll
        for (int _h = 0; _h < 2; ++_h)
#pragma unroll
            for (int _i = 0; _i < 2; ++_i) oc[_h][_i] = on[_h][_i]; }
        if (wr == 1) PG8_BAR;
    }
    PG8_WAIT_V(0);
    PG8_BAR;
#undef PG8_SA
#undef PG8_SB
#undef PG8_STAGE
#undef PG8_LDA
#undef PG8_LDB
#undef PG8_MMA
#undef PG8_WAIT_V
#undef PG8_WAIT_L
#undef PG8_BAR
#undef PG8_SCHED
#undef PG8_AOFFS
#undef PG8_F8
}
}
#define XB_TMO      128
#define XB_XCNT(j)  (256  + 64 * (j))
#define XB_XSUB(j)  (1280 + 64 * (j))
#define XB_XGEN(j)  (2304 + 64 * (j))
#define XB_TOP      3328
#define XB_TOPGEN   3392
#define XCD_BAR_WORDS 3456
#define XB_SPIN_CAP (1u << 18)

__device__ __forceinline__ unsigned xb_ld(unsigned* p)              { return __hip_atomic_load(p, __ATOMIC_RELAXED, __HIP_MEMORY_SCOPE_AGENT); }
__device__ __forceinline__ unsigned xb_add(unsigned* p, unsigned v) { return __hip_atomic_fetch_add(p, v, __ATOMIC_RELAXED, __HIP_MEMORY_SCOPE_AGENT); }
__device__ __forceinline__ unsigned xb_xcc_id() { return (unsigned)__builtin_amdgcn_s_getreg((3 << 11) | 20) & 0xFu; }
#define XB_SPIN(cond, bar) do { unsigned _sp = 0; while (cond) { __builtin_amdgcn_s_sleep(1); \
    if ((++_sp & 255u) == 0u) { if (xb_ld(&(bar)[XB_TMO])) break; if (_sp > XB_SPIN_CAP) { atomicAdd(&(bar)[XB_TMO], 1u); break; } } } } while (0)

struct XcdBarrier {
    unsigned* bar; unsigned x;
    volatile LAS unsigned* st;
};

__device__ __forceinline__ XcdBarrier xcd_barrier_post(unsigned* bar, volatile LAS unsigned* st) {
    XcdBarrier b; b.bar = bar; b.x = xb_xcc_id(); b.st = st;
    if (threadIdx.x == 0) (void)xb_add(&bar[XB_XCNT(b.x)], 1u);
    return b;
}
__device__ __forceinline__ void xcd_barrier_complete(unsigned* bar, unsigned x, unsigned& nloc, unsigned& nx) {
    const unsigned G = gridDim.x * gridDim.y * gridDim.z;
    unsigned sum, cnt, mine, sp = 0u;
    for (;;) {
        sum = 0u; cnt = 0u; mine = 0u;
#pragma unroll
        for (unsigned j = 0; j < 16; ++j) { const unsigned c = xb_ld(&bar[XB_XCNT(j)]); sum += c; cnt += (c > 0u) ? 1u : 0u; mine = (j == x) ? c : mine; }
        if (sum == G) break;
        __builtin_amdgcn_s_sleep(1);
        if ((++sp & 255u) == 0u) { if (xb_ld(&bar[XB_TMO])) break; if (sp > XB_SPIN_CAP) { atomicAdd(&bar[XB_TMO], 1u); break; } }
    }
    nloc = mine > 0u ? mine : 1u; nx = cnt > 0u ? cnt : 1u;
}

__device__ __forceinline__ void xcd_barrier(const XcdBarrier& b) {
    asm volatile("s_waitcnt vmcnt(0)" ::: "memory");
    __syncthreads();
    if (threadIdx.x == 0) {
        unsigned* bar = b.bar;
        __builtin_amdgcn_s_waitcnt(0);
        unsigned nloc = b.st[0], nx = b.st[1];
        if (nloc == 0u) { xcd_barrier_complete(bar, b.x, nloc, nx); b.st[0] = nloc; b.st[1] = nx; }
        const unsigned old = xb_add(&bar[XB_XSUB(b.x)], 1u);
        const unsigned gen = old / nloc;
        if (old + 1u == (gen + 1u) * nloc) {
            __builtin_amdgcn_fence(__ATOMIC_RELEASE, "agent");
            asm volatile("s_waitcnt vmcnt(0)" ::: "memory");
            const unsigned og = xb_add(&bar[XB_TOP], 1u);
            const unsigned tg = og / nx;
            if (og + 1u == (tg + 1u) * nx) xb_add(&bar[XB_TOPGEN], 1u);
            else XB_SPIN(xb_ld(&bar[XB_TOPGEN]) == tg, bar);
            __builtin_amdgcn_fence(__ATOMIC_ACQUIRE, "agent");
            xb_add(&bar[XB_XGEN(b.x)], 1u);
            asm volatile("s_waitcnt vmcnt(0)" ::: "memory");
        } else {
            XB_SPIN(xb_ld(&bar[XB_XGEN(b.x)]) == gen, bar);
            __builtin_amdgcn_fence(__ATOMIC_ACQUIRE, "agent");
            asm volatile("s_waitcnt vmcnt(0)" ::: "memory");
        }
    }
    __syncthreads();
}

#define LDS_WAIT() asm volatile("s_waitcnt lgkmcnt(0)" ::: "memory")
#define VM_WAIT() asm volatile("s_waitcnt vmcnt(0)" ::: "memory")
#define MFMA32(a, b, c) __builtin_amdgcn_mfma_f32_32x32x16_bf16((a), (b), (c), 0, 0, 0)
__device__ __forceinline__ float wave_sum(float v) {
#pragma unroll
    for (int o = 1; o < 64; o <<= 1) v += __shfl_xor(v, o);
    return v;
}
__device__ __forceinline__ int crow(int i, int hh) { return (i & 3) + 8 * (i >> 2) + 4 * hh; }
__device__ __forceinline__ bf16x8 pack8(float a0, float a1, float a2, float a3, float a4, float a5, float a6, float a7) {
    u32x4 p; p.x = cvt_pk_bf16(a0, a1); p.y = cvt_pk_bf16(a2, a3); p.z = cvt_pk_bf16(a4, a5); p.w = cvt_pk_bf16(a6, a7);
    return __builtin_bit_cast(bf16x8, p);
}

struct Ctx {
    LAS unsigned char* lds;
    int tid, lane, wave, vcu, G;
};

__device__ __forceinline__ void transpose_item(const float* W, int K, int N, bf16_t* WT, int k0, int n0, int drow0, LAS float* scr, int lane) {
#pragma unroll 8
    for (int i = 0; i < 32; ++i) { const int kk = 2 * i + (lane >> 5); scr[kk * 33 + (lane & 31)] = W[(size_t)(k0 + kk) * N + n0 + (lane & 31)]; }
    LDS_WAIT(); asm volatile("" ::: "memory");
    const int c = lane & 7;
#pragma unroll
    for (int j = 0; j < 4; ++j) { const int n = (lane >> 3) + 8 * j; const LAS float* s = scr + (8 * c) * 33 + n;
        u32x4 o; o.x = cvt_pk_bf16(s[0 * 33], s[1 * 33]); o.y = cvt_pk_bf16(s[2 * 33], s[3 * 33]); o.z = cvt_pk_bf16(s[4 * 33], s[5 * 33]); o.w = cvt_pk_bf16(s[6 * 33], s[7 * 33]);
        *(GAS u32x4*)(WT + (size_t)(drow0 + n) * K + k0 + 8 * c) = o; }
    LDS_WAIT(); asm volatile("" ::: "memory");
}

__device__ __forceinline__ unsigned pk4_fp8(float a, float b, float c, float d) { int p = __builtin_amdgcn_cvt_pk_fp8_f32(a, b, 0, false); p = __builtin_amdgcn_cvt_pk_fp8_f32(c, d, p, true); return (unsigned)p; }
__device__ __forceinline__ void transpose_item_f8(const float* W, int K, int N, unsigned char* WT, int k0, int n0, int drow0, float scl, LAS float* scr, int lane) {
#pragma unroll 8
    for (int i = 0; i < 32; ++i) { const int kk = 2 * i + (lane >> 5); scr[kk * 33 + (lane & 31)] = W[(size_t)(k0 + kk) * N + n0 + (lane & 31)]; }
    LDS_WAIT(); asm volatile("" ::: "memory");
    const int c = lane & 7;
#pragma unroll
    for (int j = 0; j < 4; ++j) { const int n = (lane >> 3) + 8 * j; const LAS float* s = scr + (8 * c) * 33 + n;
        u32x2 o; o.x = pk4_fp8(s[0 * 33] * scl, s[1 * 33] * scl, s[2 * 33] * scl, s[3 * 33] * scl); o.y = pk4_fp8(s[4 * 33] * scl, s[5 * 33] * scl, s[6 * 33] * scl, s[7 * 33] * scl);
        *(GAS u32x2*)(WT + (size_t)(drow0 + n) * K + k0 + 8 * c) = o; }
    LDS_WAIT(); asm volatile("" ::: "memory");
}

constexpr float WSCALE = 32.f, WDESCALE = 1.f / 32.f;
typedef const f32x4 (&AccRef)[2][2][4][2];

struct EpiNull { __device__ __forceinline__ void operator()(AccRef acc, const pg8::Unit& u, int wr, int wc, int fr, int fq) const {
        float s = 0.f;
#pragma unroll
        for (int ai = 0; ai < 2; ++ai)
#pragma unroll
            for (int bj = 0; bj < 2; ++bj)
#pragma unroll
                for (int m = 0; m < 4; ++m)
#pragma unroll
                    for (int n = 0; n < 2; ++n) s += acc[ai][bj][m][n][0] + acc[ai][bj][m][n][1] + acc[ai][bj][m][n][2] + acc[ai][bj][m][n][3];
        asm volatile("" :: "v"(s)); } };
struct EpiStore {
    bf16_t* O; int ldc;
    __device__ __forceinline__ void operator()(AccRef acc, const pg8::Unit& u, int wr, int wc, int fr, int fq) const {
        const int row0 = u.pm * 256 + wr * 64 + fr, col0 = u.pn * 256 + wc * 32 + 8 * fq;
#pragma unroll
        for (int ai = 0; ai < 2; ++ai)
#pragma unroll
            for (int m = 0; m < 4; ++m) { bf16_t* rowp = O + (size_t)(row0 + ai * 128 + m * 16) * ldc + col0;
#pragma unroll
                for (int bj = 0; bj < 2; ++bj) { const f32x4 v0 = acc[ai][bj][m][0], v1 = acc[ai][bj][m][1];
                    u32x4 w; w.x = cvt_pk_bf16(v0[0], v0[1]); w.y = cvt_pk_bf16(v0[2], v0[3]); w.z = cvt_pk_bf16(v1[0], v1[1]); w.w = cvt_pk_bf16(v1[2], v1[3]);
                    *(u32x4*)(rowp + bj * 128) = w; } }
    }
};

struct EpiProj {
    bf16_t *QL, *KVL, *KPE, *SB, *SGA, *SGB; int cbase; float dsc;
    __device__ __forceinline__ void operator()(AccRef acc, const pg8::Unit& u, int wr, int wc, int fr, int fq) const {
        const int row0 = u.pm * 256 + wr * 64 + fr;
#pragma unroll
        for (int bj = 0; bj < 2; ++bj) {
            const int cg = cbase + u.pn * 256 + bj * 128 + wc * 32;
            bf16_t* base; int ld, co; bool sig = false;
            if (cg < 384) { base = QL; ld = 384; co = cg; }
            else if (cg < 640) { base = KVL; ld = 256; co = cg - 384; }
            else if (cg < 672) { base = KPE; ld = 32; co = cg - 640; }
            else if (cg < 768) { continue; }
            else if (cg < 2304) { base = SB; ld = 1536; co = cg - 768; }
            else if (cg < 3328) { base = SGA; ld = 1024; co = cg - 2304; sig = true; }
            else { base = SGB; ld = 1024; co = cg - 3328; sig = true; }
#pragma unroll
            for (int ai = 0; ai < 2; ++ai)
#pragma unroll
                for (int m = 0; m < 4; ++m) { f32x4 v0 = acc[ai][bj][m][0], v1 = acc[ai][bj][m][1];
                    if (sig) {
#pragma unroll
                        for (int j = 0; j < 4; ++j) { v0[j] = fast_sigmoid(v0[j] * dsc); v1[j] = fast_sigmoid(v1[j] * dsc); } }
                    u32x4 w; w.x = cvt_pk_bf16(v0[0], v0[1]); w.y = cvt_pk_bf16(v0[2], v0[3]); w.z = cvt_pk_bf16(v1[0], v1[1]); w.w = cvt_pk_bf16(v1[2], v1[3]);
                    *(u32x4*)(base + (size_t)(row0 + ai * 128 + m * 16) * ld + co + 8 * fq) = w; }
        }
    }
};

template <bool SECOND> struct EpiMerge {
    bf16_t* MG; const bf16_t* SG;
    __device__ __forceinline__ void operator()(AccRef acc, const pg8::Unit& u, int wr, int wc, int fr, int fq) const {
        const int row0 = u.pm * 256 + wr * 64 + fr, col0 = u.pn * 256 + wc * 32 + 8 * fq;
#pragma unroll
        for (int ai = 0; ai < 2; ++ai)
#pragma unroll
            for (int m = 0; m < 4; ++m) { const size_t ro = (size_t)(row0 + ai * 128 + m * 16) * 1024 + col0;
#pragma unroll
                for (int bj = 0; bj < 2; ++bj) { const f32x4 v0 = acc[ai][bj][m][0], v1 = acc[ai][bj][m][1];
                    const u32x4 g = *(const u32x4*)(SG + ro + bj * 128);
                    float r0 = bf_lo(g.x) * v0[0], r1 = bf_hi(g.x) * v0[1], r2 = bf_lo(g.y) * v0[2], r3 = bf_hi(g.y) * v0[3];
                    float r4 = bf_lo(g.z) * v1[0], r5 = bf_hi(g.z) * v1[1], r6 = bf_lo(g.w) * v1[2], r7 = bf_hi(g.w) * v1[3];
                    if (SECOND) { const u32x4 p = *(const u32x4*)(MG + ro + bj * 128);
                        r0 += bf_lo(p.x); r1 += bf_hi(p.x); r2 += bf_lo(p.y); r3 += bf_hi(p.y); r4 += bf_lo(p.z); r5 += bf_hi(p.z); r6 += bf_lo(p.w); r7 += bf_hi(p.w); }
                    u32x4 w; w.x = cvt_pk_bf16(r0, r1); w.y = cvt_pk_bf16(r2, r3); w.z = cvt_pk_bf16(r4, r5); w.w = cvt_pk_bf16(r6, r7);
                    *(u32x4*)(MG + ro + bj * 128) = w; } }
    }
};

struct EpiWout {
    const float* X; float* OUT; const float* MOD;
    __device__ __forceinline__ void operator()(AccRef acc, const pg8::Unit& u, int wr, int wc, int fr, int fq) const {
        const int row0 = u.pm * 256 + wr * 64 + fr, col0 = u.pn * 256 + wc * 32 + 8 * fq;
        const float* ga = MOD + (size_t)(u.pm >> 3) * 6144 + 2048 + col0;
        f32x4 g[2][2];
#pragma unroll
        for (int bj = 0; bj < 2; ++bj)
#pragma unroll
            for (int n = 0; n < 2; ++n) g[bj][n] = *(const f32x4*)(ga + bj * 128 + 4 * n);
#pragma unroll
        for (int ai = 0; ai < 2; ++ai)
#pragma unroll
            for (int m = 0; m < 4; ++m) { const size_t ro = (size_t)(row0 + ai * 128 + m * 16) * 1024 + col0;
#pragma unroll
                for (int bj = 0; bj < 2; ++bj)
#pragma unroll
                    for (int n = 0; n < 2; ++n) { const f32x4 xv = *(const f32x4*)(X + ro + bj * 128 + 4 * n);
                        *(f32x4*)(OUT + ro + bj * 128 + 4 * n) = xv + g[bj][n] * acc[ai][bj][m][n]; } }
    }
};

struct EpiGateUp {
    unsigned char* HID; const float* BGU;
    __device__ __forceinline__ void operator()(AccRef acc, const pg8::Unit& u, int wr, int wc, int fr, int fq) const {
        const int row0 = u.pm * 256 + wr * 64 + fr, hc = u.pn * 128 + wc * 32 + 8 * fq;
        const float* bg = BGU + (size_t)u.e * 2048 + hc;
        f32x4 bgate[2], bup[2];
#pragma unroll
        for (int n = 0; n < 2; ++n) { bgate[n] = *(const f32x4*)(bg + 4 * n); bup[n] = *(const f32x4*)(bg + 1024 + 4 * n); }
#pragma unroll
        for (int ai = 0; ai < 2; ++ai)
#pragma unroll
            for (int m = 0; m < 4; ++m) { float r[8];
#pragma unroll
                for (int n = 0; n < 2; ++n) { const f32x4 gv = acc[ai][0][m][n] * WDESCALE + bgate[n], uv = acc[ai][1][m][n] * WDESCALE + bup[n];
#pragma unroll
                    for (int j = 0; j < 4; ++j) { const float g = __builtin_fminf(gv[j], 7.f); const float up = __builtin_fminf(__builtin_fmaxf(uv[j], -7.f), 7.f);
                        r[4 * n + j] = (up + 1.f) * (g * fast_sigmoid(1.702f * g)); } }
                u32x2 w; w.x = pk4_fp8(r[0], r[1], r[2], r[3]); w.y = pk4_fp8(r[4], r[5], r[6], r[7]);
                *(u32x2*)(HID + (size_t)(row0 + ai * 128 + m * 16) * 1024 + hc) = w; asm volatile("" ::: "memory"); }
    }
};

struct EpiDown {
    float* OUT; const float* BDN; const float* MOD; const int* TOKL; const float* WL;
    __device__ __forceinline__ void operator()(AccRef acc, const pg8::Unit& u, int wr, int wc, int fr, int fq) const {
        const int col0 = u.pn * 256 + wc * 32 + 8 * fq;
        const float* bd = BDN + (size_t)u.e * 1024 + col0;
        f32x4 b4[2][2];
#pragma unroll
        for (int bj = 0; bj < 2; ++bj)
#pragma unroll
            for (int n = 0; n < 2; ++n) b4[bj][n] = *(const f32x4*)(bd + bj * 128 + 4 * n);
        const int* tl = TOKL + (size_t)u.e * LISTCAP; const float* wl = WL + (size_t)u.e * LISTCAP;
#pragma unroll
        for (int ai = 0; ai < 2; ++ai)
#pragma unroll
            for (int m = 0; m < 4; ++m) { const int slot = u.j0 + ai * 128 + wr * 64 + m * 16 + fr;
                if (slot < u.ne) { const int tok = tl[slot]; const float wgt = wl[slot];
                    const float* ga = MOD + (size_t)(tok >> 11) * 6144 + 5120 + col0; float* op = OUT + (size_t)tok * 1024 + col0;
#pragma unroll
                    for (int bj = 0; bj < 2; ++bj)
#pragma unroll
                        for (int n = 0; n < 2; ++n) { const f32x4 g = *(const f32x4*)(ga + bj * 128 + 4 * n); const f32x4 o = *(const f32x4*)(op + bj * 128 + 4 * n);
                            *(f32x4*)(op + bj * 128 + 4 * n) = o + g * ((acc[ai][bj][m][n] * WDESCALE + b4[bj][n]) * wgt); } }
                asm volatile("" ::: "memory"); }
    }
};

template <int NPN, bool GATHER> struct MoeOrder {
    const char* A; const char* Bt; size_t estride; const int* lists; int G, c; const LAS int* tbase; const LAS int* nearr; const LAS int* tilee;
    __device__ __forceinline__ bool next(int i, pg8::Unit& u) const {
        const int L = i * G + c, T = L / NPN; const int total = __builtin_amdgcn_readfirstlane(tbase[NE]);
        if (T >= total) return false;
        const int e = __builtin_amdgcn_readfirstlane(tilee[T]);
        u.pm = T; u.pn = L % NPN; u.e = e; u.j0 = (T - __builtin_amdgcn_readfirstlane(tbase[e])) * 256; u.ne = __builtin_amdgcn_readfirstlane(nearr[e]); return true;
    }
    __device__ __forceinline__ const char* a_base(const pg8::Unit& u) const { return GATHER ? A : A + (size_t)u.pm * (size_t)(256 * 1024); }
    __device__ __forceinline__ const char* b_base(const pg8::Unit& u) const { return Bt + (size_t)u.e * estride + (size_t)u.pn * (size_t)(256 * 1024); }
    __device__ __forceinline__ unsigned row_of(const pg8::Unit& u, int r) const { const int slot = u.j0 + r; return slot < u.ne ? (unsigned)lists[(size_t)u.e * LISTCAP + slot] : 0u; }
};

constexpr int ATT_KBYTES = 12 * 1024;
constexpr int ATT_VPITCH = 136;
constexpr int ATT_VBYTES = 64 * ATT_VPITCH;
constexpr int ATT_BUF = ATT_KBYTES + ATT_VBYTES;
constexpr int ATT_WS = 2 * ATT_BUF;
static_assert(ATT_WS + 8 * 256 + 64 <= RING_BYTES, "attention LDS");

__device__ __forceinline__ void mla_unit(LAS unsigned char* lds, const bf16_t* Q, const bf16_t* Kb, const bf16_t* KV, bf16_t* O, int b, int h, int qb) {
    const int tid = threadIdx.x, lane = tid & 63, r = lane & 31, hh = lane >> 5; const int wid = __builtin_amdgcn_readfirstlane(tid >> 6);
    const size_t rowbase = (size_t)b * SEQ; const int q0 = qb * 256, qw = q0 + 32 * wid;
    const int cq = qw >> 6, NT = (q0 >> 6) + 4;
    LAS float* wsf = (LAS float*)(lds + ATT_WS) + wid * 64;
    bf16x8 qf[6];
    { const bf16_t* qp = Q + (rowbase + qw + r) * 768 + h * 96 + hh * 8;
#pragma unroll
      for (int s = 0; s < 6; ++s) qf[s] = *(const bf16x8*)(qp + 16 * s); }
    const int lkv = tid & 63, lc = tid >> 6;
    const bf16_t* kg0 = Kb + (rowbase + lkv) * 768 + h * 96 + lc * 8;
    const bf16_t* vg = KV + (rowbase + lkv) * 1024 + h * 128 + 64 + lc * 8;
    u32x4 kr0, kr1 = (u32x4){0u, 0u, 0u, 0u}, vr;
#define ATT_LOAD(t) do { kr0 = *(const u32x4*)(kg0 + (size_t)(t) * 64 * 768); if (tid < 256) kr1 = *(const u32x4*)(kg0 + (size_t)(t) * 64 * 768 + 64); vr = *(const u32x4*)(vg + (size_t)(t) * 64 * 1024); } while (0)
#define ATT_STORE(bufi) do { LAS unsigned char* kb_ = lds + (bufi) * ATT_BUF; *(LAS u32x4*)(kb_ + tid * 16) = kr0; if (tid < 256) *(LAS u32x4*)(kb_ + 8192 + tid * 16) = kr1; \
        LAS unsigned char* vb_ = kb_ + ATT_KBYTES + (lc * 8) * ATT_VPITCH + lkv * 2; \
        _Pragma("unroll") for (int j_ = 0; j_ < 8; ++j_) *(LAS unsigned short*)(vb_ + j_ * ATT_VPITCH) = (unsigned short)(vr[j_ >> 1] >> (16 * (j_ & 1))); } while (0)
    ATT_LOAD(0); ATT_STORE(0); __syncthreads();
    float m_run = -INFINITY, l_run = 0.f;
    f32x16 o0, o1;
#pragma unroll
    for (int i = 0; i < 16; ++i) { o0[i] = 0.f; o1[i] = 0.f; }
    for (int t = 0; t < NT; ++t) {
        const int buf = t & 1;
        if (t + 1 < NT) ATT_LOAD(t + 1);
        if (t <= cq) {
            const LAS unsigned char* kb = lds + buf * ATT_BUF; const LAS unsigned char* vb = kb + ATT_KBYTES;
            f32x16 p0, p1;
#pragma unroll
            for (int i = 0; i < 16; ++i) { p0[i] = 0.f; p1[i] = 0.f; }
#pragma unroll
            for (int s = 0; s < 6; ++s) { const bf16x8 a0 = *(const LAS bf16x8*)(kb + (2 * s + hh) * 1024 + r * 16), a1 = *(const LAS bf16x8*)(kb + (2 * s + hh) * 1024 + (r + 32) * 16);
                p0 = MFMA32(a0, qf[s], p0); p1 = MFMA32(a1, qf[s], p1); }
            float mx = p0[0];
#pragma unroll
            for (int i = 0; i < 16; ++i) { mx = __builtin_fmaxf(mx, p0[i]); mx = __builtin_fmaxf(mx, p1[i]); }
            mx = __builtin_fmaxf(mx, __shfl_xor(mx, 32));
            const float m_new = __builtin_fmaxf(m_run, mx), alpha = __builtin_amdgcn_exp2f(m_run - m_new); m_run = m_new;
            float rs = 0.f;
#pragma unroll
            for (int i = 0; i < 16; ++i) { p0[i] = __builtin_amdgcn_exp2f(p0[i] - m_new); p1[i] = __builtin_amdgcn_exp2f(p1[i] - m_new); rs += p0[i] + p1[i]; }
            l_run = l_run * alpha + rs;
            if (hh == 0) wsf[r] = alpha;
            LDS_WAIT();
#pragma unroll
            for (int g = 0; g < 4; ++g) { const f32x4 al = *(const LAS f32x4*)(wsf + 8 * g + 4 * hh);
#pragma unroll
                for (int e = 0; e < 4; ++e) { o0[4 * g + e] *= al[e]; o1[4 * g + e] *= al[e]; } }
#pragma unroll
            for (int half = 0; half < 2; ++half)
#pragma unroll
                for (int s2 = 0; s2 < 2; ++s2) {
                    const f32x16& P = half ? p1 : p0;
                    const bf16x8 pa = pack8(P[8 * s2], P[8 * s2 + 1], P[8 * s2 + 2], P[8 * s2 + 3], P[8 * s2 + 4], P[8 * s2 + 5], P[8 * s2 + 6], P[8 * s2 + 7]);
                    const int kvo = (32 * half + 16 * s2 + 4 * hh) * 2;
                    { const s16x4 lo = *(const LAS s16x4*)(vb + r * ATT_VPITCH + kvo), hi = *(const LAS s16x4*)(vb + r * ATT_VPITCH + kvo + 16);
                      const bf16x8 vf = __builtin_shufflevector(lo, hi, 0, 1, 2, 3, 4, 5, 6, 7); o0 = MFMA32(pa, vf, o0); }
                    { const s16x4 lo = *(const LAS s16x4*)(vb + (r + 32) * ATT_VPITCH + kvo), hi = *(const LAS s16x4*)(vb + (r + 32) * ATT_VPITCH + kvo + 16);
                      const bf16x8 vf = __builtin_shufflevector(lo, hi, 0, 1, 2, 3, 4, 5, 6, 7); o1 = MFMA32(pa, vf, o1); }
                }
        }
        if (t + 1 < NT) ATT_STORE(buf ^ 1);
        __syncthreads();
    }
    const float l_tot = l_run + __shfl_xor(l_run, 32);
    if (hh == 0) wsf[r] = 1.f / l_tot;
    LDS_WAIT();
#pragma unroll
    for (int g = 0; g < 4; ++g) { const f32x4 rl = *(const LAS f32x4*)(wsf + 8 * g + 4 * hh);
#pragma unroll
        for (int e = 0; e < 4; ++e) { const int i = 4 * g + e; bf16_t* op = O + (rowbase + qw + crow(i, hh)) * 512 + h * 64 + r;
            op[0] = (bf16_t)(cvt_pk_bf16(o0[i] * rl[e], 0.f) & 0xffffu); op[32] = (bf16_t)(cvt_pk_bf16(o1[i] * rl[e], 0.f) & 0xffffu); } }
    LDS_WAIT();
#undef ATT_LOAD
#undef ATT_STORE
}

__device__ __forceinline__ void sb_unit(LAS unsigned char* lds, const bf16_t* SBQ, bf16_t* O, int b, int h, int qb) {
    const int tid = threadIdx.x, lane = tid & 63, r = lane & 31, hh = lane >> 5; const int wid = __builtin_amdgcn_readfirstlane(tid >> 6);
    const size_t rowbase = (size_t)b * SEQ; const int q0 = qb * 256, qw = q0 + 32 * wid;
    const int NT = (q0 >> 6) + 4;
    constexpr float C2 = 0.125f * LOG2E;
    bf16x8 qf[4];
    { const bf16_t* qp = SBQ + (rowbase + qw + r) * 1536 + h * 64 + hh * 8;
#pragma unroll
      for (int s = 0; s < 4; ++s) qf[s] = *(const bf16x8*)(qp + 16 * s); }
    const int lkv = tid & 63, lc = tid >> 6;
    const bf16_t* kg0 = SBQ + (rowbase + lkv) * 1536 + 512 + h * 64 + lc * 8;
    const bf16_t* vg = SBQ + (rowbase + lkv) * 1536 + 1024 + h * 64 + lc * 8;
    u32x4 kr0, vr;
#define ATT_LOAD(t) do { kr0 = *(const u32x4*)(kg0 + (size_t)(t) * 64 * 1536); vr = *(const u32x4*)(vg + (size_t)(t) * 64 * 1536); } while (0)
#define ATT_STORE(bufi) do { LAS unsigned char* kb_ = lds + (bufi) * ATT_BUF; *(LAS u32x4*)(kb_ + tid * 16) = kr0; \
        LAS unsigned char* vb_ = kb_ + ATT_KBYTES + (lc * 8) * ATT_VPITCH + lkv * 2; \
        _Pragma("unroll") for (int j_ = 0; j_ < 8; ++j_) *(LAS unsigned short*)(vb_ + j_ * ATT_VPITCH) = (unsigned short)(vr[j_ >> 1] >> (16 * (j_ & 1))); } while (0)
    LAS unsigned* dflag = (LAS unsigned*)(lds + ATT_WS + 8 * 256);
    ATT_LOAD(NT - 1); ATT_STORE(0); __syncthreads();
    float carry = 0.f; bool wdone = false;
    f32x16 o0, o1;
#pragma unroll
    for (int i = 0; i < 16; ++i) { o0[i] = 0.f; o1[i] = 0.f; }
#define SB_SUB(X, kvh0, kvl) do { const bool diag_ = ((kvh0) == qw); float lk_[16], z_[16]; \
        _Pragma("unroll") for (int i = 0; i < 16; ++i) { const float z2 = X[i] * C2; const float ex = __builtin_amdgcn_exp2f(z2); float sp = __builtin_amdgcn_logf(1.f + ex); sp = z2 > 64.f ? z2 : sp; \
            const bool valid = !diag_ || (crow(i, hh) < r); lk_[i] = valid ? -sp : 0.f; z_[i] = z2; } \
        float G_[4], Gp_[4]; \
        _Pragma("unroll") for (int g = 0; g < 4; ++g) { G_[g] = (lk_[4 * g] + lk_[4 * g + 1]) + (lk_[4 * g + 2] + lk_[4 * g + 3]); Gp_[g] = __shfl_xor(G_[g], 32); } \
        float tail_[4]; tail_[3] = 0.f; tail_[2] = G_[3] + Gp_[3]; tail_[1] = tail_[2] + (G_[2] + Gp_[2]); tail_[0] = tail_[1] + (G_[1] + Gp_[1]); const float total_ = tail_[0] + (G_[0] + Gp_[0]); \
        float a_[16]; \
        _Pragma("unroll") for (int g = 0; g < 4; ++g) { const float base_ = carry + tail_[g] + (hh == 0 ? Gp_[g] : 0.f); \
            const float s3 = base_ + lk_[4 * g + 3], s2_ = s3 + lk_[4 * g + 2], s1 = s2_ + lk_[4 * g + 1], s0 = s1 + lk_[4 * g]; \
            a_[4 * g + 3] = __builtin_amdgcn_exp2f(z_[4 * g + 3] + s3); a_[4 * g + 2] = __builtin_amdgcn_exp2f(z_[4 * g + 2] + s2_); a_[4 * g + 1] = __builtin_amdgcn_exp2f(z_[4 * g + 1] + s1); a_[4 * g] = __builtin_amdgcn_exp2f(z_[4 * g] + s0); } \
        if (diag_) { _Pragma("unroll") for (int i = 0; i < 16; ++i) a_[i] = (crow(i, hh) < r) ? a_[i] : 0.f; } \
        carry += total_; \
        _Pragma("unroll") for (int s2 = 0; s2 < 2; ++s2) { \
            const bf16x8 pa = pack8(a_[8 * s2], a_[8 * s2 + 1], a_[8 * s2 + 2], a_[8 * s2 + 3], a_[8 * s2 + 4], a_[8 * s2 + 5], a_[8 * s2 + 6], a_[8 * s2 + 7]); \
            const int kvo = ((kvl) + 16 * s2 + 4 * hh) * 2; \
            { const s16x4 lo = *(const LAS s16x4*)(vb + r * ATT_VPITCH + kvo), hi = *(const LAS s16x4*)(vb + r * ATT_VPITCH + kvo + 16); \
              const bf16x8 vf = __builtin_shufflevector(lo, hi, 0, 1, 2, 3, 4, 5, 6, 7); o0 = MFMA32(pa, vf, o0); } \
            { const s16x4 lo = *(const LAS s16x4*)(vb + (r + 32) * ATT_VPITCH + kvo), hi = *(const LAS s16x4*)(vb + (r + 32) * ATT_VPITCH + kvo + 16); \
              const bf16x8 vf = __builtin_shufflevector(lo, hi, 0, 1, 2, 3, 4, 5, 6, 7); o1 = MFMA32(pa, vf, o1); } } } while (0)
    for (int it = 0; it < NT; ++it) {
        const int t = NT - 1 - it, buf = it & 1, kv0 = 64 * t;
        if (t > 0) ATT_LOAD(t - 1);
        if (kv0 <= qw && !wdone) {
            const LAS unsigned char* kb = lds + buf * ATT_BUF; const LAS unsigned char* vb = kb + ATT_KBYTES;
            const bool upper = (kv0 + 32 <= qw);
            f32x16 p0, p1;
#pragma unroll
            for (int i = 0; i < 16; ++i) { p0[i] = 0.f; p1[i] = 0.f; }
#pragma unroll
            for (int s = 0; s < 4; ++s) { const bf16x8 a0 = *(const LAS bf16x8*)(kb + (2 * s + hh) * 1024 + r * 16); p0 = MFMA32(a0, qf[s], p0); }
            if (upper) {
#pragma unroll
                for (int s = 0; s < 4; ++s) { const bf16x8 a1 = *(const LAS bf16x8*)(kb + (2 * s + hh) * 1024 + (r + 32) * 16); p1 = MFMA32(a1, qf[s], p1); }
                SB_SUB(p1, kv0 + 32, 32);
            }
            SB_SUB(p0, kv0, 0);
            wdone = __all(carry < -170.f) != 0;
        }
        if (lane == 0) dflag[(it & 1) * 8 + wid] = wdone ? 1u : 0u;
        if (t > 0) ATT_STORE(buf ^ 1);
        __syncthreads();
        { const u32x4 f0 = *(const LAS u32x4*)(dflag + (it & 1) * 8), f1 = *(const LAS u32x4*)(dflag + (it & 1) * 8 + 4);
          if ((f0.x & f0.y & f0.z & f0.w & f1.x & f1.y & f1.z & f1.w) != 0u) break; }
    }
    __syncthreads();
#pragma unroll
    for (int i = 0; i < 16; ++i) { bf16_t* op = O + (rowbase + qw + crow(i, hh)) * 512 + h * 64 + r;
        op[0] = (bf16_t)(cvt_pk_bf16(o0[i], 0.f) & 0xffffu); op[32] = (bf16_t)(cvt_pk_bf16(o1[i], 0.f) & 0xffffu); }
#undef SB_SUB
#undef ATT_LOAD
#undef ATT_STORE
}

#ifndef PHMASK
#define PHMASK 0xFFFF
#endif
#define PH(n) ((PHMASK >> (n)) & 1)
#ifndef DUPMASK
#define DUPMASK 0
#endif
#define DUP(n) (1 + ((DUPMASK >> (n)) & 1))
struct Args { const void* in[23]; float* out; unsigned char* ws; };

__global__ void __launch_bounds__(512, 2) fwd_kernel(Args args) {
    extern __shared__ __attribute__((aligned(16))) unsigned char lds_raw[];
    LAS unsigned char* lds = (LAS unsigned char*)lds_raw;
    const int tid = threadIdx.x, lane = tid & 63, wave = __builtin_amdgcn_readfirstlane(tid >> 6);
    const int G = gridDim.x; const int bx = blockIdx.x; const int vcu = (G % 8 == 0) ? (bx % 8) * (G / 8) + bx / 8 : bx;
    const int gw = vcu * 8 + wave, NGW = G * 8;
    unsigned char* ws = args.ws;
    unsigned* ctl = (unsigned*)(ws + WS_CTL);
    const float* x = (const float*)args.in[0]; const float* cvec = (const float*)args.in[1]; const int* positions = (const int*)args.in[2];
    const float* w_ada = (const float*)args.in[3]; const float* b_ada = (const float*)args.in[4]; const float* g_norm1 = (const float*)args.in[5];
    const float* w_in = (const float*)args.in[6]; const float* g_q_lat = (const float*)args.in[7]; const float* w_uq = (const float*)args.in[8];
    const float* g_kv_lat = (const float*)args.in[9]; const float* w_ukv = (const float*)args.in[10]; const float* g_qk_q = (const float*)args.in[11];
    const float* g_qk_k = (const float*)args.in[12]; const float* w_o_mla = (const float*)args.in[13]; const float* w_o_sb = (const float*)args.in[14];
    const float* w_out = (const float*)args.in[15]; const float* g_norm2 = (const float*)args.in[16]; const float* w_router = (const float*)args.in[17];
    const float* b_router = (const float*)args.in[18]; const float* w_gate_up = (const float*)args.in[19]; const float* b_gate_up = (const float*)args.in[20];
    const float* w_down = (const float*)args.in[21]; const float* b_down = (const float*)args.in[22];
    float* out = args.out;
    bf16_t* WIN = (bf16_t*)(ws + WS_WIN); bf16_t* WUQ = (bf16_t*)(ws + WS_WUQ); bf16_t* WUKV = (bf16_t*)(ws + WS_WUKV); bf16_t* WOM = (bf16_t*)(ws + WS_WOM);
    bf16_t* WOS = (bf16_t*)(ws + WS_WOS); bf16_t* WOUT = (bf16_t*)(ws + WS_WOUT); float* MOD = (float*)(ws + WS_MOD);
    unsigned char* WIN8 = ws + WS_WIN8; unsigned char* H8 = ws + WS_H8;
    bf16_t* HB = (bf16_t*)(ws + WS_H); bf16_t* KVRAW = (bf16_t*)(ws + WS_KVRAW); bf16_t* MERGED = (bf16_t*)(ws + WS_MERGED);
    bf16_t* SGA = (bf16_t*)(ws + WS_SGA); bf16_t* SGB = (bf16_t*)(ws + WS_SGB); unsigned char* H2 = ws + WS_H2;
    unsigned char* WGU = ws + WS_WGU; unsigned char* WDN = ws + WS_WDN; bf16_t* SBQ = (bf16_t*)(ws + WS_SB);
    int* TOKL = (int*)(ws + WS_TOKL); float* WLST = (float*)(ws + WS_WL); unsigned char* HID = ws + WS_HID;
    bf16_t* QL = (bf16_t*)(ws + WS_QL); bf16_t* KVL = (bf16_t*)(ws + WS_KVL); bf16_t* KPE = (bf16_t*)(ws + WS_KPE);
    bf16_t* QB = (bf16_t*)(ws + WS_Q); bf16_t* KB = (bf16_t*)(ws + WS_K); bf16_t* OMLA = (bf16_t*)(ws + WS_OMLA); bf16_t* OSB = (bf16_t*)(ws + WS_OSB);

    for (int u = tid; u < (LDS_BYTES - LDSCTL_OFF) / 4; u += 512) ((LAS unsigned*)(lds + LDSCTL_OFF))[u] = 0u;
    __syncthreads();
    XcdBarrier bar = xcd_barrier_post(ctl + CW_BAR, (volatile LAS unsigned*)(lds + LDSCTL_OFF + LC_BARST));
    LAS float* scr = (LAS float*)(lds + wave * 16384);

#if PH(0)
    {
        constexpr int I_IN = 16 * 133, I_UQ = 6 * 24, I_UKV = 4 * 32, I_OM = 8 * 32, I_OS = 8 * 32, I_OUT = 16 * 32;
        constexpr int NIT = I_IN + I_UQ + I_UKV + I_OM + I_OS + I_OUT;
        for (int it = gw; it < NIT; it += NGW) {
            int q = it;
            if (q < I_IN) { const int kb = q / 133, nb = q % 133, n0 = 32 * nb;
                if (nb < 69) transpose_item(w_in, 1024, DIN, WIN, 64 * kb, n0, n0 < 672 ? n0 : n0 + 96, scr, lane);
                else transpose_item_f8(w_in, 1024, DIN, WIN8, 64 * kb, n0, n0 - 2208, WSCALE, scr, lane);
                continue; } q -= I_IN;
            if (q < I_UQ) { const int kb = q / 24, nb = q % 24; transpose_item(w_uq, 384, 768, WUQ, 64 * kb, 32 * nb, 32 * nb, scr, lane); continue; } q -= I_UQ;
            if (q < I_UKV) { const int kb = q / 32, nb = q % 32; transpose_item(w_ukv, 256, 1024, WUKV, 64 * kb, 32 * nb, 32 * nb, scr, lane); continue; } q -= I_UKV;
            if (q < I_OM) { const int kb = q / 32, nb = q % 32; transpose_item(w_o_mla, 512, 1024, WOM, 64 * kb, 32 * nb, 32 * nb, scr, lane); continue; } q -= I_OM;
            if (q < I_OS) { const int kb = q / 32, nb = q % 32; transpose_item(w_o_sb, 512, 1024, WOS, 64 * kb, 32 * nb, 32 * nb, scr, lane); continue; } q -= I_OS;
            { const int kb = q / 32, nb = q % 32; transpose_item(w_out, 1024, 1024, WOUT, 64 * kb, 32 * nb, 32 * nb, scr, lane); }
        }
        for (int i = vcu * 512 + tid; i < 96 * 1024 * 2 / 16; i += G * 512) ((u32x4*)(WIN + 672 * 1024))[i] = (u32x4){0u, 0u, 0u, 0u};
        __syncthreads();
        for (int it = vcu; it < 6144 / 64; it += G) {
            for (int idx = lane; idx < 32 * 128; idx += 64) { const int b = idx >> 7, kk = idx & 127; const float cv = cvec[b * 1024 + 128 * wave + kk]; scr[idx] = cv / (1.f + __expf(-cv)); }
            LDS_WAIT(); asm volatile("" ::: "memory");
            float acc[32];
#pragma unroll
            for (int b = 0; b < 32; ++b) acc[b] = 0.f;
            const float* wp = w_ada + (size_t)(128 * wave) * 6144 + 64 * it + lane;
            for (int k4 = 0; k4 < 32; ++k4) {
                const float w0 = wp[(size_t)(4 * k4) * 6144], w1 = wp[(size_t)(4 * k4 + 1) * 6144], w2 = wp[(size_t)(4 * k4 + 2) * 6144], w3 = wp[(size_t)(4 * k4 + 3) * 6144];
#pragma unroll
                for (int b = 0; b < 32; ++b) { const f32x4 s = *(const LAS f32x4*)(scr + b * 128 + 4 * k4); acc[b] += s.x * w0 + s.y * w1 + s.z * w2 + s.w * w3; }
            }
            LDS_WAIT(); asm volatile("" ::: "memory");
#pragma unroll
            for (int b = 0; b < 32; ++b) scr[b * 64 + lane] = acc[b];
            __syncthreads();
#pragma unroll
            for (int bb = 0; bb < 4; ++bb) { const int b = 4 * wave + bb; float s = 0.f;
#pragma unroll
                for (int w2 = 0; w2 < 8; ++w2) s += ((const LAS float*)(lds + w2 * 16384))[b * 64 + lane];
                MOD[b * 6144 + 64 * it + lane] = s + b_ada[64 * it + lane]; }
            __syncthreads();
        }
    }
#endif
    xcd_barrier(bar);

#if PH(1)
    for (int gi = gw; gi < NTOK / 4; gi += NGW) {
        f32x4 v[4][4];
#pragma unroll
        for (int rr = 0; rr < 4; ++rr) { const f32x4* xr = (const f32x4*)(x + (size_t)(4 * gi + rr) * 1024) + lane;
#pragma unroll
            for (int j = 0; j < 4; ++j) v[rr][j] = xr[64 * j]; }
        const int b = (4 * gi) >> 11;
        const float* mb = MOD + (size_t)b * 6144;
        f32x4 gsc[4], shv[4];
#pragma unroll
        for (int j = 0; j < 4; ++j) { const int col = 4 * lane + 256 * j; gsc[j] = *(const f32x4*)(g_norm1 + col) * (*(const f32x4*)(mb + 1024 + col) + 1.f); shv[j] = *(const f32x4*)(mb + col); }
#pragma unroll
        for (int rr = 0; rr < 4; ++rr) { float ss = 0.f;
#pragma unroll
            for (int j = 0; j < 4; ++j) ss += (v[rr][j].x * v[rr][j].x + v[rr][j].y * v[rr][j].y) + (v[rr][j].z * v[rr][j].z + v[rr][j].w * v[rr][j].w);
            const float rstd = rsqrtf(wave_sum(ss) * (1.f / 1024.f) + EPS);
#pragma unroll
            for (int j = 0; j < 4; ++j) { const int col = 4 * lane + 256 * j; const f32x4 y = (v[rr][j] * rstd) * gsc[j] + shv[j];
                u32x2 o; o.x = cvt_pk_bf16(y.x, y.y); o.y = cvt_pk_bf16(y.z, y.w);
                *(u32x2*)(HB + (size_t)(4 * gi + rr) * 1024 + col) = o;
                *(unsigned*)(H8 + (size_t)(4 * gi + rr) * 1024 + col) = pk4_fp8(y.x, y.y, y.z, y.w); } }
    }
#endif
    xcd_barrier(bar);

#if PH(2)
    { pg8::DenseOrder S; S.init(HB, WIN, NTOK, 2304, 1024, G, bx);
      EpiProj E{QL, KVL, KPE, SBQ, SGA, SGB, 0, 1.f};
      pg8::gemm_phase<false>(lds, 1024, S, E); }
    { pg8::DenseOrder S; S.init(H8, WIN8, NTOK, 2048, 512, G, bx);
      EpiProj E{QL, KVL, KPE, SBQ, SGA, SGB, 2304, WDESCALE};
      pg8::gemm_phase_f8<false>(lds, 512, S, E); }
#endif
    xcd_barrier(bar);

#if PH(3)
    {
        f32x4 gq0 = (f32x4){0.f, 0.f, 0.f, 0.f}, gq1 = gq0, gk0 = gq0, gk1 = gq0;
        if (lane < 48) { gq0 = *(const f32x4*)(g_q_lat + lane * 8); gq1 = *(const f32x4*)(g_q_lat + lane * 8 + 4); }
        if (lane < 32) { gk0 = *(const f32x4*)(g_kv_lat + lane * 8); gk1 = *(const f32x4*)(g_kv_lat + lane * 8 + 4); }
        for (int gi = gw; gi < NTOK / 4; gi += NGW) {
            u32x4 vq[4], vk[4];
#pragma unroll
            for (int rr = 0; rr < 4; ++rr) { vq[rr] = (u32x4){0u, 0u, 0u, 0u}; vk[rr] = vq[rr];
                if (lane < 48) vq[rr] = *(const u32x4*)(QL + (size_t)(4 * gi + rr) * 384 + lane * 8);
                if (lane < 32) vk[rr] = *(const u32x4*)(KVL + (size_t)(4 * gi + rr) * 256 + lane * 8); }
#pragma unroll
            for (int rr = 0; rr < 4; ++rr) {
                { const u32x4 v = vq[rr]; float f[8] = {bf_lo(v.x), bf_hi(v.x), bf_lo(v.y), bf_hi(v.y), bf_lo(v.z), bf_hi(v.z), bf_lo(v.w), bf_hi(v.w)}; float ss = 0.f;
#pragma unroll
                  for (int j = 0; j < 8; ++j) ss += f[j] * f[j];
                  const float rstd = rsqrtf(wave_sum(ss) * (1.f / 384.f) + EPS);
                  if (lane < 48) { u32x4 o; o.x = cvt_pk_bf16(f[0] * rstd * gq0.x, f[1] * rstd * gq0.y); o.y = cvt_pk_bf16(f[2] * rstd * gq0.z, f[3] * rstd * gq0.w);
                      o.z = cvt_pk_bf16(f[4] * rstd * gq1.x, f[5] * rstd * gq1.y); o.w = cvt_pk_bf16(f[6] * rstd * gq1.z, f[7] * rstd * gq1.w); *(u32x4*)(QL + (size_t)(4 * gi + rr) * 384 + lane * 8) = o; } }
                { const u32x4 v = vk[rr]; float f[8] = {bf_lo(v.x), bf_hi(v.x), bf_lo(v.y), bf_hi(v.y), bf_lo(v.z), bf_hi(v.z), bf_lo(v.w), bf_hi(v.w)}; float ss = 0.f;
#pragma unroll
                  for (int j = 0; j < 8; ++j) ss += f[j] * f[j];
                  const float rstd = rsqrtf(wave_sum(ss) * (1.f / 256.f) + EPS);
                  if (lane < 32) { u32x4 o; o.x = cvt_pk_bf16(f[0] * rstd * gk0.x, f[1] * rstd * gk0.y); o.y = cvt_pk_bf16(f[2] * rstd * gk0.z, f[3] * rstd * gk0.w);
                      o.z = cvt_pk_bf16(f[4] * rstd * gk1.x, f[5] * rstd * gk1.y); o.w = cvt_pk_bf16(f[6] * rstd * gk1.z, f[7] * rstd * gk1.w); *(u32x4*)(KVL + (size_t)(4 * gi + rr) * 256 + lane * 8) = o; } }
            }
        }
    }
#endif
    xcd_barrier(bar);

#if PH(4)
    for (int rep = 0; rep < DUP(5); ++rep) {
    { pg8::DenseOrder S; S.init(QL, WUQ, NTOK, 768, 384, G, bx); EpiStore E{QB, 768}; pg8::gemm_phase<false>(lds, 384, S, E); }
    { pg8::DenseOrder S; S.init(KVL, WUKV, NTOK, 1024, 256, G, bx); EpiStore E{KVRAW, 1024}; pg8::gemm_phase<false>(lds, 256, S, E); } }
#endif
    xcd_barrier(bar);

#if PH(5)
    {
        const int hd = lane >> 3, sub = lane & 7;
        const float QSC = 0.10206207261596575f * LOG2E;
        const float if0 = exp2f(-(float)(2 * sub) * (13.287712379549449f / 16.f)), if1 = exp2f(-(float)(2 * sub + 1) * (13.287712379549449f / 16.f));
        f32x4 gq0 = *(const f32x4*)(g_qk_q + sub * 8), gq1 = *(const f32x4*)(g_qk_q + sub * 8 + 4); const f32x2 gqa = *(const f32x2*)(g_qk_q + 64 + 2 * sub), gqb = *(const f32x2*)(g_qk_q + 80 + 2 * sub);
        f32x4 gk0 = *(const f32x4*)(g_qk_k + sub * 8), gk1 = *(const f32x4*)(g_qk_k + sub * 8 + 4); const f32x2 gka = *(const f32x2*)(g_qk_k + 64 + 2 * sub), gkb = *(const f32x2*)(g_qk_k + 80 + 2 * sub);
        for (int gi = gw; gi < NTOK / 4; gi += NGW) {
            u32x4 A[4][2]; unsigned B1[4][2], B2[4][2]; float posf[4];
#pragma unroll
            for (int t = 0; t < 4; ++t) { const int m = 4 * gi + t; posf[t] = (float)positions[m];
                const bf16_t* qp = QB + (size_t)m * 768 + hd * 96; A[t][0] = *(const u32x4*)(qp + sub * 8); B1[t][0] = *(const unsigned*)(qp + 64 + 2 * sub); B2[t][0] = *(const unsigned*)(qp + 80 + 2 * sub);
                A[t][1] = *(const u32x4*)(KVRAW + (size_t)m * 1024 + hd * 128 + sub * 8); B1[t][1] = *(const unsigned*)(KPE + (size_t)m * 32 + 2 * sub); B2[t][1] = *(const unsigned*)(KPE + (size_t)m * 32 + 16 + 2 * sub); }
#pragma unroll
            for (int t = 0; t < 4; ++t) { const int m = 4 * gi + t;
                float cs[2], sn[2];
                { const float a0 = posf[t] * if0, a1 = posf[t] * if1;
                  double r0 = (double)a0 * 0.15915494309189535, r1 = (double)a1 * 0.15915494309189535; r0 -= __builtin_rint(r0); r1 -= __builtin_rint(r1);
                  cs[0] = __builtin_amdgcn_cosf((float)r0); sn[0] = __builtin_amdgcn_sinf((float)r0); cs[1] = __builtin_amdgcn_cosf((float)r1); sn[1] = __builtin_amdgcn_sinf((float)r1); }
#pragma unroll
                for (int which = 0; which < 2; ++which) {
                    const u32x4 Av = A[t][which]; const unsigned b1 = B1[t][which], b2 = B2[t][which];
                    bf16_t* dst = which ? KB + (size_t)m * 768 + hd * 96 : QB + (size_t)m * 768 + hd * 96;
                    float f[8] = {bf_lo(Av.x), bf_hi(Av.x), bf_lo(Av.y), bf_hi(Av.y), bf_lo(Av.z), bf_hi(Av.z), bf_lo(Av.w), bf_hi(Av.w)};
                    float x1[2] = {bf_lo(b1), bf_hi(b1)}, x2[2] = {bf_lo(b2), bf_hi(b2)};
                    float ss = x1[0] * x1[0] + x1[1] * x1[1] + x2[0] * x2[0] + x2[1] * x2[1];
#pragma unroll
                    for (int j = 0; j < 8; ++j) ss += f[j] * f[j];
                    ss += __shfl_xor(ss, 1); ss += __shfl_xor(ss, 2); ss += __shfl_xor(ss, 4);
                    const float rstd = rsqrtf(ss * (1.f / 96.f) + EPS);
                    const f32x4 g0 = which ? gk0 : gq0, g1 = which ? gk1 : gq1; const f32x2 ga = which ? gka : gqa, gb = which ? gkb : gqb;
                    const float sc = which ? 1.f : QSC;
                    float y[8] = {f[0] * rstd * g0.x, f[1] * rstd * g0.y, f[2] * rstd * g0.z, f[3] * rstd * g0.w, f[4] * rstd * g1.x, f[5] * rstd * g1.y, f[6] * rstd * g1.z, f[7] * rstd * g1.w};
                    const float y1a = x1[0] * rstd * ga.x, y1b = x1[1] * rstd * ga.y, y2a = x2[0] * rstd * gb.x, y2b = x2[1] * rstd * gb.y;
                    const float o1a = y1a * cs[0] - y2a * sn[0], o1b = y1b * cs[1] - y2b * sn[1], o2a = y2a * cs[0] + y1a * sn[0], o2b = y2b * cs[1] + y1b * sn[1];
                    u32x4 o; o.x = cvt_pk_bf16(y[0] * sc, y[1] * sc); o.y = cvt_pk_bf16(y[2] * sc, y[3] * sc); o.z = cvt_pk_bf16(y[4] * sc, y[5] * sc); o.w = cvt_pk_bf16(y[6] * sc, y[7] * sc);
                    *(u32x4*)(dst + sub * 8) = o; *(unsigned*)(dst + 64 + 2 * sub) = cvt_pk_bf16(o1a * sc, o1b * sc); *(unsigned*)(dst + 80 + 2 * sub) = cvt_pk_bf16(o2a * sc, o2b * sc);
                }
            }
        }
    }
#endif
    xcd_barrier(bar);

#if PH(6)
    for (int bh = vcu; bh < NB * NH; bh += G) {
        for (int rep = 0; rep < DUP(0); ++rep) for (int qb = 0; qb < 8; ++qb) mla_unit(lds, QB, KB, KVRAW, OMLA, bh >> 3, bh & 7, qb);
        for (int rep = 0; rep < DUP(1); ++rep) for (int qb = 0; qb < 8; ++qb) sb_unit(lds, SBQ, OSB, bh >> 3, bh & 7, qb);
    }
#endif
    xcd_barrier(bar);

#if PH(8)
    for (int rep = 0; rep < DUP(6); ++rep) {
    { pg8::DenseOrder S; S.init(OMLA, WOM, NTOK, 1024, 512, G, bx); EpiMerge<false> E{MERGED, SGA}; pg8::gemm_phase<false>(lds, 512, S, E); }
    { pg8::DenseOrder S; S.init(OSB, WOS, NTOK, 1024, 512, G, bx); EpiMerge<true> E{MERGED, SGB}; pg8::gemm_phase<false>(lds, 512, S, E); } }
#endif
    xcd_barrier(bar);

#if PH(9)
    { pg8::DenseOrder S; S.init(MERGED, WOUT, NTOK, 1024, 1024, G, bx); EpiWout E{x, out, MOD}; for (int rep = 0; rep < DUP(7); ++rep) pg8::gemm_phase<false>(lds, 1024, S, E); }
#endif
    xcd_barrier(bar);

#if PH(10)
    {
        constexpr int I_GU = 16 * 64, I_DN = 16 * 32;
        for (int rep = 0; rep < DUP(2); ++rep) for (int it = gw; it < NE * (I_GU + I_DN); it += NGW) {
            if (it < NE * I_GU) { const int e = it / I_GU, q = it % I_GU, kb = q / 64, nb = q % 64, n0 = 32 * nb; const int g = n0 >> 10, jj = n0 & 1023;
                transpose_item_f8(w_gate_up + (size_t)e * 1024 * 2048, 1024, 2048, WGU + (size_t)e * 2048 * 1024, 64 * kb, n0, 256 * (jj >> 7) + 128 * g + (jj & 127), WSCALE, scr, lane); }
            else { const int r2 = it - NE * I_GU, e = r2 / I_DN, q = r2 % I_DN, kb = q / 32, nb = q % 32;
                transpose_item_f8(w_down + (size_t)e * 1024 * 1024, 1024, 1024, WDN + (size_t)e * 1024 * 1024, 64 * kb, 32 * nb, 32 * nb, WSCALE, scr, lane); }
        }
        __syncthreads();
        {
            const int r = lane & 31, hh = lane >> 5;
            constexpr int TP = 1026;
            LAS float* tile = (LAS float*)lds;
            float areg[64];
#pragma unroll
            for (int mm = 0; mm < 64; ++mm) areg[mm] = w_router[(size_t)(128 * wave + 4 * (mm >> 1) + 2 * hh + (mm & 1)) * 32 + r];
            const float br = b_router[r];
            for (int tt = vcu; tt < NTOK / 32; tt += G) {
                { f32x4 v[4][4];
#pragma unroll
                  for (int rr = 0; rr < 4; ++rr) { const f32x4* xr = (const f32x4*)(out + (size_t)(32 * tt + 4 * wave + rr) * 1024) + lane;
#pragma unroll
                      for (int j = 0; j < 4; ++j) v[rr][j] = xr[64 * j]; }
                  const float* mb = MOD + (size_t)((32 * tt) >> 11) * 6144;
                  f32x4 gsc[4], shv[4];
#pragma unroll
                  for (int j = 0; j < 4; ++j) { const int col = 4 * lane + 256 * j; gsc[j] = *(const f32x4*)(g_norm2 + col) * (*(const f32x4*)(mb + 4096 + col) + 1.f); shv[j] = *(const f32x4*)(mb + 3072 + col); }
#pragma unroll
                  for (int rr = 0; rr < 4; ++rr) { float ss = 0.f; const int row = 4 * wave + rr;
#pragma unroll
                      for (int j = 0; j < 4; ++j) ss += (v[rr][j].x * v[rr][j].x + v[rr][j].y * v[rr][j].y) + (v[rr][j].z * v[rr][j].z + v[rr][j].w * v[rr][j].w);
                      const float rstd = rsqrtf(wave_sum(ss) * (1.f / 1024.f) + EPS);
#pragma unroll
                      for (int j = 0; j < 4; ++j) { const int col = 4 * lane + 256 * j; const f32x4 y = (v[rr][j] * rstd) * gsc[j] + shv[j];
                          *(unsigned*)(H2 + (size_t)(32 * tt + row) * 1024 + col) = pk4_fp8(y.x, y.y, y.z, y.w);
                          *(LAS f32x2*)(tile + row * TP + col) = (f32x2){y.x, y.y}; *(LAS f32x2*)(tile + row * TP + col + 2) = (f32x2){y.z, y.w}; } } }
                __syncthreads();
                f32x16 acc;
#pragma unroll
                for (int i = 0; i < 16; ++i) acc[i] = 0.f;
#pragma unroll
                for (int sg = 0; sg < 32; ++sg) { const f32x2 hv = *(const LAS f32x2*)(tile + r * TP + 128 * wave + 4 * sg + 2 * hh);
                    acc = __builtin_amdgcn_mfma_f32_32x32x2f32(areg[2 * sg], hv.x, acc, 0, 0, 0); acc = __builtin_amdgcn_mfma_f32_32x32x2f32(areg[2 * sg + 1], hv.y, acc, 0, 0, 0); }
                __syncthreads();
#pragma unroll
                for (int i = 0; i < 16; ++i) tile[wave * 1024 + i * 64 + lane] = acc[i];
                __syncthreads();
                { const int e = r, he = (e >> 2) & 1, ie = (e & 3) + 4 * (e >> 3);
#pragma unroll
                  for (int rr = 0; rr < 4; ++rr) { const int row = 4 * wave + rr; float v = br;
#pragma unroll
                      for (int w2 = 0; w2 < 8; ++w2) v += tile[w2 * 1024 + ie * 64 + row + 32 * he];
                      float tv[4]; int te[4];
#pragma unroll
                      for (int k = 0; k < 4; ++k) { float bv = v; int bi = e;
#pragma unroll
                          for (int off = 16; off >= 1; off >>= 1) { const float ov = __shfl_xor(bv, off); const int oi = __shfl_xor(bi, off); if (ov > bv || (ov == bv && oi < bi)) { bv = ov; bi = oi; } }
                          tv[k] = bv; te[k] = bi; if (e == bi) v = -INFINITY; }
                      const float e1 = __expf(tv[1] - tv[0]), e2 = __expf(tv[2] - tv[0]), e3 = __expf(tv[3] - tv[0]); const float inv = 1.f / (1.f + e1 + e2 + e3);
                      if (lane < 4) { const int k = lane; const int ek = k == 0 ? te[0] : k == 1 ? te[1] : k == 2 ? te[2] : te[3]; const float wk = (k == 0 ? 1.f : k == 1 ? e1 : k == 2 ? e2 : e3) * inv;
                          const unsigned slot = atomicAdd(ctl + CW_CNT + (k * 32 + ek) * 16, 1u);
                          TOKL[(size_t)(k * 32 + ek) * LISTCAP + slot] = 32 * tt + row; WLST[(size_t)(k * 32 + ek) * LISTCAP + slot] = wk; } } }
                __syncthreads();
            }
        }
    }
#endif
    xcd_barrier(bar);

#if PH(11)
    LAS int* tbase = (LAS int*)(lds + LDSCTL_OFF + LC_TBASE); LAS int* nearr = (LAS int*)(lds + LDSCTL_OFF + LC_NE); LAS int* tilee = (LAS int*)(lds + LDSCTL_OFF + LC_TILEE);
    for (int k = 0; k < TOPK; ++k) {
        int tid = threadIdx.x; asm volatile("" : "+v"(tid));
        __syncthreads();
        if (tid < NE) nearr[tid] = (int)ctl[CW_CNT + (k * 32 + tid) * 16];
        __syncthreads();
        if (tid == 0) { int a = 0;
#pragma nounroll
            for (int e = 0; e < NE; ++e) { tbase[e] = a; a += (nearr[e] + 255) >> 8; } tbase[NE] = a; }
        __syncthreads();
        { const int total = tbase[NE];
          for (int T = tid; T < total; T += 512) { int e = 0;
#pragma nounroll
              while (e < NE - 1 && tbase[e + 1] <= T) ++e;
              tilee[T] = e; } }
        __syncthreads();
#ifndef NO_GU
        { MoeOrder<8, true> S{(const char*)H2, (const char*)WGU, (size_t)2048 * 1024, TOKL + (size_t)k * NE * LISTCAP, G, vcu, tbase, nearr, tilee};
          EpiGateUp E{HID, b_gate_up};
          pg8::gemm_phase_f8<true>(lds, 512, S, E); }
#endif
        xcd_barrier(bar);
#ifndef NO_DN
        { MoeOrder<4, false> S{(const char*)HID, (const char*)WDN, (size_t)1024 * 1024, TOKL + (size_t)k * NE * LISTCAP, G, vcu, tbase, nearr, tilee};
          EpiDown E{out, b_down, MOD, TOKL + (size_t)k * NE * LISTCAP, WLST + (size_t)k * NE * LISTCAP};
          pg8::gemm_phase_f8<false>(lds, 512, S, E); }
#endif
        if (k + 1 < TOPK) xcd_barrier(bar);
    }
#endif
}

extern "C" void kernel_launch(void* const* d_in, const int* in_sizes, int n_in, void* d_out, int out_size, void* d_ws, size_t ws_size, hipStream_t stream) {
    static int grid = 0;
    if (grid == 0) {
        if (n_in != 23 || in_sizes[0] != NTOK * DM || out_size != NTOK * DM || ws_size < WS_END) { fprintf(stderr, "kernel_launch: unexpected shapes (n_in %d, in0 %d, out %d, ws %zu); nothing launched\n", n_in, n_in > 0 ? in_sizes[0] : -1, out_size, ws_size); grid = -1; return; }
        int dev = 0, cus = 0, per_cu = 0;
        if (hipGetDevice(&dev) != hipSuccess || hipDeviceGetAttribute(&cus, hipDeviceAttributeMultiprocessorCount, dev) != hipSuccess) { grid = -1; return; }
        if (hipFuncSetAttribute((const void*)fwd_kernel, hipFuncAttributeMaxDynamicSharedMemorySize, LDS_BYTES) != hipSuccess) { fprintf(stderr, "kernel_launch: hipFuncSetAttribute failed\n"); grid = -1; return; }
        if (hipOccupancyMaxActiveBlocksPerMultiprocessor(&per_cu, (const void*)fwd_kernel, 512, LDS_BYTES) != hipSuccess || per_cu < 1) fprintf(stderr, "kernel_launch: occupancy query reports %d\n", per_cu);
        (void)hipGetLastError();
        grid = cus;
    }
    if (grid < 0) return;
    if (hipMemsetAsync((char*)d_ws + WS_CTL, 0, CTL_ZERO_BYTES, stream) != hipSuccess) return;
    Args a{};
    for (int i = 0; i < 23; ++i) a.in[i] = d_in[i];
    a.out = (float*)d_out; a.ws = (unsigned char*)d_ws;
    hipLaunchKernelGGL(fwd_kernel, dim3(grid), dim3(512), LDS_BYTES, stream, a);
}
```

```cpp
#include <hip/hip_runtime.h>
#include <cstdio>
#include <cstdint>

#define LAS __attribute__((address_space(3)))
#define GAS __attribute__((address_space(1)))
typedef unsigned short bf16_t;
typedef short bf16x8 __attribute__((ext_vector_type(8)));
typedef short s16x4 __attribute__((ext_vector_type(4)));
typedef float f32x2 __attribute__((ext_vector_type(2)));
typedef float f32x4 __attribute__((ext_vector_type(4)));
typedef float f32x16 __attribute__((ext_vector_type(16)));
typedef unsigned u32x2 __attribute__((ext_vector_type(2)));
typedef unsigned u32x4 __attribute__((ext_vector_type(4)));
typedef int v8i __attribute__((ext_vector_type(8)));
typedef unsigned u32x8 __attribute__((ext_vector_type(8)));

constexpr int NB = 32, SEQ = 2048, DM = 1024, NTOK = NB * SEQ;
constexpr int QLORA = 384, KVLORA = 256, ROPE = 32, NOPE = 64, VD = 64, QKD = 96, NH = 8;
constexpr int SBD = 64;
constexpr int NE = 32, TOPK = 4, DE = 1024;
constexpr int DIN = 4256, DINP = 4352;
constexpr float EPS = 1e-6f;
constexpr float LOG2E = 1.4426950408889634f;
constexpr int LISTCAP = NTOK;
constexpr int MAXTILES = NTOK / 256 + NE;

constexpr size_t MiB = 1u << 20;
constexpr size_t WS_CTL = 0, CTL_ZERO_BYTES = 1 * MiB;
constexpr size_t WS_WIN = 1 * MiB;
constexpr size_t WS_WUQ = 10 * MiB;
constexpr size_t WS_WUKV = 11 * MiB;
constexpr size_t WS_WOM = 12 * MiB;
constexpr size_t WS_WOS = 13 * MiB;
constexpr size_t WS_WOUT = 14 * MiB;
constexpr size_t WS_MOD = 16 * MiB;
constexpr size_t WS_WIN8 = 18 * MiB;
constexpr size_t WS_H = 32 * MiB;
constexpr size_t WS_KVRAW = WS_H, WS_MERGED = WS_H;
constexpr size_t WS_SGA = 160 * MiB;
constexpr size_t WS_H2 = WS_SGA;
constexpr size_t WS_SGB = 288 * MiB;
constexpr size_t WS_WGU = WS_SGB;
constexpr size_t WS_SB = 416 * MiB;
constexpr size_t WS_WDN = 416 * MiB;
constexpr size_t WS_TOKL = 480 * MiB;
constexpr size_t WS_WL = 512 * MiB;
constexpr size_t WS_HID = 544 * MiB;
constexpr size_t WS_QL = 608 * MiB;
constexpr size_t WS_KVL = 656 * MiB;
constexpr size_t WS_KPE = 688 * MiB;
constexpr size_t WS_Q = 692 * MiB;
constexpr size_t WS_K = 788 * MiB;
constexpr size_t WS_OMLA = 884 * MiB;
constexpr size_t WS_H8 = WS_OMLA;
constexpr size_t WS_OSB = 948 * MiB;
constexpr size_t WS_END = 1012 * MiB;
static_assert(WS_HID + (size_t)4 * MAXTILES * 256 * 1024 <= WS_END, "hid (fp8, all four rounds)");
constexpr int CW_BAR = 4096;
constexpr int CW_CNT = 16384;

constexpr int RING_BYTES = 131072;
constexpr int LDSCTL_OFF = RING_BYTES + 1024;
constexpr int LC_BARST = 0;
constexpr int LC_RBASE = 32;
constexpr int LC_TBASE = 64;
constexpr int LC_NE = 640;
constexpr int LC_TILEE = 1152;
constexpr int LDS_BYTES = 147456;
static_assert(LC_TILEE + 4 * MAXTILES * 4 <= LDS_BYTES - LDSCTL_OFF, "lds ctl");

__device__ __forceinline__ unsigned cvt_pk_bf16(float lo, float hi) { unsigned r; asm volatile("v_cvt_pk_bf16_f32 %0, %1, %2" : "=v"(r) : "v"(lo), "v"(hi)); return r; }
__device__ __forceinline__ float bf_lo(unsigned u) { return __builtin_bit_cast(float, u << 16); }
__device__ __forceinline__ float bf_hi(unsigned u) { return __builtin_bit_cast(float, u & 0xffff0000u); }
__device__ __forceinline__ float fast_sigmoid(float x) { return __builtin_amdgcn_rcpf(1.f + __builtin_amdgcn_exp2f(-x * LOG2E)); }

namespace pg8 {
constexpr int BM = 256, BK = 64, HALF = 128, HTB = HALF * BK * 2, STAGE_BYTES = 8 * HTB, NXCD = 8, WGM = 8;
__host__ __device__ __forceinline__ int lds_byte(int r, int c) { const int st = (r >> 4) * 2 + (c >> 5), rr = r & 15, cc = c & 31, ob = rr * 64 + cc * 2; return st * 1024 + (ob ^ (((ob >> 9) & 1) << 5)); }
__host__ __device__ __forceinline__ void stage_rc(int b, int& R, int& C) { const int st = b / 1024, sb = b % 1024, swz = sb ^ (((sb >> 9) & 1) << 5); R = (st >> 1) * 16 + swz / 64; C = (st & 1) * 32 + (swz % 64) / 2; }
__host__ __device__ __forceinline__ int perm32(int rho) { const int n = rho >> 4, i = rho & 15; return 8 * (i >> 2) + 4 * n + (i & 3); }

struct Unit { int pm, pn, e, j0, ne, kk; };

struct DenseOrder {
    const char* A; const char* Bt; int K; int nM, nN, nwg, G, c;
    __device__ void init(const void* A_, const void* Bt_, int M, int N, int K_, int G_, int c_) { A = (const char*)A_; Bt = (const char*)Bt_; K = K_; nM = M / BM; nN = N / BM; nwg = nM * nN; G = G_; c = c_; }
    __device__ __forceinline__ bool next(int i, Unit& u) const {
        const long L = (long)i * G + c; if (L >= nwg) return false;
        int wgid = (int)L; { const int q = nwg / NXCD, r = nwg % NXCD, xcd = wgid % NXCD, off = wgid / NXCD; wgid = (xcd < r ? xcd * (q + 1) : r * (q + 1) + (xcd - r) * q) + off; }
        const int nig = WGM * nN, gid = wgid / nig, fm = gid * WGM, gsz = (nM - fm) < WGM ? (nM - fm) : WGM;
        u.pm = fm + ((wgid % nig) % gsz); u.pn = (wgid % nig) / gsz; u.e = 0; u.j0 = 0; u.ne = 0; u.kk = 0; return true;
    }
    __device__ __forceinline__ const char* a_base(const Unit& u) const { return A + (size_t)u.pm * (size_t)(BM * 2) * K; }
    __device__ __forceinline__ const char* b_base(const Unit& u) const { return Bt + (size_t)u.pn * (size_t)(BM * 2) * K; }
    __device__ __forceinline__ unsigned row_of(const Unit&, int) const { return 0u; }
};

template <bool GATHER, class Epi, class Sched>
__device__ __forceinline__ void gemm_phase(LAS unsigned char* lds, const int K, const Sched& S, const Epi& E) {
    int tid_ = threadIdx.x; asm volatile("" : "+v"(tid_));
    const int tid = tid_, wid = __builtin_amdgcn_readfirstlane(tid >> 6), lane = tid & 63, wr = wid >> 2, wc = wid & 3, fr = lane & 15, fq = lane >> 4;
    const int nt = K / BK;
    int RA[2]; unsigned cofA[2], voffB[2];
#pragma unroll
    for (int i = 0; i < 2; ++i) { int R, C; stage_rc(tid * 16 + i * 8192, R, C); const int Rb = (R & ~31) + perm32(R & 31);
        RA[i] = R; cofA[i] = (unsigned)C * 2u; voffB[i] = (unsigned)(Rb * K + C) * 2u; }
    const size_t kstep = (size_t)(BK * 2);
    const size_t hstep = (size_t)HALF * K * 2;
    const unsigned ldsw = (unsigned)wid * 1024u;
    const int aoff = lds_byte(wr * 64 + fr, fq * 8), boff = lds_byte(wc * 32 + fr, fq * 8);
#define PG8_SA(b, h) (((b) * 2 + (h)) * HTB)
#define PG8_SB(b, h) ((4 + (b) * 2 + (h)) * HTB)
#define PG8_STAGE(bufoff, gbase, voff) do { _Pragma("unroll") for (int _i = 0; _i < 2; ++_i) \
        __builtin_amdgcn_global_load_lds((const unsigned*)((const char*)(gbase) + (voff)[_i]), (LAS unsigned*)(lds + (bufoff) + ldsw + _i * 8192), 16, 0, 0); } while (0)
#define PG8_LDA(dst, b, h) do { _Pragma("unroll") for (int m = 0; m < 4; ++m) _Pragma("unroll") for (int k = 0; k < 2; ++k) dst[m][k] = *(const LAS bf16x8*)(lds + PG8_SA(b, h) + aoff + m * 2048 + k * 1024); } while (0)
#define PG8_LDB(dst, b, h) do { _Pragma("unroll") for (int n = 0; n < 2; ++n) _Pragma("unroll") for (int k = 0; k < 2; ++k) dst[n][k] = *(const LAS bf16x8*)(lds + PG8_SB(b, h) + boff + n * 2048 + k * 1024); } while (0)
#define PG8_MMA(ai, bj, At, Bt) do { __builtin_amdgcn_s_setprio(1); _Pragma("unroll") for (int m = 0; m < 4; ++m) _Pragma("unroll") for (int n = 0; n < 2; ++n) _Pragma("unroll") for (int k = 0; k < 2; ++k) \
        acc[ai][bj][m][n] = __builtin_amdgcn_mfma_f32_16x16x32_bf16(Bt[n][k], At[m][k], acc[ai][bj][m][n], 0, 0, 0); __builtin_amdgcn_s_setprio(0); } while (0)
#define PG8_WAIT_V(n) asm volatile("s_waitcnt vmcnt(" #n ")" ::: "memory")
#define PG8_WAIT_L(n) asm volatile("s_waitcnt lgkmcnt(" #n ")" ::: "memory")
#define PG8_BAR __builtin_amdgcn_s_barrier()
#define PG8_SCHED __builtin_amdgcn_sched_barrier(0)
#define PG8_AOFFS(dst, u) do { _Pragma("unroll") for (int _h = 0; _h < 2; ++_h) _Pragma("unroll") for (int _i = 0; _i < 2; ++_i) { \
        const unsigned _row = GATHER ? S.row_of(u, _h * HALF + RA[_i]) : (unsigned)(_h * HALF + RA[_i]); dst[_h][_i] = _row * (unsigned)(K * 2) + cofA[_i]; } } while (0)
    Unit cur, nxt; int ui = 0;
    if (!S.next(0, cur)) return;
    f32x4 acc[2][2][4][2];
#pragma unroll
    for (int a = 0; a < 2; ++a)
#pragma unroll
        for (int b = 0; b < 2; ++b)
#pragma unroll
            for (int m = 0; m < 4; ++m)
#pragma unroll
                for (int n = 0; n < 2; ++n) acc[a][b][m][n] = (f32x4){0.f, 0.f, 0.f, 0.f};
    bf16x8 At[4][2], B0[2][2], B1[2][2];
    unsigned oc[2][2], on[2][2];
    PG8_AOFFS(oc, cur);
    const char* cA = S.a_base(cur); const char* cB = S.b_base(cur);
    PG8_STAGE(PG8_SB(0, 0), cB, voffB); PG8_STAGE(PG8_SB(0, 1), cB + hstep, voffB); PG8_STAGE(PG8_SA(0, 0), cA, oc[0]); PG8_STAGE(PG8_SA(0, 1), cA, oc[1]);
    if (wr == 1) PG8_BAR;
    PG8_WAIT_V(2); PG8_BAR;
    PG8_STAGE(PG8_SB(1, 0), cB + kstep, voffB); PG8_STAGE(PG8_SA(1, 0), cA + kstep, oc[0]); PG8_STAGE(PG8_SB(1, 1), cB + hstep + kstep, voffB);
    PG8_WAIT_V(6); PG8_BAR;
    for (;;) {
        const bool has_next = S.next(ui + 1, nxt);
        const char* nA = has_next ? S.a_base(nxt) : cA; const char* nB = has_next ? S.b_base(nxt) : cB;
        if constexpr (GATHER) { if (has_next) { PG8_AOFFS(on, nxt);
            _Pragma("unroll") for (int _h = 0; _h < 2; ++_h) _Pragma("unroll") for (int _i = 0; _i < 2; ++_i) asm volatile("" : "+v"(on[_h][_i]));
          } else {
#pragma unroll
            for (int _h = 0; _h < 2; ++_h)
#pragma unroll
                for (int _i = 0; _i < 2; ++_i) on[_h][_i] = oc[_h][_i]; } }
#pragma nounroll
        for (int t = 0; t < nt; t += 2) {
            const bool last = (t == nt - 2);
            const char* a1 = cA + (size_t)(t + 1) * kstep;
            const char* a2 = last ? nA : cA + (size_t)(t + 2) * kstep; const char* b2 = last ? nB : cB + (size_t)(t + 2) * kstep;
            const char* a3 = a2 + kstep; const char* b3 = b2 + kstep;
            unsigned o2[2][2];
#pragma unroll
            for (int _h = 0; _h < 2; ++_h)
#pragma unroll
                for (int _i = 0; _i < 2; ++_i) o2[_h][_i] = (GATHER && last) ? on[_h][_i] : oc[_h][_i];
            PG8_LDB(B0, 0, 0); PG8_LDB(B1, 0, 1); PG8_SCHED; PG8_LDA(At, 0, 0); PG8_STAGE(PG8_SA(1, 1), a1, oc[1]);
            PG8_WAIT_V(8); PG8_WAIT_L(0); PG8_BAR; PG8_MMA(0, 0, At, B0); PG8_MMA(0, 1, At, B1); PG8_BAR; PG8_SCHED;
            PG8_LDA(At, 0, 1); PG8_STAGE(PG8_SB(0, 0), b2, voffB); PG8_STAGE(PG8_SB(0, 1), b2 + hstep, voffB); PG8_STAGE(PG8_SA(0, 0), a2, o2[0]);
            PG8_WAIT_V(8); PG8_WAIT_L(0); PG8_BAR; PG8_MMA(1, 0, At, B0); PG8_MMA(1, 1, At, B1); PG8_BAR; PG8_SCHED;
            PG8_LDB(B0, 1, 0); PG8_LDB(B1, 1, 1); PG8_SCHED; PG8_LDA(At, 1, 0); PG8_STAGE(PG8_SA(0, 1), a2, o2[1]);
            PG8_WAIT_V(8); PG8_WAIT_L(0); PG8_BAR; PG8_MMA(0, 0, At, B0); PG8_MMA(0, 1, At, B1); PG8_BAR; PG8_SCHED;
            PG8_LDA(At, 1, 1); PG8_STAGE(PG8_SB(1, 0), b3, voffB); PG8_STAGE(PG8_SB(1, 1), b3 + hstep, voffB); PG8_STAGE(PG8_SA(1, 0), a3, o2[0]);
            PG8_WAIT_V(8); PG8_WAIT_L(0); PG8_BAR; PG8_MMA(1, 0, At, B0); PG8_MMA(1, 1, At, B1); PG8_BAR; PG8_SCHED;
        }
        if (wr == 0) PG8_BAR;
        E(acc, cur, wr, wc, fr, fq);
        if (!has_next) break;
#pragma unroll
        for (int a = 0; a < 2; ++a)
#pragma unroll
            for (int b = 0; b < 2; ++b)
#pragma unroll
                for (int m = 0; m < 4; ++m)
#pragma unroll
                    for (int n = 0; n < 2; ++n) acc[a][b][m][n] = (f32x4){0.f, 0.f, 0.f, 0.f};
        cur = nxt; cA = nA; cB = nB; ++ui;
        if constexpr (GATHER) {
#pragma unroll
        for (int _h = 0; _h < 2; ++_h)
#pragma unroll
            for (int _i = 0; _i < 2; ++_i) oc[_h][_i] = on[_h][_i]; }
        if (wr == 1) PG8_BAR;
    }
    PG8_WAIT_V(0);
    PG8_BAR;
#undef PG8_SA
#undef PG8_SB
#undef PG8_STAGE
#undef PG8_LDA
#undef PG8_LDB
#undef PG8_MMA
#undef PG8_WAIT_V
#undef PG8_WAIT_L
#undef PG8_BAR
#undef PG8_SCHED
#undef PG8_AOFFS
}
template <bool GATHER, class Epi, class Sched>
__device__ __forceinline__ void gemm_phase_f8(LAS unsigned char* lds, const int K, const Sched& S, const Epi& E) {
    int tid_ = threadIdx.x; asm volatile("" : "+v"(tid_));
    const int tid = tid_, wid = __builtin_amdgcn_readfirstlane(tid >> 6), lane = tid & 63, wr = wid >> 2, wc = wid & 3, fr = lane & 15, fq = lane >> 4;
    const int nt = K / BK;
    int RA[2]; unsigned cofA[2], voffB[2];
#pragma unroll
    for (int i = 0; i < 2; ++i) { int R, C; stage_rc(tid * 16 + i * 8192, R, C); const int Rb = (R & ~31) + perm32(R & 31);
        RA[i] = R; cofA[i] = (unsigned)C * 2u; voffB[i] = (unsigned)(Rb * K + C) * 2u; }
    const size_t kstep = (size_t)(BK * 2);
    const size_t hstep = (size_t)HALF * K * 2;
    const unsigned ldsw = (unsigned)wid * 1024u;
    const int aoff = lds_byte(wr * 64 + fr, 16 * (fq & 1)) + (fq >> 1) * 1024, boff = lds_byte(wc * 32 + fr, 16 * (fq & 1)) + (fq >> 1) * 1024;
#define PG8_SA(b, h) (((b) * 2 + (h)) * HTB)
#define PG8_SB(b, h) ((4 + (b) * 2 + (h)) * HTB)
#define PG8_STAGE(bufoff, gbase, voff) do { _Pragma("unroll") for (int _i = 0; _i < 2; ++_i) \
        __builtin_amdgcn_global_load_lds((const unsigned*)((const char*)(gbase) + (voff)[_i]), (LAS unsigned*)(lds + (bufoff) + ldsw + _i * 8192), 16, 0, 0); } while (0)
#define PG8_LD32(p_) __builtin_shufflevector(*(const LAS u32x4*)(p_), *(const LAS u32x4*)((p_) + 16), 0, 1, 2, 3, 4, 5, 6, 7)
#define PG8_LDA(dst, b, h) do { _Pragma("unroll") for (int m = 0; m < 4; ++m) dst[m] = PG8_LD32(lds + PG8_SA(b, h) + aoff + m * 2048); } while (0)
#define PG8_LDB(dst, b, h) do { _Pragma("unroll") for (int n = 0; n < 2; ++n) dst[n] = PG8_LD32(lds + PG8_SB(b, h) + boff + n * 2048); } while (0)
#define PG8_F8(fr_) ((v8i){(int)fr_[0][0], (int)fr_[0][1], (int)fr_[0][2], (int)fr_[0][3], (int)fr_[1][0], (int)fr_[1][1], (int)fr_[1][2], (int)fr_[1][3]})
#define PG8_MMA(ai, bj, At, Bt) do { __builtin_amdgcn_s_setprio(1); _Pragma("unroll") for (int m = 0; m < 4; ++m) _Pragma("unroll") for (int n = 0; n < 2; ++n) \
        asm volatile("v_mfma_scale_f32_16x16x128_f8f6f4 %0, %1, %2, %0, %3, %3 op_sel_hi:[0,0,0]" : "+v"(acc[ai][bj][m][n]) : "v"(Bt[n]), "v"(At[m]), "v"(one_scale)); __builtin_amdgcn_s_setprio(0); } while (0)
#define PG8_WAIT_V(n) asm volatile("s_waitcnt vmcnt(" #n ")" ::: "memory")
#define PG8_WAIT_L(n) asm volatile("s_waitcnt lgkmcnt(" #n ")" ::: "memory")
#define PG8_BAR __builtin_amdgcn_s_barrier()
#define PG8_SCHED __builtin_amdgcn_sched_barrier(0)
#define PG8_AOFFS(dst, u) do { _Pragma("unroll") for (int _h = 0; _h < 2; ++_h) _Pragma("unroll") for (int _i = 0; _i < 2; ++_i) { \
        const unsigned _row = GATHER ? S.row_of(u, _h * HALF + RA[_i]) : (unsigned)(_h * HALF + RA[_i]); dst[_h][_i] = _row * (unsigned)(K * 2) + cofA[_i]; } } while (0)
    Unit cur, nxt; int ui = 0;
    if (!S.next(0, cur)) return;
    f32x4 acc[2][2][4][2];
#pragma unroll
    for (int a = 0; a < 2; ++a)
#pragma unroll
        for (int b = 0; b < 2; ++b)
#pragma unroll
            for (int m = 0; m < 4; ++m)
#pragma unroll
                for (int n = 0; n < 2; ++n) { acc[a][b][m][n] = (f32x4){0.f, 0.f, 0.f, 0.f}; asm volatile("" : "+v"(acc[a][b][m][n])); }
    u32x8 At[4], B0[2], B1[2];
    int one_scale = 0x7f7f7f7f; asm volatile("" : "+v"(one_scale));
    unsigned oc[2][2], on[2][2];
    PG8_AOFFS(oc, cur);
    const char* cA = S.a_base(cur); const char* cB = S.b_base(cur);
    PG8_STAGE(PG8_SB(0, 0), cB, voffB); PG8_STAGE(PG8_SB(0, 1), cB + hstep, voffB); PG8_STAGE(PG8_SA(0, 0), cA, oc[0]); PG8_STAGE(PG8_SA(0, 1), cA, oc[1]);
    if (wr == 1) PG8_BAR;
    PG8_WAIT_V(2); PG8_BAR;
    PG8_STAGE(PG8_SB(1, 0), cB + kstep, voffB); PG8_STAGE(PG8_SA(1, 0), cA + kstep, oc[0]); PG8_STAGE(PG8_SB(1, 1), cB + hstep + kstep, voffB);
    PG8_WAIT_V(6); PG8_BAR;
    for (;;) {
        const bool has_next = S.next(ui + 1, nxt);
        const char* nA = has_next ? S.a_base(nxt) : cA; const char* nB = has_next ? S.b_base(nxt) : cB;
        if constexpr (GATHER) { if (has_next) { PG8_AOFFS(on, nxt);
            _Pragma("unroll") for (int _h = 0; _h < 2; ++_h) _Pragma("unroll") for (int _i = 0; _i < 2; ++_i) asm volatile("" : "+v"(on[_h][_i]));
          } else {
#pragma unroll
            for (int _h = 0; _h < 2; ++_h)
#pragma unroll
                for (int _i = 0; _i < 2; ++_i) on[_h][_i] = oc[_h][_i]; } }
#pragma nounroll
        for (int t = 0; t < nt; t += 2) {
            const bool last = (t == nt - 2);
            const char* a1 = cA + (size_t)(t + 1) * kstep;
            const char* a2 = last ? nA : cA + (size_t)(t + 2) * kstep; const char* b2 = last ? nB : cB + (size_t)(t + 2) * kstep;
            const char* a3 = a2 + kstep; const char* b3 = b2 + kstep;
            unsigned o2[2][2];
#pragma unroll
            for (int _h = 0; _h < 2; ++_h)
#pragma unroll
                for (int _i = 0; _i < 2; ++_i) o2[_h][_i] = (GATHER && last) ? on[_h][_i] : oc[_h][_i];
            PG8_LDB(B0, 0, 0); PG8_LDB(B1, 0, 1); PG8_SCHED; PG8_LDA(At, 0, 0); PG8_STAGE(PG8_SA(1, 1), a1, oc[1]);
            PG8_WAIT_V(8); PG8_WAIT_L(0); PG8_BAR; PG8_MMA(0, 0, At, B0); PG8_MMA(0, 1, At, B1); PG8_BAR; PG8_SCHED;
            PG8_LDA(At, 0, 1); PG8_STAGE(PG8_SB(0, 0), b2, voffB); PG8_STAGE(PG8_SB(0, 1), b2 + hstep, voffB); PG8_STAGE(PG8_SA(0, 0), a2, o2[0]);
            PG8_WAIT_V(8); PG8_WAIT_L(0); PG8_BAR; PG8_MMA(1, 0, At, B0); PG8_MMA(1, 1, At, B1); PG8_BAR; PG8_SCHED;
            PG8_LDB(B0, 1, 0); PG8_LDB(B1, 1, 1); PG8_SCHED; PG8_LDA(At, 1, 0); PG8_STAGE(PG8_SA(0, 1), a2, o2[1]);
            PG8_WAIT_V(8); PG8_WAIT_L(0); PG8_BAR; PG8_MMA(0, 0, At, B0); PG8_MMA(0, 1, At, B1); PG8_BAR; PG8_SCHED;
            PG8_LDA(At, 1, 1); PG8_STAGE(PG8_SB(1, 0), b3, voffB); PG8_STAGE(PG8_SB(1, 1), b3 + hstep, voffB); PG8_STAGE(PG8_SA(1, 0), a3, o2[0]);
            PG8_WAIT_V(8); PG8_WAIT_L(0); PG8_BAR; PG8_MMA(1, 0, At, B0); PG8_MMA(1, 1, At, B1); PG8_BAR; PG8_SCHED;
        }
        asm volatile("s_nop 15\n\ts_nop 15" ::: "memory");
        if (wr == 0) PG8_BAR;
        E(acc, cur, wr, wc, fr, fq);
        if (!has_next) break;
#pragma unroll
        for (int a = 0; a < 2; ++a)
#pragma unroll
            for (int b = 0; b < 2; ++b)
#pragma unroll
                for (int m = 0; m < 4; ++m)
#pragma unroll
                    for (int n = 0; n < 2; ++n) { acc[a][b][m][n] = (f32x4){0.f, 0.f, 0.f, 0.f}; asm volatile("" : "+v"(acc[a][b][m][n])); }
        cur = nxt; cA = nA; cB = nB; ++ui;
        if constexpr (GATHER) {
#pragma unroll
        for (int _h = 0; _h < 2; ++_h)
#pragma unroll
            for (int _i = 0; _i < 2; ++_i) oc[_h][_i] = on[_h][_i]; }
        if (wr == 1) PG8_BAR;
    }
    PG8_WAIT_V(0);
    PG8_BAR;
#undef PG8_SA
#undef PG8_SB
#undef PG8_STAGE
#undef PG8_LDA
#undef PG8_LDB
#undef PG8_MMA
#undef PG8_WAIT_V
#undef PG8_WAIT_L
#undef PG8_BAR
#undef PG8_SCHED
#undef PG8_AOFFS
#undef PG8_F8
}
}
#define XB_TMO      128
#define XB_XCNT(j)  (256  + 64 * (j))
#define XB_XSUB(j)  (1280 + 64 * (j))
#define XB_XGEN(j)  (2304 + 64 * (j))
#define XB_TOP      3328
#define XB_TOPGEN   3392
#define XCD_BAR_WORDS 3456
#define XB_SPIN_CAP (1u << 18)

__device__ __forceinline__ unsigned xb_ld(unsigned* p)              { return __hip_atomic_load(p, __ATOMIC_RELAXED, __HIP_MEMORY_SCOPE_AGENT); }
__device__ __forceinline__ unsigned xb_add(unsigned* p, unsigned v) { return __hip_atomic_fetch_add(p, v, __ATOMIC_RELAXED, __HIP_MEMORY_SCOPE_AGENT); }
__device__ __forceinline__ unsigned xb_xcc_id() { return (unsigned)__builtin_amdgcn_s_getreg((3 << 11) | 20) & 0xFu; }
#define XB_SPIN(cond, bar) do { unsigned _sp = 0; while (cond) { __builtin_amdgcn_s_sleep(1); \
    if ((++_sp & 255u) == 0u) { if (xb_ld(&(bar)[XB_TMO])) break; if (_sp > XB_SPIN_CAP) { atomicAdd(&(bar)[XB_TMO], 1u); break; } } } } while (0)

struct XcdBarrier {
    unsigned* bar; unsigned x;
    volatile LAS unsigned* st;
};

__device__ __forceinline__ XcdBarrier xcd_barrier_post(unsigned* bar, volatile LAS unsigned* st) {
    XcdBarrier b; b.bar = bar; b.x = xb_xcc_id(); b.st = st;
    if (threadIdx.x == 0) (void)xb_add(&bar[XB_XCNT(b.x)], 1u);
    return b;
}
__device__ __forceinline__ void xcd_barrier_complete(unsigned* bar, unsigned x, unsigned& nloc, unsigned& nx) {
    const unsigned G = gridDim.x * gridDim.y * gridDim.z;
    unsigned sum, cnt, mine, sp = 0u;
    for (;;) {
        sum = 0u; cnt = 0u; mine = 0u;
#pragma unroll
        for (unsigned j = 0; j < 16; ++j) { const unsigned c = xb_ld(&bar[XB_XCNT(j)]); sum += c; cnt += (c > 0u) ? 1u : 0u; mine = (j == x) ? c : mine; }
        if (sum == G) break;
        __builtin_amdgcn_s_sleep(1);
        if ((++sp & 255u) == 0u) { if (xb_ld(&bar[XB_TMO])) break; if (sp > XB_SPIN_CAP) { atomicAdd(&bar[XB_TMO], 1u); break; } }
    }
    nloc = mine > 0u ? mine : 1u; nx = cnt > 0u ? cnt : 1u;
}

__device__ __forceinline__ void xcd_barrier(const XcdBarrier& b) {
    asm volatile("s_waitcnt vmcnt(0)" ::: "memory");
    __syncthreads();
    if (threadIdx.x == 0) {
        unsigned* bar = b.bar;
        __builtin_amdgcn_s_waitcnt(0);
        unsigned nloc = b.st[0], nx = b.st[1];
        if (nloc == 0u) { xcd_barrier_complete(bar, b.x, nloc, nx); b.st[0] = nloc; b.st[1] = nx; }
        const unsigned old = xb_add(&bar[XB_XSUB(b.x)], 1u);
        const unsigned gen = old / nloc;
        if (old + 1u == (gen + 1u) * nloc) {
            __builtin_amdgcn_fence(__ATOMIC_RELEASE, "agent");
            asm volatile("s_waitcnt vmcnt(0)" ::: "memory");
            const unsigned og = xb_add(&bar[XB_TOP], 1u);
            const unsigned tg = og / nx;
            if (og + 1u == (tg + 1u) * nx) xb_add(&bar[XB_TOPGEN], 1u);
            else XB_SPIN(xb_ld(&bar[XB_TOPGEN]) == tg, bar);
            __builtin_amdgcn_fence(__ATOMIC_ACQUIRE, "agent");
            xb_add(&bar[XB_XGEN(b.x)], 1u);
            asm volatile("s_waitcnt vmcnt(0)" ::: "memory");
        } else {
            XB_SPIN(xb_ld(&bar[XB_XGEN(b.x)]) == gen, bar);
            __builtin_amdgcn_fence(__ATOMIC_ACQUIRE, "agent");
            asm volatile("s_waitcnt vmcnt(0)" ::: "memory");
        }
    }
    __syncthreads();
}

#define LDS_WAIT() asm volatile("s_waitcnt lgkmcnt(0)" ::: "memory")
#define VM_WAIT() asm volatile("s_waitcnt vmcnt(0)" ::: "memory")
#define MFMA32(a, b, c) __builtin_amdgcn_mfma_f32_32x32x16_bf16((a), (b), (c), 0, 0, 0)
__device__ __forceinline__ float wave_sum(float v) {
#pragma unroll
    for (int o = 1; o < 64; o <<= 1) v += __shfl_xor(v, o);
    return v;
}
__device__ __forceinline__ int crow(int i, int hh) { return (i & 3) + 8 * (i >> 2) + 4 * hh; }
__device__ __forceinline__ bf16x8 pack8(float a0, float a1, float a2, float a3, float a4, float a5, float a6, float a7) {
    u32x4 p; p.x = cvt_pk_bf16(a0, a1); p.y = cvt_pk_bf16(a2, a3); p.z = cvt_pk_bf16(a4, a5); p.w = cvt_pk_bf16(a6, a7);
    return __builtin_bit_cast(bf16x8, p);
}

struct Ctx {
    LAS unsigned char* lds;
    int tid, lane, wave, vcu, G;
};

__device__ __forceinline__ void transpose_item(const float* W, int K, int N, bf16_t* WT, int k0, int n0, int drow0, LAS float* scr, int lane) {
#pragma unroll 8
    for (int i = 0; i < 32; ++i) { const int kk = 2 * i + (lane >> 5); scr[kk * 33 + (lane & 31)] = W[(size_t)(k0 + kk) * N + n0 + (lane & 31)]; }
    LDS_WAIT(); asm volatile("" ::: "memory");
    const int c = lane & 7;
#pragma unroll
    for (int j = 0; j < 4; ++j) { const int n = (lane >> 3) + 8 * j; const LAS float* s = scr + (8 * c) * 33 + n;
        u32x4 o; o.x = cvt_pk_bf16(s[0 * 33], s[1 * 33]); o.y = cvt_pk_bf16(s[2 * 33], s[3 * 33]); o.z = cvt_pk_bf16(s[4 * 33], s[5 * 33]); o.w = cvt_pk_bf16(s[6 * 33], s[7 * 33]);
        *(GAS u32x4*)(WT + (size_t)(drow0 + n) * K + k0 + 8 * c) = o; }
    LDS_WAIT(); asm volatile("" ::: "memory");
}

__device__ __forceinline__ unsigned pk4_fp8(float a, float b, float c, float d) { int p = __builtin_amdgcn_cvt_pk_fp8_f32(a, b, 0, false); p = __builtin_amdgcn_cvt_pk_fp8_f32(c, d, p, true); return (unsigned)p; }
__device__ __forceinline__ void transpose_item_f8(const float* W, int K, int N, unsigned char* WT, int k0, int n0, int drow0, float scl, LAS float* scr, int lane) {
#pragma unroll 8
    for (int i = 0; i < 32; ++i) { const int kk = 2 * i + (lane >> 5); scr[kk * 33 + (lane & 31)] = W[(size_t)(k0 + kk) * N + n0 + (lane & 31)]; }
    LDS_WAIT(); asm volatile("" ::: "memory");
    const int c = lane & 7;
#pragma unroll
    for (int j = 0; j < 4; ++j) { const int n = (lane >> 3) + 8 * j; const LAS float* s = scr + (8 * c) * 33 + n;
        u32x2 o; o.x = pk4_fp8(s[0 * 33] * scl, s[1 * 33] * scl, s[2 * 33] * scl, s[3 * 33] * scl); o.y = pk4_fp8(s[4 * 33] * scl, s[5 * 33] * scl, s[6 * 33] * scl, s[7 * 33] * scl);
        *(GAS u32x2*)(WT + (size_t)(drow0 + n) * K + k0 + 8 * c) = o; }
    LDS_WAIT(); asm volatile("" ::: "memory");
}

constexpr float WSCALE = 32.f, WDESCALE = 1.f / 32.f;
typedef const f32x4 (&AccRef)[2][2][4][2];

struct EpiNull { __device__ __forceinline__ void operator()(AccRef acc, const pg8::Unit& u, int wr, int wc, int fr, int fq) const {
        float s = 0.f;
#pragma unroll
        for (int ai = 0; ai < 2; ++ai)
#pragma unroll
            for (int bj = 0; bj < 2; ++bj)
#pragma unroll
                for (int m = 0; m < 4; ++m)
#pragma unroll
                    for (int n = 0; n < 2; ++n) s += acc[ai][bj][m][n][0] + acc[ai][bj][m][n][1] + acc[ai][bj][m][n][2] + acc[ai][bj][m][n][3];
        asm volatile("" :: "v"(s)); } };
struct EpiStore {
    bf16_t* O; int ldc;
    __device__ __forceinline__ void operator()(AccRef acc, const pg8::Unit& u, int wr, int wc, int fr, int fq) const {
        const int row0 = u.pm * 256 + wr * 64 + fr, col0 = u.pn * 256 + wc * 32 + 8 * fq;
#pragma unroll
        for (int ai = 0; ai < 2; ++ai)
#pragma unroll
            for (int m = 0; m < 4; ++m) { bf16_t* rowp = O + (size_t)(row0 + ai * 128 + m * 16) * ldc + col0;
#pragma unroll
                for (int bj = 0; bj < 2; ++bj) { const f32x4 v0 = acc[ai][bj][m][0], v1 = acc[ai][bj][m][1];
                    u32x4 w; w.x = cvt_pk_bf16(v0[0], v0[1]); w.y = cvt_pk_bf16(v0[2], v0[3]); w.z = cvt_pk_bf16(v1[0], v1[1]); w.w = cvt_pk_bf16(v1[2], v1[3]);
                    *(u32x4*)(rowp + bj * 128) = w; } }
    }
};

struct EpiProj {
    bf16_t *QL, *KVL, *KPE, *SB, *SGA, *SGB; int cbase; float dsc;
    __device__ __forceinline__ void operator()(AccRef acc, const pg8::Unit& u, int wr, int wc, int fr, int fq) const {
        const int row0 = u.pm * 256 + wr * 64 + fr;
#pragma unroll
        for (int bj = 0; bj < 2; ++bj) {
            const int cg = cbase + u.pn * 256 + bj * 128 + wc * 32;
            bf16_t* base; int ld, co; bool sig = false;
            if (cg < 384) { base = QL; ld = 384; co = cg; }
            else if (cg < 640) { base = KVL; ld = 256; co = cg - 384; }
            else if (cg < 672) { base = KPE; ld = 32; co = cg - 640; }
            else if (cg < 768) { continue; }
            else if (cg < 2304) { base = SB; ld = 1536; co = cg - 768; }
            else if (cg < 3328) { base = SGA; ld = 1024; co = cg - 2304; sig = true; }
            else { base = SGB; ld = 1024; co = cg - 3328; sig = true; }
#pragma unroll
            for (int ai = 0; ai < 2; ++ai)
#pragma unroll
                for (int m = 0; m < 4; ++m) { f32x4 v0 = acc[ai][bj][m][0], v1 = acc[ai][bj][m][1];
                    if (sig) {
#pragma unroll
                        for (int j = 0; j < 4; ++j) { v0[j] = fast_sigmoid(v0[j] * dsc); v1[j] = fast_sigmoid(v1[j] * dsc); } }
                    u32x4 w; w.x = cvt_pk_bf16(v0[0], v0[1]); w.y = cvt_pk_bf16(v0[2], v0[3]); w.z = cvt_pk_bf16(v1[0], v1[1]); w.w = cvt_pk_bf16(v1[2], v1[3]);
                    *(u32x4*)(base + (size_t)(row0 + ai * 128 + m * 16) * ld + co + 8 * fq) = w; }
        }
    }
};

template <bool SECOND> struct EpiMerge {
    bf16_t* MG; const bf16_t* SG;
    __device__ __forceinline__ void operator()(AccRef acc, const pg8::Unit& u, int wr, int wc, int fr, int fq) const {
        const int row0 = u.pm * 256 + wr * 64 + fr, col0 = u.pn * 256 + wc * 32 + 8 * fq;
#pragma unroll
        for (int ai = 0; ai < 2; ++ai)
#pragma unroll
            for (int m = 0; m < 4; ++m) { const size_t ro = (size_t)(row0 + ai * 128 + m * 16) * 1024 + col0;
#pragma unroll
                for (int bj = 0; bj < 2; ++bj) { const f32x4 v0 = acc[ai][bj][m][0], v1 = acc[ai][bj][m][1];
                    const u32x4 g = *(const u32x4*)(SG + ro + bj * 128);
                    float r0 = bf_lo(g.x) * v0[0], r1 = bf_hi(g.x) * v0[1], r2 = bf_lo(g.y) * v0[2], r3 = bf_hi(g.y) * v0[3];
                    float r4 = bf_lo(g.z) * v1[0], r5 = bf_hi(g.z) * v1[1], r6 = bf_lo(g.w) * v1[2], r7 = bf_hi(g.w) * v1[3];
                    if (SECOND) { const u32x4 p = *(const u32x4*)(MG + ro + bj * 128);
                        r0 += bf_lo(p.x); r1 += bf_hi(p.x); r2 += bf_lo(p.y); r3 += bf_hi(p.y); r4 += bf_lo(p.z); r5 += bf_hi(p.z); r6 += bf_lo(p.w); r7 += bf_hi(p.w); }
                    u32x4 w; w.x = cvt_pk_bf16(r0, r1); w.y = cvt_pk_bf16(r2, r3); w.z = cvt_pk_bf16(r4, r5); w.w = cvt_pk_bf16(r6, r7);
                    *(u32x4*)(MG + ro + bj * 128) = w; } }
    }
};

struct EpiWout {
    const float* X; float* OUT; const float* MOD;
    __device__ __forceinline__ void operator()(AccRef acc, const pg8::Unit& u, int wr, int wc, int fr, int fq) const {
        const int row0 = u.pm * 256 + wr * 64 + fr, col0 = u.pn * 256 + wc * 32 + 8 * fq;
        const float* ga = MOD + (size_t)(u.pm >> 3) * 6144 + 2048 + col0;
        f32x4 g[2][2];
#pragma unroll
        for (int bj = 0; bj < 2; ++bj)
#pragma unroll
            for (int n = 0; n < 2; ++n) g[bj][n] = *(const f32x4*)(ga + bj * 128 + 4 * n);
#pragma unroll
        for (int ai = 0; ai < 2; ++ai)
#pragma unroll
            for (int m = 0; m < 4; ++m) { const size_t ro = (size_t)(row0 + ai * 128 + m * 16) * 1024 + col0;
#pragma unroll
                for (int bj = 0; bj < 2; ++bj)
#pragma unroll
                    for (int n = 0; n < 2; ++n) { const f32x4 xv = *(const f32x4*)(X + ro + bj * 128 + 4 * n);
                        *(f32x4*)(OUT + ro + bj * 128 + 4 * n) = xv + g[bj][n] * acc[ai][bj][m][n]; } }
    }
};

struct EpiGateUp {
    unsigned char* HID; const float* BGU;
    __device__ __forceinline__ void operator()(AccRef acc, const pg8::Unit& u, int wr, int wc, int fr, int fq) const {
        const int row0 = u.pm * 256 + wr * 64 + fr, hc = u.pn * 128 + wc * 32 + 8 * fq;
        const float* bg = BGU + (size_t)u.e * 2048 + hc;
        f32x4 bgate[2], bup[2];
#pragma unroll
        for (int n = 0; n < 2; ++n) { bgate[n] = *(const f32x4*)(bg + 4 * n); bup[n] = *(const f32x4*)(bg + 1024 + 4 * n); }
#pragma unroll
        for (int ai = 0; ai < 2; ++ai)
#pragma unroll
            for (int m = 0; m < 4; ++m) { float r[8];
#pragma unroll
                for (int n = 0; n < 2; ++n) { const f32x4 gv = acc[ai][0][m][n] * WDESCALE + bgate[n], uv = acc[ai][1][m][n] * WDESCALE + bup[n];
#pragma unroll
                    for (int j = 0; j < 4; ++j) { const float g = __builtin_fminf(gv[j], 7.f); const float up = __builtin_fminf(__builtin_fmaxf(uv[j], -7.f), 7.f);
                        r[4 * n + j] = (up + 1.f) * (g * fast_sigmoid(1.702f * g)); } }
                u32x2 w; w.x = pk4_fp8(r[0], r[1], r[2], r[3]); w.y = pk4_fp8(r[4], r[5], r[6], r[7]);
                *(u32x2*)(HID + (size_t)(row0 + ai * 128 + m * 16) * 1024 + hc) = w; asm volatile("" ::: "memory"); }
    }
};

struct EpiDown {
    float* OUT; bf16_t* Y; const float* BDN; const float* MOD; const int* TOKL; const float* WL; int mode;
    __device__ __forceinline__ void operator()(AccRef acc, const pg8::Unit& u, int wr, int wc, int fr, int fq) const {
        const int col0 = u.pn * 256 + wc * 32 + 8 * fq;
        const float* bd = BDN + (size_t)u.e * 1024 + col0;
        f32x4 b4[2][2];
#pragma unroll
        for (int bj = 0; bj < 2; ++bj)
#pragma unroll
            for (int n = 0; n < 2; ++n) b4[bj][n] = *(const f32x4*)(bd + bj * 128 + 4 * n);
        const int* tl = TOKL + (size_t)u.e * LISTCAP; const float* wl = WL + (size_t)u.e * LISTCAP;
#pragma unroll
        for (int ai = 0; ai < 2; ++ai)
#pragma unroll
            for (int m = 0; m < 4; ++m) { const int slot = u.j0 + ai * 128 + wr * 64 + m * 16 + fr;
                if (slot < u.ne) { const int tok = tl[slot]; const float wgt = wl[slot];
                    const float* ga = MOD + (size_t)(tok >> 11) * 6144 + 5120 + col0; float* op = OUT + (size_t)tok * 1024 + col0; bf16_t* yp = Y + (size_t)tok * 1024 + col0;
#pragma unroll
                    for (int bj = 0; bj < 2; ++bj) {
                        f32x4 v0 = *(const f32x4*)(ga + bj * 128) * ((acc[ai][bj][m][0] * WDESCALE + b4[bj][0]) * wgt), v1 = *(const f32x4*)(ga + bj * 128 + 4) * ((acc[ai][bj][m][1] * WDESCALE + b4[bj][1]) * wgt);
                        if (mode != 0) { const u32x4 p = *(const u32x4*)(yp + bj * 128);
                            v0[0] += bf_lo(p.x); v0[1] += bf_hi(p.x); v0[2] += bf_lo(p.y); v0[3] += bf_hi(p.y); v1[0] += bf_lo(p.z); v1[1] += bf_hi(p.z); v1[2] += bf_lo(p.w); v1[3] += bf_hi(p.w); }
                        if (mode == 2) { *(f32x4*)(op + bj * 128) = *(const f32x4*)(op + bj * 128) + v0; *(f32x4*)(op + bj * 128 + 4) = *(const f32x4*)(op + bj * 128 + 4) + v1; }
                        else { u32x4 w; w.x = cvt_pk_bf16(v0[0], v0[1]); w.y = cvt_pk_bf16(v0[2], v0[3]); w.z = cvt_pk_bf16(v1[0], v1[1]); w.w = cvt_pk_bf16(v1[2], v1[3]); *(u32x4*)(yp + bj * 128) = w; } } }
                asm volatile("" ::: "memory"); }
    }
};

struct MoeTabs { const LAS int* rbase; const LAS int* tbase; const LAS int* nearr; const LAS int* tilee; };
struct MoeOrderGU {
    const char* A; const char* Bt; const int* lists; int G, c; MoeTabs tb;
    __device__ __forceinline__ bool next(int i, pg8::Unit& u) const {
        const int L = i * G + c, TT = L >> 3; const int total = __builtin_amdgcn_readfirstlane(tb.rbase[4]);
        if (TT >= total) return false;
        int k = 0;
#pragma unroll
        for (int q = 1; q < 4; ++q) k += (TT >= __builtin_amdgcn_readfirstlane(tb.rbase[q])) ? 1 : 0;
        const int T = TT - __builtin_amdgcn_readfirstlane(tb.rbase[k]);
        const int e = __builtin_amdgcn_readfirstlane(tb.tilee[k * MAXTILES + T]);
        u.pm = TT; u.pn = L & 7; u.e = e; u.kk = k; u.j0 = (T - __builtin_amdgcn_readfirstlane(tb.tbase[k * 33 + e])) * 256; u.ne = __builtin_amdgcn_readfirstlane(tb.nearr[k * 32 + e]); return true;
    }
    __device__ __forceinline__ const char* a_base(const pg8::Unit&) const { return A; }
    __device__ __forceinline__ const char* b_base(const pg8::Unit& u) const { return Bt + (size_t)u.e * (size_t)(2048 * 1024) + (size_t)u.pn * (size_t)(256 * 1024); }
    __device__ __forceinline__ unsigned row_of(const pg8::Unit& u, int r) const { const int slot = u.j0 + r; return slot < u.ne ? (unsigned)lists[(size_t)(u.kk * 32 + u.e) * LISTCAP + slot] : 0u; }
};
struct MoeOrderDN {
    const char* A; const char* Bt; int G, c, k; MoeTabs tb;
    __device__ __forceinline__ bool next(int i, pg8::Unit& u) const {
        const int L = i * G + c, T = L >> 2; const int r0 = __builtin_amdgcn_readfirstlane(tb.rbase[k]), r1 = __builtin_amdgcn_readfirstlane(tb.rbase[k + 1]);
        if (T >= r1 - r0) return false;
        const int e = __builtin_amdgcn_readfirstlane(tb.tilee[k * MAXTILES + T]);
        u.pm = r0 + T; u.pn = L & 3; u.e = e; u.kk = k; u.j0 = (T - __builtin_amdgcn_readfirstlane(tb.tbase[k * 33 + e])) * 256; u.ne = __builtin_amdgcn_readfirstlane(tb.nearr[k * 32 + e]); return true;
    }
    __device__ __forceinline__ const char* a_base(const pg8::Unit& u) const { return A + (size_t)u.pm * (size_t)(256 * 1024); }
    __device__ __forceinline__ const char* b_base(const pg8::Unit& u) const { return Bt + (size_t)u.e * (size_t)(1024 * 1024) + (size_t)u.pn * (size_t)(256 * 1024); }
    __device__ __forceinline__ unsigned row_of(const pg8::Unit&, int) const { return 0u; }
};

constexpr int ATT_KBYTES = 12 * 1024;
constexpr int ATT_VPITCH = 136;
constexpr int ATT_VBYTES = 64 * ATT_VPITCH;
constexpr int ATT_BUF = ATT_KBYTES + ATT_VBYTES;
constexpr int ATT_WS = 2 * ATT_BUF;
static_assert(ATT_WS + 8 * 256 + 64 <= RING_BYTES, "attention LDS");

__device__ __forceinline__ void mla_unit(LAS unsigned char* lds, const bf16_t* Q, const bf16_t* Kb, const bf16_t* KV, bf16_t* O, int b, int h, int qb) {
    const int tid = threadIdx.x, lane = tid & 63, r = lane & 31, hh = lane >> 5; const int wid = __builtin_amdgcn_readfirstlane(tid >> 6);
    const size_t rowbase = (size_t)b * SEQ; const int q0 = qb * 256, qw = q0 + 32 * wid;
    const int cq = qw >> 6, NT = (q0 >> 6) + 4;
    LAS float* wsf = (LAS float*)(lds + ATT_WS) + wid * 64;
    bf16x8 qf[6];
    { const bf16_t* qp = Q + (rowbase + qw + r) * 768 + h * 96 + hh * 8;
#pragma unroll
      for (int s = 0; s < 6; ++s) qf[s] = *(const bf16x8*)(qp + 16 * s); }
    const int lkv = tid & 63, lc = tid >> 6;
    const bf16_t* kg0 = Kb + (rowbase + lkv) * 768 + h * 96 + lc * 8;
    const bf16_t* vg = KV + (rowbase + lkv) * 1024 + h * 128 + 64 + lc * 8;
    u32x4 kr0, kr1 = (u32x4){0u, 0u, 0u, 0u}, vr;
#define ATT_LOAD(t) do { kr0 = *(const u32x4*)(kg0 + (size_t)(t) * 64 * 768); if (tid < 256) kr1 = *(const u32x4*)(kg0 + (size_t)(t) * 64 * 768 + 64); vr = *(const u32x4*)(vg + (size_t)(t) * 64 * 1024); } while (0)
#define ATT_STORE(bufi) do { LAS unsigned char* kb_ = lds + (bufi) * ATT_BUF; *(LAS u32x4*)(kb_ + tid * 16) = kr0; if (tid < 256) *(LAS u32x4*)(kb_ + 8192 + tid * 16) = kr1; \
        LAS unsigned char* vb_ = kb_ + ATT_KBYTES + (lc * 8) * ATT_VPITCH + lkv * 2; \
        _Pragma("unroll") for (int j_ = 0; j_ < 8; ++j_) *(LAS unsigned short*)(vb_ + j_ * ATT_VPITCH) = (unsigned short)(vr[j_ >> 1] >> (16 * (j_ & 1))); } while (0)
    ATT_LOAD(0); ATT_STORE(0); __syncthreads();
    float m_run = -INFINITY, l_run = 0.f;
    f32x16 o0, o1;
#pragma unroll
    for (int i = 0; i < 16; ++i) { o0[i] = 0.f; o1[i] = 0.f; }
    for (int t = 0; t < NT; ++t) {
        const int buf = t & 1;
        if (t + 1 < NT) ATT_LOAD(t + 1);
        if (t <= cq) {
            const LAS unsigned char* kb = lds + buf * ATT_BUF; const LAS unsigned char* vb = kb + ATT_KBYTES;
            f32x16 p0, p1;
#pragma unroll
            for (int i = 0; i < 16; ++i) { p0[i] = 0.f; p1[i] = 0.f; }
#pragma unroll
            for (int s = 0; s < 6; ++s) { const bf16x8 a0 = *(const LAS bf16x8*)(kb + (2 * s + hh) * 1024 + r * 16), a1 = *(const LAS bf16x8*)(kb + (2 * s + hh) * 1024 + (r + 32) * 16);
                p0 = MFMA32(a0, qf[s], p0); p1 = MFMA32(a1, qf[s], p1); }
            float mx = p0[0];
#pragma unroll
            for (int i = 0; i < 16; ++i) { mx = __builtin_fmaxf(mx, p0[i]); mx = __builtin_fmaxf(mx, p1[i]); }
            mx = __builtin_fmaxf(mx, __shfl_xor(mx, 32));
            const float m_new = __builtin_fmaxf(m_run, mx), alpha = __builtin_amdgcn_exp2f(m_run - m_new); m_run = m_new;
            float rs = 0.f;
#pragma unroll
            for (int i = 0; i < 16; ++i) { p0[i] = __builtin_amdgcn_exp2f(p0[i] - m_new); p1[i] = __builtin_amdgcn_exp2f(p1[i] - m_new); rs += p0[i] + p1[i]; }
            l_run = l_run * alpha + rs;
            if (hh == 0) wsf[r] = alpha;
            LDS_WAIT();
#pragma unroll
            for (int g = 0; g < 4; ++g) { const f32x4 al = *(const LAS f32x4*)(wsf + 8 * g + 4 * hh);
#pragma unroll
                for (int e = 0; e < 4; ++e) { o0[4 * g + e] *= al[e]; o1[4 * g + e] *= al[e]; } }
#pragma unroll
            for (int half = 0; half < 2; ++half)
#pragma unroll
                for (int s2 = 0; s2 < 2; ++s2) {
                    const f32x16& P = half ? p1 : p0;
                    const bf16x8 pa = pack8(P[8 * s2], P[8 * s2 + 1], P[8 * s2 + 2], P[8 * s2 + 3], P[8 * s2 + 4], P[8 * s2 + 5], P[8 * s2 + 6], P[8 * s2 + 7]);
                    const int kvo = (32 * half + 16 * s2 + 4 * hh) * 2;
                    { const s16x4 lo = *(const LAS s16x4*)(vb + r * ATT_VPITCH + kvo), hi = *(const LAS s16x4*)(vb + r * ATT_VPITCH + kvo + 16);
                      const bf16x8 vf = __builtin_shufflevector(lo, hi, 0, 1, 2, 3, 4, 5, 6, 7); o0 = MFMA32(pa, vf, o0); }
                    { const s16x4 lo = *(const LAS s16x4*)(vb + (r + 32) * ATT_VPITCH + kvo), hi = *(const LAS s16x4*)(vb + (r + 32) * ATT_VPITCH + kvo + 16);
                      const bf16x8 vf = __builtin_shufflevector(lo, hi, 0, 1, 2, 3, 4, 5, 6, 7); o1 = MFMA32(pa, vf, o1); }
                }
        }
        if (t + 1 < NT) ATT_STORE(buf ^ 1);
        __syncthreads();
    }
    const float l_tot = l_run + __shfl_xor(l_run, 32);
    if (hh == 0) wsf[r] = 1.f / l_tot;
    LDS_WAIT();
#pragma unroll
    for (int g = 0; g < 4; ++g) { const f32x4 rl = *(const LAS f32x4*)(wsf + 8 * g + 4 * hh);
#pragma unroll
        for (int e = 0; e < 4; ++e) { const int i = 4 * g + e; bf16_t* op = O + (rowbase + qw + crow(i, hh)) * 512 + h * 64 + r;
            op[0] = (bf16_t)(cvt_pk_bf16(o0[i] * rl[e], 0.f) & 0xffffu); op[32] = (bf16_t)(cvt_pk_bf16(o1[i] * rl[e], 0.f) & 0xffffu); } }
    LDS_WAIT();
#undef ATT_LOAD
#undef ATT_STORE
}

__device__ __forceinline__ void sb_unit(LAS unsigned char* lds, const bf16_t* SBQ, bf16_t* O, int b, int h, int qb) {
    const int tid = threadIdx.x, lane = tid & 63, r = lane & 31, hh = lane >> 5; const int wid = __builtin_amdgcn_readfirstlane(tid >> 6);
    const size_t rowbase = (size_t)b * SEQ; const int q0 = qb * 256, qw = q0 + 32 * wid;
    const int NT = (q0 >> 6) + 4;
    constexpr float C2 = 0.125f * LOG2E;
    bf16x8 qf[4];
    { const bf16_t* qp = SBQ + (rowbase + qw + r) * 1536 + h * 64 + hh * 8;
#pragma unroll
      for (int s = 0; s < 4; ++s) qf[s] = *(const bf16x8*)(qp + 16 * s); }
    const int lkv = tid & 63, lc = tid >> 6;
    const bf16_t* kg0 = SBQ + (rowbase + lkv) * 1536 + 512 + h * 64 + lc * 8;
    const bf16_t* vg = SBQ + (rowbase + lkv) * 1536 + 1024 + h * 64 + lc * 8;
    u32x4 kr0, vr;
#define ATT_LOAD(t) do { kr0 = *(const u32x4*)(kg0 + (size_t)(t) * 64 * 1536); vr = *(const u32x4*)(vg + (size_t)(t) * 64 * 1536); } while (0)
#define ATT_STORE(bufi) do { LAS unsigned char* kb_ = lds + (bufi) * ATT_BUF; *(LAS u32x4*)(kb_ + tid * 16) = kr0; \
        LAS unsigned char* vb_ = kb_ + ATT_KBYTES + (lc * 8) * ATT_VPITCH + lkv * 2; \
        _Pragma("unroll") for (int j_ = 0; j_ < 8; ++j_) *(LAS unsigned short*)(vb_ + j_ * ATT_VPITCH) = (unsigned short)(vr[j_ >> 1] >> (16 * (j_ & 1))); } while (0)
    LAS unsigned* dflag = (LAS unsigned*)(lds + ATT_WS + 8 * 256);
    ATT_LOAD(NT - 1); ATT_STORE(0); __syncthreads();
    float carry = 0.f; bool wdone = false;
    f32x16 o0, o1;
#pragma unroll
    for (int i = 0; i < 16; ++i) { o0[i] = 0.f; o1[i] = 0.f; }
#define SB_SUB(X, kvh0, kvl) do { const bool diag_ = ((kvh0) == qw); float lk_[16], z_[16]; \
        _Pragma("unroll") for (int i = 0; i < 16; ++i) { const float z2 = X[i] * C2; const float ex = __builtin_amdgcn_exp2f(z2); float sp = __builtin_amdgcn_logf(1.f + ex); sp = z2 > 64.f ? z2 : sp; \
            const bool valid = !diag_ || (crow(i, hh) < r); lk_[i] = valid ? -sp : 0.f; z_[i] = z2; } \
        float G_[4], Gp_[4]; \
        _Pragma("unroll") for (int g = 0; g < 4; ++g) { G_[g] = (lk_[4 * g] + lk_[4 * g + 1]) + (lk_[4 * g + 2] + lk_[4 * g + 3]); Gp_[g] = __shfl_xor(G_[g], 32); } \
        float tail_[4]; tail_[3] = 0.f; tail_[2] = G_[3] + Gp_[3]; tail_[1] = tail_[2] + (G_[2] + Gp_[2]); tail_[0] = tail_[1] + (G_[1] + Gp_[1]); const float total_ = tail_[0] + (G_[0] + Gp_[0]); \
        float a_[16]; \
        _Pragma("unroll") for (int g = 0; g < 4; ++g) { const float base_ = carry + tail_[g] + (hh == 0 ? Gp_[g] : 0.f); \
            const float s3 = base_ + lk_[4 * g + 3], s2_ = s3 + lk_[4 * g + 2], s1 = s2_ + lk_[4 * g + 1], s0 = s1 + lk_[4 * g]; \
            a_[4 * g + 3] = __builtin_amdgcn_exp2f(z_[4 * g + 3] + s3); a_[4 * g + 2] = __builtin_amdgcn_exp2f(z_[4 * g + 2] + s2_); a_[4 * g + 1] = __builtin_amdgcn_exp2f(z_[4 * g + 1] + s1); a_[4 * g] = __builtin_amdgcn_exp2f(z_[4 * g] + s0); } \
        if (diag_) { _Pragma("unroll") for (int i = 0; i < 16; ++i) a_[i] = (crow(i, hh) < r) ? a_[i] : 0.f; } \
        carry += total_; \
        _Pragma("unroll") for (int s2 = 0; s2 < 2; ++s2) { \
            const bf16x8 pa = pack8(a_[8 * s2], a_[8 * s2 + 1], a_[8 * s2 + 2], a_[8 * s2 + 3], a_[8 * s2 + 4], a_[8 * s2 + 5], a_[8 * s2 + 6], a_[8 * s2 + 7]); \
            const int kvo = ((kvl) + 16 * s2 + 4 * hh) * 2; \
            { const s16x4 lo = *(const LAS s16x4*)(vb + r * ATT_VPITCH + kvo), hi = *(const LAS s16x4*)(vb + r * ATT_VPITCH + kvo + 16); \
              const bf16x8 vf = __builtin_shufflevector(lo, hi, 0, 1, 2, 3, 4, 5, 6, 7); o0 = MFMA32(pa, vf, o0); } \
            { const s16x4 lo = *(const LAS s16x4*)(vb + (r + 32) * ATT_VPITCH + kvo), hi = *(const LAS s16x4*)(vb + (r + 32) * ATT_VPITCH + kvo + 16); \
              const bf16x8 vf = __builtin_shufflevector(lo, hi, 0, 1, 2, 3, 4, 5, 6, 7); o1 = MFMA32(pa, vf, o1); } } } while (0)
    for (int it = 0; it < NT; ++it) {
        const int t = NT - 1 - it, buf = it & 1, kv0 = 64 * t;
        if (t > 0) ATT_LOAD(t - 1);
        if (kv0 <= qw && !wdone) {
            const LAS unsigned char* kb = lds + buf * ATT_BUF; const LAS unsigned char* vb = kb + ATT_KBYTES;
            const bool upper = (kv0 + 32 <= qw);
            f32x16 p0, p1;
#pragma unroll
            for (int i = 0; i < 16; ++i) { p0[i] = 0.f; p1[i] = 0.f; }
#pragma unroll
            for (int s = 0; s < 4; ++s) { const bf16x8 a0 = *(const LAS bf16x8*)(kb + (2 * s + hh) * 1024 + r * 16); p0 = MFMA32(a0, qf[s], p0); }
            if (upper) {
#pragma unroll
                for (int s = 0; s < 4; ++s) { const bf16x8 a1 = *(const LAS bf16x8*)(kb + (2 * s + hh) * 1024 + (r + 32) * 16); p1 = MFMA32(a1, qf[s], p1); }
                SB_SUB(p1, kv0 + 32, 32);
            }
            SB_SUB(p0, kv0, 0);
            wdone = __all(carry < -170.f) != 0;
        }
        if (lane == 0) dflag[(it & 1) * 8 + wid] = wdone ? 1u : 0u;
        if (t > 0) ATT_STORE(buf ^ 1);
        __syncthreads();
        { const u32x4 f0 = *(const LAS u32x4*)(dflag + (it & 1) * 8), f1 = *(const LAS u32x4*)(dflag + (it & 1) * 8 + 4);
          if ((f0.x & f0.y & f0.z & f0.w & f1.x & f1.y & f1.z & f1.w) != 0u) break; }
    }
    __syncthreads();
#pragma unroll
    for (int i = 0; i < 16; ++i) { bf16_t* op = O + (rowbase + qw + crow(i, hh)) * 512 + h * 64 + r;
        op[0] = (bf16_t)(cvt_pk_bf16(o0[i], 0.f) & 0xffffu); op[32] = (bf16_t)(cvt_pk_bf16(o1[i], 0.f) & 0xffffu); }
#undef SB_SUB
#undef ATT_LOAD
#undef ATT_STORE
}

#ifndef PHMASK
#define PHMASK 0xFFFF
#endif
#define PH(n) ((PHMASK >> (n)) & 1)
#ifndef DUPMASK
#define DUPMASK 0
#endif
#define DUP(n) (1 + ((DUPMASK >> (n)) & 1))
struct Args { const void* in[23]; float* out; unsigned char* ws; };

__global__ void __launch_bounds__(512, 2) fwd_kernel(Args args) {
    extern __shared__ __attribute__((aligned(16))) unsigned char lds_raw[];
    LAS unsigned char* lds = (LAS unsigned char*)lds_raw;
    const int tid = threadIdx.x, lane = tid & 63, wave = __builtin_amdgcn_readfirstlane(tid >> 6);
    const int G = gridDim.x; const int bx = blockIdx.x; const int vcu = (G % 8 == 0) ? (bx % 8) * (G / 8) + bx / 8 : bx;
    const int gw = vcu * 8 + wave, NGW = G * 8;
    unsigned char* ws = args.ws;
    unsigned* ctl = (unsigned*)(ws + WS_CTL);
    const float* x = (const float*)args.in[0]; const float* cvec = (const float*)args.in[1]; const int* positions = (const int*)args.in[2];
    const float* w_ada = (const float*)args.in[3]; const float* b_ada = (const float*)args.in[4]; const float* g_norm1 = (const float*)args.in[5];
    const float* w_in = (const float*)args.in[6]; const float* g_q_lat = (const float*)args.in[7]; const float* w_uq = (const float*)args.in[8];
    const float* g_kv_lat = (const float*)args.in[9]; const float* w_ukv = (const float*)args.in[10]; const float* g_qk_q = (const float*)args.in[11];
    const float* g_qk_k = (const float*)args.in[12]; const float* w_o_mla = (const float*)args.in[13]; const float* w_o_sb = (const float*)args.in[14];
    const float* w_out = (const float*)args.in[15]; const float* g_norm2 = (const float*)args.in[16]; const float* w_router = (const float*)args.in[17];
    const float* b_router = (const float*)args.in[18]; const float* w_gate_up = (const float*)args.in[19]; const float* b_gate_up = (const float*)args.in[20];
    const float* w_down = (const float*)args.in[21]; const float* b_down = (const float*)args.in[22];
    float* out = args.out;
    bf16_t* WIN = (bf16_t*)(ws + WS_WIN); bf16_t* WUQ = (bf16_t*)(ws + WS_WUQ); bf16_t* WUKV = (bf16_t*)(ws + WS_WUKV); bf16_t* WOM = (bf16_t*)(ws + WS_WOM);
    bf16_t* WOS = (bf16_t*)(ws + WS_WOS); bf16_t* WOUT = (bf16_t*)(ws + WS_WOUT); float* MOD = (float*)(ws + WS_MOD);
    unsigned char* WIN8 = ws + WS_WIN8; unsigned char* H8 = ws + WS_H8;
    bf16_t* HB = (bf16_t*)(ws + WS_H); bf16_t* KVRAW = (bf16_t*)(ws + WS_KVRAW); bf16_t* MERGED = (bf16_t*)(ws + WS_MERGED);
    bf16_t* SGA = (bf16_t*)(ws + WS_SGA); bf16_t* SGB = (bf16_t*)(ws + WS_SGB); unsigned char* H2 = ws + WS_H2;
    unsigned char* WGU = ws + WS_WGU; unsigned char* WDN = ws + WS_WDN; bf16_t* SBQ = (bf16_t*)(ws + WS_SB);
    int* TOKL = (int*)(ws + WS_TOKL); float* WLST = (float*)(ws + WS_WL); unsigned char* HID = ws + WS_HID;
    bf16_t* QL = (bf16_t*)(ws + WS_QL); bf16_t* KVL = (bf16_t*)(ws + WS_KVL); bf16_t* KPE = (bf16_t*)(ws + WS_KPE);
    bf16_t* QB = (bf16_t*)(ws + WS_Q); bf16_t* KB = (bf16_t*)(ws + WS_K); bf16_t* OMLA = (bf16_t*)(ws + WS_OMLA); bf16_t* OSB = (bf16_t*)(ws + WS_OSB);

    for (int u = tid; u < (LDS_BYTES - LDSCTL_OFF) / 4; u += 512) ((LAS unsigned*)(lds + LDSCTL_OFF))[u] = 0u;
    __syncthreads();
    XcdBarrier bar = xcd_barrier_post(ctl + CW_BAR, (volatile LAS unsigned*)(lds + LDSCTL_OFF + LC_BARST));
    LAS float* scr = (LAS float*)(lds + wave * 16384);

#if PH(0)
    {
        constexpr int I_IN = 16 * 133, I_UQ = 6 * 24, I_UKV = 4 * 32, I_OM = 8 * 32, I_OS = 8 * 32, I_OUT = 16 * 32;
        constexpr int NIT = I_IN + I_UQ + I_UKV + I_OM + I_OS + I_OUT;
        for (int it = gw; it < NIT; it += NGW) {
            int q = it;
            if (q < I_IN) { const int kb = q / 133, nb = q % 133, n0 = 32 * nb;
                if (nb < 69) transpose_item(w_in, 1024, DIN, WIN, 64 * kb, n0, n0 < 672 ? n0 : n0 + 96, scr, lane);
                else transpose_item_f8(w_in, 1024, DIN, WIN8, 64 * kb, n0, n0 - 2208, WSCALE, scr, lane);
                continue; } q -= I_IN;
            if (q < I_UQ) { const int kb = q / 24, nb = q % 24; transpose_item(w_uq, 384, 768, WUQ, 64 * kb, 32 * nb, 32 * nb, scr, lane); continue; } q -= I_UQ;
            if (q < I_UKV) { const int kb = q / 32, nb = q % 32; transpose_item(w_ukv, 256, 1024, WUKV, 64 * kb, 32 * nb, 32 * nb, scr, lane); continue; } q -= I_UKV;
            if (q < I_OM) { const int kb = q / 32, nb = q % 32; transpose_item(w_o_mla, 512, 1024, WOM, 64 * kb, 32 * nb, 32 * nb, scr, lane); continue; } q -= I_OM;
            if (q < I_OS) { const int kb = q / 32, nb = q % 32; transpose_item(w_o_sb, 512, 1024, WOS, 64 * kb, 32 * nb, 32 * nb, scr, lane); continue; } q -= I_OS;
            { const int kb = q / 32, nb = q % 32; transpose_item(w_out, 1024, 1024, WOUT, 64 * kb, 32 * nb, 32 * nb, scr, lane); }
        }
        for (int i = vcu * 512 + tid; i < 96 * 1024 * 2 / 16; i += G * 512) ((u32x4*)(WIN + 672 * 1024))[i] = (u32x4){0u, 0u, 0u, 0u};
        __syncthreads();
        for (int it = vcu; it < 6144 / 64; it += G) {
            for (int idx = lane; idx < 32 * 128; idx += 64) { const int b = idx >> 7, kk = idx & 127; const float cv = cvec[b * 1024 + 128 * wave + kk]; scr[idx] = cv / (1.f + __expf(-cv)); }
            LDS_WAIT(); asm volatile("" ::: "memory");
            float acc[32];
#pragma unroll
            for (int b = 0; b < 32; ++b) acc[b] = 0.f;
            const float* wp = w_ada + (size_t)(128 * wave) * 6144 + 64 * it + lane;
            float wc[8];
#pragma unroll
            for (int j = 0; j < 8; ++j) wc[j] = wp[(size_t)j * 6144];
#pragma nounroll
            for (int k8 = 0; k8 < 16; ++k8) {
                float wn[8];
                const int kn = k8 < 15 ? k8 + 1 : k8;
#pragma unroll
                for (int j = 0; j < 8; ++j) wn[j] = wp[(size_t)(8 * kn + j) * 6144];
#pragma unroll
                for (int j4 = 0; j4 < 2; ++j4) {
#pragma unroll
                    for (int b = 0; b < 32; ++b) { const f32x4 s = *(const LAS f32x4*)(scr + b * 128 + 8 * k8 + 4 * j4); acc[b] += s.x * wc[4 * j4] + s.y * wc[4 * j4 + 1] + s.z * wc[4 * j4 + 2] + s.w * wc[4 * j4 + 3];
                        if ((b & 7) == 7) asm volatile("" ::: "memory"); } }
#pragma unroll
                for (int j = 0; j < 8; ++j) wc[j] = wn[j];
            }
            LDS_WAIT(); asm volatile("" ::: "memory");
#pragma unroll
            for (int b = 0; b < 32; ++b) scr[b * 64 + lane] = acc[b];
            __syncthreads();
#pragma unroll
            for (int bb = 0; bb < 4; ++bb) { const int b = 4 * wave + bb; float s = 0.f;
#pragma unroll
                for (int w2 = 0; w2 < 8; ++w2) s += ((const LAS float*)(lds + w2 * 16384))[b * 64 + lane];
                MOD[b * 6144 + 64 * it + lane] = s + b_ada[64 * it + lane]; }
            __syncthreads();
        }
    }
#endif
    xcd_barrier(bar);

#if PH(1)
    for (int gi = gw; gi < NTOK / 4; gi += NGW) {
        f32x4 v[4][4];
#pragma unroll
        for (int rr = 0; rr < 4; ++rr) { const f32x4* xr = (const f32x4*)(x + (size_t)(4 * gi + rr) * 1024) + lane;
#pragma unroll
            for (int j = 0; j < 4; ++j) v[rr][j] = xr[64 * j]; }
        const int b = (4 * gi) >> 11;
        const float* mb = MOD + (size_t)b * 6144;
        f32x4 gsc[4], shv[4];
#pragma unroll
        for (int j = 0; j < 4; ++j) { const int col = 4 * lane + 256 * j; gsc[j] = *(const f32x4*)(g_norm1 + col) * (*(const f32x4*)(mb + 1024 + col) + 1.f); shv[j] = *(const f32x4*)(mb + col); }
#pragma unroll
        for (int rr = 0; rr < 4; ++rr) { float ss = 0.f;
#pragma unroll
            for (int j = 0; j < 4; ++j) ss += (v[rr][j].x * v[rr][j].x + v[rr][j].y * v[rr][j].y) + (v[rr][j].z * v[rr][j].z + v[rr][j].w * v[rr][j].w);
            const float rstd = rsqrtf(wave_sum(ss) * (1.f / 1024.f) + EPS);
#pragma unroll
            for (int j = 0; j < 4; ++j) { const int col = 4 * lane + 256 * j; const f32x4 y = (v[rr][j] * rstd) * gsc[j] + shv[j];
                u32x2 o; o.x = cvt_pk_bf16(y.x, y.y); o.y = cvt_pk_bf16(y.z, y.w);
                *(u32x2*)(HB + (size_t)(4 * gi + rr) * 1024 + col) = o;
                *(unsigned*)(H8 + (size_t)(4 * gi + rr) * 1024 + col) = pk4_fp8(y.x, y.y, y.z, y.w); } }
    }
#endif
    xcd_barrier(bar);

#if PH(2)
    { pg8::DenseOrder S; S.init(HB, WIN, NTOK, 2304, 1024, G, bx);
      EpiProj E{QL, KVL, KPE, SBQ, SGA, SGB, 0, 1.f};
      pg8::gemm_phase<false>(lds, 1024, S, E); }
    { pg8::DenseOrder S; S.init(H8, WIN8, NTOK, 2048, 512, G, bx);
      EpiProj E{QL, KVL, KPE, SBQ, SGA, SGB, 2304, WDESCALE};
      pg8::gemm_phase_f8<false>(lds, 512, S, E); }
#endif
    xcd_barrier(bar);

#if PH(3)
    {
        f32x4 gq0 = (f32x4){0.f, 0.f, 0.f, 0.f}, gq1 = gq0, gk0 = gq0, gk1 = gq0;
        if (lane < 48) { gq0 = *(const f32x4*)(g_q_lat + lane * 8); gq1 = *(const f32x4*)(g_q_lat + lane * 8 + 4); }
        if (lane < 32) { gk0 = *(const f32x4*)(g_kv_lat + lane * 8); gk1 = *(const f32x4*)(g_kv_lat + lane * 8 + 4); }
        for (int gi = gw; gi < NTOK / 4; gi += NGW) {
            u32x4 vq[4], vk[4];
#pragma unroll
            for (int rr = 0; rr < 4; ++rr) { vq[rr] = (u32x4){0u, 0u, 0u, 0u}; vk[rr] = vq[rr];
                if (lane < 48) vq[rr] = *(const u32x4*)(QL + (size_t)(4 * gi + rr) * 384 + lane * 8);
                if (lane < 32) vk[rr] = *(const u32x4*)(KVL + (size_t)(4 * gi + rr) * 256 + lane * 8); }
#pragma unroll
            for (int rr = 0; rr < 4; ++rr) {
                { const u32x4 v = vq[rr]; float f[8] = {bf_lo(v.x), bf_hi(v.x), bf_lo(v.y), bf_hi(v.y), bf_lo(v.z), bf_hi(v.z), bf_lo(v.w), bf_hi(v.w)}; float ss = 0.f;
#pragma unroll
                  for (int j = 0; j < 8; ++j) ss += f[j] * f[j];
                  const float rstd = rsqrtf(wave_sum(ss) * (1.f / 384.f) + EPS);
                  if (lane < 48) { u32x4 o; o.x = cvt_pk_bf16(f[0] * rstd * gq0.x, f[1] * rstd * gq0.y); o.y = cvt_pk_bf16(f[2] * rstd * gq0.z, f[3] * rstd * gq0.w);
                      o.z = cvt_pk_bf16(f[4] * rstd * gq1.x, f[5] * rstd * gq1.y); o.w = cvt_pk_bf16(f[6] * rstd * gq1.z, f[7] * rstd * gq1.w); *(u32x4*)(QL + (size_t)(4 * gi + rr) * 384 + lane * 8) = o; } }
                { const u32x4 v = vk[rr]; float f[8] = {bf_lo(v.x), bf_hi(v.x), bf_lo(v.y), bf_hi(v.y), bf_lo(v.z), bf_hi(v.z), bf_lo(v.w), bf_hi(v.w)}; float ss = 0.f;
#pragma unroll
                  for (int j = 0; j < 8; ++j) ss += f[j] * f[j];
                  const float rstd = rsqrtf(wave_sum(ss) * (1.f / 256.f) + EPS);
                  if (lane < 32) { u32x4 o; o.x = cvt_pk_bf16(f[0] * rstd * gk0.x, f[1] * rstd * gk0.y); o.y = cvt_pk_bf16(f[2] * rstd * gk0.z, f[3] * rstd * gk0.w);
                      o.z = cvt_pk_bf16(f[4] * rstd * gk1.x, f[5] * rstd * gk1.y); o.w = cvt_pk_bf16(f[6] * rstd * gk1.z, f[7] * rstd * gk1.w); *(u32x4*)(KVL + (size_t)(4 * gi + rr) * 256 + lane * 8) = o; } }
            }
        }
    }
#endif
    xcd_barrier(bar);

#if PH(4)
    for (int rep = 0; rep < DUP(5); ++rep) {
    { pg8::DenseOrder S; S.init(QL, WUQ, NTOK, 768, 384, G, bx); EpiStore E{QB, 768}; pg8::gemm_phase<false>(lds, 384, S, E); }
    { pg8::DenseOrder S; S.init(KVL, WUKV, NTOK, 1024, 256, G, bx); EpiStore E{KVRAW, 1024}; pg8::gemm_phase<false>(lds, 256, S, E); } }
#endif
    xcd_barrier(bar);

#if PH(5)
    {
        const int hd = lane >> 3, sub = lane & 7;
        const float QSC = 0.10206207261596575f * LOG2E;
        const float if0 = exp2f(-(float)(2 * sub) * (13.287712379549449f / 16.f)), if1 = exp2f(-(float)(2 * sub + 1) * (13.287712379549449f / 16.f));
        f32x4 gq0 = *(const f32x4*)(g_qk_q + sub * 8), gq1 = *(const f32x4*)(g_qk_q + sub * 8 + 4); const f32x2 gqa = *(const f32x2*)(g_qk_q + 64 + 2 * sub), gqb = *(const f32x2*)(g_qk_q + 80 + 2 * sub);
        f32x4 gk0 = *(const f32x4*)(g_qk_k + sub * 8), gk1 = *(const f32x4*)(g_qk_k + sub * 8 + 4); const f32x2 gka = *(const f32x2*)(g_qk_k + 64 + 2 * sub), gkb = *(const f32x2*)(g_qk_k + 80 + 2 * sub);
        for (int gi = gw; gi < NTOK / 4; gi += NGW) {
            u32x4 A[4][2]; unsigned B1[4][2], B2[4][2]; float posf[4];
#pragma unroll
            for (int t = 0; t < 4; ++t) { const int m = 4 * gi + t; posf[t] = (float)positions[m];
                const bf16_t* qp = QB + (size_t)m * 768 + hd * 96; A[t][0] = *(const u32x4*)(qp + sub * 8); B1[t][0] = *(const unsigned*)(qp + 64 + 2 * sub); B2[t][0] = *(const unsigned*)(qp + 80 + 2 * sub);
                A[t][1] = *(const u32x4*)(KVRAW + (size_t)m * 1024 + hd * 128 + sub * 8); B1[t][1] = *(const unsigned*)(KPE + (size_t)m * 32 + 2 * sub); B2[t][1] = *(const unsigned*)(KPE + (size_t)m * 32 + 16 + 2 * sub); }
#pragma unroll
            for (int t = 0; t < 4; ++t) { const int m = 4 * gi + t;
                float cs[2], sn[2];
                { const float a0 = posf[t] * if0, a1 = posf[t] * if1;
                  double r0 = (double)a0 * 0.15915494309189535, r1 = (double)a1 * 0.15915494309189535; r0 -= __builtin_rint(r0); r1 -= __builtin_rint(r1);
                  cs[0] = __builtin_amdgcn_cosf((float)r0); sn[0] = __builtin_amdgcn_sinf((float)r0); cs[1] = __builtin_amdgcn_cosf((float)r1); sn[1] = __builtin_amdgcn_sinf((float)r1); }
#pragma unroll
                for (int which = 0; which < 2; ++which) {
                    const u32x4 Av = A[t][which]; const unsigned b1 = B1[t][which], b2 = B2[t][which];
                    bf16_t* dst = which ? KB + (size_t)m * 768 + hd * 96 : QB + (size_t)m * 768 + hd * 96;
                    float f[8] = {bf_lo(Av.x), bf_hi(Av.x), bf_lo(Av.y), bf_hi(Av.y), bf_lo(Av.z), bf_hi(Av.z), bf_lo(Av.w), bf_hi(Av.w)};
                    float x1[2] = {bf_lo(b1), bf_hi(b1)}, x2[2] = {bf_lo(b2), bf_hi(b2)};
                    float ss = x1[0] * x1[0] + x1[1] * x1[1] + x2[0] * x2[0] + x2[1] * x2[1];
#pragma unroll
                    for (int j = 0; j < 8; ++j) ss += f[j] * f[j];
                    ss += __shfl_xor(ss, 1); ss += __shfl_xor(ss, 2); ss += __shfl_xor(ss, 4);
                    const float rstd = rsqrtf(ss * (1.f / 96.f) + EPS);
                    const f32x4 g0 = which ? gk0 : gq0, g1 = which ? gk1 : gq1; const f32x2 ga = which ? gka : gqa, gb = which ? gkb : gqb;
                    const float sc = which ? 1.f : QSC;
                    float y[8] = {f[0] * rstd * g0.x, f[1] * rstd * g0.y, f[2] * rstd * g0.z, f[3] * rstd * g0.w, f[4] * rstd * g1.x, f[5] * rstd * g1.y, f[6] * rstd * g1.z, f[7] * rstd * g1.w};
                    const float y1a = x1[0] * rstd * ga.x, y1b = x1[1] * rstd * ga.y, y2a = x2[0] * rstd * gb.x, y2b = x2[1] * rstd * gb.y;
                    const float o1a = y1a * cs[0] - y2a * sn[0], o1b = y1b * cs[1] - y2b * sn[1], o2a = y2a * cs[0] + y1a * sn[0], o2b = y2b * cs[1] + y1b * sn[1];
                    u32x4 o; o.x = cvt_pk_bf16(y[0] * sc, y[1] * sc); o.y = cvt_pk_bf16(y[2] * sc, y[3] * sc); o.z = cvt_pk_bf16(y[4] * sc, y[5] * sc); o.w = cvt_pk_bf16(y[6] * sc, y[7] * sc);
                    *(u32x4*)(dst + sub * 8) = o; *(unsigned*)(dst + 64 + 2 * sub) = cvt_pk_bf16(o1a * sc, o1b * sc); *(unsigned*)(dst + 80 + 2 * sub) = cvt_pk_bf16(o2a * sc, o2b * sc);
                }
            }
        }
    }
#endif
    xcd_barrier(bar);

#if PH(6)
    for (int bh = vcu; bh < NB * NH; bh += G) {
        for (int rep = 0; rep < DUP(0); ++rep) for (int qb = 0; qb < 8; ++qb) mla_unit(lds, QB, KB, KVRAW, OMLA, bh >> 3, bh & 7, qb);
        for (int rep = 0; rep < DUP(1); ++rep) for (int qb = 0; qb < 8; ++qb) sb_unit(lds, SBQ, OSB, bh >> 3, bh & 7, qb);
    }
#endif
    xcd_barrier(bar);

#if PH(8)
    for (int rep = 0; rep < DUP(6); ++rep) {
    { pg8::DenseOrder S; S.init(OMLA, WOM, NTOK, 1024, 512, G, bx); EpiMerge<false> E{MERGED, SGA}; pg8::gemm_phase<false>(lds, 512, S, E); }
    { pg8::DenseOrder S; S.init(OSB, WOS, NTOK, 1024, 512, G, bx); EpiMerge<true> E{MERGED, SGB}; pg8::gemm_phase<false>(lds, 512, S, E); } }
#endif
    xcd_barrier(bar);

#if PH(9)
    { pg8::DenseOrder S; S.init(MERGED, WOUT, NTOK, 1024, 1024, G, bx); EpiWout E{x, out, MOD}; for (int rep = 0; rep < DUP(7); ++rep) pg8::gemm_phase<false>(lds, 1024, S, E); }
#endif
    xcd_barrier(bar);

#if PH(10)
    {
        constexpr int I_GU = 16 * 64, I_DN = 16 * 32;
        for (int rep = 0; rep < DUP(2); ++rep) for (int it = gw; it < NE * (I_GU + I_DN); it += NGW) {
            if (it < NE * I_GU) { const int e = it / I_GU, q = it % I_GU, kb = q / 64, nb = q % 64, n0 = 32 * nb; const int g = n0 >> 10, jj = n0 & 1023;
                transpose_item_f8(w_gate_up + (size_t)e * 1024 * 2048, 1024, 2048, WGU + (size_t)e * 2048 * 1024, 64 * kb, n0, 256 * (jj >> 7) + 128 * g + (jj & 127), WSCALE, scr, lane); }
            else { const int r2 = it - NE * I_GU, e = r2 / I_DN, q = r2 % I_DN, kb = q / 32, nb = q % 32;
                transpose_item_f8(w_down + (size_t)e * 1024 * 1024, 1024, 1024, WDN + (size_t)e * 1024 * 1024, 64 * kb, 32 * nb, 32 * nb, WSCALE, scr, lane); }
        }
        __syncthreads();
        {
            const int r = lane & 31, hh = lane >> 5;
            constexpr int TP = 1026;
            LAS float* tile = (LAS float*)lds;
            float areg[64];
#pragma unroll
            for (int mm = 0; mm < 64; ++mm) areg[mm] = w_router[(size_t)(128 * wave + 4 * (mm >> 1) + 2 * hh + (mm & 1)) * 32 + r];
            const float br = b_router[r];
            for (int tt = vcu; tt < NTOK / 32; tt += G) {
                { f32x4 v[4][4];
#pragma unroll
                  for (int rr = 0; rr < 4; ++rr) { const f32x4* xr = (const f32x4*)(out + (size_t)(32 * tt + 4 * wave + rr) * 1024) + lane;
#pragma unroll
                      for (int j = 0; j < 4; ++j) v[rr][j] = xr[64 * j]; }
                  const float* mb = MOD + (size_t)((32 * tt) >> 11) * 6144;
                  f32x4 gsc[4], shv[4];
#pragma unroll
                  for (int j = 0; j < 4; ++j) { const int col = 4 * lane + 256 * j; gsc[j] = *(const f32x4*)(g_norm2 + col) * (*(const f32x4*)(mb + 4096 + col) + 1.f); shv[j] = *(const f32x4*)(mb + 3072 + col); }
#pragma unroll
                  for (int rr = 0; rr < 4; ++rr) { float ss = 0.f; const int row = 4 * wave + rr;
#pragma unroll
                      for (int j = 0; j < 4; ++j) ss += (v[rr][j].x * v[rr][j].x + v[rr][j].y * v[rr][j].y) + (v[rr][j].z * v[rr][j].z + v[rr][j].w * v[rr][j].w);
                      const float rstd = rsqrtf(wave_sum(ss) * (1.f / 1024.f) + EPS);
#pragma unroll
                      for (int j = 0; j < 4; ++j) { const int col = 4 * lane + 256 * j; const f32x4 y = (v[rr][j] * rstd) * gsc[j] + shv[j];
                          *(unsigned*)(H2 + (size_t)(32 * tt + row) * 1024 + col) = pk4_fp8(y.x, y.y, y.z, y.w);
                          *(LAS f32x2*)(tile + row * TP + col) = (f32x2){y.x, y.y}; *(LAS f32x2*)(tile + row * TP + col + 2) = (f32x2){y.z, y.w}; } } }
                __syncthreads();
                f32x16 acc;
#pragma unroll
                for (int i = 0; i < 16; ++i) acc[i] = 0.f;
#pragma unroll
                for (int sg = 0; sg < 32; ++sg) { const f32x2 hv = *(const LAS f32x2*)(tile + r * TP + 128 * wave + 4 * sg + 2 * hh);
                    acc = __builtin_amdgcn_mfma_f32_32x32x2f32(areg[2 * sg], hv.x, acc, 0, 0, 0); acc = __builtin_amdgcn_mfma_f32_32x32x2f32(areg[2 * sg + 1], hv.y, acc, 0, 0, 0); }
                __syncthreads();
#pragma unroll
                for (int i = 0; i < 16; ++i) tile[wave * 1024 + i * 64 + lane] = acc[i];
                __syncthreads();
                { const int e = r, he = (e >> 2) & 1, ie = (e & 3) + 4 * (e >> 3);
#pragma unroll
                  for (int rr = 0; rr < 4; ++rr) { const int row = 4 * wave + rr; float v = br;
#pragma unroll
                      for (int w2 = 0; w2 < 8; ++w2) v += tile[w2 * 1024 + ie * 64 + row + 32 * he];
                      float tv[4]; int te[4];
#pragma unroll
                      for (int k = 0; k < 4; ++k) { float bv = v; int bi = e;
#pragma unroll
                          for (int off = 16; off >= 1; off >>= 1) { const float ov = __shfl_xor(bv, off); const int oi = __shfl_xor(bi, off); if (ov > bv || (ov == bv && oi < bi)) { bv = ov; bi = oi; } }
                          tv[k] = bv; te[k] = bi; if (e == bi) v = -INFINITY; }
                      const float e1 = __expf(tv[1] - tv[0]), e2 = __expf(tv[2] - tv[0]), e3 = __expf(tv[3] - tv[0]); const float inv = 1.f / (1.f + e1 + e2 + e3);
                      if (lane < 4) { const int k = lane; const int ek = k == 0 ? te[0] : k == 1 ? te[1] : k == 2 ? te[2] : te[3]; const float wk = (k == 0 ? 1.f : k == 1 ? e1 : k == 2 ? e2 : e3) * inv;
                          const unsigned slot = atomicAdd(ctl + CW_CNT + (k * 32 + ek) * 16, 1u);
                          TOKL[(size_t)(k * 32 + ek) * LISTCAP + slot] = 32 * tt + row; WLST[(size_t)(k * 32 + ek) * LISTCAP + slot] = wk; } } }
                __syncthreads();
            }
        }
    }
#endif
    xcd_barrier(bar);

#if PH(11)
    {
        LAS int* rbase = (LAS int*)(lds + LDSCTL_OFF + LC_RBASE); LAS int* tbase = (LAS int*)(lds + LDSCTL_OFF + LC_TBASE); LAS int* nearr = (LAS int*)(lds + LDSCTL_OFF + LC_NE); LAS int* tilee = (LAS int*)(lds + LDSCTL_OFF + LC_TILEE);
        { int tid = threadIdx.x; asm volatile("" : "+v"(tid));
          if (tid < 4 * NE) nearr[tid] = (int)ctl[CW_CNT + tid * 16];
          __syncthreads();
          if (tid < 4) { int a = 0;
#pragma nounroll
              for (int e = 0; e < NE; ++e) { tbase[tid * 33 + e] = a; a += (nearr[tid * 32 + e] + 255) >> 8; } tbase[tid * 33 + NE] = a; }
          __syncthreads();
          if (tid == 0) { int a = 0;
#pragma nounroll
              for (int k = 0; k < 4; ++k) { rbase[k] = a; a += tbase[k * 33 + NE]; } rbase[4] = a; }
          for (int q = tid; q < 4 * MAXTILES; q += 512) { const int k = q / MAXTILES, T = q % MAXTILES;
              if (T < tbase[k * 33 + NE]) { int e = 0;
#pragma nounroll
                  while (e < NE - 1 && tbase[k * 33 + e + 1] <= T) ++e;
                  tilee[k * MAXTILES + T] = e; } }
          __syncthreads(); }
        const MoeTabs tb{rbase, tbase, nearr, tilee};
        { MoeOrderGU S{(const char*)H2, (const char*)WGU, TOKL, G, vcu, tb};
          EpiGateUp E{HID, b_gate_up};
          pg8::gemm_phase_f8<true>(lds, 512, S, E); }
        xcd_barrier(bar);
        for (int k = 0; k < TOPK; ++k) {
            { MoeOrderDN S{(const char*)HID, (const char*)WDN, G, vcu, k, tb};
              EpiDown E{out, MERGED  , b_down, MOD, TOKL + (size_t)k * NE * LISTCAP, WLST + (size_t)k * NE * LISTCAP, k == 0 ? 0 : (k == TOPK - 1 ? 2 : 1)};
              pg8::gemm_phase_f8<false>(lds, 512, S, E); }
            if (k + 1 < TOPK) xcd_barrier(bar);
        }
    }
#endif
}

extern "C" void kernel_launch(void* const* d_in, const int* in_sizes, int n_in, void* d_out, int out_size, void* d_ws, size_t ws_size, hipStream_t stream) {
    static int grid = 0;
    if (grid == 0) {
        if (n_in != 23 || in_sizes[0] != NTOK * DM || out_size != NTOK * DM || ws_size < WS_END) { fprintf(stderr, "kernel_launch: unexpected shapes (n_in %d, in0 %d, out %d, ws %zu); nothing launched\n", n_in, n_in > 0 ? in_sizes[0] : -1, out_size, ws_size); grid = -1; return; }
        int dev = 0, cus = 0, per_cu = 0;
        if (hipGetDevice(&dev) != hipSuccess || hipDeviceGetAttribute(&cus, hipDeviceAttributeMultiprocessorCount, dev) != hipSuccess) { grid = -1; return; }
        if (hipFuncSetAttribute((const void*)fwd_kernel, hipFuncAttributeMaxDynamicSharedMemorySize, LDS_BYTES) != hipSuccess) { fprintf(stderr, "kernel_launch: hipFuncSetAttribute failed\n"); grid = -1; return; }
        if (hipOccupancyMaxActiveBlocksPerMultiprocessor(&per_cu, (const void*)fwd_kernel, 512, LDS_BYTES) != hipSuccess || per_cu < 1) fprintf(stderr, "kernel_launch: occupancy query reports %d\n", per_cu);
        (void)hipGetLastError();
        grid = cus;
    }
    if (grid < 0) return;
    if (hipMemsetAsync((char*)d_ws + WS_CTL, 0, CTL_ZERO_BYTES, stream) != hipSuccess) return;
    Args a{};
    for (int i = 0; i < 23; ++i) a.in[i] = d_in[i];
    a.out = (float*)d_out; a.ws = (unsigned char*)d_ws;
    hipLaunchKernelGGL(fwd_kernel, dim3(grid), dim3(512), LDS_BYTES, stream, a);
}
```

```cpp
#include <hip/hip_runtime.h>
#include <cstdio>
#include <cstdint>

#define LAS __attribute__((address_space(3)))
#define GAS __attribute__((address_space(1)))
typedef unsigned short bf16_t;
typedef short bf16x8 __attribute__((ext_vector_type(8)));
typedef short s16x4 __attribute__((ext_vector_type(4)));
typedef float f32x2 __attribute__((ext_vector_type(2)));
typedef float f32x4 __attribute__((ext_vector_type(4)));
typedef float f32x16 __attribute__((ext_vector_type(16)));
typedef unsigned u32x2 __attribute__((ext_vector_type(2)));
typedef unsigned u32x4 __attribute__((ext_vector_type(4)));
typedef int v8i __attribute__((ext_vector_type(8)));
typedef unsigned u32x8 __attribute__((ext_vector_type(8)));

constexpr int NB = 32, SEQ = 2048, DM = 1024, NTOK = NB * SEQ;
constexpr int QLORA = 384, KVLORA = 256, ROPE = 32, NOPE = 64, VD = 64, QKD = 96, NH = 8;
constexpr int SBD = 64;
constexpr int NE = 32, TOPK = 4, DE = 1024;
constexpr int DIN = 4256, DINP = 4352;
constexpr float EPS = 1e-6f;
constexpr float LOG2E = 1.4426950408889634f;
constexpr int LISTCAP = NTOK;
constexpr int MAXTILES = NTOK / 256 + NE;

constexpr size_t MiB = 1u << 20;
constexpr size_t WS_CTL = 0, CTL_ZERO_BYTES = 1 * MiB;
constexpr size_t WS_WIN = 1 * MiB;
constexpr size_t WS_WUQ = 10 * MiB;
constexpr size_t WS_WUKV = 11 * MiB;
constexpr size_t WS_WOM = 12 * MiB;
constexpr size_t WS_WOS = 13 * MiB;
constexpr size_t WS_WOUT = 14 * MiB;
constexpr size_t WS_MOD = 16 * MiB;
constexpr size_t WS_WIN8 = 18 * MiB;
constexpr size_t WS_H = 32 * MiB;
constexpr size_t WS_KVRAW = WS_H, WS_MERGED = WS_H;
constexpr size_t WS_SGA = 160 * MiB;
constexpr size_t WS_H2 = WS_SGA;
constexpr size_t WS_SGB = 288 * MiB;
constexpr size_t WS_WGU = WS_SGB;
constexpr size_t WS_SB = 416 * MiB;
constexpr size_t WS_WDN = 416 * MiB;
constexpr size_t WS_TOKL = 480 * MiB;
constexpr size_t WS_WL = 512 * MiB;
constexpr size_t WS_HID = 544 * MiB;
constexpr size_t WS_QL = 608 * MiB;
constexpr size_t WS_KVL = 656 * MiB;
constexpr size_t WS_KPE = 688 * MiB;
constexpr size_t WS_Q = 692 * MiB;
constexpr size_t WS_K = 788 * MiB;
constexpr size_t WS_OMLA = 884 * MiB;
constexpr size_t WS_H8 = WS_OMLA;
constexpr size_t WS_OSB = 948 * MiB;
constexpr size_t WS_END = 1012 * MiB;
static_assert(WS_HID + (size_t)4 * MAXTILES * 256 * 1024 <= WS_END, "hid (fp8, all four rounds)");
constexpr int CW_BAR = 4096;
constexpr int CW_CNT = 16384;

constexpr int RING_BYTES = 131072;
constexpr int LDSCTL_OFF = RING_BYTES + 1024;
constexpr int LC_BARST = 0;
constexpr int LC_RBASE = 32;
constexpr int LC_TBASE = 64;
constexpr int LC_NE = 640;
constexpr int LC_TILEE = 1152;
constexpr int LDS_BYTES = 147456;
static_assert(LC_TILEE + 4 * MAXTILES * 4 <= LDS_BYTES - LDSCTL_OFF, "lds ctl");

__device__ __forceinline__ unsigned cvt_pk_bf16(float lo, float hi) { unsigned r; asm volatile("v_cvt_pk_bf16_f32 %0, %1, %2" : "=v"(r) : "v"(lo), "v"(hi)); return r; }
__device__ __forceinline__ float bf_lo(unsigned u) { return __builtin_bit_cast(float, u << 16); }
__device__ __forceinline__ float bf_hi(unsigned u) { return __builtin_bit_cast(float, u & 0xffff0000u); }
__device__ __forceinline__ float fast_sigmoid(float x) { return __builtin_amdgcn_rcpf(1.f + __builtin_amdgcn_exp2f(-x * LOG2E)); }

namespace pg8 {
constexpr int BM = 256, BK = 64, HALF = 128, HTB = HALF * BK * 2, STAGE_BYTES = 8 * HTB, NXCD = 8, WGM = 8;
__host__ __device__ __forceinline__ int lds_byte(int r, int c) { const int st = (r >> 4) * 2 + (c >> 5), rr = r & 15, cc = c & 31, ob = rr * 64 + cc * 2; return st * 1024 + (ob ^ (((ob >> 9) & 1) << 5)); }
__host__ __device__ __forceinline__ void stage_rc(int b, int& R, int& C) { const int st = b / 1024, sb = b % 1024, swz = sb ^ (((sb >> 9) & 1) << 5); R = (st >> 1) * 16 + swz / 64; C = (st & 1) * 32 + (swz % 64) / 2; }
__host__ __device__ __forceinline__ int perm32(int rho) { const int n = rho >> 4, i = rho & 15; return 8 * (i >> 2) + 4 * n + (i & 3); }

struct Unit { int pm, pn, e, j0, ne, kk; };

struct DenseOrder {
    const char* A; const char* Bt; int K; int nM, nN, nwg, G, c;
    __device__ void init(const void* A_, const void* Bt_, int M, int N, int K_, int G_, int c_) { A = (const char*)A_; Bt = (const char*)Bt_; K = K_; nM = M / BM; nN = N / BM; nwg = nM * nN; G = G_; c = c_; }
    __device__ __forceinline__ bool next(int i, Unit& u) const {
        const long L = (long)i * G + c; if (L >= nwg) return false;
        int wgid = (int)L; { const int q = nwg / NXCD, r = nwg % NXCD, xcd = wgid % NXCD, off = wgid / NXCD; wgid = (xcd < r ? xcd * (q + 1) : r * (q + 1) + (xcd - r) * q) + off; }
        const int nig = WGM * nN, gid = wgid / nig, fm = gid * WGM, gsz = (nM - fm) < WGM ? (nM - fm) : WGM;
        u.pm = fm + ((wgid % nig) % gsz); u.pn = (wgid % nig) / gsz; u.e = 0; u.j0 = 0; u.ne = 0; u.kk = 0; return true;
    }
    __device__ __forceinline__ const char* a_base(const Unit& u) const { return A + (size_t)u.pm * (size_t)(BM * 2) * K; }
    __device__ __forceinline__ const char* b_base(const Unit& u) const { return Bt + (size_t)u.pn * (size_t)(BM * 2) * K; }
    __device__ __forceinline__ unsigned row_of(const Unit&, int) const { return 0u; }
};

template <bool GATHER, class Epi, class Sched>
__device__ __forceinline__ void gemm_phase(LAS unsigned char* lds, const int K, const Sched& S, const Epi& E) {
    int tid_ = threadIdx.x; asm volatile("" : "+v"(tid_));
    const int tid = tid_, wid = __builtin_amdgcn_readfirstlane(tid >> 6), lane = tid & 63, wr = wid >> 2, wc = wid & 3, fr = lane & 15, fq = lane >> 4;
    const int nt = K / BK;
    int RA[2]; unsigned cofA[2], voffB[2];
#pragma unroll
    for (int i = 0; i < 2; ++i) { int R, C; stage_rc(tid * 16 + i * 8192, R, C); const int Rb = (R & ~31) + perm32(R & 31);
        RA[i] = R; cofA[i] = (unsigned)C * 2u; voffB[i] = (unsigned)(Rb * K + C) * 2u; }
    const size_t kstep = (size_t)(BK * 2);
    const size_t hstep = (size_t)HALF * K * 2;
    const unsigned ldsw = (unsigned)wid * 1024u;
    const int aoff = lds_byte(wr * 64 + fr, fq * 8), boff = lds_byte(wc * 32 + fr, fq * 8);
#define PG8_SA(b, h) (((b) * 2 + (h)) * HTB)
#define PG8_SB(b, h) ((4 + (b) * 2 + (h)) * HTB)
#define PG8_STAGE(bufoff, gbase, voff) do { _Pragma("unroll") for (int _i = 0; _i < 2; ++_i) \
        __builtin_amdgcn_global_load_lds((const unsigned*)((const char*)(gbase) + (voff)[_i]), (LAS unsigned*)(lds + (bufoff) + ldsw + _i * 8192), 16, 0, 0); } while (0)
#define PG8_LDA(dst, b, h) do { _Pragma("unroll") for (int m = 0; m < 4; ++m) _Pragma("unroll") for (int k = 0; k < 2; ++k) dst[m][k] = *(const LAS bf16x8*)(lds + PG8_SA(b, h) + aoff + m * 2048 + k * 1024); } while (0)
#define PG8_LDB(dst, b, h) do { _Pragma("unroll") for (int n = 0; n < 2; ++n) _Pragma("unroll") for (int k = 0; k < 2; ++k) dst[n][k] = *(const LAS bf16x8*)(lds + PG8_SB(b, h) + boff + n * 2048 + k * 1024); } while (0)
#define PG8_MMA(ai, bj, At, Bt) do { __builtin_amdgcn_s_setprio(1); _Pragma("unroll") for (int m = 0; m < 4; ++m) _Pragma("unroll") for (int n = 0; n < 2; ++n) _Pragma("unroll") for (int k = 0; k < 2; ++k) \
        acc[ai][bj][m][n] = __builtin_amdgcn_mfma_f32_16x16x32_bf16(Bt[n][k], At[m][k], acc[ai][bj][m][n], 0, 0, 0); __builtin_amdgcn_s_setprio(0); } while (0)
#define PG8_WAIT_V(n) asm volatile("s_waitcnt vmcnt(" #n ")" ::: "memory")
#define PG8_WAIT_L(n) asm volatile("s_waitcnt lgkmcnt(" #n ")" ::: "memory")
#define PG8_BAR __builtin_amdgcn_s_barrier()
#define PG8_SCHED __builtin_amdgcn_sched_barrier(0)
#define PG8_AOFFS(dst, u) do { _Pragma("unroll") for (int _h = 0; _h < 2; ++_h) _Pragma("unroll") for (int _i = 0; _i < 2; ++_i) { \
        const unsigned _row = GATHER ? S.row_of(u, _h * HALF + RA[_i]) : (unsigned)(_h * HALF + RA[_i]); dst[_h][_i] = _row * (unsigned)(K * 2) + cofA[_i]; } } while (0)
    Unit cur, nxt; int ui = 0;
    if (!S.next(0, cur)) return;
    f32x4 acc[2][2][4][2];
#pragma unroll
    for (int a = 0; a < 2; ++a)
#pragma unroll
        for (int b = 0; b < 2; ++b)
#pragma unroll
            for (int m = 0; m < 4; ++m)
#pragma unroll
                for (int n = 0; n < 2; ++n) acc[a][b][m][n] = (f32x4){0.f, 0.f, 0.f, 0.f};
    bf16x8 At[4][2], B0[2][2], B1[2][2];
    unsigned oc[2][2], on[2][2];
    PG8_AOFFS(oc, cur);
    const char* cA = S.a_base(cur); const char* cB = S.b_base(cur);
    PG8_STAGE(PG8_SB(0, 0), cB, voffB); PG8_STAGE(PG8_SB(0, 1), cB + hstep, voffB); PG8_STAGE(PG8_SA(0, 0), cA, oc[0]); PG8_STAGE(PG8_SA(0, 1), cA, oc[1]);
    if (wr == 1) PG8_BAR;
    PG8_WAIT_V(2); PG8_BAR;
    PG8_STAGE(PG8_SB(1, 0), cB + kstep, voffB); PG8_STAGE(PG8_SA(1, 0), cA + kstep, oc[0]); PG8_STAGE(PG8_SB(1, 1), cB + hstep + kstep, voffB);
    PG8_WAIT_V(6); PG8_BAR;
    for (;;) {
        const bool has_next = S.next(ui + 1, nxt);
        const char* nA = has_next ? S.a_base(nxt) : cA; const char* nB = has_next ? S.b_base(nxt) : cB;
        if constexpr (GATHER) { if (has_next) { PG8_AOFFS(on, nxt);
            _Pragma("unroll") for (int _h = 0; _h < 2; ++_h) _Pragma("unroll") for (int _i = 0; _i < 2; ++_i) asm volatile("" : "+v"(on[_h][_i]));
          } else {
#pragma unroll
            for (int _h = 0; _h < 2; ++_h)
#pragma unroll
                for (int _i = 0; _i < 2; ++_i) on[_h][_i] = oc[_h][_i]; } }
#pragma nounroll
        for (int t = 0; t < nt; t += 2) {
            const bool last = (t == nt - 2);
            const char* a1 = cA + (size_t)(t + 1) * kstep;
            const char* a2 = last ? nA : cA + (size_t)(t + 2) * kstep; const char* b2 = last ? nB : cB + (size_t)(t + 2) * kstep;
            const char* a3 = a2 + kstep; const char* b3 = b2 + kstep;
            unsigned o2[2][2];
#pragma unroll
            for (int _h = 0; _h < 2; ++_h)
#pragma unroll
                for (int _i = 0; _i < 2; ++_i) o2[_h][_i] = (GATHER && last) ? on[_h][_i] : oc[_h][_i];
            PG8_LDB(B0, 0, 0); PG8_LDB(B1, 0, 1); PG8_SCHED; PG8_LDA(At, 0, 0); PG8_STAGE(PG8_SA(1, 1), a1, oc[1]);
            PG8_WAIT_V(8); PG8_WAIT_L(0); PG8_BAR; PG8_MMA(0, 0, At, B0); PG8_MMA(0, 1, At, B1); PG8_BAR; PG8_SCHED;
            PG8_LDA(At, 0, 1); PG8_STAGE(PG8_SB(0, 0), b2, voffB); PG8_STAGE(PG8_SB(0, 1), b2 + hstep, voffB); PG8_STAGE(PG8_SA(0, 0), a2, o2[0]);
            PG8_WAIT_V(8); PG8_WAIT_L(0); PG8_BAR; PG8_MMA(1, 0, At, B0); PG8_MMA(1, 1, At, B1); PG8_BAR; PG8_SCHED;
            PG8_LDB(B0, 1, 0); PG8_LDB(B1, 1, 1); PG8_SCHED; PG8_LDA(At, 1, 0); PG8_STAGE(PG8_SA(0, 1), a2, o2[1]);
            PG8_WAIT_V(8); PG8_WAIT_L(0); PG8_BAR; PG8_MMA(0, 0, At, B0); PG8_MMA(0, 1, At, B1); PG8_BAR; PG8_SCHED;
            PG8_LDA(At, 1, 1); PG8_STAGE(PG8_SB(1, 0), b3, voffB); PG8_STAGE(PG8_SB(1, 1), b3 + hstep, voffB); PG8_STAGE(PG8_SA(1, 0), a3, o2[0]);
            PG8_WAIT_V(8); PG8_WAIT_L(0); PG8_BAR; PG8_MMA(1, 0, At, B0); PG8_MMA(1, 1, At, B1); PG8_BAR; PG8_SCHED;
        }
        if (wr == 0) PG8_BAR;
        E(acc, cur, wr, wc, fr, fq);
        if (!has_next) break;
#pragma unroll
        for (int a = 0; a < 2; ++a)
#pragma unroll
            for (int b = 0; b < 2; ++b)
#pragma unroll
                for (int m = 0; m < 4; ++m)
#pragma unroll
                    for (int n = 0; n < 2; ++n) acc[a][b][m][n] = (f32x4){0.f, 0.f, 0.f, 0.f};
        cur = nxt; cA = nA; cB = nB; ++ui;
        if constexpr (GATHER) {
#pragma unroll
        for (int _h = 0; _h < 2; ++_h)
#pragma unroll
            for (int _i = 0; _i < 2; ++_i) oc[_h][_i] = on[_h][_i]; }
        if (wr == 1) PG8_BAR;
    }
    PG8_WAIT_V(0);
    PG8_BAR;
#undef PG8_SA
#undef PG8_SB
#undef PG8_STAGE
#undef PG8_LDA
#undef PG8_LDB
#undef PG8_MMA
#undef PG8_WAIT_V
#undef PG8_WAIT_L
#undef PG8_BAR
#undef PG8_SCHED
#undef PG8_AOFFS
}
template <bool GATHER, class Epi, class Sched>
__device__ __forceinline__ void gemm_phase_f8(LAS unsigned char* lds, const int K, const Sched& S, const Epi& E) {
    int tid_ = threadIdx.x; asm volatile("" : "+v"(tid_));
    const int tid = tid_, wid = __builtin_amdgcn_readfirstlane(tid >> 6), lane = tid & 63, wr = wid >> 2, wc = wid & 3, fr = lane & 15, fq = lane >> 4;
    const int nt = K / BK;
    int RA[2]; unsigned cofA[2], voffB[2];
#pragma unroll
    for (int i = 0; i < 2; ++i) { int R, C; stage_rc(tid * 16 + i * 8192, R, C); const int Rb = (R & ~31) + perm32(R & 31);
        RA[i] = R; cofA[i] = (unsigned)C * 2u; voffB[i] = (unsigned)(Rb * K + C) * 2u; }
    const size_t kstep = (size_t)(BK * 2);
    const size_t hstep = (size_t)HALF * K * 2;
    const unsigned ldsw = (unsigned)wid * 1024u;
    const int aoff = lds_byte(wr * 64 + fr, 16 * (fq & 1)) + (fq >> 1) * 1024, boff = lds_byte(wc * 32 + fr, 16 * (fq & 1)) + (fq >> 1) * 1024;
#define PG8_SA(b, h) (((b) * 2 + (h)) * HTB)
#define PG8_SB(b, h) ((4 + (b) * 2 + (h)) * HTB)
#define PG8_STAGE(bufoff, gbase, voff) do { _Pragma("unroll") for (int _i = 0; _i < 2; ++_i) \
        __builtin_amdgcn_global_load_lds((const unsigned*)((const char*)(gbase) + (voff)[_i]), (LAS unsigned*)(lds + (bufoff) + ldsw + _i * 8192), 16, 0, 0); } while (0)
#define PG8_LD32(p_) __builtin_shufflevector(*(const LAS u32x4*)(p_), *(const LAS u32x4*)((p_) + 16), 0, 1, 2, 3, 4, 5, 6, 7)
#define PG8_LDA(dst, b, h) do { _Pragma("unroll") for (int m = 0; m < 4; ++m) dst[m] = PG8_LD32(lds + PG8_SA(b, h) + aoff + m * 2048); } while (0)
#define PG8_LDB(dst, b, h) do { _Pragma("unroll") for (int n = 0; n < 2; ++n) dst[n] = PG8_LD32(lds + PG8_SB(b, h) + boff + n * 2048); } while (0)
#define PG8_F8(fr_) ((v8i){(int)fr_[0][0], (int)fr_[0][1], (int)fr_[0][2], (int)fr_[0][3], (int)fr_[1][0], (int)fr_[1][1], (int)fr_[1][2], (int)fr_[1][3]})
#define PG8_MMA(ai, bj, At, Bt) do { __builtin_amdgcn_s_setprio(1); _Pragma("unroll") for (int m = 0; m < 4; ++m) _Pragma("unroll") for (int n = 0; n < 2; ++n) \
        asm volatile("v_mfma_scale_f32_16x16x128_f8f6f4 %0, %1, %2, %0, %3, %3 op_sel_hi:[0,0,0]" : "+v"(acc[ai][bj][m][n]) : "v"(Bt[n]), "v"(At[m]), "v"(one_scale)); __builtin_amdgcn_s_setprio(0); } while (0)
#define PG8_WAIT_V(n) asm volatile("s_waitcnt vmcnt(" #n ")" ::: "memory")
#define PG8_WAIT_L(n) asm volatile("s_waitcnt lgkmcnt(" #n ")" ::: "memory")
#define PG8_BAR __builtin_amdgcn_s_barrier()
#define PG8_SCHED __builtin_amdgcn_sched_barrier(0)
#define PG8_AOFFS(dst, u) do { _Pragma("unroll") for (int _h = 0; _h < 2; ++_h) _Pragma("unroll") for (int _i = 0; _i < 2; ++_i) { \
        const unsigned _row = GATHER ? S.row_of(u, _h * HALF + RA[_i]) : (unsigned)(_h * HALF + RA[_i]); dst[_h][_i] = _row * (unsigned)(K * 2) + cofA[_i]; } } while (0)
    Unit cur, nxt; int ui = 0;
    if (!S.next(0, cur)) return;
    f32x4 acc[2][2][4][2];
#pragma unroll
    for (int a = 0; a < 2; ++a)
#pragma unroll
        for (int b = 0; b < 2; ++b)
#pragma unroll
            for (int m = 0; m < 4; ++m)
#pragma unroll
                for (int n = 0; n < 2; ++n) { acc[a][b][m][n] = (f32x4){0.f, 0.f, 0.f, 0.f}; asm volatile("" : "+v"(acc[a][b][m][n])); }
    u32x8 At[4], B0[2], B1[2];
    int one_scale = 0x7f7f7f7f; asm volatile("" : "+v"(one_scale));
    unsigned oc[2][2], on[2][2];
    PG8_AOFFS(oc, cur);
    const char* cA = S.a_base(cur); const char* cB = S.b_base(cur);
    PG8_STAGE(PG8_SB(0, 0), cB, voffB); PG8_STAGE(PG8_SB(0, 1), cB + hstep, voffB); PG8_STAGE(PG8_SA(0, 0), cA, oc[0]); PG8_STAGE(PG8_SA(0, 1), cA, oc[1]);
    if (wr == 1) PG8_BAR;
    PG8_WAIT_V(2); PG8_BAR;
    PG8_STAGE(PG8_SB(1, 0), cB + kstep, voffB); PG8_STAGE(PG8_SA(1, 0), cA + kstep, oc[0]); PG8_STAGE(PG8_SB(1, 1), cB + hstep + kstep, voffB);
    PG8_WAIT_V(6); PG8_BAR;
    Unit nn; bool has_next = S.next(1, nxt);
    if constexpr (GATHER) { if (has_next) { PG8_AOFFS(on, nxt);
            _Pragma("unroll") for (int _h = 0; _h < 2; ++_h) _Pragma("unroll") for (int _i = 0; _i < 2; ++_i) asm volatile("" : "+v"(on[_h][_i]));
          } else {
#pragma unroll
            for (int _h = 0; _h < 2; ++_h)
#pragma unroll
                for (int _i = 0; _i < 2; ++_i) on[_h][_i] = oc[_h][_i]; } }
    for (;;) {
        const char* nA = has_next ? S.a_base(nxt) : cA; const char* nB = has_next ? S.b_base(nxt) : cB;
#pragma nounroll
        for (int t = 0; t < nt; t += 2) {
            const bool last = (t == nt - 2);
            const char* a1 = cA + (size_t)(t + 1) * kstep;
            const char* a2 = last ? nA : cA + (size_t)(t + 2) * kstep; const char* b2 = last ? nB : cB + (size_t)(t + 2) * kstep;
            const char* a3 = a2 + kstep; const char* b3 = b2 + kstep;
            unsigned o2[2][2];
#pragma unroll
            for (int _h = 0; _h < 2; ++_h)
#pragma unroll
                for (int _i = 0; _i < 2; ++_i) o2[_h][_i] = (GATHER && last) ? on[_h][_i] : oc[_h][_i];
            PG8_LDB(B0, 0, 0); PG8_LDB(B1, 0, 1); PG8_SCHED; PG8_LDA(At, 0, 0); PG8_STAGE(PG8_SA(1, 1), a1, oc[1]);
            PG8_WAIT_V(8); PG8_WAIT_L(0); PG8_BAR; PG8_MMA(0, 0, At, B0); PG8_MMA(0, 1, At, B1); PG8_BAR; PG8_SCHED;
            PG8_LDA(At, 0, 1); PG8_STAGE(PG8_SB(0, 0), b2, voffB); PG8_STAGE(PG8_SB(0, 1), b2 + hstep, voffB); PG8_STAGE(PG8_SA(0, 0), a2, o2[0]);
            PG8_WAIT_V(8); PG8_WAIT_L(0); PG8_BAR; PG8_MMA(1, 0, At, B0); PG8_MMA(1, 1, At, B1); PG8_BAR; PG8_SCHED;
            PG8_LDB(B0, 1, 0); PG8_LDB(B1, 1, 1); PG8_SCHED; PG8_LDA(At, 1, 0); PG8_STAGE(PG8_SA(0, 1), a2, o2[1]);
            PG8_WAIT_V(8); PG8_WAIT_L(0); PG8_BAR; PG8_MMA(0, 0, At, B0); PG8_MMA(0, 1, At, B1); PG8_BAR; PG8_SCHED;
            PG8_LDA(At, 1, 1); PG8_STAGE(PG8_SB(1, 0), b3, voffB); PG8_STAGE(PG8_SB(1, 1), b3 + hstep, voffB); PG8_STAGE(PG8_SA(1, 0), a3, o2[0]);
            PG8_WAIT_V(8); PG8_WAIT_L(0); PG8_BAR; PG8_MMA(1, 0, At, B0); PG8_MMA(1, 1, At, B1); PG8_BAR; PG8_SCHED;
        }
        asm volatile("s_nop 15\n\ts_nop 15" ::: "memory");
        if (wr == 0) PG8_BAR;
        const bool has_nn = has_next && S.next(ui + 2, nn);
        unsigned onn[2][2];
        if constexpr (GATHER) { if (has_nn) { PG8_AOFFS(onn, nn); } else {
#pragma unroll
            for (int _h = 0; _h < 2; ++_h)
#pragma unroll
                for (int _i = 0; _i < 2; ++_i) onn[_h][_i] = on[_h][_i]; } }
        E(acc, cur, wr, wc, fr, fq);
        if (!has_next) break;
#pragma unroll
        for (int a = 0; a < 2; ++a)
#pragma unroll
            for (int b = 0; b < 2; ++b)
#pragma unroll
                for (int m = 0; m < 4; ++m)
#pragma unroll
                    for (int n = 0; n < 2; ++n) { acc[a][b][m][n] = (f32x4){0.f, 0.f, 0.f, 0.f}; asm volatile("" : "+v"(acc[a][b][m][n])); }
        cur = nxt; cA = nA; cB = nB; ++ui; nxt = nn; has_next = has_nn;
        if constexpr (GATHER) {
#pragma unroll
        for (int _h = 0; _h < 2; ++_h)
#pragma unroll
            for (int _i = 0; _i < 2; ++_i) { oc[_h][_i] = on[_h][_i]; asm volatile("" : "+v"(onn[_h][_i])); on[_h][_i] = onn[_h][_i]; } }
        if (wr == 1) PG8_BAR;
    }
    PG8_WAIT_V(0);
    PG8_BAR;
#undef PG8_SA
#undef PG8_SB
#undef PG8_STAGE
#undef PG8_LDA
#undef PG8_LDB
#undef PG8_MMA
#undef PG8_WAIT_V
#undef PG8_WAIT_L
#undef PG8_BAR
#undef PG8_SCHED
#undef PG8_AOFFS
#undef PG8_F8
}
}
#define XB_TMO      128
#define XB_XCNT(j)  (256  + 64 * (j))
#define XB_XSUB(j)  (1280 + 64 * (j))
#define XB_XGEN(j)  (2304 + 64 * (j))
#define XB_TOP      3328
#define XB_TOPGEN   3392
#define XCD_BAR_WORDS 3456
#define XB_SPIN_CAP (1u << 18)

__device__ __forceinline__ unsigned xb_ld(unsigned* p)              { return __hip_atomic_load(p, __ATOMIC_RELAXED, __HIP_MEMORY_SCOPE_AGENT); }
__device__ __forceinline__ unsigned xb_add(unsigned* p, unsigned v) { return __hip_atomic_fetch_add(p, v, __ATOMIC_RELAXED, __HIP_MEMORY_SCOPE_AGENT); }
__device__ __forceinline__ unsigned xb_xcc_id() { return (unsigned)__builtin_amdgcn_s_getreg((3 << 11) | 20) & 0xFu; }
#define XB_SPIN(cond, bar) do { unsigned _sp = 0; while (cond) { __builtin_amdgcn_s_sleep(1); \
    if ((++_sp & 255u) == 0u) { if (xb_ld(&(bar)[XB_TMO])) break; if (_sp > XB_SPIN_CAP) { atomicAdd(&(bar)[XB_TMO], 1u); break; } } } } while (0)

struct XcdBarrier {
    unsigned* bar; unsigned x;
    volatile LAS unsigned* st;
};

__device__ __forceinline__ XcdBarrier xcd_barrier_post(unsigned* bar, volatile LAS unsigned* st) {
    XcdBarrier b; b.bar = bar; b.x = xb_xcc_id(); b.st = st;
    if (threadIdx.x == 0) (void)xb_add(&bar[XB_XCNT(b.x)], 1u);
    return b;
}
__device__ __forceinline__ void xcd_barrier_complete(unsigned* bar, unsigned x, unsigned& nloc, unsigned& nx) {
    const unsigned G = gridDim.x * gridDim.y * gridDim.z;
    unsigned sum, cnt, mine, sp = 0u;
    for (;;) {
        sum = 0u; cnt = 0u; mine = 0u;
#pragma unroll
        for (unsigned j = 0; j < 16; ++j) { const unsigned c = xb_ld(&bar[XB_XCNT(j)]); sum += c; cnt += (c > 0u) ? 1u : 0u; mine = (j == x) ? c : mine; }
        if (sum == G) break;
        __builtin_amdgcn_s_sleep(1);
        if ((++sp & 255u) == 0u) { if (xb_ld(&bar[XB_TMO])) break; if (sp > XB_SPIN_CAP) { atomicAdd(&bar[XB_TMO], 1u); break; } }
    }
    nloc = mine > 0u ? mine : 1u; nx = cnt > 0u ? cnt : 1u;
}

__device__ __forceinline__ void xcd_barrier(const XcdBarrier& b) {
    asm volatile("s_waitcnt vmcnt(0)" ::: "memory");
    __syncthreads();
    if (threadIdx.x == 0) {
        unsigned* bar = b.bar;
        __builtin_amdgcn_s_waitcnt(0);
        unsigned nloc = b.st[0], nx = b.st[1];
        if (nloc == 0u) { xcd_barrier_complete(bar, b.x, nloc, nx); b.st[0] = nloc; b.st[1] = nx; }
        const unsigned old = xb_add(&bar[XB_XSUB(b.x)], 1u);
        const unsigned gen = old / nloc;
        if (old + 1u == (gen + 1u) * nloc) {
            __builtin_amdgcn_fence(__ATOMIC_RELEASE, "agent");
            asm volatile("s_waitcnt vmcnt(0)" ::: "memory");
            const unsigned og = xb_add(&bar[XB_TOP], 1u);
            const unsigned tg = og / nx;
            if (og + 1u == (tg + 1u) * nx) xb_add(&bar[XB_TOPGEN], 1u);
            else XB_SPIN(xb_ld(&bar[XB_TOPGEN]) == tg, bar);
            __builtin_amdgcn_fence(__ATOMIC_ACQUIRE, "agent");
            xb_add(&bar[XB_XGEN(b.x)], 1u);
            asm volatile("s_waitcnt vmcnt(0)" ::: "memory");
        } else {
            XB_SPIN(xb_ld(&bar[XB_XGEN(b.x)]) == gen, bar);
            __builtin_amdgcn_fence(__ATOMIC_ACQUIRE, "agent");
            asm volatile("s_waitcnt vmcnt(0)" ::: "memory");
        }
    }
    __syncthreads();
}

#define LDS_WAIT() asm volatile("s_waitcnt lgkmcnt(0)" ::: "memory")
#define VM_WAIT() asm volatile("s_waitcnt vmcnt(0)" ::: "memory")
#define MFMA32(a, b, c) __builtin_amdgcn_mfma_f32_32x32x16_bf16((a), (b), (c), 0, 0, 0)
__device__ __forceinline__ float wave_sum(float v) {
#pragma unroll
    for (int o = 1; o < 64; o <<= 1) v += __shfl_xor(v, o);
    return v;
}
__device__ __forceinline__ int crow(int i, int hh) { return (i & 3) + 8 * (i >> 2) + 4 * hh; }
__device__ __forceinline__ bf16x8 pack8(float a0, float a1, float a2, float a3, float a4, float a5, float a6, float a7) {
    u32x4 p; p.x = cvt_pk_bf16(a0, a1); p.y = cvt_pk_bf16(a2, a3); p.z = cvt_pk_bf16(a4, a5); p.w = cvt_pk_bf16(a6, a7);
    return __builtin_bit_cast(bf16x8, p);
}

struct Ctx {
    LAS unsigned char* lds;
    int tid, lane, wave, vcu, G;
};

__device__ __forceinline__ void transpose_item(const float* W, int K, int N, bf16_t* WT, int k0, int n0, int drow0, LAS float* scr, int lane) {
#pragma unroll 8
    for (int i = 0; i < 32; ++i) { const int kk = 2 * i + (lane >> 5); scr[kk * 33 + (lane & 31)] = W[(size_t)(k0 + kk) * N + n0 + (lane & 31)]; }
    LDS_WAIT(); asm volatile("" ::: "memory");
    const int c = lane & 7;
#pragma unroll
    for (int j = 0; j < 4; ++j) { const int n = (lane >> 3) + 8 * j; const LAS float* s = scr + (8 * c) * 33 + n;
        u32x4 o; o.x = cvt_pk_bf16(s[0 * 33], s[1 * 33]); o.y = cvt_pk_bf16(s[2 * 33], s[3 * 33]); o.z = cvt_pk_bf16(s[4 * 33], s[5 * 33]); o.w = cvt_pk_bf16(s[6 * 33], s[7 * 33]);
        *(GAS u32x4*)(WT + (size_t)(drow0 + n) * K + k0 + 8 * c) = o; }
    LDS_WAIT(); asm volatile("" ::: "memory");
}

__device__ __forceinline__ unsigned pk4_fp8(float a, float b, float c, float d) { int p = __builtin_amdgcn_cvt_pk_fp8_f32(a, b, 0, false); p = __builtin_amdgcn_cvt_pk_fp8_f32(c, d, p, true); return (unsigned)p; }
__device__ __forceinline__ void transpose_item_f8(const float* W, int K, int N, unsigned char* WT, int k0, int n0, int drow0, float scl, LAS float* scr, int lane) {
#pragma unroll 8
    for (int i = 0; i < 32; ++i) { const int kk = 2 * i + (lane >> 5); scr[kk * 33 + (lane & 31)] = W[(size_t)(k0 + kk) * N + n0 + (lane & 31)]; }
    LDS_WAIT(); asm volatile("" ::: "memory");
    const int c = lane & 7;
#pragma unroll
    for (int j = 0; j < 4; ++j) { const int n = (lane >> 3) + 8 * j; const LAS float* s = scr + (8 * c) * 33 + n;
        u32x2 o; o.x = pk4_fp8(s[0 * 33] * scl, s[1 * 33] * scl, s[2 * 33] * scl, s[3 * 33] * scl); o.y = pk4_fp8(s[4 * 33] * scl, s[5 * 33] * scl, s[6 * 33] * scl, s[7 * 33] * scl);
        *(GAS u32x2*)(WT + (size_t)(drow0 + n) * K + k0 + 8 * c) = o; }
    LDS_WAIT(); asm volatile("" ::: "memory");
}

constexpr float WSCALE = 32.f, WDESCALE = 1.f / 32.f;
typedef const f32x4 (&AccRef)[2][2][4][2];

struct EpiNull { __device__ __forceinline__ void operator()(AccRef acc, const pg8::Unit& u, int wr, int wc, int fr, int fq) const {
        float s = 0.f;
#pragma unroll
        for (int ai = 0; ai < 2; ++ai)
#pragma unroll
            for (int bj = 0; bj < 2; ++bj)
#pragma unroll
                for (int m = 0; m < 4; ++m)
#pragma unroll
                    for (int n = 0; n < 2; ++n) s += acc[ai][bj][m][n][0] + acc[ai][bj][m][n][1] + acc[ai][bj][m][n][2] + acc[ai][bj][m][n][3];
        asm volatile("" :: "v"(s)); } };
struct EpiStore {
    bf16_t* O; int ldc;
    __device__ __forceinline__ void operator()(AccRef acc, const pg8::Unit& u, int wr, int wc, int fr, int fq) const {
        const int row0 = u.pm * 256 + wr * 64 + fr, col0 = u.pn * 256 + wc * 32 + 8 * fq;
#pragma unroll
        for (int ai = 0; ai < 2; ++ai)
#pragma unroll
            for (int m = 0; m < 4; ++m) { bf16_t* rowp = O + (size_t)(row0 + ai * 128 + m * 16) * ldc + col0;
#pragma unroll
                for (int bj = 0; bj < 2; ++bj) { const f32x4 v0 = acc[ai][bj][m][0], v1 = acc[ai][bj][m][1];
                    u32x4 w; w.x = cvt_pk_bf16(v0[0], v0[1]); w.y = cvt_pk_bf16(v0[2], v0[3]); w.z = cvt_pk_bf16(v1[0], v1[1]); w.w = cvt_pk_bf16(v1[2], v1[3]);
                    *(u32x4*)(rowp + bj * 128) = w; } }
    }
};

struct EpiProj {
    bf16_t *QL, *KVL, *KPE, *SB, *SGA, *SGB; int cbase; float dsc;
    __device__ __forceinline__ void operator()(AccRef acc, const pg8::Unit& u, int wr, int wc, int fr, int fq) const {
        const int row0 = u.pm * 256 + wr * 64 + fr;
#pragma unroll
        for (int bj = 0; bj < 2; ++bj) {
            const int cg = cbase + u.pn * 256 + bj * 128 + wc * 32;
            bf16_t* base; int ld, co; bool sig = false;
            if (cg < 384) { base = QL; ld = 384; co = cg; }
            else if (cg < 640) { base = KVL; ld = 256; co = cg - 384; }
            else if (cg < 672) { base = KPE; ld = 32; co = cg - 640; }
            else if (cg < 768) { continue; }
            else if (cg < 2304) { base = SB; ld = 1536; co = cg - 768; }
            else if (cg < 3328) { base = SGA; ld = 1024; co = cg - 2304; sig = true; }
            else { base = SGB; ld = 1024; co = cg - 3328; sig = true; }
#pragma unroll
            for (int ai = 0; ai < 2; ++ai)
#pragma unroll
                for (int m = 0; m < 4; ++m) { f32x4 v0 = acc[ai][bj][m][0], v1 = acc[ai][bj][m][1];
                    if (sig) {
#pragma unroll
                        for (int j = 0; j < 4; ++j) { v0[j] = fast_sigmoid(v0[j] * dsc); v1[j] = fast_sigmoid(v1[j] * dsc); } }
                    u32x4 w; w.x = cvt_pk_bf16(v0[0], v0[1]); w.y = cvt_pk_bf16(v0[2], v0[3]); w.z = cvt_pk_bf16(v1[0], v1[1]); w.w = cvt_pk_bf16(v1[2], v1[3]);
                    *(u32x4*)(base + (size_t)(row0 + ai * 128 + m * 16) * ld + co + 8 * fq) = w; }
        }
    }
};

template <bool SECOND> struct EpiMerge {
    bf16_t* MG; const bf16_t* SG;
    __device__ __forceinline__ void operator()(AccRef acc, const pg8::Unit& u, int wr, int wc, int fr, int fq) const {
        const int row0 = u.pm * 256 + wr * 64 + fr, col0 = u.pn * 256 + wc * 32 + 8 * fq;
#pragma unroll
        for (int ai = 0; ai < 2; ++ai)
#pragma unroll
            for (int m = 0; m < 4; ++m) { const size_t ro = (size_t)(row0 + ai * 128 + m * 16) * 1024 + col0;
#pragma unroll
                for (int bj = 0; bj < 2; ++bj) { const f32x4 v0 = acc[ai][bj][m][0], v1 = acc[ai][bj][m][1];
                    const u32x4 g = *(const u32x4*)(SG + ro + bj * 128);
                    float r0 = bf_lo(g.x) * v0[0], r1 = bf_hi(g.x) * v0[1], r2 = bf_lo(g.y) * v0[2], r3 = bf_hi(g.y) * v0[3];
                    float r4 = bf_lo(g.z) * v1[0], r5 = bf_hi(g.z) * v1[1], r6 = bf_lo(g.w) * v1[2], r7 = bf_hi(g.w) * v1[3];
                    if (SECOND) { const u32x4 p = *(const u32x4*)(MG + ro + bj * 128);
                        r0 += bf_lo(p.x); r1 += bf_hi(p.x); r2 += bf_lo(p.y); r3 += bf_hi(p.y); r4 += bf_lo(p.z); r5 += bf_hi(p.z); r6 += bf_lo(p.w); r7 += bf_hi(p.w); }
                    u32x4 w; w.x = cvt_pk_bf16(r0, r1); w.y = cvt_pk_bf16(r2, r3); w.z = cvt_pk_bf16(r4, r5); w.w = cvt_pk_bf16(r6, r7);
                    *(u32x4*)(MG + ro + bj * 128) = w; } }
    }
};

struct EpiWout {
    const float* X; float* OUT; const float* MOD;
    __device__ __forceinline__ void operator()(AccRef acc, const pg8::Unit& u, int wr, int wc, int fr, int fq) const {
        const int row0 = u.pm * 256 + wr * 64 + fr, col0 = u.pn * 256 + wc * 32 + 8 * fq;
        const float* ga = MOD + (size_t)(u.pm >> 3) * 6144 + 2048 + col0;
        f32x4 g[2][2];
#pragma unroll
        for (int bj = 0; bj < 2; ++bj)
#pragma unroll
            for (int n = 0; n < 2; ++n) g[bj][n] = *(const f32x4*)(ga + bj * 128 + 4 * n);
#pragma unroll
        for (int ai = 0; ai < 2; ++ai)
#pragma unroll
            for (int m = 0; m < 4; ++m) { const size_t ro = (size_t)(row0 + ai * 128 + m * 16) * 1024 + col0;
#pragma unroll
                for (int bj = 0; bj < 2; ++bj)
#pragma unroll
                    for (int n = 0; n < 2; ++n) { const f32x4 xv = *(const f32x4*)(X + ro + bj * 128 + 4 * n);
                        *(f32x4*)(OUT + ro + bj * 128 + 4 * n) = xv + g[bj][n] * acc[ai][bj][m][n]; } }
    }
};

struct EpiGateUp {
    unsigned char* HID; const float* BGU;
    __device__ __forceinline__ void operator()(AccRef acc, const pg8::Unit& u, int wr, int wc, int fr, int fq) const {
        const int row0 = u.pm * 256 + wr * 64 + fr, hc = u.pn * 128 + wc * 32 + 8 * fq;
        const float* bg = BGU + (size_t)u.e * 2048 + hc;
        f32x4 bgate[2], bup[2];
#pragma unroll
        for (int n = 0; n < 2; ++n) { bgate[n] = *(const f32x4*)(bg + 4 * n); bup[n] = *(const f32x4*)(bg + 1024 + 4 * n); }
#pragma unroll
        for (int ai = 0; ai < 2; ++ai)
#pragma unroll
            for (int m = 0; m < 4; ++m) { float r[8];
#pragma unroll
                for (int n = 0; n < 2; ++n) { const f32x4 gv = acc[ai][0][m][n] * WDESCALE + bgate[n], uv = acc[ai][1][m][n] * WDESCALE + bup[n];
#pragma unroll
                    for (int j = 0; j < 4; ++j) { const float g = __builtin_fminf(gv[j], 7.f); const float up = __builtin_fminf(__builtin_fmaxf(uv[j], -7.f), 7.f);
                        r[4 * n + j] = (up + 1.f) * (g * fast_sigmoid(1.702f * g)); } }
                u32x2 w; w.x = pk4_fp8(r[0], r[1], r[2], r[3]); w.y = pk4_fp8(r[4], r[5], r[6], r[7]);
                *(u32x2*)(HID + (size_t)(row0 + ai * 128 + m * 16) * 1024 + hc) = w; asm volatile("" ::: "memory"); }
    }
};

struct EpiDown {
    float* OUT; bf16_t* Y; const float* BDN; const float* MOD; const int* TOKL; const float* WL; int mode;
    __device__ __forceinline__ void operator()(AccRef acc, const pg8::Unit& u, int wr, int wc, int fr, int fq) const {
        const int col0 = u.pn * 256 + wc * 32 + 8 * fq;
        const float* bd = BDN + (size_t)u.e * 1024 + col0;
        f32x4 b4[2][2];
#pragma unroll
        for (int bj = 0; bj < 2; ++bj)
#pragma unroll
            for (int n = 0; n < 2; ++n) b4[bj][n] = *(const f32x4*)(bd + bj * 128 + 4 * n);
        const int* tl = TOKL + (size_t)u.e * LISTCAP; const float* wl = WL + (size_t)u.e * LISTCAP;
#pragma unroll
        for (int ai = 0; ai < 2; ++ai)
#pragma unroll
            for (int m = 0; m < 4; ++m) { const int slot = u.j0 + ai * 128 + wr * 64 + m * 16 + fr;
                if (slot < u.ne) { const int tok = tl[slot]; const float wgt = wl[slot];
                    const float* ga = MOD + (size_t)(tok >> 11) * 6144 + 5120 + col0; float* op = OUT + (size_t)tok * 1024 + col0; bf16_t* yp = Y + (size_t)tok * 1024 + col0;
#pragma unroll
                    for (int bj = 0; bj < 2; ++bj) {
                        f32x4 v0 = *(const f32x4*)(ga + bj * 128) * ((acc[ai][bj][m][0] * WDESCALE + b4[bj][0]) * wgt), v1 = *(const f32x4*)(ga + bj * 128 + 4) * ((acc[ai][bj][m][1] * WDESCALE + b4[bj][1]) * wgt);
                        if (mode != 0) { const u32x4 p = *(const u32x4*)(yp + bj * 128);
                            v0[0] += bf_lo(p.x); v0[1] += bf_hi(p.x); v0[2] += bf_lo(p.y); v0[3] += bf_hi(p.y); v1[0] += bf_lo(p.z); v1[1] += bf_hi(p.z); v1[2] += bf_lo(p.w); v1[3] += bf_hi(p.w); }
                        if (mode == 2) { *(f32x4*)(op + bj * 128) = *(const f32x4*)(op + bj * 128) + v0; *(f32x4*)(op + bj * 128 + 4) = *(const f32x4*)(op + bj * 128 + 4) + v1; }
                        else { u32x4 w; w.x = cvt_pk_bf16(v0[0], v0[1]); w.y = cvt_pk_bf16(v0[2], v0[3]); w.z = cvt_pk_bf16(v1[0], v1[1]); w.w = cvt_pk_bf16(v1[2], v1[3]); *(u32x4*)(yp + bj * 128) = w; } } }
                asm volatile("" ::: "memory"); }
    }
};

struct MoeTabs { const LAS int* rbase; const LAS int* tbase; const LAS int* nearr; const LAS int* tilee; };
struct MoeOrderGU {
    const char* A; const char* Bt; const int* lists; int G, c; MoeTabs tb;
    __device__ __forceinline__ bool next(int i, pg8::Unit& u) const {
        const int L = i * G + c, TT = L >> 3; const int total = __builtin_amdgcn_readfirstlane(tb.rbase[4]);
        if (TT >= total) return false;
        int k = 0;
#pragma unroll
        for (int q = 1; q < 4; ++q) k += (TT >= __builtin_amdgcn_readfirstlane(tb.rbase[q])) ? 1 : 0;
        const int T = TT - __builtin_amdgcn_readfirstlane(tb.rbase[k]);
        const int e = __builtin_amdgcn_readfirstlane(tb.tilee[k * MAXTILES + T]);
        u.pm = TT; u.pn = L & 7; u.e = e; u.kk = k; u.j0 = (T - __builtin_amdgcn_readfirstlane(tb.tbase[k * 33 + e])) * 256; u.ne = __builtin_amdgcn_readfirstlane(tb.nearr[k * 32 + e]); return true;
    }
    __device__ __forceinline__ const char* a_base(const pg8::Unit&) const { return A; }
    __device__ __forceinline__ const char* b_base(const pg8::Unit& u) const { return Bt + (size_t)u.e * (size_t)(2048 * 1024) + (size_t)u.pn * (size_t)(256 * 1024); }
    __device__ __forceinline__ unsigned row_of(const pg8::Unit& u, int r) const { const int slot = u.j0 + r; return slot < u.ne ? (unsigned)lists[(size_t)(u.kk * 32 + u.e) * LISTCAP + slot] : 0u; }
};
struct MoeOrderDN {
    const char* A; const char* Bt; int G, c, k; MoeTabs tb;
    __device__ __forceinline__ bool next(int i, pg8::Unit& u) const {
        const int L = i * G + c, T = L >> 2; const int r0 = __builtin_amdgcn_readfirstlane(tb.rbase[k]), r1 = __builtin_amdgcn_readfirstlane(tb.rbase[k + 1]);
        if (T >= r1 - r0) return false;
        const int e = __builtin_amdgcn_readfirstlane(tb.tilee[k * MAXTILES + T]);
        u.pm = r0 + T; u.pn = L & 3; u.e = e; u.kk = k; u.j0 = (T - __builtin_amdgcn_readfirstlane(tb.tbase[k * 33 + e])) * 256; u.ne = __builtin_amdgcn_readfirstlane(tb.nearr[k * 32 + e]); return true;
    }
    __device__ __forceinline__ const char* a_base(const pg8::Unit& u) const { return A + (size_t)u.pm * (size_t)(256 * 1024); }
    __device__ __forceinline__ const char* b_base(const pg8::Unit& u) const { return Bt + (size_t)u.e * (size_t)(1024 * 1024) + (size_t)u.pn * (size_t)(256 * 1024); }
    __device__ __forceinline__ unsigned row_of(const pg8::Unit&, int) const { return 0u; }
};

constexpr int ATT_KBYTES = 12 * 1024;
constexpr int ATT_VPITCH = 136;
constexpr int ATT_VBYTES = 64 * ATT_VPITCH;
constexpr int ATT_BUF = ATT_KBYTES + ATT_VBYTES;
constexpr int ATT_WS = 2 * ATT_BUF;
static_assert(ATT_WS + 8 * 256 + 64 <= RING_BYTES, "attention LDS");

__device__ __forceinline__ void mla_unit(LAS unsigned char* lds, const bf16_t* Q, const bf16_t* Kb, const bf16_t* KV, bf16_t* O, int b, int h, int qb) {
    const int tid = threadIdx.x, lane = tid & 63, r = lane & 31, hh = lane >> 5; const int wid = __builtin_amdgcn_readfirstlane(tid >> 6);
    const size_t rowbase = (size_t)b * SEQ; const int q0 = qb * 256, qw = q0 + 32 * wid;
    const int cq = qw >> 6, NT = (q0 >> 6) + 4;
    LAS float* wsf = (LAS float*)(lds + ATT_WS) + wid * 64;
    bf16x8 qf[6];
    { const bf16_t* qp = Q + (rowbase + qw + r) * 768 + h * 96 + hh * 8;
#pragma unroll
      for (int s = 0; s < 6; ++s) qf[s] = *(const bf16x8*)(qp + 16 * s); }
    const int lkv = tid & 63, lc = tid >> 6;
    const bf16_t* kg0 = Kb + (rowbase + lkv) * 768 + h * 96 + lc * 8;
    const bf16_t* vg = KV + (rowbase + lkv) * 1024 + h * 128 + 64 + lc * 8;
    u32x4 ka0, ka1 = (u32x4){0u, 0u, 0u, 0u}, va;
#define ATT_LOAD(t, K0, K1, V) do { K0 = *(const u32x4*)(kg0 + (size_t)(t) * 64 * 768); if (tid < 256) K1 = *(const u32x4*)(kg0 + (size_t)(t) * 64 * 768 + 64); V = *(const u32x4*)(vg + (size_t)(t) * 64 * 1024); } while (0)
#define ATT_STORE(bufi, K0, K1, V) do { LAS unsigned char* kb_ = lds + (bufi) * ATT_BUF; *(LAS u32x4*)(kb_ + tid * 16) = K0; if (tid < 256) *(LAS u32x4*)(kb_ + 8192 + tid * 16) = K1; \
        LAS unsigned char* vb_ = kb_ + ATT_KBYTES + (lc * 8) * ATT_VPITCH + lkv * 2; \
        _Pragma("unroll") for (int j_ = 0; j_ < 8; ++j_) *(LAS unsigned short*)(vb_ + j_ * ATT_VPITCH) = (unsigned short)(V[j_ >> 1] >> (16 * (j_ & 1))); } while (0)
    ATT_LOAD(0, ka0, ka1, va); ATT_STORE(0, ka0, ka1, va); __syncthreads();
    float mref = 0.f, l_run = 0.f;
    f32x16 o0, o1, negm;
#pragma unroll
    for (int i = 0; i < 16; ++i) { o0[i] = 0.f; o1[i] = 0.f; negm[i] = 0.f; }
#define MLA_ITER(t_, BUFI, K0, K1, V) do { const int t = (t_); \
        if (t + 1 < NT) ATT_LOAD(t + 1, K0, K1, V); \
        if (t <= cq) { \
            const LAS unsigned char* kb = lds + (BUFI) * ATT_BUF; const LAS unsigned char* vb = kb + ATT_KBYTES; \
            f32x16 p0, p1; \
        _Pragma("unroll") \
            for (int s = 0; s < 6; ++s) { const bf16x8 a0 = *(const LAS bf16x8*)(kb + (2 * s + hh) * 1024 + r * 16), a1 = *(const LAS bf16x8*)(kb + (2 * s + hh) * 1024 + (r + 32) * 16); \
                if (s == 0) { p0 = MFMA32(a0, qf[0], negm); p1 = MFMA32(a1, qf[0], negm); } else { p0 = MFMA32(a0, qf[s], p0); p1 = MFMA32(a1, qf[s], p1); } } \
            float d = p0[0]; \
        _Pragma("unroll") \
            for (int i = 0; i < 16; ++i) { d = __builtin_fmaxf(d, p0[i]); d = __builtin_fmaxf(d, p1[i]); } \
            d = __builtin_fmaxf(d, __shfl_xor(d, 32)); \
            if (t == 0) { mref = d; \
        _Pragma("unroll") \
                for (int i = 0; i < 16; ++i) { p0[i] -= d; p1[i] -= d; negm[i] = -d; } \
            } else if (__any(d > 8.f)) { \
                const float delta = __builtin_fmaxf(d, 0.f), alpha = __builtin_amdgcn_exp2f(-delta); mref += delta; l_run *= alpha; \
        _Pragma("unroll") \
                for (int i = 0; i < 16; ++i) { p0[i] -= delta; p1[i] -= delta; negm[i] = -mref; } \
                if (hh == 0) wsf[r] = alpha; \
                LDS_WAIT(); \
        _Pragma("unroll") \
                for (int g = 0; g < 4; ++g) { const f32x4 al = *(const LAS f32x4*)(wsf + 8 * g + 4 * hh); \
        _Pragma("unroll") \
                    for (int e = 0; e < 4; ++e) { o0[4 * g + e] *= al[e]; o1[4 * g + e] *= al[e]; } } \
                LDS_WAIT(); \
            } \
            float rs = 0.f; \
        _Pragma("unroll") \
            for (int i = 0; i < 16; ++i) { p0[i] = __builtin_amdgcn_exp2f(p0[i]); p1[i] = __builtin_amdgcn_exp2f(p1[i]); rs += p0[i] + p1[i]; } \
            l_run += rs; \
        _Pragma("unroll") \
            for (int half = 0; half < 2; ++half) \
        _Pragma("unroll") \
                for (int s2 = 0; s2 < 2; ++s2) { \
                    const f32x16& P = half ? p1 : p0; \
                    const bf16x8 pa = pack8(P[8 * s2], P[8 * s2 + 1], P[8 * s2 + 2], P[8 * s2 + 3], P[8 * s2 + 4], P[8 * s2 + 5], P[8 * s2 + 6], P[8 * s2 + 7]); \
                    const int kvo = (32 * half + 16 * s2 + 4 * hh) * 2; \
                    { const s16x4 lo = *(const LAS s16x4*)(vb + r * ATT_VPITCH + kvo), hi = *(const LAS s16x4*)(vb + r * ATT_VPITCH + kvo + 16); \
                      const bf16x8 vf = __builtin_shufflevector(lo, hi, 0, 1, 2, 3, 4, 5, 6, 7); o0 = MFMA32(pa, vf, o0); } \
                    { const s16x4 lo = *(const LAS s16x4*)(vb + (r + 32) * ATT_VPITCH + kvo), hi = *(const LAS s16x4*)(vb + (r + 32) * ATT_VPITCH + kvo + 16); \
                      const bf16x8 vf = __builtin_shufflevector(lo, hi, 0, 1, 2, 3, 4, 5, 6, 7); o1 = MFMA32(pa, vf, o1); } \
                } \
        } \
        if (t + 1 < NT) ATT_STORE((BUFI) ^ 1, K0, K1, V); \
        __syncthreads(); } while (0)
    for (int t2 = 0; t2 < NT; t2 += 2) {
        MLA_ITER(t2, 0, ka0, ka1, va);
        MLA_ITER(t2 + 1, 1, ka0, ka1, va);
    }
#undef MLA_ITER
    const float l_tot = l_run + __shfl_xor(l_run, 32);
    if (hh == 0) wsf[r] = 1.f / l_tot;
    LDS_WAIT();
#pragma unroll
    for (int g = 0; g < 4; ++g) { const f32x4 rl = *(const LAS f32x4*)(wsf + 8 * g + 4 * hh);
#pragma unroll
        for (int e = 0; e < 4; ++e) { const int i = 4 * g + e; bf16_t* op = O + (rowbase + qw + crow(i, hh)) * 512 + h * 64 + r;
            op[0] = (bf16_t)(cvt_pk_bf16(o0[i] * rl[e], 0.f) & 0xffffu); op[32] = (bf16_t)(cvt_pk_bf16(o1[i] * rl[e], 0.f) & 0xffffu); } }
    LDS_WAIT();
#undef ATT_LOAD
#undef ATT_STORE
}

__device__ __forceinline__ void sb_unit(LAS unsigned char* lds, const bf16_t* SBQ, bf16_t* O, int b, int h, int qb) {
    const int tid = threadIdx.x, lane = tid & 63, r = lane & 31, hh = lane >> 5; const int wid = __builtin_amdgcn_readfirstlane(tid >> 6);
    const size_t rowbase = (size_t)b * SEQ; const int q0 = qb * 256, qw = q0 + 32 * wid;
    const int NT = (q0 >> 6) + 4;
    constexpr float C2 = 0.125f * LOG2E;
    bf16x8 qf[4];
    { const bf16_t* qp = SBQ + (rowbase + qw + r) * 1536 + h * 64 + hh * 8;
#pragma unroll
      for (int s = 0; s < 4; ++s) qf[s] = *(const bf16x8*)(qp + 16 * s); }
    const int lkv = tid & 63, lc = tid >> 6;
    const bf16_t* kg0 = SBQ + (rowbase + lkv) * 1536 + 512 + h * 64 + lc * 8;
    const bf16_t* vg = SBQ + (rowbase + lkv) * 1536 + 1024 + h * 64 + lc * 8;
    u32x4 ka0, va, kb0, vb2;
#define ATT_LOAD(t, K0, V) do { K0 = *(const u32x4*)(kg0 + (size_t)(t) * 64 * 1536); V = *(const u32x4*)(vg + (size_t)(t) * 64 * 1536); } while (0)
#define ATT_STORE(bufi, K0, V) do { LAS unsigned char* kb_ = lds + (bufi) * ATT_BUF; *(LAS u32x4*)(kb_ + tid * 16) = K0; \
        LAS unsigned char* vb_ = kb_ + ATT_KBYTES + (lc * 8) * ATT_VPITCH + lkv * 2; \
        _Pragma("unroll") for (int j_ = 0; j_ < 8; ++j_) *(LAS unsigned short*)(vb_ + j_ * ATT_VPITCH) = (unsigned short)(V[j_ >> 1] >> (16 * (j_ & 1))); } while (0)
    LAS unsigned* dflag = (LAS unsigned*)(lds + ATT_WS + 8 * 256);
    ATT_LOAD(NT - 1, ka0, va); ATT_STORE(0, ka0, va); __syncthreads();
    ATT_LOAD(NT - 2, kb0, vb2); ATT_LOAD(NT - 3, ka0, va);
    float carry = 0.f; bool wdone = false;
    f32x16 o0, o1;
#pragma unroll
    for (int i = 0; i < 16; ++i) { o0[i] = 0.f; o1[i] = 0.f; }
#define SB_SUB(X, kvh0, kvl) do { const bool diag_ = ((kvh0) == qw); float lk_[16], z_[16]; \
        _Pragma("unroll") for (int i = 0; i < 16; ++i) { const float z2 = X[i] * C2; const float ex = __builtin_amdgcn_exp2f(z2); float sp = __builtin_amdgcn_logf(1.f + ex); sp = z2 > 64.f ? z2 : sp; \
            const bool valid = !diag_ || (crow(i, hh) < r); lk_[i] = valid ? -sp : 0.f; z_[i] = z2; } \
        float G_[4], Gp_[4]; \
        _Pragma("unroll") for (int g = 0; g < 4; ++g) { G_[g] = (lk_[4 * g] + lk_[4 * g + 1]) + (lk_[4 * g + 2] + lk_[4 * g + 3]); Gp_[g] = __shfl_xor(G_[g], 32); } \
        float tail_[4]; tail_[3] = 0.f; tail_[2] = G_[3] + Gp_[3]; tail_[1] = tail_[2] + (G_[2] + Gp_[2]); tail_[0] = tail_[1] + (G_[1] + Gp_[1]); const float total_ = tail_[0] + (G_[0] + Gp_[0]); \
        float a_[16]; \
        _Pragma("unroll") for (int g = 0; g < 4; ++g) { const float base_ = carry + tail_[g] + (hh == 0 ? Gp_[g] : 0.f); \
            const float s3 = base_ + lk_[4 * g + 3], s2_ = s3 + lk_[4 * g + 2], s1 = s2_ + lk_[4 * g + 1], s0 = s1 + lk_[4 * g]; \
            a_[4 * g + 3] = __builtin_amdgcn_exp2f(z_[4 * g + 3] + s3); a_[4 * g + 2] = __builtin_amdgcn_exp2f(z_[4 * g + 2] + s2_); a_[4 * g + 1] = __builtin_amdgcn_exp2f(z_[4 * g + 1] + s1); a_[4 * g] = __builtin_amdgcn_exp2f(z_[4 * g] + s0); } \
        if (diag_) { _Pragma("unroll") for (int i = 0; i < 16; ++i) a_[i] = (crow(i, hh) < r) ? a_[i] : 0.f; } \
        carry += total_; \
        _Pragma("unroll") for (int s2 = 0; s2 < 2; ++s2) { \
            const bf16x8 pa = pack8(a_[8 * s2], a_[8 * s2 + 1], a_[8 * s2 + 2], a_[8 * s2 + 3], a_[8 * s2 + 4], a_[8 * s2 + 5], a_[8 * s2 + 6], a_[8 * s2 + 7]); \
            const int kvo = ((kvl) + 16 * s2 + 4 * hh) * 2; \
            { const s16x4 lo = *(const LAS s16x4*)(vb + r * ATT_VPITCH + kvo), hi = *(const LAS s16x4*)(vb + r * ATT_VPITCH + kvo + 16); \
              const bf16x8 vf = __builtin_shufflevector(lo, hi, 0, 1, 2, 3, 4, 5, 6, 7); o0 = MFMA32(pa, vf, o0); } \
            { const s16x4 lo = *(const LAS s16x4*)(vb + (r + 32) * ATT_VPITCH + kvo), hi = *(const LAS s16x4*)(vb + (r + 32) * ATT_VPITCH + kvo + 16); \
              const bf16x8 vf = __builtin_shufflevector(lo, hi, 0, 1, 2, 3, 4, 5, 6, 7); o1 = MFMA32(pa, vf, o1); } } } while (0)
    bool alldone = false;
#define SB_ITER(it_, BUFI, K0, V) do { const int it = (it_), t = NT - 1 - it, kv0 = 64 * t; \
        if (kv0 <= qw && !wdone) { \
            const LAS unsigned char* kb = lds + (BUFI) * ATT_BUF; const LAS unsigned char* vb = kb + ATT_KBYTES; \
            const bool upper = (kv0 + 32 <= qw); \
            f32x16 p0, p1; \
        _Pragma("unroll") \
            for (int i = 0; i < 16; ++i) { p0[i] = 0.f; p1[i] = 0.f; } \
        _Pragma("unroll") \
            for (int s = 0; s < 4; ++s) { const bf16x8 a0 = *(const LAS bf16x8*)(kb + (2 * s + hh) * 1024 + r * 16); p0 = MFMA32(a0, qf[s], p0); } \
            if (upper) { \
        _Pragma("unroll") \
                for (int s = 0; s < 4; ++s) { const bf16x8 a1 = *(const LAS bf16x8*)(kb + (2 * s + hh) * 1024 + (r + 32) * 16); p1 = MFMA32(a1, qf[s], p1); } \
                SB_SUB(p1, kv0 + 32, 32); \
            } \
            SB_SUB(p0, kv0, 0); \
            wdone = __all(carry < -170.f) != 0; \
        } \
        if (lane == 0) dflag[(BUFI) * 8 + wid] = wdone ? 1u : 0u; \
        if (t > 0) ATT_STORE((BUFI) ^ 1, K0, V); \
        if (t > 2) ATT_LOAD(t - 3, K0, V); \
        __syncthreads(); \
        { const u32x4 f0 = *(const LAS u32x4*)(dflag + (BUFI) * 8), f1 = *(const LAS u32x4*)(dflag + (BUFI) * 8 + 4); \
          alldone = (f0.x & f0.y & f0.z & f0.w & f1.x & f1.y & f1.z & f1.w) != 0u; } } while (0)
    for (int i2 = 0; i2 < NT; i2 += 2) {
        SB_ITER(i2, 0, kb0, vb2); if (alldone) break;
        SB_ITER(i2 + 1, 1, ka0, va); if (alldone) break;
    }
#undef SB_ITER
    __syncthreads();
#pragma unroll
    for (int i = 0; i < 16; ++i) { bf16_t* op = O + (rowbase + qw + crow(i, hh)) * 512 + h * 64 + r;
        op[0] = (bf16_t)(cvt_pk_bf16(o0[i], 0.f) & 0xffffu); op[32] = (bf16_t)(cvt_pk_bf16(o1[i], 0.f) & 0xffffu); }
#undef SB_SUB
#undef ATT_LOAD
#undef ATT_STORE
}

#ifndef PHMASK
#define PHMASK 0xFFFF
#endif
#define PH(n) ((PHMASK >> (n)) & 1)
#ifndef DUPMASK
#define DUPMASK 0
#endif
#define DUP(n) (1 + ((DUPMASK >> (n)) & 1))
struct Args { const void* in[23]; float* out; unsigned char* ws; };

__global__ void __launch_bounds__(512, 2) fwd_kernel(Args args) {
    extern __shared__ __attribute__((aligned(16))) unsigned char lds_raw[];
    LAS unsigned char* lds = (LAS unsigned char*)lds_raw;
    const int tid = threadIdx.x, lane = tid & 63, wave = __builtin_amdgcn_readfirstlane(tid >> 6);
    const int G = gridDim.x; const int bx = blockIdx.x; const int vcu = (G % 8 == 0) ? (bx % 8) * (G / 8) + bx / 8 : bx;
    const int gw = vcu * 8 + wave, NGW = G * 8;
    unsigned char* ws = args.ws;
    unsigned* ctl = (unsigned*)(ws + WS_CTL);
    const float* x = (const float*)args.in[0]; const float* cvec = (const float*)args.in[1]; const int* positions = (const int*)args.in[2];
    const float* w_ada = (const float*)args.in[3]; const float* b_ada = (const float*)args.in[4]; const float* g_norm1 = (const float*)args.in[5];
    const float* w_in = (const float*)args.in[6]; const float* g_q_lat = (const float*)args.in[7]; const float* w_uq = (const float*)args.in[8];
    const float* g_kv_lat = (const float*)args.in[9]; const float* w_ukv = (const float*)args.in[10]; const float* g_qk_q = (const float*)args.in[11];
    const float* g_qk_k = (const float*)args.in[12]; const float* w_o_mla = (const float*)args.in[13]; const float* w_o_sb = (const float*)args.in[14];
    const float* w_out = (const float*)args.in[15]; const float* g_norm2 = (const float*)args.in[16]; const float* w_router = (const float*)args.in[17];
    const float* b_router = (const float*)args.in[18]; const float* w_gate_up = (const float*)args.in[19]; const float* b_gate_up = (const float*)args.in[20];
    const float* w_down = (const float*)args.in[21]; const float* b_down = (const float*)args.in[22];
    float* out = args.out;
    bf16_t* WIN = (bf16_t*)(ws + WS_WIN); bf16_t* WUQ = (bf16_t*)(ws + WS_WUQ); bf16_t* WUKV = (bf16_t*)(ws + WS_WUKV); bf16_t* WOM = (bf16_t*)(ws + WS_WOM);
    bf16_t* WOS = (bf16_t*)(ws + WS_WOS); bf16_t* WOUT = (bf16_t*)(ws + WS_WOUT); float* MOD = (float*)(ws + WS_MOD);
    unsigned char* WIN8 = ws + WS_WIN8; unsigned char* H8 = ws + WS_H8;
    bf16_t* HB = (bf16_t*)(ws + WS_H); bf16_t* KVRAW = (bf16_t*)(ws + WS_KVRAW); bf16_t* MERGED = (bf16_t*)(ws + WS_MERGED);
    bf16_t* SGA = (bf16_t*)(ws + WS_SGA); bf16_t* SGB = (bf16_t*)(ws + WS_SGB); unsigned char* H2 = ws + WS_H2;
    unsigned char* WGU = ws + WS_WGU; unsigned char* WDN = ws + WS_WDN; bf16_t* SBQ = (bf16_t*)(ws + WS_SB);
    int* TOKL = (int*)(ws + WS_TOKL); float* WLST = (float*)(ws + WS_WL); unsigned char* HID = ws + WS_HID;
    bf16_t* QL = (bf16_t*)(ws + WS_QL); bf16_t* KVL = (bf16_t*)(ws + WS_KVL); bf16_t* KPE = (bf16_t*)(ws + WS_KPE);
    bf16_t* QB = (bf16_t*)(ws + WS_Q); bf16_t* KB = (bf16_t*)(ws + WS_K); bf16_t* OMLA = (bf16_t*)(ws + WS_OMLA); bf16_t* OSB = (bf16_t*)(ws + WS_OSB);

    for (int u = tid; u < (LDS_BYTES - LDSCTL_OFF) / 4; u += 512) ((LAS unsigned*)(lds + LDSCTL_OFF))[u] = 0u;
    __syncthreads();
    XcdBarrier bar = xcd_barrier_post(ctl + CW_BAR, (volatile LAS unsigned*)(lds + LDSCTL_OFF + LC_BARST));
    LAS float* scr = (LAS float*)(lds + wave * 16384);

#if PH(0)
    {
        constexpr int I_IN = 16 * 133, I_UQ = 6 * 24, I_UKV = 4 * 32, I_OM = 8 * 32, I_OS = 8 * 32, I_OUT = 16 * 32;
        constexpr int NIT = I_IN + I_UQ + I_UKV + I_OM + I_OS + I_OUT;
        for (int it = gw; it < NIT; it += NGW) {
            int q = it;
            if (q < I_IN) { const int kb = q / 133, nb = q % 133, n0 = 32 * nb;
                if (nb < 69) transpose_item(w_in, 1024, DIN, WIN, 64 * kb, n0, n0 < 672 ? n0 : n0 + 96, scr, lane);
                else transpose_item_f8(w_in, 1024, DIN, WIN8, 64 * kb, n0, n0 - 2208, WSCALE, scr, lane);
                continue; } q -= I_IN;
            if (q < I_UQ) { const int kb = q / 24, nb = q % 24; transpose_item(w_uq, 384, 768, WUQ, 64 * kb, 32 * nb, 32 * nb, scr, lane); continue; } q -= I_UQ;
            if (q < I_UKV) { const int kb = q / 32, nb = q % 32; transpose_item(w_ukv, 256, 1024, WUKV, 64 * kb, 32 * nb, 32 * nb, scr, lane); continue; } q -= I_UKV;
            if (q < I_OM) { const int kb = q / 32, nb = q % 32; transpose_item(w_o_mla, 512, 1024, WOM, 64 * kb, 32 * nb, 32 * nb, scr, lane); continue; } q -= I_OM;
            if (q < I_OS) { const int kb = q / 32, nb = q % 32; transpose_item(w_o_sb, 512, 1024, WOS, 64 * kb, 32 * nb, 32 * nb, scr, lane); continue; } q -= I_OS;
            { const int kb = q / 32, nb = q % 32; transpose_item(w_out, 1024, 1024, WOUT, 64 * kb, 32 * nb, 32 * nb, scr, lane); }
        }
        for (int i = vcu * 512 + tid; i < 96 * 1024 * 2 / 16; i += G * 512) ((u32x4*)(WIN + 672 * 1024))[i] = (u32x4){0u, 0u, 0u, 0u};
        __syncthreads();
        for (int it = vcu; it < 6144 / 64; it += G) {
            for (int idx = lane; idx < 32 * 128; idx += 64) { const int b = idx >> 7, kk = idx & 127; const float cv = cvec[b * 1024 + 128 * wave + kk]; scr[idx] = cv / (1.f + __expf(-cv)); }
            LDS_WAIT(); asm volatile("" ::: "memory");
            float acc[32];
#pragma unroll
            for (int b = 0; b < 32; ++b) acc[b] = 0.f;
            const float* wp = w_ada + (size_t)(128 * wave) * 6144 + 64 * it + lane;
            float wc[8];
#pragma unroll
            for (int j = 0; j < 8; ++j) wc[j] = wp[(size_t)j * 6144];
#pragma nounroll
            for (int k8 = 0; k8 < 16; ++k8) {
                float wn[8];
                const int kn = k8 < 15 ? k8 + 1 : k8;
#pragma unroll
                for (int j = 0; j < 8; ++j) wn[j] = wp[(size_t)(8 * kn + j) * 6144];
#pragma unroll
                for (int j4 = 0; j4 < 2; ++j4) {
#pragma unroll
                    for (int b = 0; b < 32; ++b) { const f32x4 s = *(const LAS f32x4*)(scr + b * 128 + 8 * k8 + 4 * j4); acc[b] += s.x * wc[4 * j4] + s.y * wc[4 * j4 + 1] + s.z * wc[4 * j4 + 2] + s.w * wc[4 * j4 + 3];
                        if ((b & 7) == 7) asm volatile("" ::: "memory"); } }
#pragma unroll
                for (int j = 0; j < 8; ++j) wc[j] = wn[j];
            }
            LDS_WAIT(); asm volatile("" ::: "memory");
#pragma unroll
            for (int b = 0; b < 32; ++b) scr[b * 64 + lane] = acc[b];
            __syncthreads();
#pragma unroll
            for (int bb = 0; bb < 4; ++bb) { const int b = 4 * wave + bb; float s = 0.f;
#pragma unroll
                for (int w2 = 0; w2 < 8; ++w2) s += ((const LAS float*)(lds + w2 * 16384))[b * 64 + lane];
                MOD[b * 6144 + 64 * it + lane] = s + b_ada[64 * it + lane]; }
            __syncthreads();
        }
    }
#endif
    xcd_barrier(bar);

#if PH(1)
    for (int gi = gw; gi < NTOK / 4; gi += NGW) {
        f32x4 v[4][4];
#pragma unroll
        for (int rr = 0; rr < 4; ++rr) { const f32x4* xr = (const f32x4*)(x + (size_t)(4 * gi + rr) * 1024) + lane;
#pragma unroll
            for (int j = 0; j < 4; ++j) v[rr][j] = xr[64 * j]; }
        const int b = (4 * gi) >> 11;
        const float* mb = MOD + (size_t)b * 6144;
        f32x4 gsc[4], shv[4];
#pragma unroll
        for (int j = 0; j < 4; ++j) { const int col = 4 * lane + 256 * j; gsc[j] = *(const f32x4*)(g_norm1 + col) * (*(const f32x4*)(mb + 1024 + col) + 1.f); shv[j] = *(const f32x4*)(mb + col); }
#pragma unroll
        for (int rr = 0; rr < 4; ++rr) { float ss = 0.f;
#pragma unroll
            for (int j = 0; j < 4; ++j) ss += (v[rr][j].x * v[rr][j].x + v[rr][j].y * v[rr][j].y) + (v[rr][j].z * v[rr][j].z + v[rr][j].w * v[rr][j].w);
            const float rstd = rsqrtf(wave_sum(ss) * (1.f / 1024.f) + EPS);
#pragma unroll
            for (int j = 0; j < 4; ++j) { const int col = 4 * lane + 256 * j; const f32x4 y = (v[rr][j] * rstd) * gsc[j] + shv[j];
                u32x2 o; o.x = cvt_pk_bf16(y.x, y.y); o.y = cvt_pk_bf16(y.z, y.w);
                *(u32x2*)(HB + (size_t)(4 * gi + rr) * 1024 + col) = o;
                *(unsigned*)(H8 + (size_t)(4 * gi + rr) * 1024 + col) = pk4_fp8(y.x, y.y, y.z, y.w); } }
    }
#endif
    xcd_barrier(bar);

#if PH(2)
    { pg8::DenseOrder S; S.init(HB, WIN, NTOK, 2304, 1024, G, bx);
      EpiProj E{QL, KVL, KPE, SBQ, SGA, SGB, 0, 1.f};
      pg8::gemm_phase<false>(lds, 1024, S, E); }
    { pg8::DenseOrder S; S.init(H8, WIN8, NTOK, 2048, 512, G, bx);
      EpiProj E{QL, KVL, KPE, SBQ, SGA, SGB, 2304, WDESCALE};
      pg8::gemm_phase_f8<false>(lds, 512, S, E); }
#endif
    xcd_barrier(bar);

#if PH(3)
    {
        f32x4 gq0 = (f32x4){0.f, 0.f, 0.f, 0.f}, gq1 = gq0, gk0 = gq0, gk1 = gq0;
        if (lane < 48) { gq0 = *(const f32x4*)(g_q_lat + lane * 8); gq1 = *(const f32x4*)(g_q_lat + lane * 8 + 4); }
        if (lane < 32) { gk0 = *(const f32x4*)(g_kv_lat + lane * 8); gk1 = *(const f32x4*)(g_kv_lat + lane * 8 + 4); }
        for (int gi = gw; gi < NTOK / 4; gi += NGW) {
            u32x4 vq[4], vk[4];
#pragma unroll
            for (int rr = 0; rr < 4; ++rr) { vq[rr] = (u32x4){0u, 0u, 0u, 0u}; vk[rr] = vq[rr];
                if (lane < 48) vq[rr] = *(const u32x4*)(QL + (size_t)(4 * gi + rr) * 384 + lane * 8);
                if (lane < 32) vk[rr] = *(const u32x4*)(KVL + (size_t)(4 * gi + rr) * 256 + lane * 8); }
#pragma unroll
            for (int rr = 0; rr < 4; ++rr) {
                { const u32x4 v = vq[rr]; float f[8] = {bf_lo(v.x), bf_hi(v.x), bf_lo(v.y), bf_hi(v.y), bf_lo(v.z), bf_hi(v.z), bf_lo(v.w), bf_hi(v.w)}; float ss = 0.f;
#pragma unroll
                  for (int j = 0; j < 8; ++j) ss += f[j] * f[j];
                  const float rstd = rsqrtf(wave_sum(ss) * (1.f / 384.f) + EPS);
                  if (lane < 48) { u32x4 o; o.x = cvt_pk_bf16(f[0] * rstd * gq0.x, f[1] * rstd * gq0.y); o.y = cvt_pk_bf16(f[2] * rstd * gq0.z, f[3] * rstd * gq0.w);
                      o.z = cvt_pk_bf16(f[4] * rstd * gq1.x, f[5] * rstd * gq1.y); o.w = cvt_pk_bf16(f[6] * rstd * gq1.z, f[7] * rstd * gq1.w); *(u32x4*)(QL + (size_t)(4 * gi + rr) * 384 + lane * 8) = o; } }
                { const u32x4 v = vk[rr]; float f[8] = {bf_lo(v.x), bf_hi(v.x), bf_lo(v.y), bf_hi(v.y), bf_lo(v.z), bf_hi(v.z), bf_lo(v.w), bf_hi(v.w)}; float ss = 0.f;
#pragma unroll
                  for (int j = 0; j < 8; ++j) ss += f[j] * f[j];
                  const float rstd = rsqrtf(wave_sum(ss) * (1.f / 256.f) + EPS);
                  if (lane < 32) { u32x4 o; o.x = cvt_pk_bf16(f[0] * rstd * gk0.x, f[1] * rstd * gk0.y); o.y = cvt_pk_bf16(f[2] * rstd * gk0.z, f[3] * rstd * gk0.w);
                      o.z = cvt_pk_bf16(f[4] * rstd * gk1.x, f[5] * rstd * gk1.y); o.w = cvt_pk_bf16(f[6] * rstd * gk1.z, f[7] * rstd * gk1.w); *(u32x4*)(KVL + (size_t)(4 * gi + rr) * 256 + lane * 8) = o; } }
            }
        }
    }
#endif
    xcd_barrier(bar);

#if PH(4)
    for (int rep = 0; rep < DUP(5); ++rep) {
    { pg8::DenseOrder S; S.init(QL, WUQ, NTOK, 768, 384, G, bx); EpiStore E{QB, 768}; pg8::gemm_phase<false>(lds, 384, S, E); }
    { pg8::DenseOrder S; S.init(KVL, WUKV, NTOK, 1024, 256, G, bx); EpiStore E{KVRAW, 1024}; pg8::gemm_phase<false>(lds, 256, S, E); } }
#endif
    xcd_barrier(bar);

#if PH(5)
    {
        const int hd = lane >> 3, sub = lane & 7;
        const float QSC = 0.10206207261596575f * LOG2E;
        const float if0 = exp2f(-(float)(2 * sub) * (13.287712379549449f / 16.f)), if1 = exp2f(-(float)(2 * sub + 1) * (13.287712379549449f / 16.f));
        f32x4 gq0 = *(const f32x4*)(g_qk_q + sub * 8), gq1 = *(const f32x4*)(g_qk_q + sub * 8 + 4); const f32x2 gqa = *(const f32x2*)(g_qk_q + 64 + 2 * sub), gqb = *(const f32x2*)(g_qk_q + 80 + 2 * sub);
        f32x4 gk0 = *(const f32x4*)(g_qk_k + sub * 8), gk1 = *(const f32x4*)(g_qk_k + sub * 8 + 4); const f32x2 gka = *(const f32x2*)(g_qk_k + 64 + 2 * sub), gkb = *(const f32x2*)(g_qk_k + 80 + 2 * sub);
        for (int gi = gw; gi < NTOK / 4; gi += NGW) {
            u32x4 A[4][2]; unsigned B1[4][2], B2[4][2]; float posf[4];
#pragma unroll
            for (int t = 0; t < 4; ++t) { const int m = 4 * gi + t; posf[t] = (float)positions[m];
                const bf16_t* qp = QB + (size_t)m * 768 + hd * 96; A[t][0] = *(const u32x4*)(qp + sub * 8); B1[t][0] = *(const unsigned*)(qp + 64 + 2 * sub); B2[t][0] = *(const unsigned*)(qp + 80 + 2 * sub);
                A[t][1] = *(const u32x4*)(KVRAW + (size_t)m * 1024 + hd * 128 + sub * 8); B1[t][1] = *(const unsigned*)(KPE + (size_t)m * 32 + 2 * sub); B2[t][1] = *(const unsigned*)(KPE + (size_t)m * 32 + 16 + 2 * sub); }
#pragma unroll
            for (int t = 0; t < 4; ++t) { const int m = 4 * gi + t;
                float cs[2], sn[2];
                { const float a0 = posf[t] * if0, a1 = posf[t] * if1;
                  double r0 = (double)a0 * 0.15915494309189535, r1 = (double)a1 * 0.15915494309189535; r0 -= __builtin_rint(r0); r1 -= __builtin_rint(r1);
                  cs[0] = __builtin_amdgcn_cosf((float)r0); sn[0] = __builtin_amdgcn_sinf((float)r0); cs[1] = __builtin_amdgcn_cosf((float)r1); sn[1] = __builtin_amdgcn_sinf((float)r1); }
#pragma unroll
                for (int which = 0; which < 2; ++which) {
                    const u32x4 Av = A[t][which]; const unsigned b1 = B1[t][which], b2 = B2[t][which];
                    bf16_t* dst = which ? KB + (size_t)m * 768 + hd * 96 : QB + (size_t)m * 768 + hd * 96;
                    float f[8] = {bf_lo(Av.x), bf_hi(Av.x), bf_lo(Av.y), bf_hi(Av.y), bf_lo(Av.z), bf_hi(Av.z), bf_lo(Av.w), bf_hi(Av.w)};
                    float x1[2] = {bf_lo(b1), bf_hi(b1)}, x2[2] = {bf_lo(b2), bf_hi(b2)};
                    float ss = x1[0] * x1[0] + x1[1] * x1[1] + x2[0] * x2[0] + x2[1] * x2[1];
#pragma unroll
                    for (int j = 0; j < 8; ++j) ss += f[j] * f[j];
                    ss += __shfl_xor(ss, 1); ss += __shfl_xor(ss, 2); ss += __shfl_xor(ss, 4);
                    const float rstd = rsqrtf(ss * (1.f / 96.f) + EPS);
                    const f32x4 g0 = which ? gk0 : gq0, g1 = which ? gk1 : gq1; const f32x2 ga = which ? gka : gqa, gb = which ? gkb : gqb;
                    const float sc = which ? 1.f : QSC;
                    float y[8] = {f[0] * rstd * g0.x, f[1] * rstd * g0.y, f[2] * rstd * g0.z, f[3] * rstd * g0.w, f[4] * rstd * g1.x, f[5] * rstd * g1.y, f[6] * rstd * g1.z, f[7] * rstd * g1.w};
                    const float y1a = x1[0] * rstd * ga.x, y1b = x1[1] * rstd * ga.y, y2a = x2[0] * rstd * gb.x, y2b = x2[1] * rstd * gb.y;
                    const float o1a = y1a * cs[0] - y2a * sn[0], o1b = y1b * cs[1] - y2b * sn[1], o2a = y2a * cs[0] + y1a * sn[0], o2b = y2b * cs[1] + y1b * sn[1];
                    u32x4 o; o.x = cvt_pk_bf16(y[0] * sc, y[1] * sc); o.y = cvt_pk_bf16(y[2] * sc, y[3] * sc); o.z = cvt_pk_bf16(y[4] * sc, y[5] * sc); o.w = cvt_pk_bf16(y[6] * sc, y[7] * sc);
                    *(u32x4*)(dst + sub * 8) = o; *(unsigned*)(dst + 64 + 2 * sub) = cvt_pk_bf16(o1a * sc, o1b * sc); *(unsigned*)(dst + 80 + 2 * sub) = cvt_pk_bf16(o2a * sc, o2b * sc);
                }
            }
        }
    }
#endif
    xcd_barrier(bar);

#if PH(6)
    for (int bh = vcu; bh < NB * NH; bh += G) {
        for (int rep = 0; rep < DUP(0); ++rep) for (int qb = 0; qb < 8; ++qb) mla_unit(lds, QB, KB, KVRAW, OMLA, bh >> 3, bh & 7, qb);
        for (int rep = 0; rep < DUP(1); ++rep) for (int qb = 0; qb < 8; ++qb) sb_unit(lds, SBQ, OSB, bh >> 3, bh & 7, qb);
    }
#endif
    xcd_barrier(bar);

#if PH(8)
    for (int rep = 0; rep < DUP(6); ++rep) {
    { pg8::DenseOrder S; S.init(OMLA, WOM, NTOK, 1024, 512, G, bx); EpiMerge<false> E{MERGED, SGA}; pg8::gemm_phase<false>(lds, 512, S, E); }
    { pg8::DenseOrder S; S.init(OSB, WOS, NTOK, 1024, 512, G, bx); EpiMerge<true> E{MERGED, SGB}; pg8::gemm_phase<false>(lds, 512, S, E); } }
#endif
    xcd_barrier(bar);

#if PH(9)
    { pg8::DenseOrder S; S.init(MERGED, WOUT, NTOK, 1024, 1024, G, bx); EpiWout E{x, out, MOD}; for (int rep = 0; rep < DUP(7); ++rep) pg8::gemm_phase<false>(lds, 1024, S, E); }
#endif
    xcd_barrier(bar);

#if PH(10)
    {
        constexpr int I_GU = 16 * 64, I_DN = 16 * 32;
        for (int rep = 0; rep < DUP(2); ++rep) for (int it = gw; it < NE * (I_GU + I_DN); it += NGW) {
            if (it < NE * I_GU) { const int e = it / I_GU, q = it % I_GU, kb = q / 64, nb = q % 64, n0 = 32 * nb; const int g = n0 >> 10, jj = n0 & 1023;
                transpose_item_f8(w_gate_up + (size_t)e * 1024 * 2048, 1024, 2048, WGU + (size_t)e * 2048 * 1024, 64 * kb, n0, 256 * (jj >> 7) + 128 * g + (jj & 127), WSCALE, scr, lane); }
            else { const int r2 = it - NE * I_GU, e = r2 / I_DN, q = r2 % I_DN, kb = q / 32, nb = q % 32;
                transpose_item_f8(w_down + (size_t)e * 1024 * 1024, 1024, 1024, WDN + (size_t)e * 1024 * 1024, 64 * kb, 32 * nb, 32 * nb, WSCALE, scr, lane); }
        }
        __syncthreads();
        {
            const int r = lane & 31, hh = lane >> 5;
            constexpr int TP = 1026;
            LAS float* tile = (LAS float*)lds;
            float areg[64];
#pragma unroll
            for (int mm = 0; mm < 64; ++mm) areg[mm] = w_router[(size_t)(128 * wave + 4 * (mm >> 1) + 2 * hh + (mm & 1)) * 32 + r];
            const float br = b_router[r];
            for (int tt = vcu; tt < NTOK / 32; tt += G) {
                { f32x4 v[4][4];
#pragma unroll
                  for (int rr = 0; rr < 4; ++rr) { const f32x4* xr = (const f32x4*)(out + (size_t)(32 * tt + 4 * wave + rr) * 1024) + lane;
#pragma unroll
                      for (int j = 0; j < 4; ++j) v[rr][j] = xr[64 * j]; }
                  const float* mb = MOD + (size_t)((32 * tt) >> 11) * 6144;
                  f32x4 gsc[4], shv[4];
#pragma unroll
                  for (int j = 0; j < 4; ++j) { const int col = 4 * lane + 256 * j; gsc[j] = *(const f32x4*)(g_norm2 + col) * (*(const f32x4*)(mb + 4096 + col) + 1.f); shv[j] = *(const f32x4*)(mb + 3072 + col); }
#pragma unroll
                  for (int rr = 0; rr < 4; ++rr) { float ss = 0.f; const int row = 4 * wave + rr;
#pragma unroll
                      for (int j = 0; j < 4; ++j) ss += (v[rr][j].x * v[rr][j].x + v[rr][j].y * v[rr][j].y) + (v[rr][j].z * v[rr][j].z + v[rr][j].w * v[rr][j].w);
                      const float rstd = rsqrtf(wave_sum(ss) * (1.f / 1024.f) + EPS);
#pragma unroll
                      for (int j = 0; j < 4; ++j) { const int col = 4 * lane + 256 * j; const f32x4 y = (v[rr][j] * rstd) * gsc[j] + shv[j];
                          *(unsigned*)(H2 + (size_t)(32 * tt + row) * 1024 + col) = pk4_fp8(y.x, y.y, y.z, y.w);
                          *(LAS f32x2*)(tile + row * TP + col) = (f32x2){y.x, y.y}; *(LAS f32x2*)(tile + row * TP + col + 2) = (f32x2){y.z, y.w}; } } }
                __syncthreads();
                f32x16 acc;
#pragma unroll
                for (int i = 0; i < 16; ++i) acc[i] = 0.f;
#pragma unroll
                for (int sg = 0; sg < 32; ++sg) { const f32x2 hv = *(const LAS f32x2*)(tile + r * TP + 128 * wave + 4 * sg + 2 * hh);
                    acc = __builtin_amdgcn_mfma_f32_32x32x2f32(areg[2 * sg], hv.x, acc, 0, 0, 0); acc = __builtin_amdgcn_mfma_f32_32x32x2f32(areg[2 * sg + 1], hv.y, acc, 0, 0, 0); }
                __syncthreads();
#pragma unroll
                for (int i = 0; i < 16; ++i) tile[wave * 1024 + i * 64 + lane] = acc[i];
                __syncthreads();
                { const int e = r, he = (e >> 2) & 1, ie = (e & 3) + 4 * (e >> 3);
#pragma unroll
                  for (int rr = 0; rr < 4; ++rr) { const int row = 4 * wave + rr; float v = br;
#pragma unroll
                      for (int w2 = 0; w2 < 8; ++w2) v += tile[w2 * 1024 + ie * 64 + row + 32 * he];
                      float tv[4]; int te[4];
#pragma unroll
                      for (int k = 0; k < 4; ++k) { float bv = v; int bi = e;
#pragma unroll
                          for (int off = 16; off >= 1; off >>= 1) { const float ov = __shfl_xor(bv, off); const int oi = __shfl_xor(bi, off); if (ov > bv || (ov == bv && oi < bi)) { bv = ov; bi = oi; } }
                          tv[k] = bv; te[k] = bi; if (e == bi) v = -INFINITY; }
                      const float e1 = __expf(tv[1] - tv[0]), e2 = __expf(tv[2] - tv[0]), e3 = __expf(tv[3] - tv[0]); const float inv = 1.f / (1.f + e1 + e2 + e3);
                      if (lane < 4) { const int k = lane; const int ek = k == 0 ? te[0] : k == 1 ? te[1] : k == 2 ? te[2] : te[3]; const float wk = (k == 0 ? 1.f : k == 1 ? e1 : k == 2 ? e2 : e3) * inv;
                          const unsigned slot = atomicAdd(ctl + CW_CNT + (k * 32 + ek) * 16, 1u);
                          TOKL[(size_t)(k * 32 + ek) * LISTCAP + slot] = 32 * tt + row; WLST[(size_t)(k * 32 + ek) * LISTCAP + slot] = wk; } } }
                __syncthreads();
            }
        }
    }
#endif
    xcd_barrier(bar);

#if PH(11)
    {
        LAS int* rbase = (LAS int*)(lds + LDSCTL_OFF + LC_RBASE); LAS int* tbase = (LAS int*)(lds + LDSCTL_OFF + LC_TBASE); LAS int* nearr = (LAS int*)(lds + LDSCTL_OFF + LC_NE); LAS int* tilee = (LAS int*)(lds + LDSCTL_OFF + LC_TILEE);
        { int tid = threadIdx.x; asm volatile("" : "+v"(tid));
          if (tid < 4 * NE) nearr[tid] = (int)ctl[CW_CNT + tid * 16];
          __syncthreads();
          if (tid < 4) { int a = 0;
#pragma nounroll
              for (int e = 0; e < NE; ++e) { tbase[tid * 33 + e] = a; a += (nearr[tid * 32 + e] + 255) >> 8; } tbase[tid * 33 + NE] = a; }
          __syncthreads();
          if (tid == 0) { int a = 0;
#pragma nounroll
              for (int k = 0; k < 4; ++k) { rbase[k] = a; a += tbase[k * 33 + NE]; } rbase[4] = a; }
          for (int q = tid; q < 4 * MAXTILES; q += 512) { const int k = q / MAXTILES, T = q % MAXTILES;
              if (T < tbase[k * 33 + NE]) { int e = 0;
#pragma nounroll
                  while (e < NE - 1 && tbase[k * 33 + e + 1] <= T) ++e;
                  tilee[k * MAXTILES + T] = e; } }
          __syncthreads(); }
        const MoeTabs tb{rbase, tbase, nearr, tilee};
        { MoeOrderGU S{(const char*)H2, (const char*)WGU, TOKL, G, vcu, tb};
          EpiGateUp E{HID, b_gate_up};
          pg8::gemm_phase_f8<true>(lds, 512, S, E); }
        xcd_barrier(bar);
        for (int k = 0; k < TOPK; ++k) {
            { MoeOrderDN S{(const char*)HID, (const char*)WDN, G, vcu, k, tb};
              EpiDown E{out, MERGED  , b_down, MOD, TOKL + (size_t)k * NE * LISTCAP, WLST + (size_t)k * NE * LISTCAP, k == 0 ? 0 : (k == TOPK - 1 ? 2 : 1)};
              pg8::gemm_phase_f8<false>(lds, 512, S, E); }
            if (k + 1 < TOPK) xcd_barrier(bar);
        }
    }
#endif
}

extern "C" void kernel_launch(void* const* d_in, const int* in_sizes, int n_in, void* d_out, int out_size, void* d_ws, size_t ws_size, hipStream_t stream) {
    static int grid = 0;
    if (grid == 0) {
        if (n_in != 23 || in_sizes[0] != NTOK * DM || out_size != NTOK * DM || ws_size < WS_END) { fprintf(stderr, "kernel_launch: unexpected shapes (n_in %d, in0 %d, out %d, ws %zu); nothing launched\n", n_in, n_in > 0 ? in_sizes[0] : -1, out_size, ws_size); grid = -1; return; }
        int dev = 0, cus = 0, per_cu = 0;
        if (hipGetDevice(&dev) != hipSuccess || hipDeviceGetAttribute(&cus, hipDeviceAttributeMultiprocessorCount, dev) != hipSuccess) { grid = -1; return; }
        if (hipFuncSetAttribute((const void*)fwd_kernel, hipFuncAttributeMaxDynamicSharedMemorySize, LDS_BYTES) != hipSuccess) { fprintf(stderr, "kernel_launch: hipFuncSetAttribute failed\n"); grid = -1; return; }
        if (hipOccupancyMaxActiveBlocksPerMultiprocessor(&per_cu, (const void*)fwd_kernel, 512, LDS_BYTES) != hipSuccess || per_cu < 1) fprintf(stderr, "kernel_launch: occupancy query reports %d\n", per_cu);
        (void)hipGetLastError();
        grid = cus;
    }
    if (grid < 0) return;
    if (hipMemsetAsync((char*)d_ws + WS_CTL, 0, CTL_ZERO_BYTES, stream) != hipSuccess) return;
    Args a{};
    for (int i = 0; i < 23; ++i) a.in[i] = d_in[i];
    a.out = (float*)d_out; a.ws = (unsigned char*)d_ws;
    hipLaunchKernelGGL(fwd_kernel, dim3(grid), dim3(512), LDS_BYTES, stream, a);
}
```

```cpp
#include <hip/hip_runtime.h>
#include <cstdio>
#include <cstdint>

#define LAS __attribute__((address_space(3)))
#define GAS __attribute__((address_space(1)))
typedef unsigned short bf16_t;
typedef short bf16x8 __attribute__((ext_vector_type(8)));
typedef short s16x4 __attribute__((ext_vector_type(4)));
typedef float f32x2 __attribute__((ext_vector_type(2)));
typedef float f32x4 __attribute__((ext_vector_type(4)));
typedef float f32x16 __attribute__((ext_vector_type(16)));
typedef unsigned u32x2 __attribute__((ext_vector_type(2)));
typedef unsigned u32x4 __attribute__((ext_vector_type(4)));
typedef int v8i __attribute__((ext_vector_type(8)));
typedef unsigned u32x8 __attribute__((ext_vector_type(8)));

constexpr int NB = 32, SEQ = 2048, DM = 1024, NTOK = NB * SEQ;
constexpr int QLORA = 384, KVLORA = 256, ROPE = 32, NOPE = 64, VD = 64, QKD = 96, NH = 8;
constexpr int SBD = 64;
constexpr int NE = 32, TOPK = 4, DE = 1024;
constexpr int DIN = 4256, DINP = 4352;
constexpr float EPS = 1e-6f;
constexpr float LOG2E = 1.4426950408889634f;
constexpr int LISTCAP = NTOK;
constexpr int MAXTILES = NTOK / 256 + NE;

constexpr size_t MiB = 1u << 20;
constexpr size_t WS_CTL = 0, CTL_ZERO_BYTES = 1 * MiB;
constexpr size_t WS_WIN = 1 * MiB;
constexpr size_t WS_WUQ = 10 * MiB;
constexpr size_t WS_WUKV = 11 * MiB;
constexpr size_t WS_WOM = 12 * MiB;
constexpr size_t WS_WOS = 13 * MiB;
constexpr size_t WS_WOUT = 14 * MiB;
constexpr size_t WS_MOD = 16 * MiB;
constexpr size_t WS_WIN8 = 18 * MiB;
constexpr size_t WS_H = 32 * MiB;
constexpr size_t WS_KVRAW = WS_H, WS_MERGED = WS_H;
constexpr size_t WS_SGA = 160 * MiB;
constexpr size_t WS_H2 = WS_SGA;
constexpr size_t WS_SGB = 288 * MiB;
constexpr size_t WS_WGU = WS_SGB;
constexpr size_t WS_SB = 416 * MiB;
constexpr size_t WS_WDN = 416 * MiB;
constexpr size_t WS_TOKL = 480 * MiB;
constexpr size_t WS_WL = 512 * MiB;
constexpr size_t WS_HID = 544 * MiB;
constexpr size_t WS_QL = 608 * MiB;
constexpr size_t WS_M8 = 608 * MiB;
constexpr size_t WS_KVL = 656 * MiB;
constexpr size_t WS_KPE = 688 * MiB;
constexpr size_t WS_Q = 692 * MiB;
constexpr size_t WS_K = 788 * MiB;
constexpr size_t WS_OMLA = 884 * MiB;
constexpr size_t WS_H8 = WS_OMLA;
constexpr size_t WS_OSB = 948 * MiB;
constexpr size_t WS_END = 1012 * MiB;
static_assert(WS_HID + (size_t)4 * MAXTILES * 256 * 1024 <= WS_END, "hid (fp8, all four rounds)");
constexpr int CW_BAR = 4096;
constexpr int CW_CNT = 16384;

constexpr int RING_BYTES = 131072;
constexpr int LDSCTL_OFF = RING_BYTES + 1024;
constexpr int LC_BARST = 0;
constexpr int LC_RBASE = 32;
constexpr int LC_TBASE = 64;
constexpr int LC_NE = 640;
constexpr int LC_TILEE = 1152;
constexpr int LDS_BYTES = 147456;
static_assert(LC_TILEE + 4 * MAXTILES * 4 <= LDS_BYTES - LDSCTL_OFF, "lds ctl");

__device__ __forceinline__ unsigned cvt_pk_bf16(float lo, float hi) { unsigned r; asm volatile("v_cvt_pk_bf16_f32 %0, %1, %2" : "=v"(r) : "v"(lo), "v"(hi)); return r; }
__device__ __forceinline__ float bf_lo(unsigned u) { return __builtin_bit_cast(float, u << 16); }
__device__ __forceinline__ float bf_hi(unsigned u) { return __builtin_bit_cast(float, u & 0xffff0000u); }
__device__ __forceinline__ float fast_sigmoid(float x) { return __builtin_amdgcn_rcpf(1.f + __builtin_amdgcn_exp2f(-x * LOG2E)); }

namespace pg8 {
constexpr int BM = 256, BK = 64, HALF = 128, HTB = HALF * BK * 2, STAGE_BYTES = 8 * HTB, NXCD = 8, WGM = 8;
__host__ __device__ __forceinline__ int lds_byte(int r, int c) { const int st = (r >> 4) * 2 + (c >> 5), rr = r & 15, cc = c & 31, ob = rr * 64 + cc * 2; return st * 1024 + (ob ^ (((ob >> 9) & 1) << 5)); }
__host__ __device__ __forceinline__ void stage_rc(int b, int& R, int& C) { const int st = b / 1024, sb = b % 1024, swz = sb ^ (((sb >> 9) & 1) << 5); R = (st >> 1) * 16 + swz / 64; C = (st & 1) * 32 + (swz % 64) / 2; }
__host__ __device__ __forceinline__ int perm32(int rho) { const int n = rho >> 4, i = rho & 15; return 8 * (i >> 2) + 4 * n + (i & 3); }

struct Unit { int pm, pn, e, j0, ne, kk; };

struct DenseOrder {
    const char* A; const char* Bt; int K; int nM, nN, nwg, G, c;
    __device__ void init(const void* A_, const void* Bt_, int M, int N, int K_, int G_, int c_) { A = (const char*)A_; Bt = (const char*)Bt_; K = K_; nM = M / BM; nN = N / BM; nwg = nM * nN; G = G_; c = c_; }
    __device__ __forceinline__ bool next(int i, Unit& u) const {
        const long L = (long)i * G + c; if (L >= nwg) return false;
        int wgid = (int)L; { const int q = nwg / NXCD, r = nwg % NXCD, xcd = wgid % NXCD, off = wgid / NXCD; wgid = (xcd < r ? xcd * (q + 1) : r * (q + 1) + (xcd - r) * q) + off; }
        const int nig = WGM * nN, gid = wgid / nig, fm = gid * WGM, gsz = (nM - fm) < WGM ? (nM - fm) : WGM;
        u.pm = fm + ((wgid % nig) % gsz); u.pn = (wgid % nig) / gsz; u.e = 0; u.j0 = 0; u.ne = 0; u.kk = 0; return true;
    }
    __device__ __forceinline__ const char* a_base(const Unit& u) const { return A + (size_t)u.pm * (size_t)(BM * 2) * K; }
    __device__ __forceinline__ const char* b_base(const Unit& u) const { return Bt + (size_t)u.pn * (size_t)(BM * 2) * K; }
    __device__ __forceinline__ unsigned row_of(const Unit&, int) const { return 0u; }
};

template <bool GATHER, class Epi, class Sched>
__device__ __forceinline__ void gemm_phase(LAS unsigned char* lds, const int K, const Sched& S, const Epi& E) {
    int tid_ = threadIdx.x; asm volatile("" : "+v"(tid_));
    const int tid = tid_, wid = __builtin_amdgcn_readfirstlane(tid >> 6), lane = tid & 63, wr = wid >> 2, wc = wid & 3, fr = lane & 15, fq = lane >> 4;
    const int nt = K / BK;
    int RA[2]; unsigned cofA[2], voffB[2];
#pragma unroll
    for (int i = 0; i < 2; ++i) { int R, C; stage_rc(tid * 16 + i * 8192, R, C); const int Rb = (R & ~31) + perm32(R & 31);
        RA[i] = R; cofA[i] = (unsigned)C * 2u; voffB[i] = (unsigned)(Rb * K + C) * 2u; }
    const size_t kstep = (size_t)(BK * 2);
    const size_t hstep = (size_t)HALF * K * 2;
    const unsigned ldsw = (unsigned)wid * 1024u;
    const int aoff = lds_byte(wr * 64 + fr, fq * 8), boff = lds_byte(wc * 32 + fr, fq * 8);
#define PG8_SA(b, h) (((b) * 2 + (h)) * HTB)
#define PG8_SB(b, h) ((4 + (b) * 2 + (h)) * HTB)
#define PG8_STAGE(bufoff, gbase, voff) do { _Pragma("unroll") for (int _i = 0; _i < 2; ++_i) \
        __builtin_amdgcn_global_load_lds((const unsigned*)((const char*)(gbase) + (voff)[_i]), (LAS unsigned*)(lds + (bufoff) + ldsw + _i * 8192), 16, 0, 0); } while (0)
#define PG8_LDA(dst, b, h) do { _Pragma("unroll") for (int m = 0; m < 4; ++m) _Pragma("unroll") for (int k = 0; k < 2; ++k) dst[m][k] = *(const LAS bf16x8*)(lds + PG8_SA(b, h) + aoff + m * 2048 + k * 1024); } while (0)
#define PG8_LDB(dst, b, h) do { _Pragma("unroll") for (int n = 0; n < 2; ++n) _Pragma("unroll") for (int k = 0; k < 2; ++k) dst[n][k] = *(const LAS bf16x8*)(lds + PG8_SB(b, h) + boff + n * 2048 + k * 1024); } while (0)
#define PG8_MMA(ai, bj, At, Bt) do { __builtin_amdgcn_s_setprio(1); _Pragma("unroll") for (int m = 0; m < 4; ++m) _Pragma("unroll") for (int n = 0; n < 2; ++n) _Pragma("unroll") for (int k = 0; k < 2; ++k) \
        acc[ai][bj][m][n] = __builtin_amdgcn_mfma_f32_16x16x32_bf16(Bt[n][k], At[m][k], acc[ai][bj][m][n], 0, 0, 0); __builtin_amdgcn_s_setprio(0); } while (0)
#define PG8_WAIT_V(n) asm volatile("s_waitcnt vmcnt(" #n ")" ::: "memory")
#define PG8_WAIT_L(n) asm volatile("s_waitcnt lgkmcnt(" #n ")" ::: "memory")
#define PG8_BAR __builtin_amdgcn_s_barrier()
#define PG8_SCHED __builtin_amdgcn_sched_barrier(0)
#define PG8_AOFFS(dst, u) do { _Pragma("unroll") for (int _h = 0; _h < 2; ++_h) _Pragma("unroll") for (int _i = 0; _i < 2; ++_i) { \
        const unsigned _row = GATHER ? S.row_of(u, _h * HALF + RA[_i]) : (unsigned)(_h * HALF + RA[_i]); dst[_h][_i] = _row * (unsigned)(K * 2) + cofA[_i]; } } while (0)
    Unit cur, nxt; int ui = 0;
    if (!S.next(0, cur)) return;
    f32x4 acc[2][2][4][2];
#pragma unroll
    for (int a = 0; a < 2; ++a)
#pragma unroll
        for (int b = 0; b < 2; ++b)
#pragma unroll
            for (int m = 0; m < 4; ++m)
#pragma unroll
                for (int n = 0; n < 2; ++n) acc[a][b][m][n] = (f32x4){0.f, 0.f, 0.f, 0.f};
    bf16x8 At[4][2], B0[2][2], B1[2][2];
    unsigned oc[2][2], on[2][2];
    PG8_AOFFS(oc, cur);
    const char* cA = S.a_base(cur); const char* cB = S.b_base(cur);
    PG8_STAGE(PG8_SB(0, 0), cB, voffB); PG8_STAGE(PG8_SB(0, 1), cB + hstep, voffB); PG8_STAGE(PG8_SA(0, 0), cA, oc[0]); PG8_STAGE(PG8_SA(0, 1), cA, oc[1]);
    if (wr == 1) PG8_BAR;
    PG8_WAIT_V(2); PG8_BAR;
    PG8_STAGE(PG8_SB(1, 0), cB + kstep, voffB); PG8_STAGE(PG8_SA(1, 0), cA + kstep, oc[0]); PG8_STAGE(PG8_SB(1, 1), cB + hstep + kstep, voffB);
    PG8_WAIT_V(6); PG8_BAR;
    for (;;) {
        const bool has_next = S.next(ui + 1, nxt);
        const char* nA = has_next ? S.a_base(nxt) : cA; const char* nB = has_next ? S.b_base(nxt) : cB;
        if constexpr (GATHER) { if (has_next) { PG8_AOFFS(on, nxt);
            _Pragma("unroll") for (int _h = 0; _h < 2; ++_h) _Pragma("unroll") for (int _i = 0; _i < 2; ++_i) asm volatile("" : "+v"(on[_h][_i]));
          } else {
#pragma unroll
            for (int _h = 0; _h < 2; ++_h)
#pragma unroll
                for (int _i = 0; _i < 2; ++_i) on[_h][_i] = oc[_h][_i]; } }
#pragma nounroll
        for (int t = 0; t < nt; t += 2) {
            const bool last = (t == nt - 2);
            const char* a1 = cA + (size_t)(t + 1) * kstep;
            const char* a2 = last ? nA : cA + (size_t)(t + 2) * kstep; const char* b2 = last ? nB : cB + (size_t)(t + 2) * kstep;
            const char* a3 = a2 + kstep; const char* b3 = b2 + kstep;
            unsigned o2[2][2];
#pragma unroll
            for (int _h = 0; _h < 2; ++_h)
#pragma unroll
                for (int _i = 0; _i < 2; ++_i) o2[_h][_i] = (GATHER && last) ? on[_h][_i] : oc[_h][_i];
            PG8_LDB(B0, 0, 0); PG8_LDB(B1, 0, 1); PG8_SCHED; PG8_LDA(At, 0, 0); PG8_STAGE(PG8_SA(1, 1), a1, oc[1]);
            PG8_WAIT_V(8); PG8_WAIT_L(0); PG8_BAR; PG8_MMA(0, 0, At, B0); PG8_MMA(0, 1, At, B1); PG8_BAR; PG8_SCHED;
            PG8_LDA(At, 0, 1); PG8_STAGE(PG8_SB(0, 0), b2, voffB); PG8_STAGE(PG8_SB(0, 1), b2 + hstep, voffB); PG8_STAGE(PG8_SA(0, 0), a2, o2[0]);
            PG8_WAIT_V(8); PG8_WAIT_L(0); PG8_BAR; PG8_MMA(1, 0, At, B0); PG8_MMA(1, 1, At, B1); PG8_BAR; PG8_SCHED;
            PG8_LDB(B0, 1, 0); PG8_LDB(B1, 1, 1); PG8_SCHED; PG8_LDA(At, 1, 0); PG8_STAGE(PG8_SA(0, 1), a2, o2[1]);
            PG8_WAIT_V(8); PG8_WAIT_L(0); PG8_BAR; PG8_MMA(0, 0, At, B0); PG8_MMA(0, 1, At, B1); PG8_BAR; PG8_SCHED;
            PG8_LDA(At, 1, 1); PG8_STAGE(PG8_SB(1, 0), b3, voffB); PG8_STAGE(PG8_SB(1, 1), b3 + hstep, voffB); PG8_STAGE(PG8_SA(1, 0), a3, o2[0]);
            PG8_WAIT_V(8); PG8_WAIT_L(0); PG8_BAR; PG8_MMA(1, 0, At, B0); PG8_MMA(1, 1, At, B1); PG8_BAR; PG8_SCHED;
        }
        if (wr == 0) PG8_BAR;
        E(acc, cur, wr, wc, fr, fq);
        if (!has_next) break;
#pragma unroll
        for (int a = 0; a < 2; ++a)
#pragma unroll
            for (int b = 0; b < 2; ++b)
#pragma unroll
                for (int m = 0; m < 4; ++m)
#pragma unroll
                    for (int n = 0; n < 2; ++n) acc[a][b][m][n] = (f32x4){0.f, 0.f, 0.f, 0.f};
        cur = nxt; cA = nA; cB = nB; ++ui;
        if constexpr (GATHER) {
#pragma unroll
        for (int _h = 0; _h < 2; ++_h)
#pragma unroll
            for (int _i = 0; _i < 2; ++_i) oc[_h][_i] = on[_h][_i]; }
        if (wr == 1) PG8_BAR;
    }
    PG8_WAIT_V(0);
    PG8_BAR;
#undef PG8_SA
#undef PG8_SB
#undef PG8_STAGE
#undef PG8_LDA
#undef PG8_LDB
#undef PG8_MMA
#undef PG8_WAIT_V
#undef PG8_WAIT_L
#undef PG8_BAR
#undef PG8_SCHED
#undef PG8_AOFFS
}
template <bool GATHER, class Epi, class Sched>
__device__ __forceinline__ void gemm_phase_f8(LAS unsigned char* lds, const int K, const Sched& S, const Epi& E) {
    int tid_ = threadIdx.x; asm volatile("" : "+v"(tid_));
    const int tid = tid_, wid = __builtin_amdgcn_readfirstlane(tid >> 6), lane = tid & 63, wr = wid >> 2, wc = wid & 3, fr = lane & 15, fq = lane >> 4;
    const int nt = K / BK;
    int RA[2]; unsigned cofA[2], voffB[2];
#pragma unroll
    for (int i = 0; i < 2; ++i) { int R, C; stage_rc(tid * 16 + i * 8192, R, C); const int Rb = (R & ~31) + perm32(R & 31);
        RA[i] = R; cofA[i] = (unsigned)C * 2u; voffB[i] = (unsigned)(Rb * K + C) * 2u; }
    const size_t kstep = (size_t)(BK * 2);
    const size_t hstep = (size_t)HALF * K * 2;
    const unsigned ldsw = (unsigned)wid * 1024u;
    const int aoff = lds_byte(wr * 64 + fr, 16 * (fq & 1)) + (fq >> 1) * 1024, boff = lds_byte(wc * 32 + fr, 16 * (fq & 1)) + (fq >> 1) * 1024;
#define PG8_SA(b, h) (((b) * 2 + (h)) * HTB)
#define PG8_SB(b, h) ((4 + (b) * 2 + (h)) * HTB)
#define PG8_STAGE(bufoff, gbase, voff) do { _Pragma("unroll") for (int _i = 0; _i < 2; ++_i) \
        __builtin_amdgcn_global_load_lds((const unsigned*)((const char*)(gbase) + (voff)[_i]), (LAS unsigned*)(lds + (bufoff) + ldsw + _i * 8192), 16, 0, 0); } while (0)
#define PG8_LD32(p_) __builtin_shufflevector(*(const LAS u32x4*)(p_), *(const LAS u32x4*)((p_) + 16), 0, 1, 2, 3, 4, 5, 6, 7)
#define PG8_LDA(dst, b, h) do { _Pragma("unroll") for (int m = 0; m < 4; ++m) dst[m] = PG8_LD32(lds + PG8_SA(b, h) + aoff + m * 2048); } while (0)
#define PG8_LDB(dst, b, h) do { _Pragma("unroll") for (int n = 0; n < 2; ++n) dst[n] = PG8_LD32(lds + PG8_SB(b, h) + boff + n * 2048); } while (0)
#define PG8_F8(fr_) ((v8i){(int)fr_[0][0], (int)fr_[0][1], (int)fr_[0][2], (int)fr_[0][3], (int)fr_[1][0], (int)fr_[1][1], (int)fr_[1][2], (int)fr_[1][3]})
#define PG8_MMA(ai, bj, At, Bt) do { __builtin_amdgcn_s_setprio(1); _Pragma("unroll") for (int m = 0; m < 4; ++m) _Pragma("unroll") for (int n = 0; n < 2; ++n) \
        asm volatile("v_mfma_scale_f32_16x16x128_f8f6f4 %0, %1, %2, %0, %3, %3 op_sel_hi:[0,0,0]" : "+v"(acc[ai][bj][m][n]) : "v"(Bt[n]), "v"(At[m]), "v"(one_scale)); __builtin_amdgcn_s_setprio(0); } while (0)
#define PG8_WAIT_V(n) asm volatile("s_waitcnt vmcnt(" #n ")" ::: "memory")
#define PG8_WAIT_L(n) asm volatile("s_waitcnt lgkmcnt(" #n ")" ::: "memory")
#define PG8_BAR __builtin_amdgcn_s_barrier()
#define PG8_SCHED __builtin_amdgcn_sched_barrier(0)
#define PG8_AOFFS(dst, u) do { _Pragma("unroll") for (int _h = 0; _h < 2; ++_h) _Pragma("unroll") for (int _i = 0; _i < 2; ++_i) { \
        const unsigned _row = GATHER ? S.row_of(u, _h * HALF + RA[_i]) : (unsigned)(_h * HALF + RA[_i]); dst[_h][_i] = _row * (unsigned)(K * 2) + cofA[_i]; } } while (0)
    Unit cur, nxt; int ui = 0;
    if (!S.next(0, cur)) return;
    f32x4 acc[2][2][4][2];
#pragma unroll
    for (int a = 0; a < 2; ++a)
#pragma unroll
        for (int b = 0; b < 2; ++b)
#pragma unroll
            for (int m = 0; m < 4; ++m)
#pragma unroll
                for (int n = 0; n < 2; ++n) { acc[a][b][m][n] = (f32x4){0.f, 0.f, 0.f, 0.f}; asm volatile("" : "+v"(acc[a][b][m][n])); }
    u32x8 At[4], B0[2], B1[2];
    int one_scale = 0x7f7f7f7f; asm volatile("" : "+v"(one_scale));
    unsigned oc[2][2], on[2][2];
    PG8_AOFFS(oc, cur);
    const char* cA = S.a_base(cur); const char* cB = S.b_base(cur);
    PG8_STAGE(PG8_SB(0, 0), cB, voffB); PG8_STAGE(PG8_SB(0, 1), cB + hstep, voffB); PG8_STAGE(PG8_SA(0, 0), cA, oc[0]); PG8_STAGE(PG8_SA(0, 1), cA, oc[1]);
    if (wr == 1) PG8_BAR;
    PG8_WAIT_V(2); PG8_BAR;
    PG8_STAGE(PG8_SB(1, 0), cB + kstep, voffB); PG8_STAGE(PG8_SA(1, 0), cA + kstep, oc[0]); PG8_STAGE(PG8_SB(1, 1), cB + hstep + kstep, voffB);
    PG8_WAIT_V(6); PG8_BAR;
    Unit nn; bool has_next = S.next(1, nxt);
    if constexpr (GATHER) { if (has_next) { PG8_AOFFS(on, nxt);
            _Pragma("unroll") for (int _h = 0; _h < 2; ++_h) _Pragma("unroll") for (int _i = 0; _i < 2; ++_i) asm volatile("" : "+v"(on[_h][_i]));
          } else {
#pragma unroll
            for (int _h = 0; _h < 2; ++_h)
#pragma unroll
                for (int _i = 0; _i < 2; ++_i) on[_h][_i] = oc[_h][_i]; } }
    for (;;) {
        const char* nA = has_next ? S.a_base(nxt) : cA; const char* nB = has_next ? S.b_base(nxt) : cB;
#pragma nounroll
        for (int t = 0; t < nt; t += 2) {
            const bool last = (t == nt - 2);
            const char* a1 = cA + (size_t)(t + 1) * kstep;
            const char* a2 = last ? nA : cA + (size_t)(t + 2) * kstep; const char* b2 = last ? nB : cB + (size_t)(t + 2) * kstep;
            const char* a3 = a2 + kstep; const char* b3 = b2 + kstep;
            unsigned o2[2][2];
#pragma unroll
            for (int _h = 0; _h < 2; ++_h)
#pragma unroll
                for (int _i = 0; _i < 2; ++_i) o2[_h][_i] = (GATHER && last) ? on[_h][_i] : oc[_h][_i];
            PG8_LDB(B0, 0, 0); PG8_LDB(B1, 0, 1); PG8_SCHED; PG8_LDA(At, 0, 0); PG8_STAGE(PG8_SA(1, 1), a1, oc[1]);
            PG8_WAIT_V(8); PG8_WAIT_L(0); PG8_BAR; PG8_MMA(0, 0, At, B0); PG8_MMA(0, 1, At, B1); PG8_BAR; PG8_SCHED;
            PG8_LDA(At, 0, 1); PG8_STAGE(PG8_SB(0, 0), b2, voffB); PG8_STAGE(PG8_SB(0, 1), b2 + hstep, voffB); PG8_STAGE(PG8_SA(0, 0), a2, o2[0]);
            PG8_WAIT_V(8); PG8_WAIT_L(0); PG8_BAR; PG8_MMA(1, 0, At, B0); PG8_MMA(1, 1, At, B1); PG8_BAR; PG8_SCHED;
            PG8_LDB(B0, 1, 0); PG8_LDB(B1, 1, 1); PG8_SCHED; PG8_LDA(At, 1, 0); PG8_STAGE(PG8_SA(0, 1), a2, o2[1]);
            PG8_WAIT_V(8); PG8_WAIT_L(0); PG8_BAR; PG8_MMA(0, 0, At, B0); PG8_MMA(0, 1, At, B1); PG8_BAR; PG8_SCHED;
            PG8_LDA(At, 1, 1); PG8_STAGE(PG8_SB(1, 0), b3, voffB); PG8_STAGE(PG8_SB(1, 1), b3 + hstep, voffB); PG8_STAGE(PG8_SA(1, 0), a3, o2[0]);
            PG8_WAIT_V(8); PG8_WAIT_L(0); PG8_BAR; PG8_MMA(1, 0, At, B0); PG8_MMA(1, 1, At, B1); PG8_BAR; PG8_SCHED;
        }
        asm volatile("s_nop 15\n\ts_nop 15" ::: "memory");
        if (wr == 0) PG8_BAR;
        const bool has_nn = has_next && S.next(ui + 2, nn);
        unsigned onn[2][2];
        if constexpr (GATHER) { if (has_nn) { PG8_AOFFS(onn, nn); } else {
#pragma unroll
            for (int _h = 0; _h < 2; ++_h)
#pragma unroll
                for (int _i = 0; _i < 2; ++_i) onn[_h][_i] = on[_h][_i]; } }
        E(acc, cur, wr, wc, fr, fq);
        if (!has_next) break;
#pragma unroll
        for (int a = 0; a < 2; ++a)
#pragma unroll
            for (int b = 0; b < 2; ++b)
#pragma unroll
                for (int m = 0; m < 4; ++m)
#pragma unroll
                    for (int n = 0; n < 2; ++n) { acc[a][b][m][n] = (f32x4){0.f, 0.f, 0.f, 0.f}; asm volatile("" : "+v"(acc[a][b][m][n])); }
        cur = nxt; cA = nA; cB = nB; ++ui; nxt = nn; has_next = has_nn;
        if constexpr (GATHER) {
#pragma unroll
        for (int _h = 0; _h < 2; ++_h)
#pragma unroll
            for (int _i = 0; _i < 2; ++_i) { oc[_h][_i] = on[_h][_i]; asm volatile("" : "+v"(onn[_h][_i])); on[_h][_i] = onn[_h][_i]; } }
        if (wr == 1) PG8_BAR;
    }
    PG8_WAIT_V(0);
    PG8_BAR;
#undef PG8_SA
#undef PG8_SB
#undef PG8_STAGE
#undef PG8_LDA
#undef PG8_LDB
#undef PG8_MMA
#undef PG8_WAIT_V
#undef PG8_WAIT_L
#undef PG8_BAR
#undef PG8_SCHED
#undef PG8_AOFFS
#undef PG8_F8
}
}
#define XB_TMO      128
#define XB_XCNT(j)  (256  + 64 * (j))
#define XB_XSUB(j)  (1280 + 64 * (j))
#define XB_XGEN(j)  (2304 + 64 * (j))
#define XB_TOP      3328
#define XB_TOPGEN   3392
#define XCD_BAR_WORDS 3456
#define XB_SPIN_CAP (1u << 18)

__device__ __forceinline__ unsigned xb_ld(unsigned* p)              { return __hip_atomic_load(p, __ATOMIC_RELAXED, __HIP_MEMORY_SCOPE_AGENT); }
__device__ __forceinline__ unsigned xb_add(unsigned* p, unsigned v) { return __hip_atomic_fetch_add(p, v, __ATOMIC_RELAXED, __HIP_MEMORY_SCOPE_AGENT); }
__device__ __forceinline__ unsigned xb_xcc_id() { return (unsigned)__builtin_amdgcn_s_getreg((3 << 11) | 20) & 0xFu; }
#define XB_SPIN(cond, bar) do { unsigned _sp = 0; while (cond) { __builtin_amdgcn_s_sleep(1); \
    if ((++_sp & 255u) == 0u) { if (xb_ld(&(bar)[XB_TMO])) break; if (_sp > XB_SPIN_CAP) { atomicAdd(&(bar)[XB_TMO], 1u); break; } } } } while (0)

struct XcdBarrier {
    unsigned* bar; unsigned x;
    volatile LAS unsigned* st;
};

__device__ __forceinline__ XcdBarrier xcd_barrier_post(unsigned* bar, volatile LAS unsigned* st) {
    XcdBarrier b; b.bar = bar; b.x = xb_xcc_id(); b.st = st;
    if (threadIdx.x == 0) (void)xb_add(&bar[XB_XCNT(b.x)], 1u);
    return b;
}
__device__ __forceinline__ void xcd_barrier_complete(unsigned* bar, unsigned x, unsigned& nloc, unsigned& nx) {
    const unsigned G = gridDim.x * gridDim.y * gridDim.z;
    unsigned sum, cnt, mine, sp = 0u;
    for (;;) {
        sum = 0u; cnt = 0u; mine = 0u;
#pragma unroll
        for (unsigned j = 0; j < 16; ++j) { const unsigned c = xb_ld(&bar[XB_XCNT(j)]); sum += c; cnt += (c > 0u) ? 1u : 0u; mine = (j == x) ? c : mine; }
        if (sum == G) break;
        __builtin_amdgcn_s_sleep(1);
        if ((++sp & 255u) == 0u) { if (xb_ld(&bar[XB_TMO])) break; if (sp > XB_SPIN_CAP) { atomicAdd(&bar[XB_TMO], 1u); break; } }
    }
    nloc = mine > 0u ? mine : 1u; nx = cnt > 0u ? cnt : 1u;
}

__device__ __forceinline__ void xcd_barrier(const XcdBarrier& b) {
    asm volatile("s_waitcnt vmcnt(0)" ::: "memory");
    __syncthreads();
    if (threadIdx.x == 0) {
        unsigned* bar = b.bar;
        __builtin_amdgcn_s_waitcnt(0);
        unsigned nloc = b.st[0], nx = b.st[1];
        if (nloc == 0u) { xcd_barrier_complete(bar, b.x, nloc, nx); b.st[0] = nloc; b.st[1] = nx; }
        const unsigned old = xb_add(&bar[XB_XSUB(b.x)], 1u);
        const unsigned gen = old / nloc;
        if (old + 1u == (gen + 1u) * nloc) {
            __builtin_amdgcn_fence(__ATOMIC_RELEASE, "agent");
            asm volatile("s_waitcnt vmcnt(0)" ::: "memory");
            const unsigned og = xb_add(&bar[XB_TOP], 1u);
            const unsigned tg = og / nx;
            if (og + 1u == (tg + 1u) * nx) xb_add(&bar[XB_TOPGEN], 1u);
            else XB_SPIN(xb_ld(&bar[XB_TOPGEN]) == tg, bar);
            __builtin_amdgcn_fence(__ATOMIC_ACQUIRE, "agent");
            xb_add(&bar[XB_XGEN(b.x)], 1u);
            asm volatile("s_waitcnt vmcnt(0)" ::: "memory");
        } else {
            XB_SPIN(xb_ld(&bar[XB_XGEN(b.x)]) == gen, bar);
            __builtin_amdgcn_fence(__ATOMIC_ACQUIRE, "agent");
            asm volatile("s_waitcnt vmcnt(0)" ::: "memory");
        }
    }
    __syncthreads();
}

#define LDS_WAIT() asm volatile("s_waitcnt lgkmcnt(0)" ::: "memory")
#define VM_WAIT() asm volatile("s_waitcnt vmcnt(0)" ::: "memory")
#define MFMA32(a, b, c) __builtin_amdgcn_mfma_f32_32x32x16_bf16((a), (b), (c), 0, 0, 0)
__device__ __forceinline__ float wave_sum(float v) {
#pragma unroll
    for (int o = 1; o < 64; o <<= 1) v += __shfl_xor(v, o);
    return v;
}
__device__ __forceinline__ int crow(int i, int hh) { return (i & 3) + 8 * (i >> 2) + 4 * hh; }
__device__ __forceinline__ bf16x8 pack8(float a0, float a1, float a2, float a3, float a4, float a5, float a6, float a7) {
    u32x4 p; p.x = cvt_pk_bf16(a0, a1); p.y = cvt_pk_bf16(a2, a3); p.z = cvt_pk_bf16(a4, a5); p.w = cvt_pk_bf16(a6, a7);
    return __builtin_bit_cast(bf16x8, p);
}

struct Ctx {
    LAS unsigned char* lds;
    int tid, lane, wave, vcu, G;
};

__device__ __forceinline__ void transpose_item(const float* W, int K, int N, bf16_t* WT, int k0, int n0, int drow0, LAS float* scr, int lane) {
#pragma unroll 8
    for (int i = 0; i < 32; ++i) { const int kk = 2 * i + (lane >> 5); scr[kk * 33 + (lane & 31)] = W[(size_t)(k0 + kk) * N + n0 + (lane & 31)]; }
    LDS_WAIT(); asm volatile("" ::: "memory");
    const int c = lane & 7;
#pragma unroll
    for (int j = 0; j < 4; ++j) { const int n = (lane >> 3) + 8 * j; const LAS float* s = scr + (8 * c) * 33 + n;
        u32x4 o; o.x = cvt_pk_bf16(s[0 * 33], s[1 * 33]); o.y = cvt_pk_bf16(s[2 * 33], s[3 * 33]); o.z = cvt_pk_bf16(s[4 * 33], s[5 * 33]); o.w = cvt_pk_bf16(s[6 * 33], s[7 * 33]);
        *(GAS u32x4*)(WT + (size_t)(drow0 + n) * K + k0 + 8 * c) = o; }
    LDS_WAIT(); asm volatile("" ::: "memory");
}

__device__ __forceinline__ unsigned pk4_fp8(float a, float b, float c, float d) { int p = __builtin_amdgcn_cvt_pk_fp8_f32(a, b, 0, false); p = __builtin_amdgcn_cvt_pk_fp8_f32(c, d, p, true); return (unsigned)p; }
__device__ __forceinline__ void transpose_item_f8(const float* W, int K, int N, unsigned char* WT, int k0, int n0, int drow0, float scl, LAS float* scr, int lane) {
#pragma unroll 8
    for (int i = 0; i < 32; ++i) { const int kk = 2 * i + (lane >> 5); scr[kk * 33 + (lane & 31)] = W[(size_t)(k0 + kk) * N + n0 + (lane & 31)]; }
    LDS_WAIT(); asm volatile("" ::: "memory");
    const int c = lane & 7;
#pragma unroll
    for (int j = 0; j < 4; ++j) { const int n = (lane >> 3) + 8 * j; const LAS float* s = scr + (8 * c) * 33 + n;
        u32x2 o; o.x = pk4_fp8(s[0 * 33] * scl, s[1 * 33] * scl, s[2 * 33] * scl, s[3 * 33] * scl); o.y = pk4_fp8(s[4 * 33] * scl, s[5 * 33] * scl, s[6 * 33] * scl, s[7 * 33] * scl);
        *(GAS u32x2*)(WT + (size_t)(drow0 + n) * K + k0 + 8 * c) = o; }
    LDS_WAIT(); asm volatile("" ::: "memory");
}

constexpr float WSCALE = 32.f, WDESCALE = 1.f / 32.f;
typedef const f32x4 (&AccRef)[2][2][4][2];

struct EpiNull { __device__ __forceinline__ void operator()(AccRef acc, const pg8::Unit& u, int wr, int wc, int fr, int fq) const {
        float s = 0.f;
#pragma unroll
        for (int ai = 0; ai < 2; ++ai)
#pragma unroll
            for (int bj = 0; bj < 2; ++bj)
#pragma unroll
                for (int m = 0; m < 4; ++m)
#pragma unroll
                    for (int n = 0; n < 2; ++n) s += acc[ai][bj][m][n][0] + acc[ai][bj][m][n][1] + acc[ai][bj][m][n][2] + acc[ai][bj][m][n][3];
        asm volatile("" :: "v"(s)); } };
struct EpiStore {
    bf16_t* O; int ldc;
    __device__ __forceinline__ void operator()(AccRef acc, const pg8::Unit& u, int wr, int wc, int fr, int fq) const {
        const int row0 = u.pm * 256 + wr * 64 + fr, col0 = u.pn * 256 + wc * 32 + 8 * fq;
#pragma unroll
        for (int ai = 0; ai < 2; ++ai)
#pragma unroll
            for (int m = 0; m < 4; ++m) { bf16_t* rowp = O + (size_t)(row0 + ai * 128 + m * 16) * ldc + col0;
#pragma unroll
                for (int bj = 0; bj < 2; ++bj) { const f32x4 v0 = acc[ai][bj][m][0], v1 = acc[ai][bj][m][1];
                    u32x4 w; w.x = cvt_pk_bf16(v0[0], v0[1]); w.y = cvt_pk_bf16(v0[2], v0[3]); w.z = cvt_pk_bf16(v1[0], v1[1]); w.w = cvt_pk_bf16(v1[2], v1[3]);
                    *(u32x4*)(rowp + bj * 128) = w; } }
    }
};

struct EpiProj {
    bf16_t *QL, *KVL, *KPE, *SB, *SGA, *SGB; int cbase; float dsc;
    __device__ __forceinline__ void operator()(AccRef acc, const pg8::Unit& u, int wr, int wc, int fr, int fq) const {
        const int row0 = u.pm * 256 + wr * 64 + fr;
#pragma unroll
        for (int bj = 0; bj < 2; ++bj) {
            const int cg = cbase + u.pn * 256 + bj * 128 + wc * 32;
            bf16_t* base; int ld, co; bool sig = false;
            if (cg < 384) { base = QL; ld = 384; co = cg; }
            else if (cg < 640) { base = KVL; ld = 256; co = cg - 384; }
            else if (cg < 672) { base = KPE; ld = 32; co = cg - 640; }
            else if (cg < 768) { continue; }
            else if (cg < 2304) { base = SB; ld = 1536; co = cg - 768; }
            else if (cg < 3328) { base = SGA; ld = 1024; co = cg - 2304; sig = true; }
            else { base = SGB; ld = 1024; co = cg - 3328; sig = true; }
#pragma unroll
            for (int ai = 0; ai < 2; ++ai)
#pragma unroll
                for (int m = 0; m < 4; ++m) { f32x4 v0 = acc[ai][bj][m][0], v1 = acc[ai][bj][m][1];
                    if (sig) {
#pragma unroll
                        for (int j = 0; j < 4; ++j) { v0[j] = fast_sigmoid(v0[j] * dsc); v1[j] = fast_sigmoid(v1[j] * dsc); } }
                    u32x4 w; w.x = cvt_pk_bf16(v0[0], v0[1]); w.y = cvt_pk_bf16(v0[2], v0[3]); w.z = cvt_pk_bf16(v1[0], v1[1]); w.w = cvt_pk_bf16(v1[2], v1[3]);
                    *(u32x4*)(base + (size_t)(row0 + ai * 128 + m * 16) * ld + co + 8 * fq) = w; }
        }
    }
};

template <bool SECOND> struct EpiMerge {
    bf16_t* MG; const bf16_t* SG; unsigned char* M8;
    __device__ __forceinline__ void operator()(AccRef acc, const pg8::Unit& u, int wr, int wc, int fr, int fq) const {
        const int row0 = u.pm * 256 + wr * 64 + fr, col0 = u.pn * 256 + wc * 32 + 8 * fq;
#pragma unroll
        for (int ai = 0; ai < 2; ++ai)
#pragma unroll
            for (int m = 0; m < 4; ++m) { const size_t ro = (size_t)(row0 + ai * 128 + m * 16) * 1024 + col0;
#pragma unroll
                for (int bj = 0; bj < 2; ++bj) { const f32x4 v0 = acc[ai][bj][m][0], v1 = acc[ai][bj][m][1];
                    const u32x4 g = *(const u32x4*)(SG + ro + bj * 128);
                    float r0 = bf_lo(g.x) * v0[0], r1 = bf_hi(g.x) * v0[1], r2 = bf_lo(g.y) * v0[2], r3 = bf_hi(g.y) * v0[3];
                    float r4 = bf_lo(g.z) * v1[0], r5 = bf_hi(g.z) * v1[1], r6 = bf_lo(g.w) * v1[2], r7 = bf_hi(g.w) * v1[3];
                    if (SECOND) { const u32x4 p = *(const u32x4*)(MG + ro + bj * 128);
                        r0 += bf_lo(p.x); r1 += bf_hi(p.x); r2 += bf_lo(p.y); r3 += bf_hi(p.y); r4 += bf_lo(p.z); r5 += bf_hi(p.z); r6 += bf_lo(p.w); r7 += bf_hi(p.w); }
                    if (SECOND) { u32x2 w; w.x = pk4_fp8(r0, r1, r2, r3); w.y = pk4_fp8(r4, r5, r6, r7); *(u32x2*)(M8 + ro + bj * 128) = w; }
                    else { u32x4 w; w.x = cvt_pk_bf16(r0, r1); w.y = cvt_pk_bf16(r2, r3); w.z = cvt_pk_bf16(r4, r5); w.w = cvt_pk_bf16(r6, r7);
                        *(u32x4*)(MG + ro + bj * 128) = w; } } }
    }
};

struct EpiWout {
    const float* X; float* OUT; const float* MOD; float dsc;
    __device__ __forceinline__ void operator()(AccRef acc, const pg8::Unit& u, int wr, int wc, int fr, int fq) const {
        const int row0 = u.pm * 256 + wr * 64 + fr, col0 = u.pn * 256 + wc * 32 + 8 * fq;
        const float* ga = MOD + (size_t)(u.pm >> 3) * 6144 + 2048 + col0;
        f32x4 g[2][2];
#pragma unroll
        for (int bj = 0; bj < 2; ++bj)
#pragma unroll
            for (int n = 0; n < 2; ++n) g[bj][n] = *(const f32x4*)(ga + bj * 128 + 4 * n) * dsc;
#pragma unroll
        for (int ai = 0; ai < 2; ++ai)
#pragma unroll
            for (int m = 0; m < 4; ++m) { const size_t ro = (size_t)(row0 + ai * 128 + m * 16) * 1024 + col0;
#pragma unroll
                for (int bj = 0; bj < 2; ++bj)
#pragma unroll
                    for (int n = 0; n < 2; ++n) { const f32x4 xv = *(const f32x4*)(X + ro + bj * 128 + 4 * n);
                        *(f32x4*)(OUT + ro + bj * 128 + 4 * n) = xv + g[bj][n] * acc[ai][bj][m][n]; } }
    }
};

struct EpiGateUp {
    unsigned char* HID; const float* BGU;
    __device__ __forceinline__ void operator()(AccRef acc, const pg8::Unit& u, int wr, int wc, int fr, int fq) const {
        const int row0 = u.pm * 256 + wr * 64 + fr, hc = u.pn * 128 + wc * 32 + 8 * fq;
        const float* bg = BGU + (size_t)u.e * 2048 + hc;
        f32x4 bgate[2], bup[2];
#pragma unroll
        for (int n = 0; n < 2; ++n) { bgate[n] = *(const f32x4*)(bg + 4 * n); bup[n] = *(const f32x4*)(bg + 1024 + 4 * n); }
#pragma unroll
        for (int ai = 0; ai < 2; ++ai)
#pragma unroll
            for (int m = 0; m < 4; ++m) { float r[8];
#pragma unroll
                for (int n = 0; n < 2; ++n) { const f32x4 gv = acc[ai][0][m][n] * WDESCALE + bgate[n], uv = acc[ai][1][m][n] * WDESCALE + bup[n];
#pragma unroll
                    for (int j = 0; j < 4; ++j) { const float g = __builtin_fminf(gv[j], 7.f); const float up = __builtin_fminf(__builtin_fmaxf(uv[j], -7.f), 7.f);
                        r[4 * n + j] = (up + 1.f) * (g * fast_sigmoid(1.702f * g)); } }
                u32x2 w; w.x = pk4_fp8(r[0], r[1], r[2], r[3]); w.y = pk4_fp8(r[4], r[5], r[6], r[7]);
                *(u32x2*)(HID + (size_t)(row0 + ai * 128 + m * 16) * 1024 + hc) = w; asm volatile("" ::: "memory"); }
    }
};

struct EpiDown {
    float* OUT; bf16_t* Y; const float* BDN; const float* MOD; const int* TOKL; const float* WL; int mode;
    __device__ __forceinline__ void operator()(AccRef acc, const pg8::Unit& u, int wr, int wc, int fr, int fq) const {
        const int col0 = u.pn * 256 + wc * 32 + 8 * fq;
        const float* bd = BDN + (size_t)u.e * 1024 + col0;
        f32x4 b4[2][2];
#pragma unroll
        for (int bj = 0; bj < 2; ++bj)
#pragma unroll
            for (int n = 0; n < 2; ++n) b4[bj][n] = *(const f32x4*)(bd + bj * 128 + 4 * n);
        const int* tl = TOKL + (size_t)u.e * LISTCAP; const float* wl = WL + (size_t)u.e * LISTCAP;
#pragma unroll
        for (int ai = 0; ai < 2; ++ai)
#pragma unroll
            for (int m = 0; m < 4; ++m) { const int slot = u.j0 + ai * 128 + wr * 64 + m * 16 + fr;
                if (slot < u.ne) { const int tok = tl[slot]; const float wgt = wl[slot];
                    const float* ga = MOD + (size_t)(tok >> 11) * 6144 + 5120 + col0; float* op = OUT + (size_t)tok * 1024 + col0; bf16_t* yp = Y + (size_t)tok * 1024 + col0;
#pragma unroll
                    for (int bj = 0; bj < 2; ++bj) {
                        f32x4 v0 = *(const f32x4*)(ga + bj * 128) * ((acc[ai][bj][m][0] * WDESCALE + b4[bj][0]) * wgt), v1 = *(const f32x4*)(ga + bj * 128 + 4) * ((acc[ai][bj][m][1] * WDESCALE + b4[bj][1]) * wgt);
                        if (mode != 0) { const u32x4 p = *(const u32x4*)(yp + bj * 128);
                            v0[0] += bf_lo(p.x); v0[1] += bf_hi(p.x); v0[2] += bf_lo(p.y); v0[3] += bf_hi(p.y); v1[0] += bf_lo(p.z); v1[1] += bf_hi(p.z); v1[2] += bf_lo(p.w); v1[3] += bf_hi(p.w); }
                        if (mode == 2) { *(f32x4*)(op + bj * 128) = *(const f32x4*)(op + bj * 128) + v0; *(f32x4*)(op + bj * 128 + 4) = *(const f32x4*)(op + bj * 128 + 4) + v1; }
                        else { u32x4 w; w.x = cvt_pk_bf16(v0[0], v0[1]); w.y = cvt_pk_bf16(v0[2], v0[3]); w.z = cvt_pk_bf16(v1[0], v1[1]); w.w = cvt_pk_bf16(v1[2], v1[3]); *(u32x4*)(yp + bj * 128) = w; } } }
                asm volatile("" ::: "memory"); }
    }
};

struct MoeTabs { const LAS int* rbase; const LAS int* tbase; const LAS int* nearr; const LAS int* tilee; };
struct MoeOrderGU {
    const char* A; const char* Bt; const int* lists; int G, c; MoeTabs tb;
    __device__ __forceinline__ bool next(int i, pg8::Unit& u) const {
        const int L = i * G + c, TT = L >> 3; const int total = __builtin_amdgcn_readfirstlane(tb.rbase[4]);
        if (TT >= total) return false;
        int k = 0;
#pragma unroll
        for (int q = 1; q < 4; ++q) k += (TT >= __builtin_amdgcn_readfirstlane(tb.rbase[q])) ? 1 : 0;
        const int T = TT - __builtin_amdgcn_readfirstlane(tb.rbase[k]);
        const int e = __builtin_amdgcn_readfirstlane(tb.tilee[k * MAXTILES + T]);
        u.pm = TT; u.pn = L & 7; u.e = e; u.kk = k; u.j0 = (T - __builtin_amdgcn_readfirstlane(tb.tbase[k * 33 + e])) * 256; u.ne = __builtin_amdgcn_readfirstlane(tb.nearr[k * 32 + e]); return true;
    }
    __device__ __forceinline__ const char* a_base(const pg8::Unit&) const { return A; }
    __device__ __forceinline__ const char* b_base(const pg8::Unit& u) const { return Bt + (size_t)u.e * (size_t)(2048 * 1024) + (size_t)u.pn * (size_t)(256 * 1024); }
    __device__ __forceinline__ unsigned row_of(const pg8::Unit& u, int r) const { const int slot = u.j0 + r; return slot < u.ne ? (unsigned)lists[(size_t)(u.kk * 32 + u.e) * LISTCAP + slot] : 0u; }
};
struct MoeOrderDN {
    const char* A; const char* Bt; int G, c, k; MoeTabs tb;
    __device__ __forceinline__ bool next(int i, pg8::Unit& u) const {
        const int L = i * G + c, T = L >> 2; const int r0 = __builtin_amdgcn_readfirstlane(tb.rbase[k]), r1 = __builtin_amdgcn_readfirstlane(tb.rbase[k + 1]);
        if (T >= r1 - r0) return false;
        const int e = __builtin_amdgcn_readfirstlane(tb.tilee[k * MAXTILES + T]);
        u.pm = r0 + T; u.pn = L & 3; u.e = e; u.kk = k; u.j0 = (T - __builtin_amdgcn_readfirstlane(tb.tbase[k * 33 + e])) * 256; u.ne = __builtin_amdgcn_readfirstlane(tb.nearr[k * 32 + e]); return true;
    }
    __device__ __forceinline__ const char* a_base(const pg8::Unit& u) const { return A + (size_t)u.pm * (size_t)(256 * 1024); }
    __device__ __forceinline__ const char* b_base(const pg8::Unit& u) const { return Bt + (size_t)u.e * (size_t)(1024 * 1024) + (size_t)u.pn * (size_t)(256 * 1024); }
    __device__ __forceinline__ unsigned row_of(const pg8::Unit&, int) const { return 0u; }
};

constexpr int ATT_KBYTES = 12 * 1024;
constexpr int ATT_VPITCH = 136;
constexpr int ATT_VBYTES = 64 * ATT_VPITCH;
constexpr int ATT_BUF = ATT_KBYTES + ATT_VBYTES;
constexpr int ATT_WS = 2 * ATT_BUF;
static_assert(ATT_WS + 8 * 256 + 64 <= RING_BYTES, "attention LDS");

__device__ __forceinline__ void mla_unit(LAS unsigned char* lds, const bf16_t* Q, const bf16_t* Kb, const bf16_t* KV, bf16_t* O, int b, int h, int qb) {
    const int tid = threadIdx.x, lane = tid & 63, r = lane & 31, hh = lane >> 5; const int wid = __builtin_amdgcn_readfirstlane(tid >> 6);
    const size_t rowbase = (size_t)b * SEQ; const int q0 = qb * 256, qw = q0 + 32 * wid;
    const int cq = qw >> 6, NT = (q0 >> 6) + 4;
    LAS float* wsf = (LAS float*)(lds + ATT_WS) + wid * 64;
    bf16x8 qf[6];
    { const bf16_t* qp = Q + (rowbase + qw + r) * 768 + h * 96 + hh * 8;
#pragma unroll
      for (int s = 0; s < 6; ++s) qf[s] = *(const bf16x8*)(qp + 16 * s); }
    const int lkv = tid & 63, lc = tid >> 6;
    const bf16_t* kg0 = Kb + (rowbase + lkv) * 768 + h * 96 + lc * 8;
    const bf16_t* vg = KV + (rowbase + lkv) * 1024 + h * 128 + 64 + lc * 8;
    u32x4 ka0, ka1 = (u32x4){0u, 0u, 0u, 0u}, va;
#define ATT_LOAD(t, K0, K1, V) do { K0 = *(const u32x4*)(kg0 + (size_t)(t) * 64 * 768); if (tid < 256) K1 = *(const u32x4*)(kg0 + (size_t)(t) * 64 * 768 + 64); V = *(const u32x4*)(vg + (size_t)(t) * 64 * 1024); } while (0)
#define ATT_STORE(bufi, K0, K1, V) do { LAS unsigned char* kb_ = lds + (bufi) * ATT_BUF; *(LAS u32x4*)(kb_ + tid * 16) = K0; if (tid < 256) *(LAS u32x4*)(kb_ + 8192 + tid * 16) = K1; \
        LAS unsigned char* vb_ = kb_ + ATT_KBYTES + (lc * 8) * ATT_VPITCH + lkv * 2; \
        _Pragma("unroll") for (int j_ = 0; j_ < 8; ++j_) *(LAS unsigned short*)(vb_ + j_ * ATT_VPITCH) = (unsigned short)(V[j_ >> 1] >> (16 * (j_ & 1))); } while (0)
    ATT_LOAD(0, ka0, ka1, va); ATT_STORE(0, ka0, ka1, va); __syncthreads();
    float mref = 0.f, l_run = 0.f;
    f32x16 o0, o1, negm;
#pragma unroll
    for (int i = 0; i < 16; ++i) { o0[i] = 0.f; o1[i] = 0.f; negm[i] = 0.f; }
#define MLA_ITER(t_, BUFI, K0, K1, V) do { const int t = (t_); \
        if (t + 1 < NT) ATT_LOAD(t + 1, K0, K1, V); \
        if (t <= cq) { \
            const LAS unsigned char* kb = lds + (BUFI) * ATT_BUF; const LAS unsigned char* vb = kb + ATT_KBYTES; \
            f32x16 p0, p1; \
        _Pragma("unroll") \
            for (int s = 0; s < 6; ++s) { const bf16x8 a0 = *(const LAS bf16x8*)(kb + (2 * s + hh) * 1024 + r * 16), a1 = *(const LAS bf16x8*)(kb + (2 * s + hh) * 1024 + (r + 32) * 16); \
                if (s == 0) { p0 = MFMA32(a0, qf[0], negm); p1 = MFMA32(a1, qf[0], negm); } else { p0 = MFMA32(a0, qf[s], p0); p1 = MFMA32(a1, qf[s], p1); } } \
            float d = p0[0]; \
        _Pragma("unroll") \
            for (int i = 0; i < 16; ++i) { d = __builtin_fmaxf(d, p0[i]); d = __builtin_fmaxf(d, p1[i]); } \
            d = __builtin_fmaxf(d, __shfl_xor(d, 32)); \
            if (t == 0) { mref = d; \
        _Pragma("unroll") \
                for (int i = 0; i < 16; ++i) { p0[i] -= d; p1[i] -= d; negm[i] = -d; } \
            } else if (__any(d > 8.f)) { \
                const float delta = __builtin_fmaxf(d, 0.f), alpha = __builtin_amdgcn_exp2f(-delta); mref += delta; l_run *= alpha; \
        _Pragma("unroll") \
                for (int i = 0; i < 16; ++i) { p0[i] -= delta; p1[i] -= delta; negm[i] = -mref; } \
                if (hh == 0) wsf[r] = alpha; \
                LDS_WAIT(); \
        _Pragma("unroll") \
                for (int g = 0; g < 4; ++g) { const f32x4 al = *(const LAS f32x4*)(wsf + 8 * g + 4 * hh); \
        _Pragma("unroll") \
                    for (int e = 0; e < 4; ++e) { o0[4 * g + e] *= al[e]; o1[4 * g + e] *= al[e]; } } \
                LDS_WAIT(); \
            } \
            float rs = 0.f; \
        _Pragma("unroll") \
            for (int i = 0; i < 16; ++i) { p0[i] = __builtin_amdgcn_exp2f(p0[i]); p1[i] = __builtin_amdgcn_exp2f(p1[i]); rs += p0[i] + p1[i]; } \
            l_run += rs; \
        _Pragma("unroll") \
            for (int half = 0; half < 2; ++half) \
        _Pragma("unroll") \
                for (int s2 = 0; s2 < 2; ++s2) { \
                    const f32x16& P = half ? p1 : p0; \
                    const bf16x8 pa = pack8(P[8 * s2], P[8 * s2 + 1], P[8 * s2 + 2], P[8 * s2 + 3], P[8 * s2 + 4], P[8 * s2 + 5], P[8 * s2 + 6], P[8 * s2 + 7]); \
                    const int kvo = (32 * half + 16 * s2 + 4 * hh) * 2; \
                    { const s16x4 lo = *(const LAS s16x4*)(vb + r * ATT_VPITCH + kvo), hi = *(const LAS s16x4*)(vb + r * ATT_VPITCH + kvo + 16); \
                      const bf16x8 vf = __builtin_shufflevector(lo, hi, 0, 1, 2, 3, 4, 5, 6, 7); o0 = MFMA32(pa, vf, o0); } \
                    { const s16x4 lo = *(const LAS s16x4*)(vb + (r + 32) * ATT_VPITCH + kvo), hi = *(const LAS s16x4*)(vb + (r + 32) * ATT_VPITCH + kvo + 16); \
                      const bf16x8 vf = __builtin_shufflevector(lo, hi, 0, 1, 2, 3, 4, 5, 6, 7); o1 = MFMA32(pa, vf, o1); } \
                } \
        } \
        if (t + 1 < NT) ATT_STORE((BUFI) ^ 1, K0, K1, V); \
        __syncthreads(); } while (0)
    for (int t2 = 0; t2 < NT; t2 += 2) {
        MLA_ITER(t2, 0, ka0, ka1, va);
        MLA_ITER(t2 + 1, 1, ka0, ka1, va);
    }
#undef MLA_ITER
    const float l_tot = l_run + __shfl_xor(l_run, 32);
    if (hh == 0) wsf[r] = 1.f / l_tot;
    LDS_WAIT();
#pragma unroll
    for (int g = 0; g < 4; ++g) { const f32x4 rl = *(const LAS f32x4*)(wsf + 8 * g + 4 * hh);
#pragma unroll
        for (int e = 0; e < 4; ++e) { const int i = 4 * g + e; bf16_t* op = O + (rowbase + qw + crow(i, hh)) * 512 + h * 64 + r;
            op[0] = (bf16_t)(cvt_pk_bf16(o0[i] * rl[e], 0.f) & 0xffffu); op[32] = (bf16_t)(cvt_pk_bf16(o1[i] * rl[e], 0.f) & 0xffffu); } }
    LDS_WAIT();
#undef ATT_LOAD
#undef ATT_STORE
}

__device__ __forceinline__ void sb_unit(LAS unsigned char* lds, const bf16_t* SBQ, bf16_t* O, int b, int h, int qb) {
    const int tid = threadIdx.x, lane = tid & 63, r = lane & 31, hh = lane >> 5; const int wid = __builtin_amdgcn_readfirstlane(tid >> 6);
    const size_t rowbase = (size_t)b * SEQ; const int q0 = qb * 256, qw = q0 + 32 * wid;
    const int NT = (q0 >> 6) + 4;
    constexpr float C2 = 0.125f * LOG2E;
    bf16x8 qf[4];
    { const bf16_t* qp = SBQ + (rowbase + qw + r) * 1536 + h * 64 + hh * 8;
#pragma unroll
      for (int s = 0; s < 4; ++s) qf[s] = *(const bf16x8*)(qp + 16 * s); }
    const int lkv = tid & 63, lc = tid >> 6;
    const bf16_t* kg0 = SBQ + (rowbase + lkv) * 1536 + 512 + h * 64 + lc * 8;
    const bf16_t* vg = SBQ + (rowbase + lkv) * 1536 + 1024 + h * 64 + lc * 8;
    u32x4 ka0, va, kb0, vb2;
#define ATT_LOAD(t, K0, V) do { K0 = *(const u32x4*)(kg0 + (size_t)(t) * 64 * 1536); V = *(const u32x4*)(vg + (size_t)(t) * 64 * 1536); } while (0)
#define ATT_STORE(bufi, K0, V) do { LAS unsigned char* kb_ = lds + (bufi) * ATT_BUF; *(LAS u32x4*)(kb_ + tid * 16) = K0; \
        LAS unsigned char* vb_ = kb_ + ATT_KBYTES + (lc * 8) * ATT_VPITCH + lkv * 2; \
        _Pragma("unroll") for (int j_ = 0; j_ < 8; ++j_) *(LAS unsigned short*)(vb_ + j_ * ATT_VPITCH) = (unsigned short)(V[j_ >> 1] >> (16 * (j_ & 1))); } while (0)
    LAS unsigned* dflag = (LAS unsigned*)(lds + ATT_WS + 8 * 256);
    ATT_LOAD(NT - 1, ka0, va); ATT_STORE(0, ka0, va); __syncthreads();
    ATT_LOAD(NT - 2, kb0, vb2); ATT_LOAD(NT - 3, ka0, va);
    float carry = 0.f; bool wdone = false;
    f32x16 o0, o1;
#pragma unroll
    for (int i = 0; i < 16; ++i) { o0[i] = 0.f; o1[i] = 0.f; }
#define SB_SUB(X, kvh0, kvl) do { const bool diag_ = ((kvh0) == qw); float lk_[16], z_[16]; \
        _Pragma("unroll") for (int i = 0; i < 16; ++i) { const float z2 = X[i] * C2; const float ex = __builtin_amdgcn_exp2f(z2); float sp = __builtin_amdgcn_logf(1.f + ex); sp = z2 > 64.f ? z2 : sp; \
            const bool valid = !diag_ || (crow(i, hh) < r); lk_[i] = valid ? -sp : 0.f; z_[i] = z2; } \
        float G_[4], Gp_[4]; \
        _Pragma("unroll") for (int g = 0; g < 4; ++g) { G_[g] = (lk_[4 * g] + lk_[4 * g + 1]) + (lk_[4 * g + 2] + lk_[4 * g + 3]); Gp_[g] = __shfl_xor(G_[g], 32); } \
        float tail_[4]; tail_[3] = 0.f; tail_[2] = G_[3] + Gp_[3]; tail_[1] = tail_[2] + (G_[2] + Gp_[2]); tail_[0] = tail_[1] + (G_[1] + Gp_[1]); const float total_ = tail_[0] + (G_[0] + Gp_[0]); \
        float a_[16]; \
        _Pragma("unroll") for (int g = 0; g < 4; ++g) { const float base_ = carry + tail_[g] + (hh == 0 ? Gp_[g] : 0.f); \
            const float s3 = base_ + lk_[4 * g + 3], s2_ = s3 + lk_[4 * g + 2], s1 = s2_ + lk_[4 * g + 1], s0 = s1 + lk_[4 * g]; \
            a_[4 * g + 3] = __builtin_amdgcn_exp2f(z_[4 * g + 3] + s3); a_[4 * g + 2] = __builtin_amdgcn_exp2f(z_[4 * g + 2] + s2_); a_[4 * g + 1] = __builtin_amdgcn_exp2f(z_[4 * g + 1] + s1); a_[4 * g] = __builtin_amdgcn_exp2f(z_[4 * g] + s0); } \
        if (diag_) { _Pragma("unroll") for (int i = 0; i < 16; ++i) a_[i] = (crow(i, hh) < r) ? a_[i] : 0.f; } \
        carry += total_; \
        _Pragma("unroll") for (int s2 = 0; s2 < 2; ++s2) { \
            const bf16x8 pa = pack8(a_[8 * s2], a_[8 * s2 + 1], a_[8 * s2 + 2], a_[8 * s2 + 3], a_[8 * s2 + 4], a_[8 * s2 + 5], a_[8 * s2 + 6], a_[8 * s2 + 7]); \
            const int kvo = ((kvl) + 16 * s2 + 4 * hh) * 2; \
            { const s16x4 lo = *(const LAS s16x4*)(vb + r * ATT_VPITCH + kvo), hi = *(const LAS s16x4*)(vb + r * ATT_VPITCH + kvo + 16); \
              const bf16x8 vf = __builtin_shufflevector(lo, hi, 0, 1, 2, 3, 4, 5, 6, 7); o0 = MFMA32(pa, vf, o0); } \
            { const s16x4 lo = *(const LAS s16x4*)(vb + (r + 32) * ATT_VPITCH + kvo), hi = *(const LAS s16x4*)(vb + (r + 32) * ATT_VPITCH + kvo + 16); \
              const bf16x8 vf = __builtin_shufflevector(lo, hi, 0, 1, 2, 3, 4, 5, 6, 7); o1 = MFMA32(pa, vf, o1); } } } while (0)
    bool alldone = false;
#define SB_ITER(it_, BUFI, K0, V) do { const int it = (it_), t = NT - 1 - it, kv0 = 64 * t; \
        if (kv0 <= qw && !wdone) { \
            const LAS unsigned char* kb = lds + (BUFI) * ATT_BUF; const LAS unsigned char* vb = kb + ATT_KBYTES; \
            const bool upper = (kv0 + 32 <= qw); \
            f32x16 p0, p1; \
        _Pragma("unroll") \
            for (int i = 0; i < 16; ++i) { p0[i] = 0.f; p1[i] = 0.f; } \
        _Pragma("unroll") \
            for (int s = 0; s < 4; ++s) { const bf16x8 a0 = *(const LAS bf16x8*)(kb + (2 * s + hh) * 1024 + r * 16); p0 = MFMA32(a0, qf[s], p0); } \
            if (upper) { \
        _Pragma("unroll") \
                for (int s = 0; s < 4; ++s) { const bf16x8 a1 = *(const LAS bf16x8*)(kb + (2 * s + hh) * 1024 + (r + 32) * 16); p1 = MFMA32(a1, qf[s], p1); } \
                SB_SUB(p1, kv0 + 32, 32); \
            } \
            SB_SUB(p0, kv0, 0); \
            wdone = __all(carry < -170.f) != 0; \
        } \
        if (lane == 0) dflag[(BUFI) * 8 + wid] = wdone ? 1u : 0u; \
        if (t > 0) ATT_STORE((BUFI) ^ 1, K0, V); \
        if (t > 2) ATT_LOAD(t - 3, K0, V); \
        __syncthreads(); \
        { const u32x4 f0 = *(const LAS u32x4*)(dflag + (BUFI) * 8), f1 = *(const LAS u32x4*)(dflag + (BUFI) * 8 + 4); \
          alldone = (f0.x & f0.y & f0.z & f0.w & f1.x & f1.y & f1.z & f1.w) != 0u; } } while (0)
    for (int i2 = 0; i2 < NT; i2 += 2) {
        SB_ITER(i2, 0, kb0, vb2); if (alldone) break;
        SB_ITER(i2 + 1, 1, ka0, va); if (alldone) break;
    }
#undef SB_ITER
    __syncthreads();
#pragma unroll
    for (int i = 0; i < 16; ++i) { bf16_t* op = O + (rowbase + qw + crow(i, hh)) * 512 + h * 64 + r;
        op[0] = (bf16_t)(cvt_pk_bf16(o0[i], 0.f) & 0xffffu); op[32] = (bf16_t)(cvt_pk_bf16(o1[i], 0.f) & 0xffffu); }
#undef SB_SUB
#undef ATT_LOAD
#undef ATT_STORE
}

#ifndef PHMASK
#define PHMASK 0xFFFF
#endif
#define PH(n) ((PHMASK >> (n)) & 1)
#ifndef DUPMASK
#define DUPMASK 0
#endif
#define DUP(n) (1 + ((DUPMASK >> (n)) & 1))
struct Args { const void* in[23]; float* out; unsigned char* ws; };

__global__ void __launch_bounds__(512, 2) fwd_kernel(Args args) {
    extern __shared__ __attribute__((aligned(16))) unsigned char lds_raw[];
    LAS unsigned char* lds = (LAS unsigned char*)lds_raw;
    const int tid = threadIdx.x, lane = tid & 63, wave = __builtin_amdgcn_readfirstlane(tid >> 6);
    const int G = gridDim.x; const int bx = blockIdx.x; const int vcu = (G % 8 == 0) ? (bx % 8) * (G / 8) + bx / 8 : bx;
    const int gw = vcu * 8 + wave, NGW = G * 8;
    unsigned char* ws = args.ws;
    unsigned* ctl = (unsigned*)(ws + WS_CTL);
    const float* x = (const float*)args.in[0]; const float* cvec = (const float*)args.in[1]; const int* positions = (const int*)args.in[2];
    const float* w_ada = (const float*)args.in[3]; const float* b_ada = (const float*)args.in[4]; const float* g_norm1 = (const float*)args.in[5];
    const float* w_in = (const float*)args.in[6]; const float* g_q_lat = (const float*)args.in[7]; const float* w_uq = (const float*)args.in[8];
    const float* g_kv_lat = (const float*)args.in[9]; const float* w_ukv = (const float*)args.in[10]; const float* g_qk_q = (const float*)args.in[11];
    const float* g_qk_k = (const float*)args.in[12]; const float* w_o_mla = (const float*)args.in[13]; const float* w_o_sb = (const float*)args.in[14];
    const float* w_out = (const float*)args.in[15]; const float* g_norm2 = (const float*)args.in[16]; const float* w_router = (const float*)args.in[17];
    const float* b_router = (const float*)args.in[18]; const float* w_gate_up = (const float*)args.in[19]; const float* b_gate_up = (const float*)args.in[20];
    const float* w_down = (const float*)args.in[21]; const float* b_down = (const float*)args.in[22];
    float* out = args.out;
    bf16_t* WIN = (bf16_t*)(ws + WS_WIN); bf16_t* WUQ = (bf16_t*)(ws + WS_WUQ); bf16_t* WUKV = (bf16_t*)(ws + WS_WUKV); bf16_t* WOM = (bf16_t*)(ws + WS_WOM);
    bf16_t* WOS = (bf16_t*)(ws + WS_WOS); bf16_t* WOUT = (bf16_t*)(ws + WS_WOUT); float* MOD = (float*)(ws + WS_MOD);
    unsigned char* WIN8 = ws + WS_WIN8; unsigned char* H8 = ws + WS_H8; unsigned char* M8 = ws + WS_M8; unsigned char* WOUT8 = ws + WS_WOUT;
    bf16_t* HB = (bf16_t*)(ws + WS_H); bf16_t* KVRAW = (bf16_t*)(ws + WS_KVRAW); bf16_t* MERGED = (bf16_t*)(ws + WS_MERGED);
    bf16_t* SGA = (bf16_t*)(ws + WS_SGA); bf16_t* SGB = (bf16_t*)(ws + WS_SGB); unsigned char* H2 = ws + WS_H2;
    unsigned char* WGU = ws + WS_WGU; unsigned char* WDN = ws + WS_WDN; bf16_t* SBQ = (bf16_t*)(ws + WS_SB);
    int* TOKL = (int*)(ws + WS_TOKL); float* WLST = (float*)(ws + WS_WL); unsigned char* HID = ws + WS_HID;
    bf16_t* QL = (bf16_t*)(ws + WS_QL); bf16_t* KVL = (bf16_t*)(ws + WS_KVL); bf16_t* KPE = (bf16_t*)(ws + WS_KPE);
    bf16_t* QB = (bf16_t*)(ws + WS_Q); bf16_t* KB = (bf16_t*)(ws + WS_K); bf16_t* OMLA = (bf16_t*)(ws + WS_OMLA); bf16_t* OSB = (bf16_t*)(ws + WS_OSB);

    for (int u = tid; u < (LDS_BYTES - LDSCTL_OFF) / 4; u += 512) ((LAS unsigned*)(lds + LDSCTL_OFF))[u] = 0u;
    __syncthreads();
    XcdBarrier bar = xcd_barrier_post(ctl + CW_BAR, (volatile LAS unsigned*)(lds + LDSCTL_OFF + LC_BARST));
    LAS float* scr = (LAS float*)(lds + wave * 16384);

#if PH(0)
    {
        constexpr int I_IN = 16 * 133, I_UQ = 6 * 24, I_UKV = 4 * 32, I_OM = 8 * 32, I_OS = 8 * 32, I_OUT = 16 * 32;
        constexpr int NIT = I_IN + I_UQ + I_UKV + I_OM + I_OS + I_OUT;
        for (int it = gw; it < NIT; it += NGW) {
            int q = it;
            if (q < I_IN) { const int kb = q / 133, nb = q % 133, n0 = 32 * nb;
                if (nb < 69) transpose_item(w_in, 1024, DIN, WIN, 64 * kb, n0, n0 < 672 ? n0 : n0 + 96, scr, lane);
                else transpose_item_f8(w_in, 1024, DIN, WIN8, 64 * kb, n0, n0 - 2208, WSCALE, scr, lane);
                continue; } q -= I_IN;
            if (q < I_UQ) { const int kb = q / 24, nb = q % 24; transpose_item(w_uq, 384, 768, WUQ, 64 * kb, 32 * nb, 32 * nb, scr, lane); continue; } q -= I_UQ;
            if (q < I_UKV) { const int kb = q / 32, nb = q % 32; transpose_item(w_ukv, 256, 1024, WUKV, 64 * kb, 32 * nb, 32 * nb, scr, lane); continue; } q -= I_UKV;
            if (q < I_OM) { const int kb = q / 32, nb = q % 32; transpose_item(w_o_mla, 512, 1024, WOM, 64 * kb, 32 * nb, 32 * nb, scr, lane); continue; } q -= I_OM;
            if (q < I_OS) { const int kb = q / 32, nb = q % 32; transpose_item(w_o_sb, 512, 1024, WOS, 64 * kb, 32 * nb, 32 * nb, scr, lane); continue; } q -= I_OS;
            { const int kb = q / 32, nb = q % 32; transpose_item_f8(w_out, 1024, 1024, WOUT8, 64 * kb, 32 * nb, 32 * nb, WSCALE, scr, lane); }
        }
        for (int i = vcu * 512 + tid; i < 96 * 1024 * 2 / 16; i += G * 512) ((u32x4*)(WIN + 672 * 1024))[i] = (u32x4){0u, 0u, 0u, 0u};
        __syncthreads();
        for (int it = vcu; it < 6144 / 64; it += G) {
            for (int idx = lane; idx < 32 * 128; idx += 64) { const int b = idx >> 7, kk = idx & 127; const float cv = cvec[b * 1024 + 128 * wave + kk]; scr[idx] = cv / (1.f + __expf(-cv)); }
            LDS_WAIT(); asm volatile("" ::: "memory");
            float acc[32];
#pragma unroll
            for (int b = 0; b < 32; ++b) acc[b] = 0.f;
            const float* wp = w_ada + (size_t)(128 * wave) * 6144 + 64 * it + lane;
            float wc[8];
#pragma unroll
            for (int j = 0; j < 8; ++j) wc[j] = wp[(size_t)j * 6144];
#pragma nounroll
            for (int k8 = 0; k8 < 16; ++k8) {
                float wn[8];
                const int kn = k8 < 15 ? k8 + 1 : k8;
#pragma unroll
                for (int j = 0; j < 8; ++j) wn[j] = wp[(size_t)(8 * kn + j) * 6144];
#pragma unroll
                for (int j4 = 0; j4 < 2; ++j4) {
#pragma unroll
                    for (int b = 0; b < 32; ++b) { const f32x4 s = *(const LAS f32x4*)(scr + b * 128 + 8 * k8 + 4 * j4); acc[b] += s.x * wc[4 * j4] + s.y * wc[4 * j4 + 1] + s.z * wc[4 * j4 + 2] + s.w * wc[4 * j4 + 3];
                        if ((b & 7) == 7) asm volatile("" ::: "memory"); } }
#pragma unroll
                for (int j = 0; j < 8; ++j) wc[j] = wn[j];
            }
            LDS_WAIT(); asm volatile("" ::: "memory");
#pragma unroll
            for (int b = 0; b < 32; ++b) scr[b * 64 + lane] = acc[b];
            __syncthreads();
#pragma unroll
            for (int bb = 0; bb < 4; ++bb) { const int b = 4 * wave + bb; float s = 0.f;
#pragma unroll
                for (int w2 = 0; w2 < 8; ++w2) s += ((const LAS float*)(lds + w2 * 16384))[b * 64 + lane];
                MOD[b * 6144 + 64 * it + lane] = s + b_ada[64 * it + lane]; }
            __syncthreads();
        }
    }
#endif
    xcd_barrier(bar);

#if PH(1)
    for (int gi = gw; gi < NTOK / 4; gi += NGW) {
        f32x4 v[4][4];
#pragma unroll
        for (int rr = 0; rr < 4; ++rr) { const f32x4* xr = (const f32x4*)(x + (size_t)(4 * gi + rr) * 1024) + lane;
#pragma unroll
            for (int j = 0; j < 4; ++j) v[rr][j] = xr[64 * j]; }
        const int b = (4 * gi) >> 11;
        const float* mb = MOD + (size_t)b * 6144;
        f32x4 gsc[4], shv[4];
#pragma unroll
        for (int j = 0; j < 4; ++j) { const int col = 4 * lane + 256 * j; gsc[j] = *(const f32x4*)(g_norm1 + col) * (*(const f32x4*)(mb + 1024 + col) + 1.f); shv[j] = *(const f32x4*)(mb + col); }
#pragma unroll
        for (int rr = 0; rr < 4; ++rr) { float ss = 0.f;
#pragma unroll
            for (int j = 0; j < 4; ++j) ss += (v[rr][j].x * v[rr][j].x + v[rr][j].y * v[rr][j].y) + (v[rr][j].z * v[rr][j].z + v[rr][j].w * v[rr][j].w);
            const float rstd = rsqrtf(wave_sum(ss) * (1.f / 1024.f) + EPS);
#pragma unroll
            for (int j = 0; j < 4; ++j) { const int col = 4 * lane + 256 * j; const f32x4 y = (v[rr][j] * rstd) * gsc[j] + shv[j];
                u32x2 o; o.x = cvt_pk_bf16(y.x, y.y); o.y = cvt_pk_bf16(y.z, y.w);
                *(u32x2*)(HB + (size_t)(4 * gi + rr) * 1024 + col) = o;
                *(unsigned*)(H8 + (size_t)(4 * gi + rr) * 1024 + col) = pk4_fp8(y.x, y.y, y.z, y.w); } }
    }
#endif
    xcd_barrier(bar);

#if PH(2)
    { pg8::DenseOrder S; S.init(HB, WIN, NTOK, 2304, 1024, G, bx);
      EpiProj E{QL, KVL, KPE, SBQ, SGA, SGB, 0, 1.f};
      pg8::gemm_phase<false>(lds, 1024, S, E); }
    { pg8::DenseOrder S; S.init(H8, WIN8, NTOK, 2048, 512, G, bx);
      EpiProj E{QL, KVL, KPE, SBQ, SGA, SGB, 2304, WDESCALE};
      pg8::gemm_phase_f8<false>(lds, 512, S, E); }
#endif
    xcd_barrier(bar);

#if PH(3)
    {
        f32x4 gq0 = (f32x4){0.f, 0.f, 0.f, 0.f}, gq1 = gq0, gk0 = gq0, gk1 = gq0;
        if (lane < 48) { gq0 = *(const f32x4*)(g_q_lat + lane * 8); gq1 = *(const f32x4*)(g_q_lat + lane * 8 + 4); }
        if (lane < 32) { gk0 = *(const f32x4*)(g_kv_lat + lane * 8); gk1 = *(const f32x4*)(g_kv_lat + lane * 8 + 4); }
        for (int gi = gw; gi < NTOK / 4; gi += NGW) {
            u32x4 vq[4], vk[4];
#pragma unroll
            for (int rr = 0; rr < 4; ++rr) { vq[rr] = (u32x4){0u, 0u, 0u, 0u}; vk[rr] = vq[rr];
                if (lane < 48) vq[rr] = *(const u32x4*)(QL + (size_t)(4 * gi + rr) * 384 + lane * 8);
                if (lane < 32) vk[rr] = *(const u32x4*)(KVL + (size_t)(4 * gi + rr) * 256 + lane * 8); }
#pragma unroll
            for (int rr = 0; rr < 4; ++rr) {
                { const u32x4 v = vq[rr]; float f[8] = {bf_lo(v.x), bf_hi(v.x), bf_lo(v.y), bf_hi(v.y), bf_lo(v.z), bf_hi(v.z), bf_lo(v.w), bf_hi(v.w)}; float ss = 0.f;
#pragma unroll
                  for (int j = 0; j < 8; ++j) ss += f[j] * f[j];
                  const float rstd = rsqrtf(wave_sum(ss) * (1.f / 384.f) + EPS);
                  if (lane < 48) { u32x4 o; o.x = cvt_pk_bf16(f[0] * rstd * gq0.x, f[1] * rstd * gq0.y); o.y = cvt_pk_bf16(f[2] * rstd * gq0.z, f[3] * rstd * gq0.w);
                      o.z = cvt_pk_bf16(f[4] * rstd * gq1.x, f[5] * rstd * gq1.y); o.w = cvt_pk_bf16(f[6] * rstd * gq1.z, f[7] * rstd * gq1.w); *(u32x4*)(QL + (size_t)(4 * gi + rr) * 384 + lane * 8) = o; } }
                { const u32x4 v = vk[rr]; float f[8] = {bf_lo(v.x), bf_hi(v.x), bf_lo(v.y), bf_hi(v.y), bf_lo(v.z), bf_hi(v.z), bf_lo(v.w), bf_hi(v.w)}; float ss = 0.f;
#pragma unroll
                  for (int j = 0; j < 8; ++j) ss += f[j] * f[j];
                  const float rstd = rsqrtf(wave_sum(ss) * (1.f / 256.f) + EPS);
                  if (lane < 32) { u32x4 o; o.x = cvt_pk_bf16(f[0] * rstd * gk0.x, f[1] * rstd * gk0.y); o.y = cvt_pk_bf16(f[2] * rstd * gk0.z, f[3] * rstd * gk0.w);
                      o.z = cvt_pk_bf16(f[4] * rstd * gk1.x, f[5] * rstd * gk1.y); o.w = cvt_pk_bf16(f[6] * rstd * gk1.z, f[7] * rstd * gk1.w); *(u32x4*)(KVL + (size_t)(4 * gi + rr) * 256 + lane * 8) = o; } }
            }
        }
    }
#endif
    xcd_barrier(bar);

#if PH(4)
    for (int rep = 0; rep < DUP(5); ++rep) {
    { pg8::DenseOrder S; S.init(QL, WUQ, NTOK, 768, 384, G, bx); EpiStore E{QB, 768}; pg8::gemm_phase<false>(lds, 384, S, E); }
    { pg8::DenseOrder S; S.init(KVL, WUKV, NTOK, 1024, 256, G, bx); EpiStore E{KVRAW, 1024}; pg8::gemm_phase<false>(lds, 256, S, E); } }
#endif
    xcd_barrier(bar);

#if PH(5)
    {
        const int hd = lane >> 3, sub = lane & 7;
        const float QSC = 0.10206207261596575f * LOG2E;
        const float if0 = exp2f(-(float)(2 * sub) * (13.287712379549449f / 16.f)), if1 = exp2f(-(float)(2 * sub + 1) * (13.287712379549449f / 16.f));
        f32x4 gq0 = *(const f32x4*)(g_qk_q + sub * 8), gq1 = *(const f32x4*)(g_qk_q + sub * 8 + 4); const f32x2 gqa = *(const f32x2*)(g_qk_q + 64 + 2 * sub), gqb = *(const f32x2*)(g_qk_q + 80 + 2 * sub);
        f32x4 gk0 = *(const f32x4*)(g_qk_k + sub * 8), gk1 = *(const f32x4*)(g_qk_k + sub * 8 + 4); const f32x2 gka = *(const f32x2*)(g_qk_k + 64 + 2 * sub), gkb = *(const f32x2*)(g_qk_k + 80 + 2 * sub);
        for (int gi = gw; gi < NTOK / 4; gi += NGW) {
            u32x4 A[4][2]; unsigned B1[4][2], B2[4][2]; float posf[4];
#pragma unroll
            for (int t = 0; t < 4; ++t) { const int m = 4 * gi + t; posf[t] = (float)positions[m];
                const bf16_t* qp = QB + (size_t)m * 768 + hd * 96; A[t][0] = *(const u32x4*)(qp + sub * 8); B1[t][0] = *(const unsigned*)(qp + 64 + 2 * sub); B2[t][0] = *(const unsigned*)(qp + 80 + 2 * sub);
                A[t][1] = *(const u32x4*)(KVRAW + (size_t)m * 1024 + hd * 128 + sub * 8); B1[t][1] = *(const unsigned*)(KPE + (size_t)m * 32 + 2 * sub); B2[t][1] = *(const unsigned*)(KPE + (size_t)m * 32 + 16 + 2 * sub); }
#pragma unroll
            for (int t = 0; t < 4; ++t) { const int m = 4 * gi + t;
                float cs[2], sn[2];
                { const float a0 = posf[t] * if0, a1 = posf[t] * if1;
                  double r0 = (double)a0 * 0.15915494309189535, r1 = (double)a1 * 0.15915494309189535; r0 -= __builtin_rint(r0); r1 -= __builtin_rint(r1);
                  cs[0] = __builtin_amdgcn_cosf((float)r0); sn[0] = __builtin_amdgcn_sinf((float)r0); cs[1] = __builtin_amdgcn_cosf((float)r1); sn[1] = __builtin_amdgcn_sinf((float)r1); }
#pragma unroll
                for (int which = 0; which < 2; ++which) {
                    const u32x4 Av = A[t][which]; const unsigned b1 = B1[t][which], b2 = B2[t][which];
                    bf16_t* dst = which ? KB + (size_t)m * 768 + hd * 96 : QB + (size_t)m * 768 + hd * 96;
                    float f[8] = {bf_lo(Av.x), bf_hi(Av.x), bf_lo(Av.y), bf_hi(Av.y), bf_lo(Av.z), bf_hi(Av.z), bf_lo(Av.w), bf_hi(Av.w)};
                    float x1[2] = {bf_lo(b1), bf_hi(b1)}, x2[2] = {bf_lo(b2), bf_hi(b2)};
                    float ss = x1[0] * x1[0] + x1[1] * x1[1] + x2[0] * x2[0] + x2[1] * x2[1];
#pragma unroll
                    for (int j = 0; j < 8; ++j) ss += f[j] * f[j];
                    ss += __shfl_xor(ss, 1); ss += __shfl_xor(ss, 2); ss += __shfl_xor(ss, 4);
                    const float rstd = rsqrtf(ss * (1.f / 96.f) + EPS);
                    const f32x4 g0 = which ? gk0 : gq0, g1 = which ? gk1 : gq1; const f32x2 ga = which ? gka : gqa, gb = which ? gkb : gqb;
                    const float sc = which ? 1.f : QSC;
                    float y[8] = {f[0] * rstd * g0.x, f[1] * rstd * g0.y, f[2] * rstd * g0.z, f[3] * rstd * g0.w, f[4] * rstd * g1.x, f[5] * rstd * g1.y, f[6] * rstd * g1.z, f[7] * rstd * g1.w};
                    const float y1a = x1[0] * rstd * ga.x, y1b = x1[1] * rstd * ga.y, y2a = x2[0] * rstd * gb.x, y2b = x2[1] * rstd * gb.y;
                    const float o1a = y1a * cs[0] - y2a * sn[0], o1b = y1b * cs[1] - y2b * sn[1], o2a = y2a * cs[0] + y1a * sn[0], o2b = y2b * cs[1] + y1b * sn[1];
                    u32x4 o; o.x = cvt_pk_bf16(y[0] * sc, y[1] * sc); o.y = cvt_pk_bf16(y[2] * sc, y[3] * sc); o.z = cvt_pk_bf16(y[4] * sc, y[5] * sc); o.w = cvt_pk_bf16(y[6] * sc, y[7] * sc);
                    *(u32x4*)(dst + sub * 8) = o; *(unsigned*)(dst + 64 + 2 * sub) = cvt_pk_bf16(o1a * sc, o1b * sc); *(unsigned*)(dst + 80 + 2 * sub) = cvt_pk_bf16(o2a * sc, o2b * sc);
                }
            }
        }
    }
#endif
    xcd_barrier(bar);

#if PH(6)
    for (int bh = vcu; bh < NB * NH; bh += G) {
        for (int rep = 0; rep < DUP(0); ++rep) for (int qb = 0; qb < 8; ++qb) mla_unit(lds, QB, KB, KVRAW, OMLA, bh >> 3, bh & 7, qb);
        for (int rep = 0; rep < DUP(1); ++rep) for (int qb = 0; qb < 8; ++qb) sb_unit(lds, SBQ, OSB, bh >> 3, bh & 7, qb);
    }
#endif
    xcd_barrier(bar);

#if PH(8)
    for (int rep = 0; rep < DUP(6); ++rep) {
    { pg8::DenseOrder S; S.init(OMLA, WOM, NTOK, 1024, 512, G, bx); EpiMerge<false> E{MERGED, SGA, M8}; pg8::gemm_phase<false>(lds, 512, S, E); }
    { pg8::DenseOrder S; S.init(OSB, WOS, NTOK, 1024, 512, G, bx); EpiMerge<true> E{MERGED, SGB, M8}; pg8::gemm_phase<false>(lds, 512, S, E); } }
#endif
    xcd_barrier(bar);

#if PH(9)
    { pg8::DenseOrder S; S.init(M8, WOUT8, NTOK, 1024, 512, G, bx); EpiWout E{x, out, MOD, WDESCALE}; pg8::gemm_phase_f8<false>(lds, 512, S, E); }
#endif
    xcd_barrier(bar);

#if PH(10)
    {
        constexpr int I_GU = 16 * 64, I_DN = 16 * 32;
        for (int rep = 0; rep < DUP(2); ++rep) for (int it = gw; it < NE * (I_GU + I_DN); it += NGW) {
            if (it < NE * I_GU) { const int e = it / I_GU, q = it % I_GU, kb = q / 64, nb = q % 64, n0 = 32 * nb; const int g = n0 >> 10, jj = n0 & 1023;
                transpose_item_f8(w_gate_up + (size_t)e * 1024 * 2048, 1024, 2048, WGU + (size_t)e * 2048 * 1024, 64 * kb, n0, 256 * (jj >> 7) + 128 * g + (jj & 127), WSCALE, scr, lane); }
            else { const int r2 = it - NE * I_GU, e = r2 / I_DN, q = r2 % I_DN, kb = q / 32, nb = q % 32;
                transpose_item_f8(w_down + (size_t)e * 1024 * 1024, 1024, 1024, WDN + (size_t)e * 1024 * 1024, 64 * kb, 32 * nb, 32 * nb, WSCALE, scr, lane); }
        }
        __syncthreads();
        {
            const int r = lane & 31, hh = lane >> 5;
            constexpr int TP = 1026;
            LAS float* tile = (LAS float*)lds;
            float areg[64];
#pragma unroll
            for (int mm = 0; mm < 64; ++mm) areg[mm] = w_router[(size_t)(128 * wave + 4 * (mm >> 1) + 2 * hh + (mm & 1)) * 32 + r];
            const float br = b_router[r];
            for (int tt = vcu; tt < NTOK / 32; tt += G) {
                { f32x4 v[4][4];
#pragma unroll
                  for (int rr = 0; rr < 4; ++rr) { const f32x4* xr = (const f32x4*)(out + (size_t)(32 * tt + 4 * wave + rr) * 1024) + lane;
#pragma unroll
                      for (int j = 0; j < 4; ++j) v[rr][j] = xr[64 * j]; }
                  const float* mb = MOD + (size_t)((32 * tt) >> 11) * 6144;
                  f32x4 gsc[4], shv[4];
#pragma unroll
                  for (int j = 0; j < 4; ++j) { const int col = 4 * lane + 256 * j; gsc[j] = *(const f32x4*)(g_norm2 + col) * (*(const f32x4*)(mb + 4096 + col) + 1.f); shv[j] = *(const f32x4*)(mb + 3072 + col); }
#pragma unroll
                  for (int rr = 0; rr < 4; ++rr) { float ss = 0.f; const int row = 4 * wave + rr;
#pragma unroll
                      for (int j = 0; j < 4; ++j) ss += (v[rr][j].x * v[rr][j].x + v[rr][j].y * v[rr][j].y) + (v[rr][j].z * v[rr][j].z + v[rr][j].w * v[rr][j].w);
                      const float rstd = rsqrtf(wave_sum(ss) * (1.f / 1024.f) + EPS);
#pragma unroll
                      for (int j = 0; j < 4; ++j) { const int col = 4 * lane + 256 * j; const f32x4 y = (v[rr][j] * rstd) * gsc[j] + shv[j];
                          *(unsigned*)(H2 + (size_t)(32 * tt + row) * 1024 + col) = pk4_fp8(y.x, y.y, y.z, y.w);
                          *(LAS f32x2*)(tile + row * TP + col) = (f32x2){y.x, y.y}; *(LAS f32x2*)(tile + row * TP + col + 2) = (f32x2){y.z, y.w}; } } }
                __syncthreads();
                f32x16 acc;
#pragma unroll
                for (int i = 0; i < 16; ++i) acc[i] = 0.f;
#pragma unroll
                for (int sg = 0; sg < 32; ++sg) { const f32x2 hv = *(const LAS f32x2*)(tile + r * TP + 128 * wave + 4 * sg + 2 * hh);
                    acc = __builtin_amdgcn_mfma_f32_32x32x2f32(areg[2 * sg], hv.x, acc, 0, 0, 0); acc = __builtin_amdgcn_mfma_f32_32x32x2f32(areg[2 * sg + 1], hv.y, acc, 0, 0, 0); }
                __syncthreads();
#pragma unroll
                for (int i = 0; i < 16; ++i) tile[wave * 1024 + i * 64 + lane] = acc[i];
                __syncthreads();
                { const int e = r, he = (e >> 2) & 1, ie = (e & 3) + 4 * (e >> 3);
#pragma unroll
                  for (int rr = 0; rr < 4; ++rr) { const int row = 4 * wave + rr; float v = br;
#pragma unroll
                      for (int w2 = 0; w2 < 8; ++w2) v += tile[w2 * 1024 + ie * 64 + row + 32 * he];
                      float tv[4]; int te[4];
#pragma unroll
                      for (int k = 0; k < 4; ++k) { float bv = v; int bi = e;
#pragma unroll
                          for (int off = 16; off >= 1; off >>= 1) { const float ov = __shfl_xor(bv, off); const int oi = __shfl_xor(bi, off); if (ov > bv || (ov == bv && oi < bi)) { bv = ov; bi = oi; } }
                          tv[k] = bv; te[k] = bi; if (e == bi) v = -INFINITY; }
                      const float e1 = __expf(tv[1] - tv[0]), e2 = __expf(tv[2] - tv[0]), e3 = __expf(tv[3] - tv[0]); const float inv = 1.f / (1.f + e1 + e2 + e3);
                      if (lane < 4) { const int k = lane; const int ek = k == 0 ? te[0] : k == 1 ? te[1] : k == 2 ? te[2] : te[3]; const float wk = (k == 0 ? 1.f : k == 1 ? e1 : k == 2 ? e2 : e3) * inv;
                          const unsigned slot = atomicAdd(ctl + CW_CNT + (k * 32 + ek) * 16, 1u);
                          TOKL[(size_t)(k * 32 + ek) * LISTCAP + slot] = 32 * tt + row; WLST[(size_t)(k * 32 + ek) * LISTCAP + slot] = wk; } } }
                __syncthreads();
            }
        }
    }
#endif
    xcd_barrier(bar);

#if PH(11)
    {
        LAS int* rbase = (LAS int*)(lds + LDSCTL_OFF + LC_RBASE); LAS int* tbase = (LAS int*)(lds + LDSCTL_OFF + LC_TBASE); LAS int* nearr = (LAS int*)(lds + LDSCTL_OFF + LC_NE); LAS int* tilee = (LAS int*)(lds + LDSCTL_OFF + LC_TILEE);
        { int tid = threadIdx.x; asm volatile("" : "+v"(tid));
          if (tid < 4 * NE) nearr[tid] = (int)ctl[CW_CNT + tid * 16];
          __syncthreads();
          if (tid < 4) { int a = 0;
#pragma nounroll
              for (int e = 0; e < NE; ++e) { tbase[tid * 33 + e] = a; a += (nearr[tid * 32 + e] + 255) >> 8; } tbase[tid * 33 + NE] = a; }
          __syncthreads();
          if (tid == 0) { int a = 0;
#pragma nounroll
              for (int k = 0; k < 4; ++k) { rbase[k] = a; a += tbase[k * 33 + NE]; } rbase[4] = a; }
          for (int q = tid; q < 4 * MAXTILES; q += 512) { const int k = q / MAXTILES, T = q % MAXTILES;
              if (T < tbase[k * 33 + NE]) { int e = 0;
#pragma nounroll
                  while (e < NE - 1 && tbase[k * 33 + e + 1] <= T) ++e;
                  tilee[k * MAXTILES + T] = e; } }
          __syncthreads(); }
        const MoeTabs tb{rbase, tbase, nearr, tilee};
        { MoeOrderGU S{(const char*)H2, (const char*)WGU, TOKL, G, vcu, tb};
          EpiGateUp E{HID, b_gate_up};
          pg8::gemm_phase_f8<true>(lds, 512, S, E); }
        xcd_barrier(bar);
        for (int k = 0; k < TOPK; ++k) {
            { MoeOrderDN S{(const char*)HID, (const char*)WDN, G, vcu, k, tb};
              EpiDown E{out, MERGED  , b_down, MOD, TOKL + (size_t)k * NE * LISTCAP, WLST + (size_t)k * NE * LISTCAP, k == 0 ? 0 : (k == TOPK - 1 ? 2 : 1)};
              pg8::gemm_phase_f8<false>(lds, 512, S, E); }
            if (k + 1 < TOPK) xcd_barrier(bar);
        }
    }
#endif
}

extern "C" void kernel_launch(void* const* d_in, const int* in_sizes, int n_in, void* d_out, int out_size, void* d_ws, size_t ws_size, hipStream_t stream) {
    static int grid = 0;
    if (grid == 0) {
        if (n_in != 23 || in_sizes[0] != NTOK * DM || out_size != NTOK * DM || ws_size < WS_END) { fprintf(stderr, "kernel_launch: unexpected shapes (n_in %d, in0 %d, out %d, ws %zu); nothing launched\n", n_in, n_in > 0 ? in_sizes[0] : -1, out_size, ws_size); grid = -1; return; }
        int dev = 0, cus = 0, per_cu = 0;
        if (hipGetDevice(&dev) != hipSuccess || hipDeviceGetAttribute(&cus, hipDeviceAttributeMultiprocessorCount, dev) != hipSuccess) { grid = -1; return; }
        if (hipFuncSetAttribute((const void*)fwd_kernel, hipFuncAttributeMaxDynamicSharedMemorySize, LDS_BYTES) != hipSuccess) { fprintf(stderr, "kernel_launch: hipFuncSetAttribute failed\n"); grid = -1; return; }
        if (hipOccupancyMaxActiveBlocksPerMultiprocessor(&per_cu, (const void*)fwd_kernel, 512, LDS_BYTES) != hipSuccess || per_cu < 1) fprintf(stderr, "kernel_launch: occupancy query reports %d\n", per_cu);
        (void)hipGetLastError();
        grid = cus;
    }
    if (grid < 0) return;
    if (hipMemsetAsync((char*)d_ws + WS_CTL, 0, CTL_ZERO_BYTES, stream) != hipSuccess) return;
    Args a{};
    for (int i = 0; i < 23; ++i) a.in[i] = d_in[i];
    a.out = (float*)d_out; a.ws = (unsigned char*)d_ws;
    hipLaunchKernelGGL(fwd_kernel, dim3(grid), dim3(512), LDS_BYTES, stream, a);
}
```

```cpp
#include <hip/hip_runtime.h>
#include <cstdio>
#include <cstdint>

#define LAS __attribute__((address_space(3)))
#define GAS __attribute__((address_space(1)))
typedef unsigned short bf16_t;
typedef short bf16x8 __attribute__((ext_vector_type(8)));
typedef short s16x4 __attribute__((ext_vector_type(4)));
typedef float f32x2 __attribute__((ext_vector_type(2)));
typedef float f32x4 __attribute__((ext_vector_type(4)));
typedef float f32x16 __attribute__((ext_vector_type(16)));
typedef unsigned u32x2 __attribute__((ext_vector_type(2)));
typedef unsigned u32x4 __attribute__((ext_vector_type(4)));
typedef int v8i __attribute__((ext_vector_type(8)));
typedef unsigned u32x8 __attribute__((ext_vector_type(8)));

constexpr int NB = 32, SEQ = 2048, DM = 1024, NTOK = NB * SEQ;
constexpr int QLORA = 384, KVLORA = 256, ROPE = 32, NOPE = 64, VD = 64, QKD = 96, NH = 8;
constexpr int SBD = 64;
constexpr int NE = 32, TOPK = 4, DE = 1024;
constexpr int DIN = 4256, DINP = 4352;
constexpr float EPS = 1e-6f;
constexpr float LOG2E = 1.4426950408889634f;
constexpr int LISTCAP = NTOK;
constexpr int MAXTILES = NTOK / 256 + NE;

constexpr size_t MiB = 1u << 20;
constexpr size_t WS_CTL = 0, CTL_ZERO_BYTES = 1 * MiB;
constexpr size_t WS_WIN = 1 * MiB;
constexpr size_t WS_WUQ = 10 * MiB;
constexpr size_t WS_WUKV = 11 * MiB;
constexpr size_t WS_WOM = 12 * MiB;
constexpr size_t WS_WOS = 13 * MiB;
constexpr size_t WS_WOUT = 14 * MiB;
constexpr size_t WS_MOD = 16 * MiB;
constexpr size_t WS_WIN8 = 18 * MiB;
constexpr size_t WS_H = 32 * MiB;
constexpr size_t WS_KVRAW = WS_H, WS_MERGED = WS_H;
constexpr size_t WS_SGA = 160 * MiB;
constexpr size_t WS_H2 = WS_SGA;
constexpr size_t WS_SGB = 288 * MiB;
constexpr size_t WS_WGU = WS_SGB;
constexpr size_t WS_SB = 416 * MiB;
constexpr size_t WS_WDN = 416 * MiB;
constexpr size_t WS_TOKL = 480 * MiB;
constexpr size_t WS_WL = 512 * MiB;
constexpr size_t WS_HID = 544 * MiB;
constexpr size_t WS_QL = 608 * MiB;
constexpr size_t WS_M8 = 608 * MiB;
constexpr size_t WS_KVL = 656 * MiB;
constexpr size_t WS_KPE = 688 * MiB;
constexpr size_t WS_Q = 692 * MiB;
constexpr size_t WS_K = 788 * MiB;
constexpr size_t WS_OMLA = 884 * MiB;
constexpr size_t WS_H8 = WS_OMLA;
constexpr size_t WS_OSB = 948 * MiB;
constexpr size_t WS_END = 1012 * MiB;
static_assert(WS_HID + (size_t)4 * MAXTILES * 256 * 1024 <= WS_END, "hid (fp8, all four rounds)");
constexpr int CW_BAR = 4096;
constexpr int CW_CNT = 16384;

constexpr int RING_BYTES = 131072;
constexpr int LDSCTL_OFF = RING_BYTES + 1024;
constexpr int LC_BARST = 0;
constexpr int LC_RBASE = 32;
constexpr int LC_TBASE = 64;
constexpr int LC_NE = 640;
constexpr int LC_TILEE = 1152;
constexpr int LDS_BYTES = 147456;
static_assert(LC_TILEE + 4 * MAXTILES * 4 <= LDS_BYTES - LDSCTL_OFF, "lds ctl");

__device__ __forceinline__ unsigned cvt_pk_bf16(float lo, float hi) { unsigned r; asm volatile("v_cvt_pk_bf16_f32 %0, %1, %2" : "=v"(r) : "v"(lo), "v"(hi)); return r; }
__device__ __forceinline__ float bf_lo(unsigned u) { return __builtin_bit_cast(float, u << 16); }
__device__ __forceinline__ float bf_hi(unsigned u) { return __builtin_bit_cast(float, u & 0xffff0000u); }
__device__ __forceinline__ float fast_sigmoid(float x) { return __builtin_amdgcn_rcpf(1.f + __builtin_amdgcn_exp2f(-x * LOG2E)); }

namespace pg8 {
constexpr int BM = 256, BK = 64, HALF = 128, HTB = HALF * BK * 2, STAGE_BYTES = 8 * HTB, NXCD = 8, WGM = 8;
__host__ __device__ __forceinline__ int lds_byte(int r, int c) { const int st = (r >> 4) * 2 + (c >> 5), rr = r & 15, cc = c & 31, ob = rr * 64 + cc * 2; return st * 1024 + (ob ^ (((ob >> 9) & 1) << 5)); }
__host__ __device__ __forceinline__ void stage_rc(int b, int& R, int& C) { const int st = b / 1024, sb = b % 1024, swz = sb ^ (((sb >> 9) & 1) << 5); R = (st >> 1) * 16 + swz / 64; C = (st & 1) * 32 + (swz % 64) / 2; }
__host__ __device__ __forceinline__ int perm32(int rho) { const int n = rho >> 4, i = rho & 15; return 8 * (i >> 2) + 4 * n + (i & 3); }

struct Unit { int pm, pn, e, j0, ne, kk; };

struct DenseOrder {
    const char* A; const char* Bt; int K; int nM, nN, nwg, G, c;
    __device__ void init(const void* A_, const void* Bt_, int M, int N, int K_, int G_, int c_) { A = (const char*)A_; Bt = (const char*)Bt_; K = K_; nM = M / BM; nN = N / BM; nwg = nM * nN; G = G_; c = c_; }
    __device__ __forceinline__ bool next(int i, Unit& u) const {
        const long L = (long)i * G + c; if (L >= nwg) return false;
        int wgid = (int)L; { const int q = nwg / NXCD, r = nwg % NXCD, xcd = wgid % NXCD, off = wgid / NXCD; wgid = (xcd < r ? xcd * (q + 1) : r * (q + 1) + (xcd - r) * q) + off; }
        const int nig = WGM * nN, gid = wgid / nig, fm = gid * WGM, gsz = (nM - fm) < WGM ? (nM - fm) : WGM;
        u.pm = fm + ((wgid % nig) % gsz); u.pn = (wgid % nig) / gsz; u.e = 0; u.j0 = 0; u.ne = 0; u.kk = 0; return true;
    }
    __device__ __forceinline__ const char* a_base(const Unit& u) const { return A + (size_t)u.pm * (size_t)(BM * 2) * K; }
    __device__ __forceinline__ const char* b_base(const Unit& u) const { return Bt + (size_t)u.pn * (size_t)(BM * 2) * K; }
    __device__ __forceinline__ unsigned row_of(const Unit&, int) const { return 0u; }
};

template <bool GATHER, class Epi, class Sched>
__device__ __forceinline__ void gemm_phase(LAS unsigned char* lds, const int K, const Sched& S, const Epi& E) {
    int tid_ = threadIdx.x; asm volatile("" : "+v"(tid_));
    const int tid = tid_, wid = __builtin_amdgcn_readfirstlane(tid >> 6), lane = tid & 63, wr = wid >> 2, wc = wid & 3, fr = lane & 15, fq = lane >> 4;
    const int nt = K / BK;
    int RA[2]; unsigned cofA[2], voffB[2];
#pragma unroll
    for (int i = 0; i < 2; ++i) { int R, C; stage_rc(tid * 16 + i * 8192, R, C); const int Rb = (R & ~31) + perm32(R & 31);
        RA[i] = R; cofA[i] = (unsigned)C * 2u; voffB[i] = (unsigned)(Rb * K + C) * 2u; }
    const size_t kstep = (size_t)(BK * 2);
    const size_t hstep = (size_t)HALF * K * 2;
    const unsigned ldsw = (unsigned)wid * 1024u;
    const int aoff = lds_byte(wr * 64 + fr, fq * 8), boff = lds_byte(wc * 32 + fr, fq * 8);
#define PG8_SA(b, h) (((b) * 2 + (h)) * HTB)
#define PG8_SB(b, h) ((4 + (b) * 2 + (h)) * HTB)
#define PG8_STAGE(bufoff, gbase, voff) do { _Pragma("unroll") for (int _i = 0; _i < 2; ++_i) \
        __builtin_amdgcn_global_load_lds((const unsigned*)((const char*)(gbase) + (voff)[_i]), (LAS unsigned*)(lds + (bufoff) + ldsw + _i * 8192), 16, 0, 0); } while (0)
#define PG8_LDA(dst, b, h) do { _Pragma("unroll") for (int m = 0; m < 4; ++m) _Pragma("unroll") for (int k = 0; k < 2; ++k) dst[m][k] = *(const LAS bf16x8*)(lds + PG8_SA(b, h) + aoff + m * 2048 + k * 1024); } while (0)
#define PG8_LDB(dst, b, h) do { _Pragma("unroll") for (int n = 0; n < 2; ++n) _Pragma("unroll") for (int k = 0; k < 2; ++k) dst[n][k] = *(const LAS bf16x8*)(lds + PG8_SB(b, h) + boff + n * 2048 + k * 1024); } while (0)
#define PG8_MMA(ai, bj, At, Bt) do { __builtin_amdgcn_s_setprio(1); _Pragma("unroll") for (int m = 0; m < 4; ++m) _Pragma("unroll") for (int n = 0; n < 2; ++n) _Pragma("unroll") for (int k = 0; k < 2; ++k) \
        acc[ai][bj][m][n] = __builtin_amdgcn_mfma_f32_16x16x32_bf16(Bt[n][k], At[m][k], acc[ai][bj][m][n], 0, 0, 0); __builtin_amdgcn_s_setprio(0); } while (0)
#define PG8_WAIT_V(n) asm volatile("s_waitcnt vmcnt(" #n ")" ::: "memory")
#define PG8_WAIT_L(n) asm volatile("s_waitcnt lgkmcnt(" #n ")" ::: "memory")
#define PG8_BAR __builtin_amdgcn_s_barrier()
#define PG8_SCHED __builtin_amdgcn_sched_barrier(0)
#define PG8_AOFFS(dst, u) do { _Pragma("unroll") for (int _h = 0; _h < 2; ++_h) _Pragma("unroll") for (int _i = 0; _i < 2; ++_i) { \
        const unsigned _row = GATHER ? S.row_of(u, _h * HALF + RA[_i]) : (unsigned)(_h * HALF + RA[_i]); dst[_h][_i] = _row * (unsigned)(K * 2) + cofA[_i]; } } while (0)
    Unit cur, nxt; int ui = 0;
    if (!S.next(0, cur)) return;
    f32x4 acc[2][2][4][2];
#pragma unroll
    for (int a = 0; a < 2; ++a)
#pragma unroll
        for (int b = 0; b < 2; ++b)
#pragma unroll
            for (int m = 0; m < 4; ++m)
#pragma unroll
                for (int n = 0; n < 2; ++n) acc[a][b][m][n] = (f32x4){0.f, 0.f, 0.f, 0.f};
    bf16x8 At[4][2], B0[2][2], B1[2][2];
    unsigned oc[2][2], on[2][2];
    PG8_AOFFS(oc, cur);
    const char* cA = S.a_base(cur); const char* cB = S.b_base(cur);
    PG8_STAGE(PG8_SB(0, 0), cB, voffB); PG8_STAGE(PG8_SB(0, 1), cB + hstep, voffB); PG8_STAGE(PG8_SA(0, 0), cA, oc[0]); PG8_STAGE(PG8_SA(0, 1), cA, oc[1]);
    if (wr == 1) PG8_BAR;
    PG8_WAIT_V(2); PG8_BAR;
    PG8_STAGE(PG8_SB(1, 0), cB + kstep, voffB); PG8_STAGE(PG8_SA(1, 0), cA + kstep, oc[0]); PG8_STAGE(PG8_SB(1, 1), cB + hstep + kstep, voffB);
    PG8_WAIT_V(6); PG8_BAR;
    for (;;) {
        const bool has_next = S.next(ui + 1, nxt);
        const char* nA = has_next ? S.a_base(nxt) : cA; const char* nB = has_next ? S.b_base(nxt) : cB;
        if constexpr (GATHER) { if (has_next) { PG8_AOFFS(on, nxt);
            _Pragma("unroll") for (int _h = 0; _h < 2; ++_h) _Pragma("unroll") for (int _i = 0; _i < 2; ++_i) asm volatile("" : "+v"(on[_h][_i]));
          } else {
#pragma unroll
            for (int _h = 0; _h < 2; ++_h)
#pragma unroll
                for (int _i = 0; _i < 2; ++_i) on[_h][_i] = oc[_h][_i]; } }
#pragma nounroll
        for (int t = 0; t < nt; t += 2) {
            const bool last = (t == nt - 2);
            const char* a1 = cA + (size_t)(t + 1) * kstep;
            const char* a2 = last ? nA : cA + (size_t)(t + 2) * kstep; const char* b2 = last ? nB : cB + (size_t)(t + 2) * kstep;
            const char* a3 = a2 + kstep; const char* b3 = b2 + kstep;
            unsigned o2[2][2];
#pragma unroll
            for (int _h = 0; _h < 2; ++_h)
#pragma unroll
                for (int _i = 0; _i < 2; ++_i) o2[_h][_i] = (GATHER && last) ? on[_h][_i] : oc[_h][_i];
            PG8_LDB(B0, 0, 0); PG8_LDB(B1, 0, 1); PG8_SCHED; PG8_LDA(At, 0, 0); PG8_STAGE(PG8_SA(1, 1), a1, oc[1]);
            PG8_WAIT_V(8); PG8_WAIT_L(0); PG8_BAR; PG8_MMA(0, 0, At, B0); PG8_MMA(0, 1, At, B1); PG8_BAR; PG8_SCHED;
            PG8_LDA(At, 0, 1); PG8_STAGE(PG8_SB(0, 0), b2, voffB); PG8_STAGE(PG8_SB(0, 1), b2 + hstep, voffB); PG8_STAGE(PG8_SA(0, 0), a2, o2[0]);
            PG8_WAIT_V(8); PG8_WAIT_L(0); PG8_BAR; PG8_MMA(1, 0, At, B0); PG8_MMA(1, 1, At, B1); PG8_BAR; PG8_SCHED;
            PG8_LDB(B0, 1, 0); PG8_LDB(B1, 1, 1); PG8_SCHED; PG8_LDA(At, 1, 0); PG8_STAGE(PG8_SA(0, 1), a2, o2[1]);
            PG8_WAIT_V(8); PG8_WAIT_L(0); PG8_BAR; PG8_MMA(0, 0, At, B0); PG8_MMA(0, 1, At, B1); PG8_BAR; PG8_SCHED;
            PG8_LDA(At, 1, 1); PG8_STAGE(PG8_SB(1, 0), b3, voffB); PG8_STAGE(PG8_SB(1, 1), b3 + hstep, voffB); PG8_STAGE(PG8_SA(1, 0), a3, o2[0]);
            PG8_WAIT_V(8); PG8_WAIT_L(0); PG8_BAR; PG8_MMA(1, 0, At, B0); PG8_MMA(1, 1, At, B1); PG8_BAR; PG8_SCHED;
        }
        if (wr == 0) PG8_BAR;
        E(acc, cur, wr, wc, fr, fq);
        if (!has_next) break;
#pragma unroll
        for (int a = 0; a < 2; ++a)
#pragma unroll
            for (int b = 0; b < 2; ++b)
#pragma unroll
                for (int m = 0; m < 4; ++m)
#pragma unroll
                    for (int n = 0; n < 2; ++n) acc[a][b][m][n] = (f32x4){0.f, 0.f, 0.f, 0.f};
        cur = nxt; cA = nA; cB = nB; ++ui;
        if constexpr (GATHER) {
#pragma unroll
        for (int _h = 0; _h < 2; ++_h)
#pragma unroll
            for (int _i = 0; _i < 2; ++_i) oc[_h][_i] = on[_h][_i]; }
        if (wr == 1) PG8_BAR;
    }
    PG8_WAIT_V(0);
    PG8_BAR;
#undef PG8_SA
#undef PG8_SB
#undef PG8_STAGE
#undef PG8_LDA
#undef PG8_LDB
#undef PG8_MMA
#undef PG8_WAIT_V
#undef PG8_WAIT_L
#undef PG8_BAR
#undef PG8_SCHED
#undef PG8_AOFFS
}
template <bool GATHER, class Epi, class Sched>
__device__ __forceinline__ void gemm_phase_f8(LAS unsigned char* lds, const int K, const Sched& S, const Epi& E) {
    int tid_ = threadIdx.x; asm volatile("" : "+v"(tid_));
    const int tid = tid_, wid = __builtin_amdgcn_readfirstlane(tid >> 6), lane = tid & 63, wr = wid >> 2, wc = wid & 3, fr = lane & 15, fq = lane >> 4;
    const int nt = K / BK;
    int RA[2]; unsigned cofA[2], voffB[2];
#pragma unroll
    for (int i = 0; i < 2; ++i) { int R, C; stage_rc(tid * 16 + i * 8192, R, C); const int Rb = (R & ~31) + perm32(R & 31);
        RA[i] = R; cofA[i] = (unsigned)C * 2u; voffB[i] = (unsigned)(Rb * K + C) * 2u; }
    const size_t kstep = (size_t)(BK * 2);
    const size_t hstep = (size_t)HALF * K * 2;
    const unsigned ldsw = (unsigned)wid * 1024u;
    const int aoff = lds_byte(wr * 64 + fr, 16 * (fq & 1)) + (fq >> 1) * 1024, boff = lds_byte(wc * 32 + fr, 16 * (fq & 1)) + (fq >> 1) * 1024;
#define PG8_SA(b, h) (((b) * 2 + (h)) * HTB)
#define PG8_SB(b, h) ((4 + (b) * 2 + (h)) * HTB)
#define PG8_STAGE(bufoff, gbase, voff) do { _Pragma("unroll") for (int _i = 0; _i < 2; ++_i) \
        __builtin_amdgcn_global_load_lds((const unsigned*)((const char*)(gbase) + (voff)[_i]), (LAS unsigned*)(lds + (bufoff) + ldsw + _i * 8192), 16, 0, 0); } while (0)
#define PG8_LD32(p_) __builtin_shufflevector(*(const LAS u32x4*)(p_), *(const LAS u32x4*)((p_) + 16), 0, 1, 2, 3, 4, 5, 6, 7)
#define PG8_LDA(dst, b, h) do { _Pragma("unroll") for (int m = 0; m < 4; ++m) dst[m] = PG8_LD32(lds + PG8_SA(b, h) + aoff + m * 2048); } while (0)
#define PG8_LDB(dst, b, h) do { _Pragma("unroll") for (int n = 0; n < 2; ++n) dst[n] = PG8_LD32(lds + PG8_SB(b, h) + boff + n * 2048); } while (0)
#define PG8_F8(fr_) ((v8i){(int)fr_[0][0], (int)fr_[0][1], (int)fr_[0][2], (int)fr_[0][3], (int)fr_[1][0], (int)fr_[1][1], (int)fr_[1][2], (int)fr_[1][3]})
#define PG8_MMA(ai, bj, At, Bt) do { __builtin_amdgcn_s_setprio(1); _Pragma("unroll") for (int m = 0; m < 4; ++m) _Pragma("unroll") for (int n = 0; n < 2; ++n) \
        asm volatile("v_mfma_scale_f32_16x16x128_f8f6f4 %0, %1, %2, %0, %3, %3 op_sel_hi:[0,0,0]" : "+v"(acc[ai][bj][m][n]) : "v"(Bt[n]), "v"(At[m]), "v"(one_scale)); __builtin_amdgcn_s_setprio(0); } while (0)
#define PG8_WAIT_V(n) asm volatile("s_waitcnt vmcnt(" #n ")" ::: "memory")
#define PG8_WAIT_L(n) asm volatile("s_waitcnt lgkmcnt(" #n ")" ::: "memory")
#define PG8_BAR __builtin_amdgcn_s_barrier()
#define PG8_SCHED __builtin_amdgcn_sched_barrier(0)
#define PG8_AOFFS(dst, u) do { _Pragma("unroll") for (int _h = 0; _h < 2; ++_h) _Pragma("unroll") for (int _i = 0; _i < 2; ++_i) { \
        const unsigned _row = GATHER ? S.row_of(u, _h * HALF + RA[_i]) : (unsigned)(_h * HALF + RA[_i]); dst[_h][_i] = _row * (unsigned)(K * 2) + cofA[_i]; } } while (0)
    Unit cur, nxt; int ui = 0;
    if (!S.next(0, cur)) return;
    f32x4 acc[2][2][4][2];
#pragma unroll
    for (int a = 0; a < 2; ++a)
#pragma unroll
        for (int b = 0; b < 2; ++b)
#pragma unroll
            for (int m = 0; m < 4; ++m)
#pragma unroll
                for (int n = 0; n < 2; ++n) { acc[a][b][m][n] = (f32x4){0.f, 0.f, 0.f, 0.f}; asm volatile("" : "+v"(acc[a][b][m][n])); }
    u32x8 At[4], B0[2], B1[2];
    int one_scale = 0x7f7f7f7f; asm volatile("" : "+v"(one_scale));
    unsigned oc[2][2], on[2][2];
    PG8_AOFFS(oc, cur);
    const char* cA = S.a_base(cur); const char* cB = S.b_base(cur);
    PG8_STAGE(PG8_SB(0, 0), cB, voffB); PG8_STAGE(PG8_SB(0, 1), cB + hstep, voffB); PG8_STAGE(PG8_SA(0, 0), cA, oc[0]); PG8_STAGE(PG8_SA(0, 1), cA, oc[1]);
    if (wr == 1) PG8_BAR;
    PG8_WAIT_V(2); PG8_BAR;
    PG8_STAGE(PG8_SB(1, 0), cB + kstep, voffB); PG8_STAGE(PG8_SA(1, 0), cA + kstep, oc[0]); PG8_STAGE(PG8_SB(1, 1), cB + hstep + kstep, voffB);
    PG8_WAIT_V(6); PG8_BAR;
    Unit nn; bool has_next = S.next(1, nxt);
    if constexpr (GATHER) { if (has_next) { PG8_AOFFS(on, nxt);
            _Pragma("unroll") for (int _h = 0; _h < 2; ++_h) _Pragma("unroll") for (int _i = 0; _i < 2; ++_i) asm volatile("" : "+v"(on[_h][_i]));
          } else {
#pragma unroll
            for (int _h = 0; _h < 2; ++_h)
#pragma unroll
                for (int _i = 0; _i < 2; ++_i) on[_h][_i] = oc[_h][_i]; } }
    for (;;) {
        const char* nA = has_next ? S.a_base(nxt) : cA; const char* nB = has_next ? S.b_base(nxt) : cB;
#pragma nounroll
        for (int t = 0; t < nt; t += 2) {
            const bool last = (t == nt - 2);
            const char* a1 = cA + (size_t)(t + 1) * kstep;
            const char* a2 = last ? nA : cA + (size_t)(t + 2) * kstep; const char* b2 = last ? nB : cB + (size_t)(t + 2) * kstep;
            const char* a3 = a2 + kstep; const char* b3 = b2 + kstep;
            unsigned o2[2][2];
#pragma unroll
            for (int _h = 0; _h < 2; ++_h)
#pragma unroll
                for (int _i = 0; _i < 2; ++_i) o2[_h][_i] = (GATHER && last) ? on[_h][_i] : oc[_h][_i];
            PG8_LDB(B0, 0, 0); PG8_LDB(B1, 0, 1); PG8_SCHED; PG8_LDA(At, 0, 0); PG8_STAGE(PG8_SA(1, 1), a1, oc[1]);
            PG8_WAIT_V(8); PG8_WAIT_L(0); PG8_BAR; PG8_MMA(0, 0, At, B0); PG8_MMA(0, 1, At, B1); PG8_BAR; PG8_SCHED;
            PG8_LDA(At, 0, 1); PG8_STAGE(PG8_SB(0, 0), b2, voffB); PG8_STAGE(PG8_SB(0, 1), b2 + hstep, voffB); PG8_STAGE(PG8_SA(0, 0), a2, o2[0]);
            PG8_WAIT_V(8); PG8_WAIT_L(0); PG8_BAR; PG8_MMA(1, 0, At, B0); PG8_MMA(1, 1, At, B1); PG8_BAR; PG8_SCHED;
            PG8_LDB(B0, 1, 0); PG8_LDB(B1, 1, 1); PG8_SCHED; PG8_LDA(At, 1, 0); PG8_STAGE(PG8_SA(0, 1), a2, o2[1]);
            PG8_WAIT_V(8); PG8_WAIT_L(0); PG8_BAR; PG8_MMA(0, 0, At, B0); PG8_MMA(0, 1, At, B1); PG8_BAR; PG8_SCHED;
            PG8_LDA(At, 1, 1); PG8_STAGE(PG8_SB(1, 0), b3, voffB); PG8_STAGE(PG8_SB(1, 1), b3 + hstep, voffB); PG8_STAGE(PG8_SA(1, 0), a3, o2[0]);
            PG8_WAIT_V(8); PG8_WAIT_L(0); PG8_BAR; PG8_MMA(1, 0, At, B0); PG8_MMA(1, 1, At, B1); PG8_BAR; PG8_SCHED;
        }
        asm volatile("s_nop 15\n\ts_nop 15" ::: "memory");
        if (wr == 0) PG8_BAR;
        const bool has_nn = has_next && S.next(ui + 2, nn);
        unsigned onn[2][2];
        if constexpr (GATHER) { if (has_nn) { PG8_AOFFS(onn, nn); } else {
#pragma unroll
            for (int _h = 0; _h < 2; ++_h)
#pragma unroll
                for (int _i = 0; _i < 2; ++_i) onn[_h][_i] = on[_h][_i]; } }
        E(acc, cur, wr, wc, fr, fq);
        if (!has_next) break;
#pragma unroll
        for (int a = 0; a < 2; ++a)
#pragma unroll
            for (int b = 0; b < 2; ++b)
#pragma unroll
                for (int m = 0; m < 4; ++m)
#pragma unroll
                    for (int n = 0; n < 2; ++n) { acc[a][b][m][n] = (f32x4){0.f, 0.f, 0.f, 0.f}; asm volatile("" : "+v"(acc[a][b][m][n])); }
        cur = nxt; cA = nA; cB = nB; ++ui; nxt = nn; has_next = has_nn;
        if constexpr (GATHER) {
#pragma unroll
        for (int _h = 0; _h < 2; ++_h)
#pragma unroll
            for (int _i = 0; _i < 2; ++_i) { oc[_h][_i] = on[_h][_i]; asm volatile("" : "+v"(onn[_h][_i])); on[_h][_i] = onn[_h][_i]; } }
        if (wr == 1) PG8_BAR;
    }
    PG8_WAIT_V(0);
    PG8_BAR;
#undef PG8_SA
#undef PG8_SB
#undef PG8_STAGE
#undef PG8_LDA
#undef PG8_LDB
#undef PG8_MMA
#undef PG8_WAIT_V
#undef PG8_WAIT_L
#undef PG8_BAR
#undef PG8_SCHED
#undef PG8_AOFFS
#undef PG8_F8
}
}
#define XB_TMO      128
#define XB_XCNT(j)  (256  + 64 * (j))
#define XB_XSUB(j)  (1280 + 64 * (j))
#define XB_XGEN(j)  (2304 + 64 * (j))
#define XB_TOP      3328
#define XB_TOPGEN   3392
#define XCD_BAR_WORDS 3456
#define XB_SPIN_CAP (1u << 18)

__device__ __forceinline__ unsigned xb_ld(unsigned* p)              { return __hip_atomic_load(p, __ATOMIC_RELAXED, __HIP_MEMORY_SCOPE_AGENT); }
__device__ __forceinline__ unsigned xb_add(unsigned* p, unsigned v) { return __hip_atomic_fetch_add(p, v, __ATOMIC_RELAXED, __HIP_MEMORY_SCOPE_AGENT); }
__device__ __forceinline__ unsigned xb_xcc_id() { return (unsigned)__builtin_amdgcn_s_getreg((3 << 11) | 20) & 0xFu; }
#define XB_SPIN(cond, bar) do { unsigned _sp = 0; while (cond) { __builtin_amdgcn_s_sleep(1); \
    if ((++_sp & 255u) == 0u) { if (xb_ld(&(bar)[XB_TMO])) break; if (_sp > XB_SPIN_CAP) { atomicAdd(&(bar)[XB_TMO], 1u); break; } } } } while (0)

struct XcdBarrier {
    unsigned* bar; unsigned x;
    volatile LAS unsigned* st;
};

__device__ __forceinline__ XcdBarrier xcd_barrier_post(unsigned* bar, volatile LAS unsigned* st) {
    XcdBarrier b; b.bar = bar; b.x = xb_xcc_id(); b.st = st;
    if (threadIdx.x == 0) (void)xb_add(&bar[XB_XCNT(b.x)], 1u);
    return b;
}
__device__ __forceinline__ void xcd_barrier_complete(unsigned* bar, unsigned x, unsigned& nloc, unsigned& nx) {
    const unsigned G = gridDim.x * gridDim.y * gridDim.z;
    unsigned sum, cnt, mine, sp = 0u;
    for (;;) {
        sum = 0u; cnt = 0u; mine = 0u;
#pragma unroll
        for (unsigned j = 0; j < 16; ++j) { const unsigned c = xb_ld(&bar[XB_XCNT(j)]); sum += c; cnt += (c > 0u) ? 1u : 0u; mine = (j == x) ? c : mine; }
        if (sum == G) break;
        __builtin_amdgcn_s_sleep(1);
        if ((++sp & 255u) == 0u) { if (xb_ld(&bar[XB_TMO])) break; if (sp > XB_SPIN_CAP) { atomicAdd(&bar[XB_TMO], 1u); break; } }
    }
    nloc = mine > 0u ? mine : 1u; nx = cnt > 0u ? cnt : 1u;
}

__device__ __forceinline__ void xcd_barrier(const XcdBarrier& b) {
    asm volatile("s_waitcnt vmcnt(0)" ::: "memory");
    __syncthreads();
    if (threadIdx.x == 0) {
        unsigned* bar = b.bar;
        __builtin_amdgcn_s_waitcnt(0);
        unsigned nloc = b.st[0], nx = b.st[1];
        if (nloc == 0u) { xcd_barrier_complete(bar, b.x, nloc, nx); b.st[0] = nloc; b.st[1] = nx; }
        const unsigned old = xb_add(&bar[XB_XSUB(b.x)], 1u);
        const unsigned gen = old / nloc;
        if (old + 1u == (gen + 1u) * nloc) {
            __builtin_amdgcn_fence(__ATOMIC_RELEASE, "agent");
            asm volatile("s_waitcnt vmcnt(0)" ::: "memory");
            const unsigned og = xb_add(&bar[XB_TOP], 1u);
            const unsigned tg = og / nx;
            if (og + 1u == (tg + 1u) * nx) xb_add(&bar[XB_TOPGEN], 1u);
            else XB_SPIN(xb_ld(&bar[XB_TOPGEN]) == tg, bar);
            __builtin_amdgcn_fence(__ATOMIC_ACQUIRE, "agent");
            xb_add(&bar[XB_XGEN(b.x)], 1u);
            asm volatile("s_waitcnt vmcnt(0)" ::: "memory");
        } else {
            XB_SPIN(xb_ld(&bar[XB_XGEN(b.x)]) == gen, bar);
            __builtin_amdgcn_fence(__ATOMIC_ACQUIRE, "agent");
            asm volatile("s_waitcnt vmcnt(0)" ::: "memory");
        }
    }
    __syncthreads();
}

#define LDS_WAIT() asm volatile("s_waitcnt lgkmcnt(0)" ::: "memory")
#define VM_WAIT() asm volatile("s_waitcnt vmcnt(0)" ::: "memory")
#define MFMA32(a, b, c) __builtin_amdgcn_mfma_f32_32x32x16_bf16((a), (b), (c), 0, 0, 0)
__device__ __forceinline__ float wave_sum(float v) {
#pragma unroll
    for (int o = 1; o < 64; o <<= 1) v += __shfl_xor(v, o);
    return v;
}
__device__ __forceinline__ int crow(int i, int hh) { return (i & 3) + 8 * (i >> 2) + 4 * hh; }
__device__ __forceinline__ bf16x8 pack8(float a0, float a1, float a2, float a3, float a4, float a5, float a6, float a7) {
    u32x4 p; p.x = cvt_pk_bf16(a0, a1); p.y = cvt_pk_bf16(a2, a3); p.z = cvt_pk_bf16(a4, a5); p.w = cvt_pk_bf16(a6, a7);
    return __builtin_bit_cast(bf16x8, p);
}

struct Ctx {
    LAS unsigned char* lds;
    int tid, lane, wave, vcu, G;
};

__device__ __forceinline__ void transpose_item(const float* W, int K, int N, bf16_t* WT, int k0, int n0, int drow0, LAS float* scr, int lane) {
#pragma unroll 8
    for (int i = 0; i < 32; ++i) { const int kk = 2 * i + (lane >> 5); scr[kk * 33 + (lane & 31)] = W[(size_t)(k0 + kk) * N + n0 + (lane & 31)]; }
    LDS_WAIT(); asm volatile("" ::: "memory");
    const int c = lane & 7;
#pragma unroll
    for (int j = 0; j < 4; ++j) { const int n = (lane >> 3) + 8 * j; const LAS float* s = scr + (8 * c) * 33 + n;
        u32x4 o; o.x = cvt_pk_bf16(s[0 * 33], s[1 * 33]); o.y = cvt_pk_bf16(s[2 * 33], s[3 * 33]); o.z = cvt_pk_bf16(s[4 * 33], s[5 * 33]); o.w = cvt_pk_bf16(s[6 * 33], s[7 * 33]);
        *(GAS u32x4*)(WT + (size_t)(drow0 + n) * K + k0 + 8 * c) = o; }
    LDS_WAIT(); asm volatile("" ::: "memory");
}

__device__ __forceinline__ unsigned pk4_fp8(float a, float b, float c, float d) { int p = __builtin_amdgcn_cvt_pk_fp8_f32(a, b, 0, false); p = __builtin_amdgcn_cvt_pk_fp8_f32(c, d, p, true); return (unsigned)p; }
__device__ __forceinline__ void transpose_item_f8(const float* W, int K, int N, unsigned char* WT, int k0, int n0, int drow0, float scl, LAS float* scr, int lane) {
#pragma unroll 8
    for (int i = 0; i < 32; ++i) { const int kk = 2 * i + (lane >> 5); scr[kk * 33 + (lane & 31)] = W[(size_t)(k0 + kk) * N + n0 + (lane & 31)]; }
    LDS_WAIT(); asm volatile("" ::: "memory");
    const int c = lane & 7;
#pragma unroll
    for (int j = 0; j < 4; ++j) { const int n = (lane >> 3) + 8 * j; const LAS float* s = scr + (8 * c) * 33 + n;
        u32x2 o; o.x = pk4_fp8(s[0 * 33] * scl, s[1 * 33] * scl, s[2 * 33] * scl, s[3 * 33] * scl); o.y = pk4_fp8(s[4 * 33] * scl, s[5 * 33] * scl, s[6 * 33] * scl, s[7 * 33] * scl);
        *(GAS u32x2*)(WT + (size_t)(drow0 + n) * K + k0 + 8 * c) = o; }
    LDS_WAIT(); asm volatile("" ::: "memory");
}

constexpr float WSCALE = 32.f, WDESCALE = 1.f / 32.f;
typedef const f32x4 (&AccRef)[2][2][4][2];

struct EpiNull { __device__ __forceinline__ void operator()(AccRef acc, const pg8::Unit& u, int wr, int wc, int fr, int fq) const {
        float s = 0.f;
#pragma unroll
        for (int ai = 0; ai < 2; ++ai)
#pragma unroll
            for (int bj = 0; bj < 2; ++bj)
#pragma unroll
                for (int m = 0; m < 4; ++m)
#pragma unroll
                    for (int n = 0; n < 2; ++n) s += acc[ai][bj][m][n][0] + acc[ai][bj][m][n][1] + acc[ai][bj][m][n][2] + acc[ai][bj][m][n][3];
        asm volatile("" :: "v"(s)); } };
struct EpiStore {
    bf16_t* O; int ldc;
    __device__ __forceinline__ void operator()(AccRef acc, const pg8::Unit& u, int wr, int wc, int fr, int fq) const {
        const int row0 = u.pm * 256 + wr * 64 + fr, col0 = u.pn * 256 + wc * 32 + 8 * fq;
#pragma unroll
        for (int ai = 0; ai < 2; ++ai)
#pragma unroll
            for (int m = 0; m < 4; ++m) { bf16_t* rowp = O + (size_t)(row0 + ai * 128 + m * 16) * ldc + col0;
#pragma unroll
                for (int bj = 0; bj < 2; ++bj) { const f32x4 v0 = acc[ai][bj][m][0], v1 = acc[ai][bj][m][1];
                    u32x4 w; w.x = cvt_pk_bf16(v0[0], v0[1]); w.y = cvt_pk_bf16(v0[2], v0[3]); w.z = cvt_pk_bf16(v1[0], v1[1]); w.w = cvt_pk_bf16(v1[2], v1[3]);
                    *(u32x4*)(rowp + bj * 128) = w; } }
    }
};

struct EpiProj {
    bf16_t *QL, *KVL, *KPE, *SB, *SGA, *SGB; int cbase; float dsc;
    __device__ __forceinline__ void operator()(AccRef acc, const pg8::Unit& u, int wr, int wc, int fr, int fq) const {
        const int row0 = u.pm * 256 + wr * 64 + fr;
#pragma unroll
        for (int bj = 0; bj < 2; ++bj) {
            const int cg = cbase + u.pn * 256 + bj * 128 + wc * 32;
            bf16_t* base; int ld, co; bool sig = false;
            if (cg < 384) { base = QL; ld = 384; co = cg; }
            else if (cg < 640) { base = KVL; ld = 256; co = cg - 384; }
            else if (cg < 672) { base = KPE; ld = 32; co = cg - 640; }
            else if (cg < 768) { continue; }
            else if (cg < 2304) { base = SB; ld = 1536; co = cg - 768; }
            else if (cg < 3328) { base = SGA; ld = 1024; co = cg - 2304; sig = true; }
            else { base = SGB; ld = 1024; co = cg - 3328; sig = true; }
#pragma unroll
            for (int ai = 0; ai < 2; ++ai)
#pragma unroll
                for (int m = 0; m < 4; ++m) { f32x4 v0 = acc[ai][bj][m][0], v1 = acc[ai][bj][m][1];
                    if (sig) {
                        int q0 = 0, q1 = 0;
#pragma unroll
                        for (int j = 0; j < 4; ++j) { q0 = __builtin_amdgcn_cvt_pk_u8_f32(fast_sigmoid(v0[j] * dsc) * 255.f, j, q0); q1 = __builtin_amdgcn_cvt_pk_u8_f32(fast_sigmoid(v1[j] * dsc) * 255.f, j, q1); }
                        u32x2 w8; w8.x = (unsigned)q0; w8.y = (unsigned)q1;
                        *(u32x2*)((unsigned char*)base + (size_t)(row0 + ai * 128 + m * 16) * 1024 + co + 8 * fq) = w8; continue; }
                    u32x4 w; w.x = cvt_pk_bf16(v0[0], v0[1]); w.y = cvt_pk_bf16(v0[2], v0[3]); w.z = cvt_pk_bf16(v1[0], v1[1]); w.w = cvt_pk_bf16(v1[2], v1[3]);
                    *(u32x4*)(base + (size_t)(row0 + ai * 128 + m * 16) * ld + co + 8 * fq) = w; }
        }
    }
};

template <bool SECOND> struct EpiMerge {
    bf16_t* MG; const bf16_t* SG; unsigned char* M8;
    __device__ __forceinline__ void operator()(AccRef acc, const pg8::Unit& u, int wr, int wc, int fr, int fq) const {
        const int row0 = u.pm * 256 + wr * 64 + fr, col0 = u.pn * 256 + wc * 32 + 8 * fq;
#pragma unroll
        for (int ai = 0; ai < 2; ++ai)
#pragma unroll
            for (int m = 0; m < 4; ++m) { const size_t ro = (size_t)(row0 + ai * 128 + m * 16) * 1024 + col0;
#pragma unroll
                for (int bj = 0; bj < 2; ++bj) { const f32x4 v0 = acc[ai][bj][m][0], v1 = acc[ai][bj][m][1];
                    const u32x2 g = *(const u32x2*)((const unsigned char*)SG + ro + bj * 128);
                    constexpr float I255 = 1.f / 255.f;
                    float r0 = (float)(g.x & 0xffu) * I255 * v0[0], r1 = (float)((g.x >> 8) & 0xffu) * I255 * v0[1], r2 = (float)((g.x >> 16) & 0xffu) * I255 * v0[2], r3 = (float)(g.x >> 24) * I255 * v0[3];
                    float r4 = (float)(g.y & 0xffu) * I255 * v1[0], r5 = (float)((g.y >> 8) & 0xffu) * I255 * v1[1], r6 = (float)((g.y >> 16) & 0xffu) * I255 * v1[2], r7 = (float)(g.y >> 24) * I255 * v1[3];
                    if (SECOND) { const u32x4 p = *(const u32x4*)(MG + ro + bj * 128);
                        r0 += bf_lo(p.x); r1 += bf_hi(p.x); r2 += bf_lo(p.y); r3 += bf_hi(p.y); r4 += bf_lo(p.z); r5 += bf_hi(p.z); r6 += bf_lo(p.w); r7 += bf_hi(p.w); }
                    if (SECOND) { u32x2 w; w.x = pk4_fp8(r0, r1, r2, r3); w.y = pk4_fp8(r4, r5, r6, r7); *(u32x2*)(M8 + ro + bj * 128) = w; }
                    else { u32x4 w; w.x = cvt_pk_bf16(r0, r1); w.y = cvt_pk_bf16(r2, r3); w.z = cvt_pk_bf16(r4, r5); w.w = cvt_pk_bf16(r6, r7);
                        *(u32x4*)(MG + ro + bj * 128) = w; } } }
    }
};

struct EpiWout {
    const float* X; float* OUT; const float* MOD; float dsc;
    __device__ __forceinline__ void operator()(AccRef acc, const pg8::Unit& u, int wr, int wc, int fr, int fq) const {
        const int row0 = u.pm * 256 + wr * 64 + fr, col0 = u.pn * 256 + wc * 32 + 8 * fq;
        const float* ga = MOD + (size_t)(u.pm >> 3) * 6144 + 2048 + col0;
        f32x4 g[2][2];
#pragma unroll
        for (int bj = 0; bj < 2; ++bj)
#pragma unroll
            for (int n = 0; n < 2; ++n) g[bj][n] = *(const f32x4*)(ga + bj * 128 + 4 * n) * dsc;
#pragma unroll
        for (int ai = 0; ai < 2; ++ai)
#pragma unroll
            for (int m = 0; m < 4; ++m) { const size_t ro = (size_t)(row0 + ai * 128 + m * 16) * 1024 + col0;
#pragma unroll
                for (int bj = 0; bj < 2; ++bj)
#pragma unroll
                    for (int n = 0; n < 2; ++n) { const f32x4 xv = *(const f32x4*)(X + ro + bj * 128 + 4 * n);
                        *(f32x4*)(OUT + ro + bj * 128 + 4 * n) = xv + g[bj][n] * acc[ai][bj][m][n]; } }
    }
};

struct EpiGateUp {
    unsigned char* HID; const float* BGU;
    __device__ __forceinline__ void operator()(AccRef acc, const pg8::Unit& u, int wr, int wc, int fr, int fq) const {
        const int row0 = u.pm * 256 + wr * 64 + fr, hc = u.pn * 128 + wc * 32 + 8 * fq;
        const float* bg = BGU + (size_t)u.e * 2048 + hc;
        f32x4 bgate[2], bup[2];
#pragma unroll
        for (int n = 0; n < 2; ++n) { bgate[n] = *(const f32x4*)(bg + 4 * n); bup[n] = *(const f32x4*)(bg + 1024 + 4 * n); }
#pragma unroll
        for (int ai = 0; ai < 2; ++ai)
#pragma unroll
            for (int m = 0; m < 4; ++m) { float r[8];
#pragma unroll
                for (int n = 0; n < 2; ++n) { const f32x4 gv = acc[ai][0][m][n] * WDESCALE + bgate[n], uv = acc[ai][1][m][n] * WDESCALE + bup[n];
#pragma unroll
                    for (int j = 0; j < 4; ++j) { const float g = __builtin_fminf(gv[j], 7.f); const float up = __builtin_fminf(__builtin_fmaxf(uv[j], -7.f), 7.f);
                        r[4 * n + j] = (up + 1.f) * (g * fast_sigmoid(1.702f * g)); } }
                u32x2 w; w.x = pk4_fp8(r[0], r[1], r[2], r[3]); w.y = pk4_fp8(r[4], r[5], r[6], r[7]);
                *(u32x2*)(HID + (size_t)(row0 + ai * 128 + m * 16) * 1024 + hc) = w; asm volatile("" ::: "memory"); }
    }
};

struct EpiDown {
    float* OUT; bf16_t* Y0; bf16_t* Y1; bf16_t* Y2; const float* BDN; const float* MOD; const int* TOKL; const float* WL;
    __device__ __forceinline__ void operator()(AccRef acc, const pg8::Unit& u, int wr, int wc, int fr, int fq) const {
        const int col0 = u.pn * 256 + wc * 32 + 8 * fq;
        const float* bd = BDN + (size_t)u.e * 1024 + col0;
        f32x4 b4[2][2];
#pragma unroll
        for (int bj = 0; bj < 2; ++bj)
#pragma unroll
            for (int n = 0; n < 2; ++n) b4[bj][n] = *(const f32x4*)(bd + bj * 128 + 4 * n);
        const int* tl = TOKL + (size_t)(u.kk * 32 + u.e) * LISTCAP; const float* wl = WL + (size_t)(u.kk * 32 + u.e) * LISTCAP;
        bf16_t* Yk = Y0 + (size_t)u.kk * (size_t)(Y1 - Y0);
#pragma unroll
        for (int ai = 0; ai < 2; ++ai)
#pragma unroll
            for (int m = 0; m < 4; ++m) { const int slot = u.j0 + ai * 128 + wr * 64 + m * 16 + fr;
                if (slot < u.ne) { const int tok = tl[slot]; const float wgt = wl[slot];
                    const float* ga = MOD + (size_t)(tok >> 11) * 6144 + 5120 + col0; const size_t ro = (size_t)tok * 1024 + col0;
#pragma unroll
                    for (int bj = 0; bj < 2; ++bj) {
                        f32x4 v0 = *(const f32x4*)(ga + bj * 128) * ((acc[ai][bj][m][0] * WDESCALE + b4[bj][0]) * wgt), v1 = *(const f32x4*)(ga + bj * 128 + 4) * ((acc[ai][bj][m][1] * WDESCALE + b4[bj][1]) * wgt);
                        if (u.kk == 3) {
                            const u32x4 p = *(const u32x4*)(Y0 + ro + bj * 128), q = *(const u32x4*)(Y1 + ro + bj * 128), s = *(const u32x4*)(Y2 + ro + bj * 128);
                            v0[0] += bf_lo(p.x) + bf_lo(q.x) + bf_lo(s.x); v0[1] += bf_hi(p.x) + bf_hi(q.x) + bf_hi(s.x); v0[2] += bf_lo(p.y) + bf_lo(q.y) + bf_lo(s.y); v0[3] += bf_hi(p.y) + bf_hi(q.y) + bf_hi(s.y);
                            v1[0] += bf_lo(p.z) + bf_lo(q.z) + bf_lo(s.z); v1[1] += bf_hi(p.z) + bf_hi(q.z) + bf_hi(s.z); v1[2] += bf_lo(p.w) + bf_lo(q.w) + bf_lo(s.w); v1[3] += bf_hi(p.w) + bf_hi(q.w) + bf_hi(s.w);
                            float* op = OUT + ro + bj * 128;
                            *(f32x4*)op = *(const f32x4*)op + v0; *(f32x4*)(op + 4) = *(const f32x4*)(op + 4) + v1; }
                        else { u32x4 w; w.x = cvt_pk_bf16(v0[0], v0[1]); w.y = cvt_pk_bf16(v0[2], v0[3]); w.z = cvt_pk_bf16(v1[0], v1[1]); w.w = cvt_pk_bf16(v1[2], v1[3]); *(u32x4*)(Yk + ro + bj * 128) = w; } } }
                asm volatile("" ::: "memory"); }
    }
};

struct MoeTabs { const LAS int* rbase; const LAS int* tbase; const LAS int* nearr; const LAS int* tilee; };
struct MoeOrderGU {
    const char* A; const char* Bt; const int* lists; int G, c; MoeTabs tb;
    __device__ __forceinline__ bool next(int i, pg8::Unit& u) const {
        const int L = i * G + c, TT = L >> 3; const int total = __builtin_amdgcn_readfirstlane(tb.rbase[4]);
        if (TT >= total) return false;
        int k = 0;
#pragma unroll
        for (int q = 1; q < 4; ++q) k += (TT >= __builtin_amdgcn_readfirstlane(tb.rbase[q])) ? 1 : 0;
        const int T = TT - __builtin_amdgcn_readfirstlane(tb.rbase[k]);
        const int e = __builtin_amdgcn_readfirstlane(tb.tilee[k * MAXTILES + T]);
        u.pm = TT; u.pn = L & 7; u.e = e; u.kk = k; u.j0 = (T - __builtin_amdgcn_readfirstlane(tb.tbase[k * 33 + e])) * 256; u.ne = __builtin_amdgcn_readfirstlane(tb.nearr[k * 32 + e]); return true;
    }
    __device__ __forceinline__ const char* a_base(const pg8::Unit&) const { return A; }
    __device__ __forceinline__ const char* b_base(const pg8::Unit& u) const { return Bt + (size_t)u.e * (size_t)(2048 * 1024) + (size_t)u.pn * (size_t)(256 * 1024); }
    __device__ __forceinline__ unsigned row_of(const pg8::Unit& u, int r) const { const int slot = u.j0 + r; return slot < u.ne ? (unsigned)lists[(size_t)(u.kk * 32 + u.e) * LISTCAP + slot] : 0u; }
};
struct MoeOrderDN {
    const char* A; const char* Bt; int G, c, k0, k1; MoeTabs tb;
    __device__ __forceinline__ bool next(int i, pg8::Unit& u) const {
        const int L = i * G + c; const int r0 = __builtin_amdgcn_readfirstlane(tb.rbase[k0]), r1 = __builtin_amdgcn_readfirstlane(tb.rbase[k1]);
        const int TT = r0 + (L >> 2);
        if (TT >= r1) return false;
        int k = 0;
#pragma unroll
        for (int q = 1; q < 4; ++q) k += (TT >= __builtin_amdgcn_readfirstlane(tb.rbase[q])) ? 1 : 0;
        const int T = TT - __builtin_amdgcn_readfirstlane(tb.rbase[k]);
        const int e = __builtin_amdgcn_readfirstlane(tb.tilee[k * MAXTILES + T]);
        u.pm = TT; u.pn = L & 3; u.e = e; u.kk = k; u.j0 = (T - __builtin_amdgcn_readfirstlane(tb.tbase[k * 33 + e])) * 256; u.ne = __builtin_amdgcn_readfirstlane(tb.nearr[k * 32 + e]); return true;
    }
    __device__ __forceinline__ const char* a_base(const pg8::Unit& u) const { return A + (size_t)u.pm * (size_t)(256 * 1024); }
    __device__ __forceinline__ const char* b_base(const pg8::Unit& u) const { return Bt + (size_t)u.e * (size_t)(1024 * 1024) + (size_t)u.pn * (size_t)(256 * 1024); }
    __device__ __forceinline__ unsigned row_of(const pg8::Unit&, int) const { return 0u; }
};

constexpr int ATT_KBYTES = 12 * 1024;
constexpr int ATT_VPITCH = 136;
constexpr int ATT_VBYTES = 64 * ATT_VPITCH;
constexpr int ATT_BUF = ATT_KBYTES + ATT_VBYTES;
constexpr int ATT_WS = 2 * ATT_BUF;
static_assert(ATT_WS + 8 * 256 + 64 <= RING_BYTES, "attention LDS");

__device__ __forceinline__ void mla_unit(LAS unsigned char* lds, const bf16_t* Q, const bf16_t* Kb, const bf16_t* KV, bf16_t* O, int b, int h, int qb) {
    const int tid = threadIdx.x, lane = tid & 63, r = lane & 31, hh = lane >> 5; const int wid = __builtin_amdgcn_readfirstlane(tid >> 6);
    const size_t rowbase = (size_t)b * SEQ; const int q0 = qb * 256, qw = q0 + 32 * wid;
    const int cq = qw >> 6, NT = (q0 >> 6) + 4;
    LAS float* wsf = (LAS float*)(lds + ATT_WS) + wid * 64;
    bf16x8 qf[6];
    { const bf16_t* qp = Q + (rowbase + qw + r) * 768 + h * 96 + hh * 8;
#pragma unroll
      for (int s = 0; s < 6; ++s) qf[s] = *(const bf16x8*)(qp + 16 * s); }
    const int lkv = tid & 63, lc = tid >> 6;
    const bf16_t* kg0 = Kb + (rowbase + lkv) * 768 + h * 96 + lc * 8;
    const bf16_t* vg = KV + (rowbase + lkv) * 1024 + h * 128 + 64 + lc * 8;
    u32x4 ka0, ka1 = (u32x4){0u, 0u, 0u, 0u}, va;
#define ATT_LOAD(t, K0, K1, V) do { K0 = *(const u32x4*)(kg0 + (size_t)(t) * 64 * 768); if (tid < 256) K1 = *(const u32x4*)(kg0 + (size_t)(t) * 64 * 768 + 64); V = *(const u32x4*)(vg + (size_t)(t) * 64 * 1024); } while (0)
#define ATT_STORE(bufi, K0, K1, V) do { LAS unsigned char* kb_ = lds + (bufi) * ATT_BUF; *(LAS u32x4*)(kb_ + tid * 16) = K0; if (tid < 256) *(LAS u32x4*)(kb_ + 8192 + tid * 16) = K1; \
        LAS unsigned char* vb_ = kb_ + ATT_KBYTES + (lc * 8) * ATT_VPITCH + lkv * 2; \
        _Pragma("unroll") for (int j_ = 0; j_ < 8; ++j_) *(LAS unsigned short*)(vb_ + j_ * ATT_VPITCH) = (unsigned short)(V[j_ >> 1] >> (16 * (j_ & 1))); } while (0)
    ATT_LOAD(0, ka0, ka1, va); ATT_STORE(0, ka0, ka1, va); __syncthreads();
    float mref = 0.f, l_run = 0.f;
    f32x16 o0, o1, negm;
#pragma unroll
    for (int i = 0; i < 16; ++i) { o0[i] = 0.f; o1[i] = 0.f; negm[i] = 0.f; }
#define MLA_ITER(t_, BUFI, K0, K1, V) do { const int t = (t_); \
        if (t + 1 < NT) ATT_LOAD(t + 1, K0, K1, V); \
        if (t <= cq) { \
            const LAS unsigned char* kb = lds + (BUFI) * ATT_BUF; const LAS unsigned char* vb = kb + ATT_KBYTES; \
            f32x16 p0, p1; \
        _Pragma("unroll") \
            for (int s = 0; s < 6; ++s) { const bf16x8 a0 = *(const LAS bf16x8*)(kb + (2 * s + hh) * 1024 + r * 16), a1 = *(const LAS bf16x8*)(kb + (2 * s + hh) * 1024 + (r + 32) * 16); \
                if (s == 0) { p0 = MFMA32(a0, qf[0], negm); p1 = MFMA32(a1, qf[0], negm); } else { p0 = MFMA32(a0, qf[s], p0); p1 = MFMA32(a1, qf[s], p1); } } \
            float d = p0[0]; \
        _Pragma("unroll") \
            for (int i = 0; i < 16; ++i) { d = __builtin_fmaxf(d, p0[i]); d = __builtin_fmaxf(d, p1[i]); } \
            d = __builtin_fmaxf(d, __shfl_xor(d, 32)); \
            if (t == 0) { mref = d; \
        _Pragma("unroll") \
                for (int i = 0; i < 16; ++i) { p0[i] -= d; p1[i] -= d; negm[i] = -d; } \
            } else if (__any(d > 8.f)) { \
                const float delta = __builtin_fmaxf(d, 0.f), alpha = __builtin_amdgcn_exp2f(-delta); mref += delta; l_run *= alpha; \
        _Pragma("unroll") \
                for (int i = 0; i < 16; ++i) { p0[i] -= delta; p1[i] -= delta; negm[i] = -mref; } \
                if (hh == 0) wsf[r] = alpha; \
                LDS_WAIT(); \
        _Pragma("unroll") \
                for (int g = 0; g < 4; ++g) { const f32x4 al = *(const LAS f32x4*)(wsf + 8 * g + 4 * hh); \
        _Pragma("unroll") \
                    for (int e = 0; e < 4; ++e) { o0[4 * g + e] *= al[e]; o1[4 * g + e] *= al[e]; } } \
                LDS_WAIT(); \
            } \
            float rs = 0.f; \
        _Pragma("unroll") \
            for (int i = 0; i < 16; ++i) { p0[i] = __builtin_amdgcn_exp2f(p0[i]); p1[i] = __builtin_amdgcn_exp2f(p1[i]); rs += p0[i] + p1[i]; } \
            l_run += rs; \
        _Pragma("unroll") \
            for (int half = 0; half < 2; ++half) \
        _Pragma("unroll") \
                for (int s2 = 0; s2 < 2; ++s2) { \
                    const f32x16& P = half ? p1 : p0; \
                    const bf16x8 pa = pack8(P[8 * s2], P[8 * s2 + 1], P[8 * s2 + 2], P[8 * s2 + 3], P[8 * s2 + 4], P[8 * s2 + 5], P[8 * s2 + 6], P[8 * s2 + 7]); \
                    const int kvo = (32 * half + 16 * s2 + 4 * hh) * 2; \
                    { const s16x4 lo = *(const LAS s16x4*)(vb + r * ATT_VPITCH + kvo), hi = *(const LAS s16x4*)(vb + r * ATT_VPITCH + kvo + 16); \
                      const bf16x8 vf = __builtin_shufflevector(lo, hi, 0, 1, 2, 3, 4, 5, 6, 7); o0 = MFMA32(pa, vf, o0); } \
                    { const s16x4 lo = *(const LAS s16x4*)(vb + (r + 32) * ATT_VPITCH + kvo), hi = *(const LAS s16x4*)(vb + (r + 32) * ATT_VPITCH + kvo + 16); \
                      const bf16x8 vf = __builtin_shufflevector(lo, hi, 0, 1, 2, 3, 4, 5, 6, 7); o1 = MFMA32(pa, vf, o1); } \
                } \
        } \
        if (t + 1 < NT) ATT_STORE((BUFI) ^ 1, K0, K1, V); \
        __syncthreads(); } while (0)
    for (int t2 = 0; t2 < NT; t2 += 2) {
        MLA_ITER(t2, 0, ka0, ka1, va);
        MLA_ITER(t2 + 1, 1, ka0, ka1, va);
    }
#undef MLA_ITER
    const float l_tot = l_run + __shfl_xor(l_run, 32);
    if (hh == 0) wsf[r] = 1.f / l_tot;
    LDS_WAIT();
#pragma unroll
    for (int g = 0; g < 4; ++g) { const f32x4 rl = *(const LAS f32x4*)(wsf + 8 * g + 4 * hh);
#pragma unroll
        for (int e = 0; e < 4; ++e) { const int i = 4 * g + e; bf16_t* op = O + (rowbase + qw + crow(i, hh)) * 512 + h * 64 + r;
            op[0] = (bf16_t)(cvt_pk_bf16(o0[i] * rl[e], 0.f) & 0xffffu); op[32] = (bf16_t)(cvt_pk_bf16(o1[i] * rl[e], 0.f) & 0xffffu); } }
    LDS_WAIT();
#undef ATT_LOAD
#undef ATT_STORE
}

__device__ __forceinline__ void sb_unit(LAS unsigned char* lds, const bf16_t* SBQ, bf16_t* O, int b, int h, int qb) {
    const int tid = threadIdx.x, lane = tid & 63, r = lane & 31, hh = lane >> 5; const int wid = __builtin_amdgcn_readfirstlane(tid >> 6);
    const size_t rowbase = (size_t)b * SEQ; const int q0 = qb * 256, qw = q0 + 32 * wid;
    const int NT = (q0 >> 6) + 4;
    constexpr float C2 = 0.125f * LOG2E;
    bf16x8 qf[4];
    { const bf16_t* qp = SBQ + (rowbase + qw + r) * 1536 + h * 64 + hh * 8;
#pragma unroll
      for (int s = 0; s < 4; ++s) qf[s] = *(const bf16x8*)(qp + 16 * s); }
    const int lkv = tid & 63, lc = tid >> 6;
    const bf16_t* kg0 = SBQ + (rowbase + lkv) * 1536 + 512 + h * 64 + lc * 8;
    const bf16_t* vg = SBQ + (rowbase + lkv) * 1536 + 1024 + h * 64 + lc * 8;
    u32x4 ka0, va, kb0, vb2;
#define ATT_LOAD(t, K0, V) do { K0 = *(const u32x4*)(kg0 + (size_t)(t) * 64 * 1536); V = *(const u32x4*)(vg + (size_t)(t) * 64 * 1536); } while (0)
#define ATT_STORE(bufi, K0, V) do { LAS unsigned char* kb_ = lds + (bufi) * ATT_BUF; *(LAS u32x4*)(kb_ + tid * 16) = K0; \
        LAS unsigned char* vb_ = kb_ + ATT_KBYTES + (lc * 8) * ATT_VPITCH + lkv * 2; \
        _Pragma("unroll") for (int j_ = 0; j_ < 8; ++j_) *(LAS unsigned short*)(vb_ + j_ * ATT_VPITCH) = (unsigned short)(V[j_ >> 1] >> (16 * (j_ & 1))); } while (0)
    LAS unsigned* dflag = (LAS unsigned*)(lds + ATT_WS + 8 * 256);
    ATT_LOAD(NT - 1, ka0, va); ATT_STORE(0, ka0, va); __syncthreads();
    ATT_LOAD(NT - 2, kb0, vb2); ATT_LOAD(NT - 3, ka0, va);
    float carry = 0.f; bool wdone = false;
    f32x16 o0, o1;
#pragma unroll
    for (int i = 0; i < 16; ++i) { o0[i] = 0.f; o1[i] = 0.f; }
#define SB_SUB(X, kvh0, kvl) do { const bool diag_ = ((kvh0) == qw); float lk_[16], z_[16]; \
        _Pragma("unroll") for (int i = 0; i < 16; ++i) { const float z2 = X[i] * C2; const float ex = __builtin_amdgcn_exp2f(z2); float sp = __builtin_amdgcn_logf(1.f + ex); sp = z2 > 64.f ? z2 : sp; \
            const bool valid = !diag_ || (crow(i, hh) < r); lk_[i] = valid ? -sp : 0.f; z_[i] = z2; } \
        float G_[4], Gp_[4]; \
        _Pragma("unroll") for (int g = 0; g < 4; ++g) { G_[g] = (lk_[4 * g] + lk_[4 * g + 1]) + (lk_[4 * g + 2] + lk_[4 * g + 3]); Gp_[g] = __shfl_xor(G_[g], 32); } \
        float tail_[4]; tail_[3] = 0.f; tail_[2] = G_[3] + Gp_[3]; tail_[1] = tail_[2] + (G_[2] + Gp_[2]); tail_[0] = tail_[1] + (G_[1] + Gp_[1]); const float total_ = tail_[0] + (G_[0] + Gp_[0]); \
        float a_[16]; \
        _Pragma("unroll") for (int g = 0; g < 4; ++g) { const float base_ = carry + tail_[g] + (hh == 0 ? Gp_[g] : 0.f); \
            const float s3 = base_ + lk_[4 * g + 3], s2_ = s3 + lk_[4 * g + 2], s1 = s2_ + lk_[4 * g + 1], s0 = s1 + lk_[4 * g]; \
            a_[4 * g + 3] = __builtin_amdgcn_exp2f(z_[4 * g + 3] + s3); a_[4 * g + 2] = __builtin_amdgcn_exp2f(z_[4 * g + 2] + s2_); a_[4 * g + 1] = __builtin_amdgcn_exp2f(z_[4 * g + 1] + s1); a_[4 * g] = __builtin_amdgcn_exp2f(z_[4 * g] + s0); } \
        if (diag_) { _Pragma("unroll") for (int i = 0; i < 16; ++i) a_[i] = (crow(i, hh) < r) ? a_[i] : 0.f; } \
        carry += total_; \
        _Pragma("unroll") for (int s2 = 0; s2 < 2; ++s2) { \
            const bf16x8 pa = pack8(a_[8 * s2], a_[8 * s2 + 1], a_[8 * s2 + 2], a_[8 * s2 + 3], a_[8 * s2 + 4], a_[8 * s2 + 5], a_[8 * s2 + 6], a_[8 * s2 + 7]); \
            const int kvo = ((kvl) + 16 * s2 + 4 * hh) * 2; \
            { const s16x4 lo = *(const LAS s16x4*)(vb + r * ATT_VPITCH + kvo), hi = *(const LAS s16x4*)(vb + r * ATT_VPITCH + kvo + 16); \
              const bf16x8 vf = __builtin_shufflevector(lo, hi, 0, 1, 2, 3, 4, 5, 6, 7); o0 = MFMA32(pa, vf, o0); } \
            { const s16x4 lo = *(const LAS s16x4*)(vb + (r + 32) * ATT_VPITCH + kvo), hi = *(const LAS s16x4*)(vb + (r + 32) * ATT_VPITCH + kvo + 16); \
              const bf16x8 vf = __builtin_shufflevector(lo, hi, 0, 1, 2, 3, 4, 5, 6, 7); o1 = MFMA32(pa, vf, o1); } } } while (0)
    bool alldone = false;
#define SB_ITER(it_, BUFI, K0, V) do { const int it = (it_), t = NT - 1 - it, kv0 = 64 * t; \
        if (kv0 <= qw && !wdone) { \
            const LAS unsigned char* kb = lds + (BUFI) * ATT_BUF; const LAS unsigned char* vb = kb + ATT_KBYTES; \
            const bool upper = (kv0 + 32 <= qw); \
            f32x16 p0, p1; \
        _Pragma("unroll") \
            for (int i = 0; i < 16; ++i) { p0[i] = 0.f; p1[i] = 0.f; } \
        _Pragma("unroll") \
            for (int s = 0; s < 4; ++s) { const bf16x8 a0 = *(const LAS bf16x8*)(kb + (2 * s + hh) * 1024 + r * 16); p0 = MFMA32(a0, qf[s], p0); } \
            if (upper) { \
        _Pragma("unroll") \
                for (int s = 0; s < 4; ++s) { const bf16x8 a1 = *(const LAS bf16x8*)(kb + (2 * s + hh) * 1024 + (r + 32) * 16); p1 = MFMA32(a1, qf[s], p1); } \
                SB_SUB(p1, kv0 + 32, 32); \
            } \
            SB_SUB(p0, kv0, 0); \
            wdone = __all(carry < -170.f) != 0; \
        } \
        if (lane == 0) dflag[(BUFI) * 8 + wid] = wdone ? 1u : 0u; \
        if (t > 0) ATT_STORE((BUFI) ^ 1, K0, V); \
        if (t > 2) ATT_LOAD(t - 3, K0, V); \
        __syncthreads(); \
        { const u32x4 f0 = *(const LAS u32x4*)(dflag + (BUFI) * 8), f1 = *(const LAS u32x4*)(dflag + (BUFI) * 8 + 4); \
          alldone = (f0.x & f0.y & f0.z & f0.w & f1.x & f1.y & f1.z & f1.w) != 0u; } } while (0)
    for (int i2 = 0; i2 < NT; i2 += 2) {
        SB_ITER(i2, 0, kb0, vb2); if (alldone) break;
        SB_ITER(i2 + 1, 1, ka0, va); if (alldone) break;
    }
#undef SB_ITER
    __syncthreads();
#pragma unroll
    for (int i = 0; i < 16; ++i) { bf16_t* op = O + (rowbase + qw + crow(i, hh)) * 512 + h * 64 + r;
        op[0] = (bf16_t)(cvt_pk_bf16(o0[i], 0.f) & 0xffffu); op[32] = (bf16_t)(cvt_pk_bf16(o1[i], 0.f) & 0xffffu); }
#undef SB_SUB
#undef ATT_LOAD
#undef ATT_STORE
}

#ifndef PHMASK
#define PHMASK 0xFFFF
#endif
#define PH(n) ((PHMASK >> (n)) & 1)
#ifndef DUPMASK
#define DUPMASK 0
#endif
#define DUP(n) (1 + ((DUPMASK >> (n)) & 1))
struct Args { const void* in[23]; float* out; unsigned char* ws; };

__global__ void __launch_bounds__(512, 2) fwd_kernel(Args args) {
    extern __shared__ __attribute__((aligned(16))) unsigned char lds_raw[];
    LAS unsigned char* lds = (LAS unsigned char*)lds_raw;
    const int tid = threadIdx.x, lane = tid & 63, wave = __builtin_amdgcn_readfirstlane(tid >> 6);
    const int G = gridDim.x; const int bx = blockIdx.x; const int vcu = (G % 8 == 0) ? (bx % 8) * (G / 8) + bx / 8 : bx;
    const int gw = vcu * 8 + wave, NGW = G * 8;
    unsigned char* ws = args.ws;
    unsigned* ctl = (unsigned*)(ws + WS_CTL);
    const float* x = (const float*)args.in[0]; const float* cvec = (const float*)args.in[1]; const int* positions = (const int*)args.in[2];
    const float* w_ada = (const float*)args.in[3]; const float* b_ada = (const float*)args.in[4]; const float* g_norm1 = (const float*)args.in[5];
    const float* w_in = (const float*)args.in[6]; const float* g_q_lat = (const float*)args.in[7]; const float* w_uq = (const float*)args.in[8];
    const float* g_kv_lat = (const float*)args.in[9]; const float* w_ukv = (const float*)args.in[10]; const float* g_qk_q = (const float*)args.in[11];
    const float* g_qk_k = (const float*)args.in[12]; const float* w_o_mla = (const float*)args.in[13]; const float* w_o_sb = (const float*)args.in[14];
    const float* w_out = (const float*)args.in[15]; const float* g_norm2 = (const float*)args.in[16]; const float* w_router = (const float*)args.in[17];
    const float* b_router = (const float*)args.in[18]; const float* w_gate_up = (const float*)args.in[19]; const float* b_gate_up = (const float*)args.in[20];
    const float* w_down = (const float*)args.in[21]; const float* b_down = (const float*)args.in[22];
    float* out = args.out;
    bf16_t* WIN = (bf16_t*)(ws + WS_WIN); bf16_t* WUQ = (bf16_t*)(ws + WS_WUQ); bf16_t* WUKV = (bf16_t*)(ws + WS_WUKV); bf16_t* WOM = (bf16_t*)(ws + WS_WOM);
    bf16_t* WOS = (bf16_t*)(ws + WS_WOS); bf16_t* WOUT = (bf16_t*)(ws + WS_WOUT); float* MOD = (float*)(ws + WS_MOD);
    unsigned char* WIN8 = ws + WS_WIN8; unsigned char* H8 = ws + WS_H8; unsigned char* M8 = ws + WS_M8; unsigned char* WOUT8 = ws + WS_WOUT;
    bf16_t* HB = (bf16_t*)(ws + WS_H); bf16_t* KVRAW = (bf16_t*)(ws + WS_KVRAW); bf16_t* MERGED = (bf16_t*)(ws + WS_MERGED);
    bf16_t* SGA = (bf16_t*)(ws + WS_SGA); bf16_t* SGB = (bf16_t*)(ws + WS_SGB); unsigned char* H2 = ws + WS_H2;
    unsigned char* WGU = ws + WS_WGU; unsigned char* WDN = ws + WS_WDN; bf16_t* SBQ = (bf16_t*)(ws + WS_SB);
    int* TOKL = (int*)(ws + WS_TOKL); float* WLST = (float*)(ws + WS_WL); unsigned char* HID = ws + WS_HID;
    bf16_t* QL = (bf16_t*)(ws + WS_QL); bf16_t* KVL = (bf16_t*)(ws + WS_KVL); bf16_t* KPE = (bf16_t*)(ws + WS_KPE);
    bf16_t* QB = (bf16_t*)(ws + WS_Q); bf16_t* KB = (bf16_t*)(ws + WS_K); bf16_t* OMLA = (bf16_t*)(ws + WS_OMLA); bf16_t* OSB = (bf16_t*)(ws + WS_OSB);

    for (int u = tid; u < (LDS_BYTES - LDSCTL_OFF) / 4; u += 512) ((LAS unsigned*)(lds + LDSCTL_OFF))[u] = 0u;
    __syncthreads();
    XcdBarrier bar = xcd_barrier_post(ctl + CW_BAR, (volatile LAS unsigned*)(lds + LDSCTL_OFF + LC_BARST));
    LAS float* scr = (LAS float*)(lds + wave * 16384);

#if PH(0)
    {
        constexpr int I_IN = 16 * 133, I_UQ = 6 * 24, I_UKV = 4 * 32, I_OM = 8 * 32, I_OS = 8 * 32, I_OUT = 16 * 32;
        constexpr int NIT = I_IN + I_UQ + I_UKV + I_OM + I_OS + I_OUT;
        for (int it = gw; it < NIT; it += NGW) {
            int q = it;
            if (q < I_IN) { const int kb = q / 133, nb = q % 133, n0 = 32 * nb;
                if (nb < 69) transpose_item(w_in, 1024, DIN, WIN, 64 * kb, n0, n0 < 672 ? n0 : n0 + 96, scr, lane);
                else transpose_item_f8(w_in, 1024, DIN, WIN8, 64 * kb, n0, n0 - 2208, WSCALE, scr, lane);
                continue; } q -= I_IN;
            if (q < I_UQ) { const int kb = q / 24, nb = q % 24; transpose_item(w_uq, 384, 768, WUQ, 64 * kb, 32 * nb, 32 * nb, scr, lane); continue; } q -= I_UQ;
            if (q < I_UKV) { const int kb = q / 32, nb = q % 32; transpose_item(w_ukv, 256, 1024, WUKV, 64 * kb, 32 * nb, 32 * nb, scr, lane); continue; } q -= I_UKV;
            if (q < I_OM) { const int kb = q / 32, nb = q % 32; transpose_item(w_o_mla, 512, 1024, WOM, 64 * kb, 32 * nb, 32 * nb, scr, lane); continue; } q -= I_OM;
            if (q < I_OS) { const int kb = q / 32, nb = q % 32; transpose_item(w_o_sb, 512, 1024, WOS, 64 * kb, 32 * nb, 32 * nb, scr, lane); continue; } q -= I_OS;
            { const int kb = q / 32, nb = q % 32; transpose_item_f8(w_out, 1024, 1024, WOUT8, 64 * kb, 32 * nb, 32 * nb, WSCALE, scr, lane); }
        }
        for (int i = vcu * 512 + tid; i < 96 * 1024 * 2 / 16; i += G * 512) ((u32x4*)(WIN + 672 * 1024))[i] = (u32x4){0u, 0u, 0u, 0u};
        __syncthreads();
        for (int it = vcu; it < 6144 / 64; it += G) {
            for (int idx = lane; idx < 32 * 128; idx += 64) { const int b = idx >> 7, kk = idx & 127; const float cv = cvec[b * 1024 + 128 * wave + kk]; scr[idx] = cv / (1.f + __expf(-cv)); }
            LDS_WAIT(); asm volatile("" ::: "memory");
            float acc[32];
#pragma unroll
            for (int b = 0; b < 32; ++b) acc[b] = 0.f;
            const float* wp = w_ada + (size_t)(128 * wave) * 6144 + 64 * it + lane;
            float wc[8];
#pragma unroll
            for (int j = 0; j < 8; ++j) wc[j] = wp[(size_t)j * 6144];
#pragma nounroll
            for (int k8 = 0; k8 < 16; ++k8) {
                float wn[8];
                const int kn = k8 < 15 ? k8 + 1 : k8;
#pragma unroll
                for (int j = 0; j < 8; ++j) wn[j] = wp[(size_t)(8 * kn + j) * 6144];
#pragma unroll
                for (int j4 = 0; j4 < 2; ++j4) {
#pragma unroll
                    for (int b = 0; b < 32; ++b) { const f32x4 s = *(const LAS f32x4*)(scr + b * 128 + 8 * k8 + 4 * j4); acc[b] += s.x * wc[4 * j4] + s.y * wc[4 * j4 + 1] + s.z * wc[4 * j4 + 2] + s.w * wc[4 * j4 + 3];
                        if ((b & 7) == 7) asm volatile("" ::: "memory"); } }
#pragma unroll
                for (int j = 0; j < 8; ++j) wc[j] = wn[j];
            }
            LDS_WAIT(); asm volatile("" ::: "memory");
#pragma unroll
            for (int b = 0; b < 32; ++b) scr[b * 64 + lane] = acc[b];
            __syncthreads();
#pragma unroll
            for (int bb = 0; bb < 4; ++bb) { const int b = 4 * wave + bb; float s = 0.f;
#pragma unroll
                for (int w2 = 0; w2 < 8; ++w2) s += ((const LAS float*)(lds + w2 * 16384))[b * 64 + lane];
                MOD[b * 6144 + 64 * it + lane] = s + b_ada[64 * it + lane]; }
            __syncthreads();
        }
    }
#endif
    xcd_barrier(bar);

#if PH(1)
    for (int gi = gw; gi < NTOK / 4; gi += NGW) {
        f32x4 v[4][4];
#pragma unroll
        for (int rr = 0; rr < 4; ++rr) { const f32x4* xr = (const f32x4*)(x + (size_t)(4 * gi + rr) * 1024) + lane;
#pragma unroll
            for (int j = 0; j < 4; ++j) v[rr][j] = xr[64 * j]; }
        const int b = (4 * gi) >> 11;
        const float* mb = MOD + (size_t)b * 6144;
        f32x4 gsc[4], shv[4];
#pragma unroll
        for (int j = 0; j < 4; ++j) { const int col = 4 * lane + 256 * j; gsc[j] = *(const f32x4*)(g_norm1 + col) * (*(const f32x4*)(mb + 1024 + col) + 1.f); shv[j] = *(const f32x4*)(mb + col); }
#pragma unroll
        for (int rr = 0; rr < 4; ++rr) { float ss = 0.f;
#pragma unroll
            for (int j = 0; j < 4; ++j) ss += (v[rr][j].x * v[rr][j].x + v[rr][j].y * v[rr][j].y) + (v[rr][j].z * v[rr][j].z + v[rr][j].w * v[rr][j].w);
            const float rstd = rsqrtf(wave_sum(ss) * (1.f / 1024.f) + EPS);
#pragma unroll
            for (int j = 0; j < 4; ++j) { const int col = 4 * lane + 256 * j; const f32x4 y = (v[rr][j] * rstd) * gsc[j] + shv[j];
                u32x2 o; o.x = cvt_pk_bf16(y.x, y.y); o.y = cvt_pk_bf16(y.z, y.w);
                *(u32x2*)(HB + (size_t)(4 * gi + rr) * 1024 + col) = o;
                *(unsigned*)(H8 + (size_t)(4 * gi + rr) * 1024 + col) = pk4_fp8(y.x, y.y, y.z, y.w); } }
    }
#endif
    xcd_barrier(bar);

#if PH(2)
    { pg8::DenseOrder S; S.init(HB, WIN, NTOK, 2304, 1024, G, bx);
      EpiProj E{QL, KVL, KPE, SBQ, SGA, SGB, 0, 1.f};
      pg8::gemm_phase<false>(lds, 1024, S, E); }
    { pg8::DenseOrder S; S.init(H8, WIN8, NTOK, 2048, 512, G, bx);
      EpiProj E{QL, KVL, KPE, SBQ, SGA, SGB, 2304, WDESCALE};
      pg8::gemm_phase_f8<false>(lds, 512, S, E); }
#endif
    xcd_barrier(bar);

#if PH(3)
    {
        f32x4 gq0 = (f32x4){0.f, 0.f, 0.f, 0.f}, gq1 = gq0, gk0 = gq0, gk1 = gq0;
        if (lane < 48) { gq0 = *(const f32x4*)(g_q_lat + lane * 8); gq1 = *(const f32x4*)(g_q_lat + lane * 8 + 4); }
        if (lane < 32) { gk0 = *(const f32x4*)(g_kv_lat + lane * 8); gk1 = *(const f32x4*)(g_kv_lat + lane * 8 + 4); }
        for (int gi = gw; gi < NTOK / 4; gi += NGW) {
            u32x4 vq[4], vk[4];
#pragma unroll
            for (int rr = 0; rr < 4; ++rr) { vq[rr] = (u32x4){0u, 0u, 0u, 0u}; vk[rr] = vq[rr];
                if (lane < 48) vq[rr] = *(const u32x4*)(QL + (size_t)(4 * gi + rr) * 384 + lane * 8);
                if (lane < 32) vk[rr] = *(const u32x4*)(KVL + (size_t)(4 * gi + rr) * 256 + lane * 8); }
#pragma unroll
            for (int rr = 0; rr < 4; ++rr) {
                { const u32x4 v = vq[rr]; float f[8] = {bf_lo(v.x), bf_hi(v.x), bf_lo(v.y), bf_hi(v.y), bf_lo(v.z), bf_hi(v.z), bf_lo(v.w), bf_hi(v.w)}; float ss = 0.f;
#pragma unroll
                  for (int j = 0; j < 8; ++j) ss += f[j] * f[j];
                  const float rstd = rsqrtf(wave_sum(ss) * (1.f / 384.f) + EPS);
                  if (lane < 48) { u32x4 o; o.x = cvt_pk_bf16(f[0] * rstd * gq0.x, f[1] * rstd * gq0.y); o.y = cvt_pk_bf16(f[2] * rstd * gq0.z, f[3] * rstd * gq0.w);
                      o.z = cvt_pk_bf16(f[4] * rstd * gq1.x, f[5] * rstd * gq1.y); o.w = cvt_pk_bf16(f[6] * rstd * gq1.z, f[7] * rstd * gq1.w); *(u32x4*)(QL + (size_t)(4 * gi + rr) * 384 + lane * 8) = o; } }
                { const u32x4 v = vk[rr]; float f[8] = {bf_lo(v.x), bf_hi(v.x), bf_lo(v.y), bf_hi(v.y), bf_lo(v.z), bf_hi(v.z), bf_lo(v.w), bf_hi(v.w)}; float ss = 0.f;
#pragma unroll
                  for (int j = 0; j < 8; ++j) ss += f[j] * f[j];
                  const float rstd = rsqrtf(wave_sum(ss) * (1.f / 256.f) + EPS);
                  if (lane < 32) { u32x4 o; o.x = cvt_pk_bf16(f[0] * rstd * gk0.x, f[1] * rstd * gk0.y); o.y = cvt_pk_bf16(f[2] * rstd * gk0.z, f[3] * rstd * gk0.w);
                      o.z = cvt_pk_bf16(f[4] * rstd * gk1.x, f[5] * rstd * gk1.y); o.w = cvt_pk_bf16(f[6] * rstd * gk1.z, f[7] * rstd * gk1.w); *(u32x4*)(KVL + (size_t)(4 * gi + rr) * 256 + lane * 8) = o; } }
            }
        }
    }
#endif
    xcd_barrier(bar);

#if PH(4)
    for (int rep = 0; rep < DUP(5); ++rep) {
    { pg8::DenseOrder S; S.init(QL, WUQ, NTOK, 768, 384, G, bx); EpiStore E{QB, 768}; pg8::gemm_phase<false>(lds, 384, S, E); }
    { pg8::DenseOrder S; S.init(KVL, WUKV, NTOK, 1024, 256, G, bx); EpiStore E{KVRAW, 1024}; pg8::gemm_phase<false>(lds, 256, S, E); } }
#endif
    xcd_barrier(bar);

#if PH(5)
    {
        const int hd = lane >> 3, sub = lane & 7;
        const float QSC = 0.10206207261596575f * LOG2E;
        const float if0 = exp2f(-(float)(2 * sub) * (13.287712379549449f / 16.f)), if1 = exp2f(-(float)(2 * sub + 1) * (13.287712379549449f / 16.f));
        f32x4 gq0 = *(const f32x4*)(g_qk_q + sub * 8), gq1 = *(const f32x4*)(g_qk_q + sub * 8 + 4); const f32x2 gqa = *(const f32x2*)(g_qk_q + 64 + 2 * sub), gqb = *(const f32x2*)(g_qk_q + 80 + 2 * sub);
        f32x4 gk0 = *(const f32x4*)(g_qk_k + sub * 8), gk1 = *(const f32x4*)(g_qk_k + sub * 8 + 4); const f32x2 gka = *(const f32x2*)(g_qk_k + 64 + 2 * sub), gkb = *(const f32x2*)(g_qk_k + 80 + 2 * sub);
        for (int gi = gw; gi < NTOK / 4; gi += NGW) {
            u32x4 A[4][2]; unsigned B1[4][2], B2[4][2]; float posf[4];
#pragma unroll
            for (int t = 0; t < 4; ++t) { const int m = 4 * gi + t; posf[t] = (float)positions[m];
                const bf16_t* qp = QB + (size_t)m * 768 + hd * 96; A[t][0] = *(const u32x4*)(qp + sub * 8); B1[t][0] = *(const unsigned*)(qp + 64 + 2 * sub); B2[t][0] = *(const unsigned*)(qp + 80 + 2 * sub);
                A[t][1] = *(const u32x4*)(KVRAW + (size_t)m * 1024 + hd * 128 + sub * 8); B1[t][1] = *(const unsigned*)(KPE + (size_t)m * 32 + 2 * sub); B2[t][1] = *(const unsigned*)(KPE + (size_t)m * 32 + 16 + 2 * sub); }
#pragma unroll
            for (int t = 0; t < 4; ++t) { const int m = 4 * gi + t;
                float cs[2], sn[2];
                { const float a0 = posf[t] * if0, a1 = posf[t] * if1;
                  double r0 = (double)a0 * 0.15915494309189535, r1 = (double)a1 * 0.15915494309189535; r0 -= __builtin_rint(r0); r1 -= __builtin_rint(r1);
                  cs[0] = __builtin_amdgcn_cosf((float)r0); sn[0] = __builtin_amdgcn_sinf((float)r0); cs[1] = __builtin_amdgcn_cosf((float)r1); sn[1] = __builtin_amdgcn_sinf((float)r1); }
#pragma unroll
                for (int which = 0; which < 2; ++which) {
                    const u32x4 Av = A[t][which]; const unsigned b1 = B1[t][which], b2 = B2[t][which];
                    bf16_t* dst = which ? KB + (size_t)m * 768 + hd * 96 : QB + (size_t)m * 768 + hd * 96;
                    float f[8] = {bf_lo(Av.x), bf_hi(Av.x), bf_lo(Av.y), bf_hi(Av.y), bf_lo(Av.z), bf_hi(Av.z), bf_lo(Av.w), bf_hi(Av.w)};
                    float x1[2] = {bf_lo(b1), bf_hi(b1)}, x2[2] = {bf_lo(b2), bf_hi(b2)};
                    float ss = x1[0] * x1[0] + x1[1] * x1[1] + x2[0] * x2[0] + x2[1] * x2[1];
#pragma unroll
                    for (int j = 0; j < 8; ++j) ss += f[j] * f[j];
                    ss += __shfl_xor(ss, 1); ss += __shfl_xor(ss, 2); ss += __shfl_xor(ss, 4);
                    const float rstd = rsqrtf(ss * (1.f / 96.f) + EPS);
                    const f32x4 g0 = which ? gk0 : gq0, g1 = which ? gk1 : gq1; const f32x2 ga = which ? gka : gqa, gb = which ? gkb : gqb;
                    const float sc = which ? 1.f : QSC;
                    float y[8] = {f[0] * rstd * g0.x, f[1] * rstd * g0.y, f[2] * rstd * g0.z, f[3] * rstd * g0.w, f[4] * rstd * g1.x, f[5] * rstd * g1.y, f[6] * rstd * g1.z, f[7] * rstd * g1.w};
                    const float y1a = x1[0] * rstd * ga.x, y1b = x1[1] * rstd * ga.y, y2a = x2[0] * rstd * gb.x, y2b = x2[1] * rstd * gb.y;
                    const float o1a = y1a * cs[0] - y2a * sn[0], o1b = y1b * cs[1] - y2b * sn[1], o2a = y2a * cs[0] + y1a * sn[0], o2b = y2b * cs[1] + y1b * sn[1];
                    u32x4 o; o.x = cvt_pk_bf16(y[0] * sc, y[1] * sc); o.y = cvt_pk_bf16(y[2] * sc, y[3] * sc); o.z = cvt_pk_bf16(y[4] * sc, y[5] * sc); o.w = cvt_pk_bf16(y[6] * sc, y[7] * sc);
                    *(u32x4*)(dst + sub * 8) = o; *(unsigned*)(dst + 64 + 2 * sub) = cvt_pk_bf16(o1a * sc, o1b * sc); *(unsigned*)(dst + 80 + 2 * sub) = cvt_pk_bf16(o2a * sc, o2b * sc);
                }
            }
        }
    }
#endif
    xcd_barrier(bar);

#if PH(6)
    for (int bh = vcu; bh < NB * NH; bh += G) {
        for (int rep = 0; rep < DUP(0); ++rep) for (int qb = 0; qb < 8; ++qb) mla_unit(lds, QB, KB, KVRAW, OMLA, bh >> 3, bh & 7, qb);
        for (int rep = 0; rep < DUP(1); ++rep) for (int qb = 0; qb < 8; ++qb) sb_unit(lds, SBQ, OSB, bh >> 3, bh & 7, qb);
    }
#endif
    xcd_barrier(bar);

#if PH(8)
    for (int rep = 0; rep < DUP(6); ++rep) {
    { pg8::DenseOrder S; S.init(OMLA, WOM, NTOK, 1024, 512, G, bx); EpiMerge<false> E{MERGED, SGA, M8}; pg8::gemm_phase<false>(lds, 512, S, E); }
    { pg8::DenseOrder S; S.init(OSB, WOS, NTOK, 1024, 512, G, bx); EpiMerge<true> E{MERGED, SGB, M8}; pg8::gemm_phase<false>(lds, 512, S, E); } }
#endif
    xcd_barrier(bar);

#if PH(9)
    { pg8::DenseOrder S; S.init(M8, WOUT8, NTOK, 1024, 512, G, bx); EpiWout E{x, out, MOD, WDESCALE}; pg8::gemm_phase_f8<false>(lds, 512, S, E); }
#endif
    xcd_barrier(bar);

#if PH(10)
    {
        constexpr int I_GU = 16 * 64, I_DN = 16 * 32;
        for (int rep = 0; rep < DUP(2); ++rep) for (int it = gw; it < NE * (I_GU + I_DN); it += NGW) {
            if (it < NE * I_GU) { const int e = it / I_GU, q = it % I_GU, kb = q / 64, nb = q % 64, n0 = 32 * nb; const int g = n0 >> 10, jj = n0 & 1023;
                transpose_item_f8(w_gate_up + (size_t)e * 1024 * 2048, 1024, 2048, WGU + (size_t)e * 2048 * 1024, 64 * kb, n0, 256 * (jj >> 7) + 128 * g + (jj & 127), WSCALE, scr, lane); }
            else { const int r2 = it - NE * I_GU, e = r2 / I_DN, q = r2 % I_DN, kb = q / 32, nb = q % 32;
                transpose_item_f8(w_down + (size_t)e * 1024 * 1024, 1024, 1024, WDN + (size_t)e * 1024 * 1024, 64 * kb, 32 * nb, 32 * nb, WSCALE, scr, lane); }
        }
        __syncthreads();
        {
            const int r = lane & 31, hh = lane >> 5;
            constexpr int TP = 1026;
            LAS float* tile = (LAS float*)lds;
            float areg[64];
#pragma unroll
            for (int mm = 0; mm < 64; ++mm) areg[mm] = w_router[(size_t)(128 * wave + 4 * (mm >> 1) + 2 * hh + (mm & 1)) * 32 + r];
            const float br = b_router[r];
            for (int tt = vcu; tt < NTOK / 32; tt += G) {
                { f32x4 v[4][4];
#pragma unroll
                  for (int rr = 0; rr < 4; ++rr) { const f32x4* xr = (const f32x4*)(out + (size_t)(32 * tt + 4 * wave + rr) * 1024) + lane;
#pragma unroll
                      for (int j = 0; j < 4; ++j) v[rr][j] = xr[64 * j]; }
                  const float* mb = MOD + (size_t)((32 * tt) >> 11) * 6144;
                  f32x4 gsc[4], shv[4];
#pragma unroll
                  for (int j = 0; j < 4; ++j) { const int col = 4 * lane + 256 * j; gsc[j] = *(const f32x4*)(g_norm2 + col) * (*(const f32x4*)(mb + 4096 + col) + 1.f); shv[j] = *(const f32x4*)(mb + 3072 + col); }
#pragma unroll
                  for (int rr = 0; rr < 4; ++rr) { float ss = 0.f; const int row = 4 * wave + rr;
#pragma unroll
                      for (int j = 0; j < 4; ++j) ss += (v[rr][j].x * v[rr][j].x + v[rr][j].y * v[rr][j].y) + (v[rr][j].z * v[rr][j].z + v[rr][j].w * v[rr][j].w);
                      const float rstd = rsqrtf(wave_sum(ss) * (1.f / 1024.f) + EPS);
#pragma unroll
                      for (int j = 0; j < 4; ++j) { const int col = 4 * lane + 256 * j; const f32x4 y = (v[rr][j] * rstd) * gsc[j] + shv[j];
                          *(unsigned*)(H2 + (size_t)(32 * tt + row) * 1024 + col) = pk4_fp8(y.x, y.y, y.z, y.w);
                          *(LAS f32x2*)(tile + row * TP + col) = (f32x2){y.x, y.y}; *(LAS f32x2*)(tile + row * TP + col + 2) = (f32x2){y.z, y.w}; } } }
                __syncthreads();
                f32x16 acc;
#pragma unroll
                for (int i = 0; i < 16; ++i) acc[i] = 0.f;
#pragma unroll
                for (int sg = 0; sg < 32; ++sg) { const f32x2 hv = *(const LAS f32x2*)(tile + r * TP + 128 * wave + 4 * sg + 2 * hh);
                    acc = __builtin_amdgcn_mfma_f32_32x32x2f32(areg[2 * sg], hv.x, acc, 0, 0, 0); acc = __builtin_amdgcn_mfma_f32_32x32x2f32(areg[2 * sg + 1], hv.y, acc, 0, 0, 0); }
                __syncthreads();
#pragma unroll
                for (int i = 0; i < 16; ++i) tile[wave * 1024 + i * 64 + lane] = acc[i];
                __syncthreads();
                { const int e = r, he = (e >> 2) & 1, ie = (e & 3) + 4 * (e >> 3);
#pragma unroll
                  for (int rr = 0; rr < 4; ++rr) { const int row = 4 * wave + rr; float v = br;
#pragma unroll
                      for (int w2 = 0; w2 < 8; ++w2) v += tile[w2 * 1024 + ie * 64 + row + 32 * he];
                      float tv[4]; int te[4];
#pragma unroll
                      for (int k = 0; k < 4; ++k) { float bv = v; int bi = e;
#pragma unroll
                          for (int off = 16; off >= 1; off >>= 1) { const float ov = __shfl_xor(bv, off); const int oi = __shfl_xor(bi, off); if (ov > bv || (ov == bv && oi < bi)) { bv = ov; bi = oi; } }
                          tv[k] = bv; te[k] = bi; if (e == bi) v = -INFINITY; }
                      const float e1 = __expf(tv[1] - tv[0]), e2 = __expf(tv[2] - tv[0]), e3 = __expf(tv[3] - tv[0]); const float inv = 1.f / (1.f + e1 + e2 + e3);
                      if (lane < 4) { const int k = lane; const int ek = k == 0 ? te[0] : k == 1 ? te[1] : k == 2 ? te[2] : te[3]; const float wk = (k == 0 ? 1.f : k == 1 ? e1 : k == 2 ? e2 : e3) * inv;
                          const unsigned slot = atomicAdd(ctl + CW_CNT + (k * 32 + ek) * 16, 1u);
                          TOKL[(size_t)(k * 32 + ek) * LISTCAP + slot] = 32 * tt + row; WLST[(size_t)(k * 32 + ek) * LISTCAP + slot] = wk; } } }
                __syncthreads();
            }
        }
    }
#endif
    xcd_barrier(bar);

#if PH(11)
    {
        LAS int* rbase = (LAS int*)(lds + LDSCTL_OFF + LC_RBASE); LAS int* tbase = (LAS int*)(lds + LDSCTL_OFF + LC_TBASE); LAS int* nearr = (LAS int*)(lds + LDSCTL_OFF + LC_NE); LAS int* tilee = (LAS int*)(lds + LDSCTL_OFF + LC_TILEE);
        { int tid = threadIdx.x; asm volatile("" : "+v"(tid));
          if (tid < 4 * NE) nearr[tid] = (int)ctl[CW_CNT + tid * 16];
          __syncthreads();
          if (tid < 4) { int a = 0;
#pragma nounroll
              for (int e = 0; e < NE; ++e) { tbase[tid * 33 + e] = a; a += (nearr[tid * 32 + e] + 255) >> 8; } tbase[tid * 33 + NE] = a; }
          __syncthreads();
          if (tid == 0) { int a = 0;
#pragma nounroll
              for (int k = 0; k < 4; ++k) { rbase[k] = a; a += tbase[k * 33 + NE]; } rbase[4] = a; }
          for (int q = tid; q < 4 * MAXTILES; q += 512) { const int k = q / MAXTILES, T = q % MAXTILES;
              if (T < tbase[k * 33 + NE]) { int e = 0;
#pragma nounroll
                  while (e < NE - 1 && tbase[k * 33 + e + 1] <= T) ++e;
                  tilee[k * MAXTILES + T] = e; } }
          __syncthreads(); }
        const MoeTabs tb{rbase, tbase, nearr, tilee};
        { MoeOrderGU S{(const char*)H2, (const char*)WGU, TOKL, G, vcu, tb};
          EpiGateUp E{HID, b_gate_up};
          pg8::gemm_phase_f8<true>(lds, 512, S, E); }
        xcd_barrier(bar);
        bf16_t* Y0 = MERGED; bf16_t* Y1 = (bf16_t*)(ws + WS_SGA); bf16_t* Y2 = (bf16_t*)(ws + WS_SGB);
        for (int ph = 0; ph < 2; ++ph) {
            { MoeOrderDN S{(const char*)HID, (const char*)WDN, G, vcu, ph == 0 ? 0 : 3, ph == 0 ? 3 : 4, tb};
              EpiDown E{out, Y0, Y1, Y2, b_down, MOD, TOKL, WLST};
              pg8::gemm_phase_f8<false>(lds, 512, S, E); }
            if (ph == 0) xcd_barrier(bar);
        }
    }
#endif
}

extern "C" void kernel_launch(void* const* d_in, const int* in_sizes, int n_in, void* d_out, int out_size, void* d_ws, size_t ws_size, hipStream_t stream) {
    static int grid = 0;
    if (grid == 0) {
        if (n_in != 23 || in_sizes[0] != NTOK * DM || out_size != NTOK * DM || ws_size < WS_END) { fprintf(stderr, "kernel_launch: unexpected shapes (n_in %d, in0 %d, out %d, ws %zu); nothing launched\n", n_in, n_in > 0 ? in_sizes[0] : -1, out_size, ws_size); grid = -1; return; }
        int dev = 0, cus = 0, per_cu = 0;
        if (hipGetDevice(&dev) != hipSuccess || hipDeviceGetAttribute(&cus, hipDeviceAttributeMultiprocessorCount, dev) != hipSuccess) { grid = -1; return; }
        if (hipFuncSetAttribute((const void*)fwd_kernel, hipFuncAttributeMaxDynamicSharedMemorySize, LDS_BYTES) != hipSuccess) { fprintf(stderr, "kernel_launch: hipFuncSetAttribute failed\n"); grid = -1; return; }
        if (hipOccupancyMaxActiveBlocksPerMultiprocessor(&per_cu, (const void*)fwd_kernel, 512, LDS_BYTES) != hipSuccess || per_cu < 1) fprintf(stderr, "kernel_launch: occupancy query reports %d\n", per_cu);
        (void)hipGetLastError();
        grid = cus;
    }
    if (grid < 0) return;
    if (hipMemsetAsync((char*)d_ws + WS_CTL, 0, CTL_ZERO_BYTES, stream) != hipSuccess) return;
    Args a{};
    for (int i = 0; i < 23; ++i) a.in[i] = d_in[i];
    a.out = (float*)d_out; a.ws = (unsigned char*)d_ws;
    hipLaunchKernelGGL(fwd_kernel, dim3(grid), dim3(512), LDS_BYTES, stream, a);
}
```

```cpp
#include <hip/hip_runtime.h>
#include <cstdio>
#include <cstdint>

#define LAS __attribute__((address_space(3)))
#define GAS __attribute__((address_space(1)))
typedef unsigned short bf16_t;
typedef short bf16x8 __attribute__((ext_vector_type(8)));
typedef short s16x4 __attribute__((ext_vector_type(4)));
typedef float f32x2 __attribute__((ext_vector_type(2)));
typedef float f32x4 __attribute__((ext_vector_type(4)));
typedef float f32x16 __attribute__((ext_vector_type(16)));
typedef unsigned u32x2 __attribute__((ext_vector_type(2)));
typedef unsigned u32x4 __attribute__((ext_vector_type(4)));
typedef int v8i __attribute__((ext_vector_type(8)));
typedef unsigned u32x8 __attribute__((ext_vector_type(8)));

constexpr int NB = 32, SEQ = 2048, DM = 1024, NTOK = NB * SEQ;
constexpr int QLORA = 384, KVLORA = 256, ROPE = 32, NOPE = 64, VD = 64, QKD = 96, NH = 8;
constexpr int SBD = 64;
constexpr int NE = 32, TOPK = 4, DE = 1024;
constexpr int DIN = 4256, DINP = 4352;
constexpr float EPS = 1e-6f;
constexpr float LOG2E = 1.4426950408889634f;
constexpr int LISTCAP = NTOK;
constexpr int MAXTILES = NTOK / 256 + NE;

constexpr size_t MiB = 1u << 20;
constexpr size_t WS_CTL = 0, CTL_ZERO_BYTES = 1 * MiB;
constexpr size_t WS_WIN = 1 * MiB;
constexpr size_t WS_WUQ = 10 * MiB;
constexpr size_t WS_WUKV = 11 * MiB;
constexpr size_t WS_WOM = 12 * MiB;
constexpr size_t WS_WOS = 13 * MiB;
constexpr size_t WS_WOUT = 14 * MiB;
constexpr size_t WS_MOD = 16 * MiB;
constexpr size_t WS_ROWSS = 20 * MiB;
constexpr size_t WS_WIN8 = 18 * MiB;
constexpr size_t WS_H = 32 * MiB;
constexpr size_t WS_KVRAW = WS_H, WS_MERGED = WS_H;
constexpr size_t WS_SGA = 160 * MiB;
constexpr size_t WS_H2 = WS_SGA;
constexpr size_t WS_SGB = 288 * MiB;
constexpr size_t WS_WGU = WS_SGB;
constexpr size_t WS_SB = 416 * MiB;
constexpr size_t WS_WDN = 416 * MiB;
constexpr size_t WS_TOKL = 480 * MiB;
constexpr size_t WS_WL = 512 * MiB;
constexpr size_t WS_HID = 544 * MiB;
constexpr size_t WS_QL = 608 * MiB;
constexpr size_t WS_M8 = 608 * MiB;
constexpr size_t WS_KVL = 656 * MiB;
constexpr size_t WS_KPE = 688 * MiB;
constexpr size_t WS_Q = 692 * MiB;
constexpr size_t WS_K = 788 * MiB;
constexpr size_t WS_OMLA = 884 * MiB;
constexpr size_t WS_H8 = WS_OMLA;
constexpr size_t WS_OSB = 948 * MiB;
constexpr size_t WS_END = 1012 * MiB;
static_assert(WS_HID + (size_t)4 * MAXTILES * 256 * 1024 <= WS_END, "hid (fp8, all four rounds)");
constexpr int CW_BAR = 4096;
constexpr int CW_CNT = 16384;

constexpr int RING_BYTES = 131072;
constexpr int LDSCTL_OFF = RING_BYTES + 1024;
constexpr int LC_BARST = 0;
constexpr int LC_RBASE = 32;
constexpr int LC_TBASE = 64;
constexpr int LC_NE = 640;
constexpr int LC_TILEE = 1152;
constexpr int LDS_BYTES = 147456;
static_assert(LC_TILEE + 4 * MAXTILES * 4 <= LDS_BYTES - LDSCTL_OFF, "lds ctl");

__device__ __forceinline__ unsigned cvt_pk_bf16(float lo, float hi) { unsigned r; asm volatile("v_cvt_pk_bf16_f32 %0, %1, %2" : "=v"(r) : "v"(lo), "v"(hi)); return r; }
__device__ __forceinline__ float bf_lo(unsigned u) { return __builtin_bit_cast(float, u << 16); }
__device__ __forceinline__ float bf_hi(unsigned u) { return __builtin_bit_cast(float, u & 0xffff0000u); }
__device__ __forceinline__ float fast_sigmoid(float x) { return __builtin_amdgcn_rcpf(1.f + __builtin_amdgcn_exp2f(-x * LOG2E)); }

namespace pg8 {
constexpr int BM = 256, BK = 64, HALF = 128, HTB = HALF * BK * 2, STAGE_BYTES = 8 * HTB, NXCD = 8, WGM = 8;
__host__ __device__ __forceinline__ int lds_byte(int r, int c) { const int st = (r >> 4) * 2 + (c >> 5), rr = r & 15, cc = c & 31, ob = rr * 64 + cc * 2; return st * 1024 + (ob ^ (((ob >> 9) & 1) << 5)); }
__host__ __device__ __forceinline__ void stage_rc(int b, int& R, int& C) { const int st = b / 1024, sb = b % 1024, swz = sb ^ (((sb >> 9) & 1) << 5); R = (st >> 1) * 16 + swz / 64; C = (st & 1) * 32 + (swz % 64) / 2; }
__host__ __device__ __forceinline__ int perm32(int rho) { const int n = rho >> 4, i = rho & 15; return 8 * (i >> 2) + 4 * n + (i & 3); }

struct Unit { int pm, pn, e, j0, ne, kk; };

struct DenseOrder {
    const char* A; const char* Bt; int K; int nM, nN, nwg, G, c;
    __device__ void init(const void* A_, const void* Bt_, int M, int N, int K_, int G_, int c_) { A = (const char*)A_; Bt = (const char*)Bt_; K = K_; nM = M / BM; nN = N / BM; nwg = nM * nN; G = G_; c = c_; }
    __device__ __forceinline__ bool next(int i, Unit& u) const {
        const long L = (long)i * G + c; if (L >= nwg) return false;
        int wgid = (int)L; { const int q = nwg / NXCD, r = nwg % NXCD, xcd = wgid % NXCD, off = wgid / NXCD; wgid = (xcd < r ? xcd * (q + 1) : r * (q + 1) + (xcd - r) * q) + off; }
        const int nig = WGM * nN, gid = wgid / nig, fm = gid * WGM, gsz = (nM - fm) < WGM ? (nM - fm) : WGM;
        u.pm = fm + ((wgid % nig) % gsz); u.pn = (wgid % nig) / gsz; u.e = 0; u.j0 = 0; u.ne = 0; u.kk = 0; return true;
    }
    __device__ __forceinline__ const char* a_base(const Unit& u) const { return A + (size_t)u.pm * (size_t)(BM * 2) * K; }
    __device__ __forceinline__ const char* b_base(const Unit& u) const { return Bt + (size_t)u.pn * (size_t)(BM * 2) * K; }
    __device__ __forceinline__ unsigned row_of(const Unit&, int) const { return 0u; }
};

template <bool GATHER, class Epi, class Sched>
__device__ __forceinline__ void gemm_phase(LAS unsigned char* lds, const int K, const Sched& S, const Epi& E) {
    int tid_ = threadIdx.x; asm volatile("" : "+v"(tid_));
    const int tid = tid_, wid = __builtin_amdgcn_readfirstlane(tid >> 6), lane = tid & 63, wr = wid >> 2, wc = wid & 3, fr = lane & 15, fq = lane >> 4;
    const int nt = K / BK;
    int RA[2]; unsigned cofA[2], voffB[2];
#pragma unroll
    for (int i = 0; i < 2; ++i) { int R, C; stage_rc(tid * 16 + i * 8192, R, C); const int Rb = (R & ~31) + perm32(R & 31);
        RA[i] = R; cofA[i] = (unsigned)C * 2u; voffB[i] = (unsigned)(Rb * K + C) * 2u; }
    const size_t kstep = (size_t)(BK * 2);
    const size_t hstep = (size_t)HALF * K * 2;
    const unsigned ldsw = (unsigned)wid * 1024u;
    const int aoff = lds_byte(wr * 64 + fr, fq * 8), boff = lds_byte(wc * 32 + fr, fq * 8);
#define PG8_SA(b, h) (((b) * 2 + (h)) * HTB)
#define PG8_SB(b, h) ((4 + (b) * 2 + (h)) * HTB)
#define PG8_STAGE(bufoff, gbase, voff) do { _Pragma("unroll") for (int _i = 0; _i < 2; ++_i) \
        __builtin_amdgcn_global_load_lds((const unsigned*)((const char*)(gbase) + (voff)[_i]), (LAS unsigned*)(lds + (bufoff) + ldsw + _i * 8192), 16, 0, 0); } while (0)
#define PG8_LDA(dst, b, h) do { _Pragma("unroll") for (int m = 0; m < 4; ++m) _Pragma("unroll") for (int k = 0; k < 2; ++k) dst[m][k] = *(const LAS bf16x8*)(lds + PG8_SA(b, h) + aoff + m * 2048 + k * 1024); } while (0)
#define PG8_LDB(dst, b, h) do { _Pragma("unroll") for (int n = 0; n < 2; ++n) _Pragma("unroll") for (int k = 0; k < 2; ++k) dst[n][k] = *(const LAS bf16x8*)(lds + PG8_SB(b, h) + boff + n * 2048 + k * 1024); } while (0)
#define PG8_MMA(ai, bj, At, Bt) do { __builtin_amdgcn_s_setprio(1); _Pragma("unroll") for (int m = 0; m < 4; ++m) _Pragma("unroll") for (int n = 0; n < 2; ++n) _Pragma("unroll") for (int k = 0; k < 2; ++k) \
        acc[ai][bj][m][n] = __builtin_amdgcn_mfma_f32_16x16x32_bf16(Bt[n][k], At[m][k], acc[ai][bj][m][n], 0, 0, 0); __builtin_amdgcn_s_setprio(0); } while (0)
#define PG8_WAIT_V(n) asm volatile("s_waitcnt vmcnt(" #n ")" ::: "memory")
#define PG8_WAIT_L(n) asm volatile("s_waitcnt lgkmcnt(" #n ")" ::: "memory")
#define PG8_BAR __builtin_amdgcn_s_barrier()
#define PG8_SCHED __builtin_amdgcn_sched_barrier(0)
#define PG8_AOFFS(dst, u) do { _Pragma("unroll") for (int _h = 0; _h < 2; ++_h) _Pragma("unroll") for (int _i = 0; _i < 2; ++_i) { \
        const unsigned _row = GATHER ? S.row_of(u, _h * HALF + RA[_i]) : (unsigned)(_h * HALF + RA[_i]); dst[_h][_i] = _row * (unsigned)(K * 2) + cofA[_i]; } } while (0)
    Unit cur, nxt; int ui = 0;
    if (!S.next(0, cur)) return;
    f32x4 acc[2][2][4][2];
#pragma unroll
    for (int a = 0; a < 2; ++a)
#pragma unroll
        for (int b = 0; b < 2; ++b)
#pragma unroll
            for (int m = 0; m < 4; ++m)
#pragma unroll
                for (int n = 0; n < 2; ++n) acc[a][b][m][n] = (f32x4){0.f, 0.f, 0.f, 0.f};
    bf16x8 At[4][2], B0[2][2], B1[2][2];
    unsigned oc[2][2], on[2][2];
    PG8_AOFFS(oc, cur);
    const char* cA = S.a_base(cur); const char* cB = S.b_base(cur);
    PG8_STAGE(PG8_SB(0, 0), cB, voffB); PG8_STAGE(PG8_SB(0, 1), cB + hstep, voffB); PG8_STAGE(PG8_SA(0, 0), cA, oc[0]); PG8_STAGE(PG8_SA(0, 1), cA, oc[1]);
    if (wr == 1) PG8_BAR;
    PG8_WAIT_V(2); PG8_BAR;
    PG8_STAGE(PG8_SB(1, 0), cB + kstep, voffB); PG8_STAGE(PG8_SA(1, 0), cA + kstep, oc[0]); PG8_STAGE(PG8_SB(1, 1), cB + hstep + kstep, voffB);
    PG8_WAIT_V(6); PG8_BAR;
    for (;;) {
        const bool has_next = S.next(ui + 1, nxt);
        const char* nA = has_next ? S.a_base(nxt) : cA; const char* nB = has_next ? S.b_base(nxt) : cB;
        if constexpr (GATHER) { if (has_next) { PG8_AOFFS(on, nxt);
            _Pragma("unroll") for (int _h = 0; _h < 2; ++_h) _Pragma("unroll") for (int _i = 0; _i < 2; ++_i) asm volatile("" : "+v"(on[_h][_i]));
          } else {
#pragma unroll
            for (int _h = 0; _h < 2; ++_h)
#pragma unroll
                for (int _i = 0; _i < 2; ++_i) on[_h][_i] = oc[_h][_i]; } }
#pragma nounroll
        for (int t = 0; t < nt; t += 2) {
            const bool last = (t == nt - 2);
            const char* a1 = cA + (size_t)(t + 1) * kstep;
            const char* a2 = last ? nA : cA + (size_t)(t + 2) * kstep; const char* b2 = last ? nB : cB + (size_t)(t + 2) * kstep;
            const char* a3 = a2 + kstep; const char* b3 = b2 + kstep;
            unsigned o2[2][2];
#pragma unroll
            for (int _h = 0; _h < 2; ++_h)
#pragma unroll
                for (int _i = 0; _i < 2; ++_i) o2[_h][_i] = (GATHER && last) ? on[_h][_i] : oc[_h][_i];
            PG8_LDB(B0, 0, 0); PG8_LDB(B1, 0, 1); PG8_SCHED; PG8_LDA(At, 0, 0); PG8_STAGE(PG8_SA(1, 1), a1, oc[1]);
            PG8_WAIT_V(8); PG8_WAIT_L(0); PG8_BAR; PG8_MMA(0, 0, At, B0); PG8_MMA(0, 1, At, B1); PG8_BAR; PG8_SCHED;
            PG8_LDA(At, 0, 1); PG8_STAGE(PG8_SB(0, 0), b2, voffB); PG8_STAGE(PG8_SB(0, 1), b2 + hstep, voffB); PG8_STAGE(PG8_SA(0, 0), a2, o2[0]);
            PG8_WAIT_V(8); PG8_WAIT_L(0); PG8_BAR; PG8_MMA(1, 0, At, B0); PG8_MMA(1, 1, At, B1); PG8_BAR; PG8_SCHED;
            PG8_LDB(B0, 1, 0); PG8_LDB(B1, 1, 1); PG8_SCHED; PG8_LDA(At, 1, 0); PG8_STAGE(PG8_SA(0, 1), a2, o2[1]);
            PG8_WAIT_V(8); PG8_WAIT_L(0); PG8_BAR; PG8_MMA(0, 0, At, B0); PG8_MMA(0, 1, At, B1); PG8_BAR; PG8_SCHED;
            PG8_LDA(At, 1, 1); PG8_STAGE(PG8_SB(1, 0), b3, voffB); PG8_STAGE(PG8_SB(1, 1), b3 + hstep, voffB); PG8_STAGE(PG8_SA(1, 0), a3, o2[0]);
            PG8_WAIT_V(8); PG8_WAIT_L(0); PG8_BAR; PG8_MMA(1, 0, At, B0); PG8_MMA(1, 1, At, B1); PG8_BAR; PG8_SCHED;
        }
        if (wr == 0) PG8_BAR;
        E(acc, cur, wr, wc, fr, fq);
        if (!has_next) break;
#pragma unroll
        for (int a = 0; a < 2; ++a)
#pragma unroll
            for (int b = 0; b < 2; ++b)
#pragma unroll
                for (int m = 0; m < 4; ++m)
#pragma unroll
                    for (int n = 0; n < 2; ++n) acc[a][b][m][n] = (f32x4){0.f, 0.f, 0.f, 0.f};
        cur = nxt; cA = nA; cB = nB; ++ui;
        if constexpr (GATHER) {
#pragma unroll
        for (int _h = 0; _h < 2; ++_h)
#pragma unroll
            for (int _i = 0; _i < 2; ++_i) oc[_h][_i] = on[_h][_i]; }
        if (wr == 1) PG8_BAR;
    }
    PG8_WAIT_V(0);
    PG8_BAR;
#undef PG8_SA
#undef PG8_SB
#undef PG8_STAGE
#undef PG8_LDA
#undef PG8_LDB
#undef PG8_MMA
#undef PG8_WAIT_V
#undef PG8_WAIT_L
#undef PG8_BAR
#undef PG8_SCHED
#undef PG8_AOFFS
}
template <bool GATHER, class Epi, class Sched>
__device__ __forceinline__ void gemm_phase_f8(LAS unsigned char* lds, const int K, const Sched& S, const Epi& E) {
    int tid_ = threadIdx.x; asm volatile("" : "+v"(tid_));
    const int tid = tid_, wid = __builtin_amdgcn_readfirstlane(tid >> 6), lane = tid & 63, wr = wid >> 2, wc = wid & 3, fr = lane & 15, fq = lane >> 4;
    const int nt = K / BK;
    int RA[2]; unsigned cofA[2], voffB[2];
#pragma unroll
    for (int i = 0; i < 2; ++i) { int R, C; stage_rc(tid * 16 + i * 8192, R, C); const int Rb = (R & ~31) + perm32(R & 31);
        RA[i] = R; cofA[i] = (unsigned)C * 2u; voffB[i] = (unsigned)(Rb * K + C) * 2u; }
    const size_t kstep = (size_t)(BK * 2);
    const size_t hstep = (size_t)HALF * K * 2;
    const unsigned ldsw = (unsigned)wid * 1024u;
    const int aoff = lds_byte(wr * 64 + fr, 16 * (fq & 1)) + (fq >> 1) * 1024, boff = lds_byte(wc * 32 + fr, 16 * (fq & 1)) + (fq >> 1) * 1024;
#define PG8_SA(b, h) (((b) * 2 + (h)) * HTB)
#define PG8_SB(b, h) ((4 + (b) * 2 + (h)) * HTB)
#define PG8_STAGE(bufoff, gbase, voff) do { _Pragma("unroll") for (int _i = 0; _i < 2; ++_i) \
        __builtin_amdgcn_global_load_lds((const unsigned*)((const char*)(gbase) + (voff)[_i]), (LAS unsigned*)(lds + (bufoff) + ldsw + _i * 8192), 16, 0, 0); } while (0)
#define PG8_LD32(p_) __builtin_shufflevector(*(const LAS u32x4*)(p_), *(const LAS u32x4*)((p_) + 16), 0, 1, 2, 3, 4, 5, 6, 7)
#define PG8_LDA(dst, b, h) do { _Pragma("unroll") for (int m = 0; m < 4; ++m) dst[m] = PG8_LD32(lds + PG8_SA(b, h) + aoff + m * 2048); } while (0)
#define PG8_LDB(dst, b, h) do { _Pragma("unroll") for (int n = 0; n < 2; ++n) dst[n] = PG8_LD32(lds + PG8_SB(b, h) + boff + n * 2048); } while (0)
#define PG8_F8(fr_) ((v8i){(int)fr_[0][0], (int)fr_[0][1], (int)fr_[0][2], (int)fr_[0][3], (int)fr_[1][0], (int)fr_[1][1], (int)fr_[1][2], (int)fr_[1][3]})
#define PG8_MMA(ai, bj, At, Bt) do { __builtin_amdgcn_s_setprio(1); _Pragma("unroll") for (int m = 0; m < 4; ++m) _Pragma("unroll") for (int n = 0; n < 2; ++n) \
        asm volatile("v_mfma_scale_f32_16x16x128_f8f6f4 %0, %1, %2, %0, %3, %3 op_sel_hi:[0,0,0]" : "+v"(acc[ai][bj][m][n]) : "v"(Bt[n]), "v"(At[m]), "v"(one_scale)); __builtin_amdgcn_s_setprio(0); } while (0)
#define PG8_WAIT_V(n) asm volatile("s_waitcnt vmcnt(" #n ")" ::: "memory")
#define PG8_WAIT_L(n) asm volatile("s_waitcnt lgkmcnt(" #n ")" ::: "memory")
#define PG8_BAR __builtin_amdgcn_s_barrier()
#define PG8_SCHED __builtin_amdgcn_sched_barrier(0)
#define PG8_AOFFS(dst, u) do { _Pragma("unroll") for (int _h = 0; _h < 2; ++_h) _Pragma("unroll") for (int _i = 0; _i < 2; ++_i) { \
        const unsigned _row = GATHER ? S.row_of(u, _h * HALF + RA[_i]) : (unsigned)(_h * HALF + RA[_i]); dst[_h][_i] = _row * (unsigned)(K * 2) + cofA[_i]; } } while (0)
    Unit cur, nxt; int ui = 0;
    if (!S.next(0, cur)) return;
    f32x4 acc[2][2][4][2];
#pragma unroll
    for (int a = 0; a < 2; ++a)
#pragma unroll
        for (int b = 0; b < 2; ++b)
#pragma unroll
            for (int m = 0; m < 4; ++m)
#pragma unroll
                for (int n = 0; n < 2; ++n) { acc[a][b][m][n] = (f32x4){0.f, 0.f, 0.f, 0.f}; asm volatile("" : "+v"(acc[a][b][m][n])); }
    u32x8 At[4], B0[2], B1[2];
    int one_scale = 0x7f7f7f7f; asm volatile("" : "+v"(one_scale));
    unsigned oc[2][2], on[2][2];
    PG8_AOFFS(oc, cur);
    const char* cA = S.a_base(cur); const char* cB = S.b_base(cur);
    PG8_STAGE(PG8_SB(0, 0), cB, voffB); PG8_STAGE(PG8_SB(0, 1), cB + hstep, voffB); PG8_STAGE(PG8_SA(0, 0), cA, oc[0]); PG8_STAGE(PG8_SA(0, 1), cA, oc[1]);
    if (wr == 1) PG8_BAR;
    PG8_WAIT_V(2); PG8_BAR;
    PG8_STAGE(PG8_SB(1, 0), cB + kstep, voffB); PG8_STAGE(PG8_SA(1, 0), cA + kstep, oc[0]); PG8_STAGE(PG8_SB(1, 1), cB + hstep + kstep, voffB);
    PG8_WAIT_V(6); PG8_BAR;
    Unit nn; bool has_next = S.next(1, nxt);
    if constexpr (GATHER) { if (has_next) { PG8_AOFFS(on, nxt);
            _Pragma("unroll") for (int _h = 0; _h < 2; ++_h) _Pragma("unroll") for (int _i = 0; _i < 2; ++_i) asm volatile("" : "+v"(on[_h][_i]));
          } else {
#pragma unroll
            for (int _h = 0; _h < 2; ++_h)
#pragma unroll
                for (int _i = 0; _i < 2; ++_i) on[_h][_i] = oc[_h][_i]; } }
    for (;;) {
        const char* nA = has_next ? S.a_base(nxt) : cA; const char* nB = has_next ? S.b_base(nxt) : cB;
#pragma nounroll
        for (int t = 0; t < nt; t += 2) {
            const bool last = (t == nt - 2);
            const char* a1 = cA + (size_t)(t + 1) * kstep;
            const char* a2 = last ? nA : cA + (size_t)(t + 2) * kstep; const char* b2 = last ? nB : cB + (size_t)(t + 2) * kstep;
            const char* a3 = a2 + kstep; const char* b3 = b2 + kstep;
            unsigned o2[2][2];
#pragma unroll
            for (int _h = 0; _h < 2; ++_h)
#pragma unroll
                for (int _i = 0; _i < 2; ++_i) o2[_h][_i] = (GATHER && last) ? on[_h][_i] : oc[_h][_i];
            PG8_LDB(B0, 0, 0); PG8_LDB(B1, 0, 1); PG8_SCHED; PG8_LDA(At, 0, 0); PG8_STAGE(PG8_SA(1, 1), a1, oc[1]);
            PG8_WAIT_V(8); PG8_WAIT_L(0); PG8_BAR; PG8_MMA(0, 0, At, B0); PG8_MMA(0, 1, At, B1); PG8_BAR; PG8_SCHED;
            PG8_LDA(At, 0, 1); PG8_STAGE(PG8_SB(0, 0), b2, voffB); PG8_STAGE(PG8_SB(0, 1), b2 + hstep, voffB); PG8_STAGE(PG8_SA(0, 0), a2, o2[0]);
            PG8_WAIT_V(8); PG8_WAIT_L(0); PG8_BAR; PG8_MMA(1, 0, At, B0); PG8_MMA(1, 1, At, B1); PG8_BAR; PG8_SCHED;
            PG8_LDB(B0, 1, 0); PG8_LDB(B1, 1, 1); PG8_SCHED; PG8_LDA(At, 1, 0); PG8_STAGE(PG8_SA(0, 1), a2, o2[1]);
            PG8_WAIT_V(8); PG8_WAIT_L(0); PG8_BAR; PG8_MMA(0, 0, At, B0); PG8_MMA(0, 1, At, B1); PG8_BAR; PG8_SCHED;
            PG8_LDA(At, 1, 1); PG8_STAGE(PG8_SB(1, 0), b3, voffB); PG8_STAGE(PG8_SB(1, 1), b3 + hstep, voffB); PG8_STAGE(PG8_SA(1, 0), a3, o2[0]);
            PG8_WAIT_V(8); PG8_WAIT_L(0); PG8_BAR; PG8_MMA(1, 0, At, B0); PG8_MMA(1, 1, At, B1); PG8_BAR; PG8_SCHED;
        }
        asm volatile("s_nop 15\n\ts_nop 15" ::: "memory");
        if (wr == 0) PG8_BAR;
        const bool has_nn = has_next && S.next(ui + 2, nn);
        unsigned onn[2][2];
        if constexpr (GATHER) { if (has_nn) { PG8_AOFFS(onn, nn); } else {
#pragma unroll
            for (int _h = 0; _h < 2; ++_h)
#pragma unroll
                for (int _i = 0; _i < 2; ++_i) onn[_h][_i] = on[_h][_i]; } }
        E(acc, cur, wr, wc, fr, fq);
        if (!has_next) break;
#pragma unroll
        for (int a = 0; a < 2; ++a)
#pragma unroll
            for (int b = 0; b < 2; ++b)
#pragma unroll
                for (int m = 0; m < 4; ++m)
#pragma unroll
                    for (int n = 0; n < 2; ++n) { acc[a][b][m][n] = (f32x4){0.f, 0.f, 0.f, 0.f}; asm volatile("" : "+v"(acc[a][b][m][n])); }
        cur = nxt; cA = nA; cB = nB; ++ui; nxt = nn; has_next = has_nn;
        if constexpr (GATHER) {
#pragma unroll
        for (int _h = 0; _h < 2; ++_h)
#pragma unroll
            for (int _i = 0; _i < 2; ++_i) { oc[_h][_i] = on[_h][_i]; asm volatile("" : "+v"(onn[_h][_i])); on[_h][_i] = onn[_h][_i]; } }
        if (wr == 1) PG8_BAR;
    }
    PG8_WAIT_V(0);
    PG8_BAR;
#undef PG8_SA
#undef PG8_SB
#undef PG8_STAGE
#undef PG8_LDA
#undef PG8_LDB
#undef PG8_MMA
#undef PG8_WAIT_V
#undef PG8_WAIT_L
#undef PG8_BAR
#undef PG8_SCHED
#undef PG8_AOFFS
#undef PG8_F8
}
}
#define XB_TMO      128
#define XB_XCNT(j)  (256  + 64 * (j))
#define XB_XSUB(j)  (1280 + 64 * (j))
#define XB_XGEN(j)  (2304 + 64 * (j))
#define XB_TOP      3328
#define XB_TOPGEN   3392
#define XCD_BAR_WORDS 3456
#define XB_SPIN_CAP (1u << 18)

__device__ __forceinline__ unsigned xb_ld(unsigned* p)              { return __hip_atomic_load(p, __ATOMIC_RELAXED, __HIP_MEMORY_SCOPE_AGENT); }
__device__ __forceinline__ unsigned xb_add(unsigned* p, unsigned v) { return __hip_atomic_fetch_add(p, v, __ATOMIC_RELAXED, __HIP_MEMORY_SCOPE_AGENT); }
__device__ __forceinline__ unsigned xb_xcc_id() { return (unsigned)__builtin_amdgcn_s_getreg((3 << 11) | 20) & 0xFu; }
#define XB_SPIN(cond, bar) do { unsigned _sp = 0; while (cond) { __builtin_amdgcn_s_sleep(1); \
    if ((++_sp & 255u) == 0u) { if (xb_ld(&(bar)[XB_TMO])) break; if (_sp > XB_SPIN_CAP) { atomicAdd(&(bar)[XB_TMO], 1u); break; } } } } while (0)

struct XcdBarrier {
    unsigned* bar; unsigned x;
    volatile LAS unsigned* st;
};

__device__ __forceinline__ XcdBarrier xcd_barrier_post(unsigned* bar, volatile LAS unsigned* st) {
    XcdBarrier b; b.bar = bar; b.x = xb_xcc_id(); b.st = st;
    if (threadIdx.x == 0) (void)xb_add(&bar[XB_XCNT(b.x)], 1u);
    return b;
}
__device__ __forceinline__ void xcd_barrier_complete(unsigned* bar, unsigned x, unsigned& nloc, unsigned& nx) {
    const unsigned G = gridDim.x * gridDim.y * gridDim.z;
    unsigned sum, cnt, mine, sp = 0u;
    for (;;) {
        sum = 0u; cnt = 0u; mine = 0u;
#pragma unroll
        for (unsigned j = 0; j < 16; ++j) { const unsigned c = xb_ld(&bar[XB_XCNT(j)]); sum += c; cnt += (c > 0u) ? 1u : 0u; mine = (j == x) ? c : mine; }
        if (sum == G) break;
        __builtin_amdgcn_s_sleep(1);
        if ((++sp & 255u) == 0u) { if (xb_ld(&bar[XB_TMO])) break; if (sp > XB_SPIN_CAP) { atomicAdd(&bar[XB_TMO], 1u); break; } }
    }
    nloc = mine > 0u ? mine : 1u; nx = cnt > 0u ? cnt : 1u;
}

__device__ __forceinline__ void xcd_barrier(const XcdBarrier& b) {
    asm volatile("s_waitcnt vmcnt(0)" ::: "memory");
    __syncthreads();
    if (threadIdx.x == 0) {
        unsigned* bar = b.bar;
        __builtin_amdgcn_s_waitcnt(0);
        unsigned nloc = b.st[0], nx = b.st[1];
        if (nloc == 0u) { xcd_barrier_complete(bar, b.x, nloc, nx); b.st[0] = nloc; b.st[1] = nx; }
        const unsigned old = xb_add(&bar[XB_XSUB(b.x)], 1u);
        const unsigned gen = old / nloc;
        if (old + 1u == (gen + 1u) * nloc) {
            __builtin_amdgcn_fence(__ATOMIC_RELEASE, "agent");
            asm volatile("s_waitcnt vmcnt(0)" ::: "memory");
            const unsigned og = xb_add(&bar[XB_TOP], 1u);
            const unsigned tg = og / nx;
            if (og + 1u == (tg + 1u) * nx) xb_add(&bar[XB_TOPGEN], 1u);
            else XB_SPIN(xb_ld(&bar[XB_TOPGEN]) == tg, bar);
            __builtin_amdgcn_fence(__ATOMIC_ACQUIRE, "agent");
            xb_add(&bar[XB_XGEN(b.x)], 1u);
            asm volatile("s_waitcnt vmcnt(0)" ::: "memory");
        } else {
            XB_SPIN(xb_ld(&bar[XB_XGEN(b.x)]) == gen, bar);
            __builtin_amdgcn_fence(__ATOMIC_ACQUIRE, "agent");
            asm volatile("s_waitcnt vmcnt(0)" ::: "memory");
        }
    }
    __syncthreads();
}

#define LDS_WAIT() asm volatile("s_waitcnt lgkmcnt(0)" ::: "memory")
#define VM_WAIT() asm volatile("s_waitcnt vmcnt(0)" ::: "memory")
#define MFMA32(a, b, c) __builtin_amdgcn_mfma_f32_32x32x16_bf16((a), (b), (c), 0, 0, 0)
__device__ __forceinline__ float wave_sum(float v) {
#pragma unroll
    for (int o = 1; o < 64; o <<= 1) v += __shfl_xor(v, o);
    return v;
}
__device__ __forceinline__ int crow(int i, int hh) { return (i & 3) + 8 * (i >> 2) + 4 * hh; }
__device__ __forceinline__ bf16x8 pack8(float a0, float a1, float a2, float a3, float a4, float a5, float a6, float a7) {
    u32x4 p; p.x = cvt_pk_bf16(a0, a1); p.y = cvt_pk_bf16(a2, a3); p.z = cvt_pk_bf16(a4, a5); p.w = cvt_pk_bf16(a6, a7);
    return __builtin_bit_cast(bf16x8, p);
}

struct Ctx {
    LAS unsigned char* lds;
    int tid, lane, wave, vcu, G;
};

__device__ __forceinline__ void transpose_item(const float* W, int K, int N, bf16_t* WT, int k0, int n0, int drow0, LAS float* scr, int lane, const float* kgain = nullptr) {
#pragma unroll 8
    for (int i = 0; i < 32; ++i) { const int kk = 2 * i + (lane >> 5); float wv = W[(size_t)(k0 + kk) * N + n0 + (lane & 31)]; if (kgain) wv *= kgain[k0 + kk]; scr[kk * 33 + (lane & 31)] = wv; }
    LDS_WAIT(); asm volatile("" ::: "memory");
    const int c = lane & 7;
#pragma unroll
    for (int j = 0; j < 4; ++j) { const int n = (lane >> 3) + 8 * j; const LAS float* s = scr + (8 * c) * 33 + n;
        u32x4 o; o.x = cvt_pk_bf16(s[0 * 33], s[1 * 33]); o.y = cvt_pk_bf16(s[2 * 33], s[3 * 33]); o.z = cvt_pk_bf16(s[4 * 33], s[5 * 33]); o.w = cvt_pk_bf16(s[6 * 33], s[7 * 33]);
        *(GAS u32x4*)(WT + (size_t)(drow0 + n) * K + k0 + 8 * c) = o; }
    LDS_WAIT(); asm volatile("" ::: "memory");
}

__device__ __forceinline__ unsigned pk4_fp8(float a, float b, float c, float d) { int p = __builtin_amdgcn_cvt_pk_fp8_f32(a, b, 0, false); p = __builtin_amdgcn_cvt_pk_fp8_f32(c, d, p, true); return (unsigned)p; }
__device__ __forceinline__ void transpose_item_f8(const float* W, int K, int N, unsigned char* WT, int k0, int n0, int drow0, float scl, LAS float* scr, int lane) {
#pragma unroll 8
    for (int i = 0; i < 32; ++i) { const int kk = 2 * i + (lane >> 5); scr[kk * 33 + (lane & 31)] = W[(size_t)(k0 + kk) * N + n0 + (lane & 31)]; }
    LDS_WAIT(); asm volatile("" ::: "memory");
    const int c = lane & 7;
#pragma unroll
    for (int j = 0; j < 4; ++j) { const int n = (lane >> 3) + 8 * j; const LAS float* s = scr + (8 * c) * 33 + n;
        u32x2 o; o.x = pk4_fp8(s[0 * 33] * scl, s[1 * 33] * scl, s[2 * 33] * scl, s[3 * 33] * scl); o.y = pk4_fp8(s[4 * 33] * scl, s[5 * 33] * scl, s[6 * 33] * scl, s[7 * 33] * scl);
        *(GAS u32x2*)(WT + (size_t)(drow0 + n) * K + k0 + 8 * c) = o; }
    LDS_WAIT(); asm volatile("" ::: "memory");
}

constexpr float WSCALE = 32.f, WDESCALE = 1.f / 32.f;
typedef const f32x4 (&AccRef)[2][2][4][2];

struct EpiNull { __device__ __forceinline__ void operator()(AccRef acc, const pg8::Unit& u, int wr, int wc, int fr, int fq) const {
        float s = 0.f;
#pragma unroll
        for (int ai = 0; ai < 2; ++ai)
#pragma unroll
            for (int bj = 0; bj < 2; ++bj)
#pragma unroll
                for (int m = 0; m < 4; ++m)
#pragma unroll
                    for (int n = 0; n < 2; ++n) s += acc[ai][bj][m][n][0] + acc[ai][bj][m][n][1] + acc[ai][bj][m][n][2] + acc[ai][bj][m][n][3];
        asm volatile("" :: "v"(s)); } };
struct EpiStore {
    bf16_t* O; int ldc; const float* SS; float inv_n;
    __device__ __forceinline__ void operator()(AccRef acc, const pg8::Unit& u, int wr, int wc, int fr, int fq) const {
        const int row0 = u.pm * 256 + wr * 64 + fr, col0 = u.pn * 256 + wc * 32 + 8 * fq;
#pragma unroll
        for (int ai = 0; ai < 2; ++ai)
#pragma unroll
            for (int m = 0; m < 4; ++m) { bf16_t* rowp = O + (size_t)(row0 + ai * 128 + m * 16) * ldc + col0;
                const float rs = rsqrtf(SS[(size_t)(row0 + ai * 128 + m * 16) * 2] * inv_n + EPS);
#pragma unroll
                for (int bj = 0; bj < 2; ++bj) { const f32x4 v0 = acc[ai][bj][m][0] * rs, v1 = acc[ai][bj][m][1] * rs;
                    u32x4 w; w.x = cvt_pk_bf16(v0[0], v0[1]); w.y = cvt_pk_bf16(v0[2], v0[3]); w.z = cvt_pk_bf16(v1[0], v1[1]); w.w = cvt_pk_bf16(v1[2], v1[3]);
                    *(u32x4*)(rowp + bj * 128) = w; } }
    }
};

struct EpiProj {
    bf16_t *QL, *KVL, *KPE, *SB, *SGA, *SGB; int cbase; float dsc; float* ROWSS;
    __device__ __forceinline__ void operator()(AccRef acc, const pg8::Unit& u, int wr, int wc, int fr, int fq) const {
        const int row0 = u.pm * 256 + wr * 64 + fr;
#pragma unroll
        for (int bj = 0; bj < 2; ++bj) {
            const int cg = cbase + u.pn * 256 + bj * 128 + wc * 32;
            bf16_t* base; int ld, co; bool sig = false; int lat = -1;
            if (cg < 384) { base = QL; ld = 384; co = cg; lat = 0; }
            else if (cg < 640) { base = KVL; ld = 256; co = cg - 384; lat = 1; }
            else if (cg < 672) { base = KPE; ld = 32; co = cg - 640; }
            else if (cg < 768) { continue; }
            else if (cg < 2304) { base = SB; ld = 1536; co = cg - 768; }
            else if (cg < 3328) { base = SGA; ld = 1024; co = cg - 2304; sig = true; }
            else { base = SGB; ld = 1024; co = cg - 3328; sig = true; }
#pragma unroll
            for (int ai = 0; ai < 2; ++ai)
#pragma unroll
                for (int m = 0; m < 4; ++m) { f32x4 v0 = acc[ai][bj][m][0], v1 = acc[ai][bj][m][1];
                    if (sig) {
                        int q0 = 0, q1 = 0;
#pragma unroll
                        for (int j = 0; j < 4; ++j) { q0 = __builtin_amdgcn_cvt_pk_u8_f32(fast_sigmoid(v0[j] * dsc) * 255.f, j, q0); q1 = __builtin_amdgcn_cvt_pk_u8_f32(fast_sigmoid(v1[j] * dsc) * 255.f, j, q1); }
                        u32x2 w8; w8.x = (unsigned)q0; w8.y = (unsigned)q1;
                        *(u32x2*)((unsigned char*)base + (size_t)(row0 + ai * 128 + m * 16) * 1024 + co + 8 * fq) = w8; continue; }
                    u32x4 w; w.x = cvt_pk_bf16(v0[0], v0[1]); w.y = cvt_pk_bf16(v0[2], v0[3]); w.z = cvt_pk_bf16(v1[0], v1[1]); w.w = cvt_pk_bf16(v1[2], v1[3]);
                    *(u32x4*)(base + (size_t)(row0 + ai * 128 + m * 16) * ld + co + 8 * fq) = w;
                    if (lat >= 0) {
                        float ss = bf_lo(w.x) * bf_lo(w.x) + bf_hi(w.x) * bf_hi(w.x) + bf_lo(w.y) * bf_lo(w.y) + bf_hi(w.y) * bf_hi(w.y) + bf_lo(w.z) * bf_lo(w.z) + bf_hi(w.z) * bf_hi(w.z) + bf_lo(w.w) * bf_lo(w.w) + bf_hi(w.w) * bf_hi(w.w);
                        ss += __shfl_xor(ss, 16); ss += __shfl_xor(ss, 32);
                        if (fq == 0) atomicAdd(ROWSS + (size_t)(row0 + ai * 128 + m * 16) * 2 + lat, ss); } }
        }
    }
};

template <bool SECOND> struct EpiMerge {
    bf16_t* MG; const bf16_t* SG; unsigned char* M8;
    __device__ __forceinline__ void operator()(AccRef acc, const pg8::Unit& u, int wr, int wc, int fr, int fq) const {
        const int row0 = u.pm * 256 + wr * 64 + fr, col0 = u.pn * 256 + wc * 32 + 8 * fq;
#pragma unroll
        for (int ai = 0; ai < 2; ++ai)
#pragma unroll
            for (int m = 0; m < 4; ++m) { const size_t ro = (size_t)(row0 + ai * 128 + m * 16) * 1024 + col0;
#pragma unroll
                for (int bj = 0; bj < 2; ++bj) { const f32x4 v0 = acc[ai][bj][m][0], v1 = acc[ai][bj][m][1];
                    const u32x2 g = *(const u32x2*)((const unsigned char*)SG + ro + bj * 128);
                    constexpr float I255 = 1.f / 255.f;
                    float r0 = (float)(g.x & 0xffu) * I255 * v0[0], r1 = (float)((g.x >> 8) & 0xffu) * I255 * v0[1], r2 = (float)((g.x >> 16) & 0xffu) * I255 * v0[2], r3 = (float)(g.x >> 24) * I255 * v0[3];
                    float r4 = (float)(g.y & 0xffu) * I255 * v1[0], r5 = (float)((g.y >> 8) & 0xffu) * I255 * v1[1], r6 = (float)((g.y >> 16) & 0xffu) * I255 * v1[2], r7 = (float)(g.y >> 24) * I255 * v1[3];
                    if (SECOND) { const u32x4 p = *(const u32x4*)(MG + ro + bj * 128);
                        r0 += bf_lo(p.x); r1 += bf_hi(p.x); r2 += bf_lo(p.y); r3 += bf_hi(p.y); r4 += bf_lo(p.z); r5 += bf_hi(p.z); r6 += bf_lo(p.w); r7 += bf_hi(p.w); }
                    if (SECOND) { u32x2 w; w.x = pk4_fp8(r0, r1, r2, r3); w.y = pk4_fp8(r4, r5, r6, r7); *(u32x2*)(M8 + ro + bj * 128) = w; }
                    else { u32x4 w; w.x = cvt_pk_bf16(r0, r1); w.y = cvt_pk_bf16(r2, r3); w.z = cvt_pk_bf16(r4, r5); w.w = cvt_pk_bf16(r6, r7);
                        *(u32x4*)(MG + ro + bj * 128) = w; } } }
    }
};

struct EpiWout {
    const float* X; float* OUT; const float* MOD; float dsc;
    __device__ __forceinline__ void operator()(AccRef acc, const pg8::Unit& u, int wr, int wc, int fr, int fq) const {
        const int row0 = u.pm * 256 + wr * 64 + fr, col0 = u.pn * 256 + wc * 32 + 8 * fq;
        const float* ga = MOD + (size_t)(u.pm >> 3) * 6144 + 2048 + col0;
        f32x4 g[2][2];
#pragma unroll
        for (int bj = 0; bj < 2; ++bj)
#pragma unroll
            for (int n = 0; n < 2; ++n) g[bj][n] = *(const f32x4*)(ga + bj * 128 + 4 * n) * dsc;
#pragma unroll
        for (int ai = 0; ai < 2; ++ai)
#pragma unroll
            for (int m = 0; m < 4; ++m) { const size_t ro = (size_t)(row0 + ai * 128 + m * 16) * 1024 + col0;
#pragma unroll
                for (int bj = 0; bj < 2; ++bj)
#pragma unroll
                    for (int n = 0; n < 2; ++n) { const f32x4 xv = *(const f32x4*)(X + ro + bj * 128 + 4 * n);
                        *(f32x4*)(OUT + ro + bj * 128 + 4 * n) = xv + g[bj][n] * acc[ai][bj][m][n]; } }
    }
};

struct EpiGateUp {
    unsigned char* HID; const float* BGU;
    __device__ __forceinline__ void operator()(AccRef acc, const pg8::Unit& u, int wr, int wc, int fr, int fq) const {
        const int row0 = u.pm * 256 + wr * 64 + fr, hc = u.pn * 128 + wc * 32 + 8 * fq;
        const float* bg = BGU + (size_t)u.e * 2048 + hc;
        f32x4 bgate[2], bup[2];
#pragma unroll
        for (int n = 0; n < 2; ++n) { bgate[n] = *(const f32x4*)(bg + 4 * n); bup[n] = *(const f32x4*)(bg + 1024 + 4 * n); }
#pragma unroll
        for (int ai = 0; ai < 2; ++ai)
#pragma unroll
            for (int m = 0; m < 4; ++m) { float r[8];
#pragma unroll
                for (int n = 0; n < 2; ++n) { const f32x4 gv = acc[ai][0][m][n] * WDESCALE + bgate[n], uv = acc[ai][1][m][n] * WDESCALE + bup[n];
#pragma unroll
                    for (int j = 0; j < 4; ++j) { const float g = __builtin_fminf(gv[j], 7.f); const float up = __builtin_fminf(__builtin_fmaxf(uv[j], -7.f), 7.f);
                        r[4 * n + j] = (up + 1.f) * (g * fast_sigmoid(1.702f * g)); } }
                u32x2 w; w.x = pk4_fp8(r[0], r[1], r[2], r[3]); w.y = pk4_fp8(r[4], r[5], r[6], r[7]);
                *(u32x2*)(HID + (size_t)(row0 + ai * 128 + m * 16) * 1024 + hc) = w; asm volatile("" ::: "memory"); }
    }
};

struct EpiDown {
    float* OUT; bf16_t* Y0; bf16_t* Y1; bf16_t* Y2; const float* BDN; const float* MOD; const int* TOKL; const float* WL;
    __device__ __forceinline__ void operator()(AccRef acc, const pg8::Unit& u, int wr, int wc, int fr, int fq) const {
        const int col0 = u.pn * 256 + wc * 32 + 8 * fq;
        const float* bd = BDN + (size_t)u.e * 1024 + col0;
        f32x4 b4[2][2];
#pragma unroll
        for (int bj = 0; bj < 2; ++bj)
#pragma unroll
            for (int n = 0; n < 2; ++n) b4[bj][n] = *(const f32x4*)(bd + bj * 128 + 4 * n);
        const int* tl = TOKL + (size_t)(u.kk * 32 + u.e) * LISTCAP; const float* wl = WL + (size_t)(u.kk * 32 + u.e) * LISTCAP;
        bf16_t* Yk = Y0 + (size_t)u.kk * (size_t)(Y1 - Y0);
#pragma unroll
        for (int ai = 0; ai < 2; ++ai)
#pragma unroll
            for (int m = 0; m < 4; ++m) { const int slot = u.j0 + ai * 128 + wr * 64 + m * 16 + fr;
                if (slot < u.ne) { const int tok = tl[slot]; const float wgt = wl[slot];
                    const float* ga = MOD + (size_t)(tok >> 11) * 6144 + 5120 + col0; const size_t ro = (size_t)tok * 1024 + col0;
#pragma unroll
                    for (int bj = 0; bj < 2; ++bj) {
                        f32x4 v0 = *(const f32x4*)(ga + bj * 128) * ((acc[ai][bj][m][0] * WDESCALE + b4[bj][0]) * wgt), v1 = *(const f32x4*)(ga + bj * 128 + 4) * ((acc[ai][bj][m][1] * WDESCALE + b4[bj][1]) * wgt);
                        if (u.kk == 3) {
                            const u32x4 p = *(const u32x4*)(Y0 + ro + bj * 128), q = *(const u32x4*)(Y1 + ro + bj * 128), s = *(const u32x4*)(Y2 + ro + bj * 128);
                            v0[0] += bf_lo(p.x) + bf_lo(q.x) + bf_lo(s.x); v0[1] += bf_hi(p.x) + bf_hi(q.x) + bf_hi(s.x); v0[2] += bf_lo(p.y) + bf_lo(q.y) + bf_lo(s.y); v0[3] += bf_hi(p.y) + bf_hi(q.y) + bf_hi(s.y);
                            v1[0] += bf_lo(p.z) + bf_lo(q.z) + bf_lo(s.z); v1[1] += bf_hi(p.z) + bf_hi(q.z) + bf_hi(s.z); v1[2] += bf_lo(p.w) + bf_lo(q.w) + bf_lo(s.w); v1[3] += bf_hi(p.w) + bf_hi(q.w) + bf_hi(s.w);
                            float* op = OUT + ro + bj * 128;
                            *(f32x4*)op = *(const f32x4*)op + v0; *(f32x4*)(op + 4) = *(const f32x4*)(op + 4) + v1; }
                        else { u32x4 w; w.x = cvt_pk_bf16(v0[0], v0[1]); w.y = cvt_pk_bf16(v0[2], v0[3]); w.z = cvt_pk_bf16(v1[0], v1[1]); w.w = cvt_pk_bf16(v1[2], v1[3]); *(u32x4*)(Yk + ro + bj * 128) = w; } } }
                asm volatile("" ::: "memory"); }
    }
};

struct MoeTabs { const LAS int* rbase; const LAS int* tbase; const LAS int* nearr; const LAS int* tilee; };
struct MoeOrderGU {
    const char* A; const char* Bt; const int* lists; int G, c; MoeTabs tb;
    __device__ __forceinline__ bool next(int i, pg8::Unit& u) const {
        const int L = i * G + c, TT = L >> 3; const int total = __builtin_amdgcn_readfirstlane(tb.rbase[4]);
        if (TT >= total) return false;
        int k = 0;
#pragma unroll
        for (int q = 1; q < 4; ++q) k += (TT >= __builtin_amdgcn_readfirstlane(tb.rbase[q])) ? 1 : 0;
        const int T = TT - __builtin_amdgcn_readfirstlane(tb.rbase[k]);
        const int e = __builtin_amdgcn_readfirstlane(tb.tilee[k * MAXTILES + T]);
        u.pm = TT; u.pn = L & 7; u.e = e; u.kk = k; u.j0 = (T - __builtin_amdgcn_readfirstlane(tb.tbase[k * 33 + e])) * 256; u.ne = __builtin_amdgcn_readfirstlane(tb.nearr[k * 32 + e]); return true;
    }
    __device__ __forceinline__ const char* a_base(const pg8::Unit&) const { return A; }
    __device__ __forceinline__ const char* b_base(const pg8::Unit& u) const { return Bt + (size_t)u.e * (size_t)(2048 * 1024) + (size_t)u.pn * (size_t)(256 * 1024); }
    __device__ __forceinline__ unsigned row_of(const pg8::Unit& u, int r) const { const int slot = u.j0 + r; return slot < u.ne ? (unsigned)lists[(size_t)(u.kk * 32 + u.e) * LISTCAP + slot] : 0u; }
};
struct MoeOrderDN {
    const char* A; const char* Bt; int G, c, k0, k1; MoeTabs tb;
    __device__ __forceinline__ bool next(int i, pg8::Unit& u) const {
        const int L = i * G + c; const int r0 = __builtin_amdgcn_readfirstlane(tb.rbase[k0]), r1 = __builtin_amdgcn_readfirstlane(tb.rbase[k1]);
        const int TT = r0 + (L >> 2);
        if (TT >= r1) return false;
        int k = 0;
#pragma unroll
        for (int q = 1; q < 4; ++q) k += (TT >= __builtin_amdgcn_readfirstlane(tb.rbase[q])) ? 1 : 0;
        const int T = TT - __builtin_amdgcn_readfirstlane(tb.rbase[k]);
        const int e = __builtin_amdgcn_readfirstlane(tb.tilee[k * MAXTILES + T]);
        u.pm = TT; u.pn = L & 3; u.e = e; u.kk = k; u.j0 = (T - __builtin_amdgcn_readfirstlane(tb.tbase[k * 33 + e])) * 256; u.ne = __builtin_amdgcn_readfirstlane(tb.nearr[k * 32 + e]); return true;
    }
    __device__ __forceinline__ const char* a_base(const pg8::Unit& u) const { return A + (size_t)u.pm * (size_t)(256 * 1024); }
    __device__ __forceinline__ const char* b_base(const pg8::Unit& u) const { return Bt + (size_t)u.e * (size_t)(1024 * 1024) + (size_t)u.pn * (size_t)(256 * 1024); }
    __device__ __forceinline__ unsigned row_of(const pg8::Unit&, int) const { return 0u; }
};

constexpr int ATT_KBYTES = 12 * 1024;
constexpr int ATT_VPITCH = 136;
constexpr int ATT_VBYTES = 64 * ATT_VPITCH;
constexpr int ATT_BUF = ATT_KBYTES + ATT_VBYTES;
constexpr int ATT_WS = 2 * ATT_BUF;
static_assert(ATT_WS + 8 * 256 + 64 <= RING_BYTES, "attention LDS");

__device__ __forceinline__ void mla_unit(LAS unsigned char* lds, const bf16_t* Q, const bf16_t* Kb, const bf16_t* KV, bf16_t* O, int b, int h, int qb) {
    const int tid = threadIdx.x, lane = tid & 63, r = lane & 31, hh = lane >> 5; const int wid = __builtin_amdgcn_readfirstlane(tid >> 6);
    const size_t rowbase = (size_t)b * SEQ; const int q0 = qb * 256, qw = q0 + 32 * wid;
    const int cq = qw >> 6, NT = (q0 >> 6) + 4;
    LAS float* wsf = (LAS float*)(lds + ATT_WS) + wid * 64;
    bf16x8 qf[6];
    { const bf16_t* qp = Q + (rowbase + qw + r) * 768 + h * 96 + hh * 8;
#pragma unroll
      for (int s = 0; s < 6; ++s) qf[s] = *(const bf16x8*)(qp + 16 * s); }
    const int lkv = tid & 63, lc = tid >> 6;
    const bf16_t* kg0 = Kb + (rowbase + lkv) * 768 + h * 96 + lc * 8;
    const bf16_t* vg = KV + (rowbase + lkv) * 1024 + h * 128 + 64 + lc * 8;
    u32x4 ka0, ka1 = (u32x4){0u, 0u, 0u, 0u}, va;
#define ATT_LOAD(t, K0, K1, V) do { K0 = *(const u32x4*)(kg0 + (size_t)(t) * 64 * 768); if (tid < 256) K1 = *(const u32x4*)(kg0 + (size_t)(t) * 64 * 768 + 64); V = *(const u32x4*)(vg + (size_t)(t) * 64 * 1024); } while (0)
#define ATT_STORE(bufi, K0, K1, V) do { LAS unsigned char* kb_ = lds + (bufi) * ATT_BUF; *(LAS u32x4*)(kb_ + tid * 16) = K0; if (tid < 256) *(LAS u32x4*)(kb_ + 8192 + tid * 16) = K1; \
        LAS unsigned char* vb_ = kb_ + ATT_KBYTES + (lc * 8) * ATT_VPITCH + lkv * 2; \
        _Pragma("unroll") for (int j_ = 0; j_ < 8; ++j_) *(LAS unsigned short*)(vb_ + j_ * ATT_VPITCH) = (unsigned short)(V[j_ >> 1] >> (16 * (j_ & 1))); } while (0)
    ATT_LOAD(0, ka0, ka1, va); ATT_STORE(0, ka0, ka1, va); __syncthreads();
    float mref = 0.f, l_run = 0.f;
    f32x16 o0, o1, negm;
#pragma unroll
    for (int i = 0; i < 16; ++i) { o0[i] = 0.f; o1[i] = 0.f; negm[i] = 0.f; }
#define MLA_ITER(t_, BUFI, K0, K1, V) do { const int t = (t_); \
        if (t + 1 < NT) ATT_LOAD(t + 1, K0, K1, V); \
        if (t <= cq) { \
            const LAS unsigned char* kb = lds + (BUFI) * ATT_BUF; const LAS unsigned char* vb = kb + ATT_KBYTES; \
            f32x16 p0, p1; \
        _Pragma("unroll") \
            for (int s = 0; s < 6; ++s) { const bf16x8 a0 = *(const LAS bf16x8*)(kb + (2 * s + hh) * 1024 + r * 16), a1 = *(const LAS bf16x8*)(kb + (2 * s + hh) * 1024 + (r + 32) * 16); \
                if (s == 0) { p0 = MFMA32(a0, qf[0], negm); p1 = MFMA32(a1, qf[0], negm); } else { p0 = MFMA32(a0, qf[s], p0); p1 = MFMA32(a1, qf[s], p1); } } \
            float d = p0[0]; \
        _Pragma("unroll") \
            for (int i = 0; i < 16; ++i) { d = __builtin_fmaxf(d, p0[i]); d = __builtin_fmaxf(d, p1[i]); } \
            d = __builtin_fmaxf(d, __shfl_xor(d, 32)); \
            if (t == 0) { mref = d; \
        _Pragma("unroll") \
                for (int i = 0; i < 16; ++i) { p0[i] -= d; p1[i] -= d; negm[i] = -d; } \
            } else if (__any(d > 8.f)) { \
                const float delta = __builtin_fmaxf(d, 0.f), alpha = __builtin_amdgcn_exp2f(-delta); mref += delta; l_run *= alpha; \
        _Pragma("unroll") \
                for (int i = 0; i < 16; ++i) { p0[i] -= delta; p1[i] -= delta; negm[i] = -mref; } \
                if (hh == 0) wsf[r] = alpha; \
                LDS_WAIT(); \
        _Pragma("unroll") \
                for (int g = 0; g < 4; ++g) { const f32x4 al = *(const LAS f32x4*)(wsf + 8 * g + 4 * hh); \
        _Pragma("unroll") \
                    for (int e = 0; e < 4; ++e) { o0[4 * g + e] *= al[e]; o1[4 * g + e] *= al[e]; } } \
                LDS_WAIT(); \
            } \
            float rs = 0.f; \
        _Pragma("unroll") \
            for (int i = 0; i < 16; ++i) { p0[i] = __builtin_amdgcn_exp2f(p0[i]); p1[i] = __builtin_amdgcn_exp2f(p1[i]); rs += p0[i] + p1[i]; } \
            l_run += rs; \
        _Pragma("unroll") \
            for (int half = 0; half < 2; ++half) \
        _Pragma("unroll") \
                for (int s2 = 0; s2 < 2; ++s2) { \
                    const f32x16& P = half ? p1 : p0; \
                    const bf16x8 pa = pack8(P[8 * s2], P[8 * s2 + 1], P[8 * s2 + 2], P[8 * s2 + 3], P[8 * s2 + 4], P[8 * s2 + 5], P[8 * s2 + 6], P[8 * s2 + 7]); \
                    const int kvo = (32 * half + 16 * s2 + 4 * hh) * 2; \
                    { const s16x4 lo = *(const LAS s16x4*)(vb + r * ATT_VPITCH + kvo), hi = *(const LAS s16x4*)(vb + r * ATT_VPITCH + kvo + 16); \
                      const bf16x8 vf = __builtin_shufflevector(lo, hi, 0, 1, 2, 3, 4, 5, 6, 7); o0 = MFMA32(pa, vf, o0); } \
                    { const s16x4 lo = *(const LAS s16x4*)(vb + (r + 32) * ATT_VPITCH + kvo), hi = *(const LAS s16x4*)(vb + (r + 32) * ATT_VPITCH + kvo + 16); \
                      const bf16x8 vf = __builtin_shufflevector(lo, hi, 0, 1, 2, 3, 4, 5, 6, 7); o1 = MFMA32(pa, vf, o1); } \
                } \
        } \
        if (t + 1 < NT) ATT_STORE((BUFI) ^ 1, K0, K1, V); \
        __syncthreads(); } while (0)
    for (int t2 = 0; t2 < NT; t2 += 2) {
        MLA_ITER(t2, 0, ka0, ka1, va);
        MLA_ITER(t2 + 1, 1, ka0, ka1, va);
    }
#undef MLA_ITER
    const float l_tot = l_run + __shfl_xor(l_run, 32);
    if (hh == 0) wsf[r] = 1.f / l_tot;
    LDS_WAIT();
#pragma unroll
    for (int g = 0; g < 4; ++g) { const f32x4 rl = *(const LAS f32x4*)(wsf + 8 * g + 4 * hh);
#pragma unroll
        for (int e = 0; e < 4; ++e) { const int i = 4 * g + e; bf16_t* op = O + (rowbase + qw + crow(i, hh)) * 512 + h * 64 + r;
            op[0] = (bf16_t)(cvt_pk_bf16(o0[i] * rl[e], 0.f) & 0xffffu); op[32] = (bf16_t)(cvt_pk_bf16(o1[i] * rl[e], 0.f) & 0xffffu); } }
    LDS_WAIT();
#undef ATT_LOAD
#undef ATT_STORE
}

__device__ __forceinline__ void sb_unit(LAS unsigned char* lds, const bf16_t* SBQ, bf16_t* O, int b, int h, int qb) {
    const int tid = threadIdx.x, lane = tid & 63, r = lane & 31, hh = lane >> 5; const int wid = __builtin_amdgcn_readfirstlane(tid >> 6);
    const size_t rowbase = (size_t)b * SEQ; const int q0 = qb * 256, qw = q0 + 32 * wid;
    const int NT = (q0 >> 6) + 4;
    constexpr float C2 = 0.125f * LOG2E;
    bf16x8 qf[4];
    { const bf16_t* qp = SBQ + (rowbase + qw + r) * 1536 + h * 64 + hh * 8;
#pragma unroll
      for (int s = 0; s < 4; ++s) qf[s] = *(const bf16x8*)(qp + 16 * s); }
    const int lkv = tid & 63, lc = tid >> 6;
    const bf16_t* kg0 = SBQ + (rowbase + lkv) * 1536 + 512 + h * 64 + lc * 8;
    const bf16_t* vg = SBQ + (rowbase + lkv) * 1536 + 1024 + h * 64 + lc * 8;
    u32x4 ka0, va, kb0, vb2;
#define ATT_LOAD(t, K0, V) do { K0 = *(const u32x4*)(kg0 + (size_t)(t) * 64 * 1536); V = *(const u32x4*)(vg + (size_t)(t) * 64 * 1536); } while (0)
#define ATT_STORE(bufi, K0, V) do { LAS unsigned char* kb_ = lds + (bufi) * ATT_BUF; *(LAS u32x4*)(kb_ + tid * 16) = K0; \
        LAS unsigned char* vb_ = kb_ + ATT_KBYTES + (lc * 8) * ATT_VPITCH + lkv * 2; \
        _Pragma("unroll") for (int j_ = 0; j_ < 8; ++j_) *(LAS unsigned short*)(vb_ + j_ * ATT_VPITCH) = (unsigned short)(V[j_ >> 1] >> (16 * (j_ & 1))); } while (0)
    LAS unsigned* dflag = (LAS unsigned*)(lds + ATT_WS + 8 * 256);
    ATT_LOAD(NT - 1, ka0, va); ATT_STORE(0, ka0, va); __syncthreads();
    ATT_LOAD(NT - 2, kb0, vb2); ATT_LOAD(NT - 3, ka0, va);
    float carry = 0.f; bool wdone = false;
    f32x16 o0, o1;
#pragma unroll
    for (int i = 0; i < 16; ++i) { o0[i] = 0.f; o1[i] = 0.f; }
#define SB_SUB(X, kvh0, kvl) do { const bool diag_ = ((kvh0) == qw); float lk_[16], z_[16]; \
        _Pragma("unroll") for (int i = 0; i < 16; ++i) { const float z2 = X[i] * C2; const float ex = __builtin_amdgcn_exp2f(z2); float sp = __builtin_amdgcn_logf(1.f + ex); sp = z2 > 64.f ? z2 : sp; \
            const bool valid = !diag_ || (crow(i, hh) < r); lk_[i] = valid ? -sp : 0.f; z_[i] = z2; } \
        float G_[4], Gp_[4]; \
        _Pragma("unroll") for (int g = 0; g < 4; ++g) { G_[g] = (lk_[4 * g] + lk_[4 * g + 1]) + (lk_[4 * g + 2] + lk_[4 * g + 3]); Gp_[g] = __shfl_xor(G_[g], 32); } \
        float tail_[4]; tail_[3] = 0.f; tail_[2] = G_[3] + Gp_[3]; tail_[1] = tail_[2] + (G_[2] + Gp_[2]); tail_[0] = tail_[1] + (G_[1] + Gp_[1]); const float total_ = tail_[0] + (G_[0] + Gp_[0]); \
        float a_[16]; \
        _Pragma("unroll") for (int g = 0; g < 4; ++g) { const float base_ = carry + tail_[g] + (hh == 0 ? Gp_[g] : 0.f); \
            const float s3 = base_ + lk_[4 * g + 3], s2_ = s3 + lk_[4 * g + 2], s1 = s2_ + lk_[4 * g + 1], s0 = s1 + lk_[4 * g]; \
            a_[4 * g + 3] = __builtin_amdgcn_exp2f(z_[4 * g + 3] + s3); a_[4 * g + 2] = __builtin_amdgcn_exp2f(z_[4 * g + 2] + s2_); a_[4 * g + 1] = __builtin_amdgcn_exp2f(z_[4 * g + 1] + s1); a_[4 * g] = __builtin_amdgcn_exp2f(z_[4 * g] + s0); } \
        if (diag_) { _Pragma("unroll") for (int i = 0; i < 16; ++i) a_[i] = (crow(i, hh) < r) ? a_[i] : 0.f; } \
        carry += total_; \
        _Pragma("unroll") for (int s2 = 0; s2 < 2; ++s2) { \
            const bf16x8 pa = pack8(a_[8 * s2], a_[8 * s2 + 1], a_[8 * s2 + 2], a_[8 * s2 + 3], a_[8 * s2 + 4], a_[8 * s2 + 5], a_[8 * s2 + 6], a_[8 * s2 + 7]); \
            const int kvo = ((kvl) + 16 * s2 + 4 * hh) * 2; \
            { const s16x4 lo = *(const LAS s16x4*)(vb + r * ATT_VPITCH + kvo), hi = *(const LAS s16x4*)(vb + r * ATT_VPITCH + kvo + 16); \
              const bf16x8 vf = __builtin_shufflevector(lo, hi, 0, 1, 2, 3, 4, 5, 6, 7); o0 = MFMA32(pa, vf, o0); } \
            { const s16x4 lo = *(const LAS s16x4*)(vb + (r + 32) * ATT_VPITCH + kvo), hi = *(const LAS s16x4*)(vb + (r + 32) * ATT_VPITCH + kvo + 16); \
              const bf16x8 vf = __builtin_shufflevector(lo, hi, 0, 1, 2, 3, 4, 5, 6, 7); o1 = MFMA32(pa, vf, o1); } } } while (0)
    bool alldone = false;
#define SB_ITER(it_, BUFI, K0, V) do { const int it = (it_), t = NT - 1 - it, kv0 = 64 * t; \
        if (kv0 <= qw && !wdone) { \
            const LAS unsigned char* kb = lds + (BUFI) * ATT_BUF; const LAS unsigned char* vb = kb + ATT_KBYTES; \
            const bool upper = (kv0 + 32 <= qw); \
            f32x16 p0, p1; \
        _Pragma("unroll") \
            for (int i = 0; i < 16; ++i) { p0[i] = 0.f; p1[i] = 0.f; } \
        _Pragma("unroll") \
            for (int s = 0; s < 4; ++s) { const bf16x8 a0 = *(const LAS bf16x8*)(kb + (2 * s + hh) * 1024 + r * 16); p0 = MFMA32(a0, qf[s], p0); } \
            if (upper) { \
        _Pragma("unroll") \
                for (int s = 0; s < 4; ++s) { const bf16x8 a1 = *(const LAS bf16x8*)(kb + (2 * s + hh) * 1024 + (r + 32) * 16); p1 = MFMA32(a1, qf[s], p1); } \
                SB_SUB(p1, kv0 + 32, 32); \
            } \
            SB_SUB(p0, kv0, 0); \
            wdone = __all(carry < -170.f) != 0; \
        } \
        if (lane == 0) dflag[(BUFI) * 8 + wid] = wdone ? 1u : 0u; \
        if (t > 0) ATT_STORE((BUFI) ^ 1, K0, V); \
        if (t > 2) ATT_LOAD(t - 3, K0, V); \
        __syncthreads(); \
        { const u32x4 f0 = *(const LAS u32x4*)(dflag + (BUFI) * 8), f1 = *(const LAS u32x4*)(dflag + (BUFI) * 8 + 4); \
          alldone = (f0.x & f0.y & f0.z & f0.w & f1.x & f1.y & f1.z & f1.w) != 0u; } } while (0)
    for (int i2 = 0; i2 < NT; i2 += 2) {
        SB_ITER(i2, 0, kb0, vb2); if (alldone) break;
        SB_ITER(i2 + 1, 1, ka0, va); if (alldone) break;
    }
#undef SB_ITER
    __syncthreads();
#pragma unroll
    for (int i = 0; i < 16; ++i) { bf16_t* op = O + (rowbase + qw + crow(i, hh)) * 512 + h * 64 + r;
        op[0] = (bf16_t)(cvt_pk_bf16(o0[i], 0.f) & 0xffffu); op[32] = (bf16_t)(cvt_pk_bf16(o1[i], 0.f) & 0xffffu); }
#undef SB_SUB
#undef ATT_LOAD
#undef ATT_STORE
}

#ifndef PHMASK
#define PHMASK 0xFFFF
#endif
#define PH(n) ((PHMASK >> (n)) & 1)
#ifndef DUPMASK
#define DUPMASK 0
#endif
#define DUP(n) (1 + ((DUPMASK >> (n)) & 1))
struct Args { const void* in[23]; float* out; unsigned char* ws; };

__global__ void __launch_bounds__(512, 2) fwd_kernel(Args args) {
    extern __shared__ __attribute__((aligned(16))) unsigned char lds_raw[];
    LAS unsigned char* lds = (LAS unsigned char*)lds_raw;
    const int tid = threadIdx.x, lane = tid & 63, wave = __builtin_amdgcn_readfirstlane(tid >> 6);
    const int G = gridDim.x; const int bx = blockIdx.x; const int vcu = (G % 8 == 0) ? (bx % 8) * (G / 8) + bx / 8 : bx;
    const int gw = vcu * 8 + wave, NGW = G * 8;
    unsigned char* ws = args.ws;
    unsigned* ctl = (unsigned*)(ws + WS_CTL);
    const float* x = (const float*)args.in[0]; const float* cvec = (const float*)args.in[1]; const int* positions = (const int*)args.in[2];
    const float* w_ada = (const float*)args.in[3]; const float* b_ada = (const float*)args.in[4]; const float* g_norm1 = (const float*)args.in[5];
    const float* w_in = (const float*)args.in[6]; const float* g_q_lat = (const float*)args.in[7]; const float* w_uq = (const float*)args.in[8];
    const float* g_kv_lat = (const float*)args.in[9]; const float* w_ukv = (const float*)args.in[10]; const float* g_qk_q = (const float*)args.in[11];
    const float* g_qk_k = (const float*)args.in[12]; const float* w_o_mla = (const float*)args.in[13]; const float* w_o_sb = (const float*)args.in[14];
    const float* w_out = (const float*)args.in[15]; const float* g_norm2 = (const float*)args.in[16]; const float* w_router = (const float*)args.in[17];
    const float* b_router = (const float*)args.in[18]; const float* w_gate_up = (const float*)args.in[19]; const float* b_gate_up = (const float*)args.in[20];
    const float* w_down = (const float*)args.in[21]; const float* b_down = (const float*)args.in[22];
    float* out = args.out;
    bf16_t* WIN = (bf16_t*)(ws + WS_WIN); bf16_t* WUQ = (bf16_t*)(ws + WS_WUQ); bf16_t* WUKV = (bf16_t*)(ws + WS_WUKV); bf16_t* WOM = (bf16_t*)(ws + WS_WOM);
    bf16_t* WOS = (bf16_t*)(ws + WS_WOS); bf16_t* WOUT = (bf16_t*)(ws + WS_WOUT); float* MOD = (float*)(ws + WS_MOD);
    float* ROWSS = (float*)(ws + WS_ROWSS); unsigned char* WIN8 = ws + WS_WIN8; unsigned char* H8 = ws + WS_H8; unsigned char* M8 = ws + WS_M8; unsigned char* WOUT8 = ws + WS_WOUT;
    bf16_t* HB = (bf16_t*)(ws + WS_H); bf16_t* KVRAW = (bf16_t*)(ws + WS_KVRAW); bf16_t* MERGED = (bf16_t*)(ws + WS_MERGED);
    bf16_t* SGA = (bf16_t*)(ws + WS_SGA); bf16_t* SGB = (bf16_t*)(ws + WS_SGB); unsigned char* H2 = ws + WS_H2;
    unsigned char* WGU = ws + WS_WGU; unsigned char* WDN = ws + WS_WDN; bf16_t* SBQ = (bf16_t*)(ws + WS_SB);
    int* TOKL = (int*)(ws + WS_TOKL); float* WLST = (float*)(ws + WS_WL); unsigned char* HID = ws + WS_HID;
    bf16_t* QL = (bf16_t*)(ws + WS_QL); bf16_t* KVL = (bf16_t*)(ws + WS_KVL); bf16_t* KPE = (bf16_t*)(ws + WS_KPE);
    bf16_t* QB = (bf16_t*)(ws + WS_Q); bf16_t* KB = (bf16_t*)(ws + WS_K); bf16_t* OMLA = (bf16_t*)(ws + WS_OMLA); bf16_t* OSB = (bf16_t*)(ws + WS_OSB);

    for (int u = tid; u < (LDS_BYTES - LDSCTL_OFF) / 4; u += 512) ((LAS unsigned*)(lds + LDSCTL_OFF))[u] = 0u;
    __syncthreads();
    XcdBarrier bar = xcd_barrier_post(ctl + CW_BAR, (volatile LAS unsigned*)(lds + LDSCTL_OFF + LC_BARST));
    LAS float* scr = (LAS float*)(lds + wave * 16384);

#if PH(0)
    {
        constexpr int I_IN = 16 * 133, I_UQ = 6 * 24, I_UKV = 4 * 32, I_OM = 8 * 32, I_OS = 8 * 32, I_OUT = 16 * 32;
        constexpr int NIT = I_IN + I_UQ + I_UKV + I_OM + I_OS + I_OUT;
        for (int it = gw; it < NIT; it += NGW) {
            int q = it;
            if (q < I_IN) { const int kb = q / 133, nb = q % 133, n0 = 32 * nb;
                if (nb < 69) transpose_item(w_in, 1024, DIN, WIN, 64 * kb, n0, n0 < 672 ? n0 : n0 + 96, scr, lane);
                else transpose_item_f8(w_in, 1024, DIN, WIN8, 64 * kb, n0, n0 - 2208, WSCALE, scr, lane);
                continue; } q -= I_IN;
            if (q < I_UQ) { const int kb = q / 24, nb = q % 24; transpose_item(w_uq, 384, 768, WUQ, 64 * kb, 32 * nb, 32 * nb, scr, lane, g_q_lat); continue; } q -= I_UQ;
            if (q < I_UKV) { const int kb = q / 32, nb = q % 32; transpose_item(w_ukv, 256, 1024, WUKV, 64 * kb, 32 * nb, 32 * nb, scr, lane, g_kv_lat); continue; } q -= I_UKV;
            if (q < I_OM) { const int kb = q / 32, nb = q % 32; transpose_item(w_o_mla, 512, 1024, WOM, 64 * kb, 32 * nb, 32 * nb, scr, lane); continue; } q -= I_OM;
            if (q < I_OS) { const int kb = q / 32, nb = q % 32; transpose_item(w_o_sb, 512, 1024, WOS, 64 * kb, 32 * nb, 32 * nb, scr, lane); continue; } q -= I_OS;
            { const int kb = q / 32, nb = q % 32; transpose_item_f8(w_out, 1024, 1024, WOUT8, 64 * kb, 32 * nb, 32 * nb, WSCALE, scr, lane); }
        }
        for (int i = vcu * 512 + tid; i < NTOK * 2 / 4; i += G * 512) ((f32x4*)ROWSS)[i] = (f32x4){0.f, 0.f, 0.f, 0.f};
        for (int i = vcu * 512 + tid; i < 96 * 1024 * 2 / 16; i += G * 512) ((u32x4*)(WIN + 672 * 1024))[i] = (u32x4){0u, 0u, 0u, 0u};
        __syncthreads();
        for (int it = vcu; it < 6144 / 64; it += G) {
            for (int idx = lane; idx < 32 * 128; idx += 64) { const int b = idx >> 7, kk = idx & 127; const float cv = cvec[b * 1024 + 128 * wave + kk]; scr[idx] = cv / (1.f + __expf(-cv)); }
            LDS_WAIT(); asm volatile("" ::: "memory");
            float acc[32];
#pragma unroll
            for (int b = 0; b < 32; ++b) acc[b] = 0.f;
            const float* wp = w_ada + (size_t)(128 * wave) * 6144 + 64 * it + lane;
            float wc[8];
#pragma unroll
            for (int j = 0; j < 8; ++j) wc[j] = wp[(size_t)j * 6144];
#pragma nounroll
            for (int k8 = 0; k8 < 16; ++k8) {
                float wn[8];
                const int kn = k8 < 15 ? k8 + 1 : k8;
#pragma unroll
                for (int j = 0; j < 8; ++j) wn[j] = wp[(size_t)(8 * kn + j) * 6144];
#pragma unroll
                for (int j4 = 0; j4 < 2; ++j4) {
#pragma unroll
                    for (int b = 0; b < 32; ++b) { const f32x4 s = *(const LAS f32x4*)(scr + b * 128 + 8 * k8 + 4 * j4); acc[b] += s.x * wc[4 * j4] + s.y * wc[4 * j4 + 1] + s.z * wc[4 * j4 + 2] + s.w * wc[4 * j4 + 3];
                        if ((b & 7) == 7) asm volatile("" ::: "memory"); } }
#pragma unroll
                for (int j = 0; j < 8; ++j) wc[j] = wn[j];
            }
            LDS_WAIT(); asm volatile("" ::: "memory");
#pragma unroll
            for (int b = 0; b < 32; ++b) scr[b * 64 + lane] = acc[b];
            __syncthreads();
#pragma unroll
            for (int bb = 0; bb < 4; ++bb) { const int b = 4 * wave + bb; float s = 0.f;
#pragma unroll
                for (int w2 = 0; w2 < 8; ++w2) s += ((const LAS float*)(lds + w2 * 16384))[b * 64 + lane];
                MOD[b * 6144 + 64 * it + lane] = s + b_ada[64 * it + lane]; }
            __syncthreads();
        }
    }
#endif
    xcd_barrier(bar);

#if PH(1)
    for (int gi = gw; gi < NTOK / 4; gi += NGW) {
        f32x4 v[4][4];
#pragma unroll
        for (int rr = 0; rr < 4; ++rr) { const f32x4* xr = (const f32x4*)(x + (size_t)(4 * gi + rr) * 1024) + lane;
#pragma unroll
            for (int j = 0; j < 4; ++j) v[rr][j] = xr[64 * j]; }
        const int b = (4 * gi) >> 11;
        const float* mb = MOD + (size_t)b * 6144;
        f32x4 gsc[4], shv[4];
#pragma unroll
        for (int j = 0; j < 4; ++j) { const int col = 4 * lane + 256 * j; gsc[j] = *(const f32x4*)(g_norm1 + col) * (*(const f32x4*)(mb + 1024 + col) + 1.f); shv[j] = *(const f32x4*)(mb + col); }
#pragma unroll
        for (int rr = 0; rr < 4; ++rr) { float ss = 0.f;
#pragma unroll
            for (int j = 0; j < 4; ++j) ss += (v[rr][j].x * v[rr][j].x + v[rr][j].y * v[rr][j].y) + (v[rr][j].z * v[rr][j].z + v[rr][j].w * v[rr][j].w);
            const float rstd = rsqrtf(wave_sum(ss) * (1.f / 1024.f) + EPS);
#pragma unroll
            for (int j = 0; j < 4; ++j) { const int col = 4 * lane + 256 * j; const f32x4 y = (v[rr][j] * rstd) * gsc[j] + shv[j];
                u32x2 o; o.x = cvt_pk_bf16(y.x, y.y); o.y = cvt_pk_bf16(y.z, y.w);
                *(u32x2*)(HB + (size_t)(4 * gi + rr) * 1024 + col) = o;
                *(unsigned*)(H8 + (size_t)(4 * gi + rr) * 1024 + col) = pk4_fp8(y.x, y.y, y.z, y.w); } }
    }
#endif
    xcd_barrier(bar);

#if PH(2)
    { pg8::DenseOrder S; S.init(HB, WIN, NTOK, 2304, 1024, G, bx);
      EpiProj E{QL, KVL, KPE, SBQ, SGA, SGB, 0, 1.f, ROWSS};
      pg8::gemm_phase<false>(lds, 1024, S, E); }
    { pg8::DenseOrder S; S.init(H8, WIN8, NTOK, 2048, 512, G, bx);
      EpiProj E{QL, KVL, KPE, SBQ, SGA, SGB, 2304, WDESCALE, ROWSS};
      pg8::gemm_phase_f8<false>(lds, 512, S, E); }
#endif
    xcd_barrier(bar);

#if PH(4)
    for (int rep = 0; rep < DUP(5); ++rep) {
    { pg8::DenseOrder S; S.init(QL, WUQ, NTOK, 768, 384, G, bx); EpiStore E{QB, 768, ROWSS, 1.f / 384.f}; pg8::gemm_phase<false>(lds, 384, S, E); }
    { pg8::DenseOrder S; S.init(KVL, WUKV, NTOK, 1024, 256, G, bx); EpiStore E{KVRAW, 1024, ROWSS + 1, 1.f / 256.f}; pg8::gemm_phase<false>(lds, 256, S, E); } }
#endif
    xcd_barrier(bar);

#if PH(5)
    {
        const int hd = lane >> 3, sub = lane & 7;
        const float QSC = 0.10206207261596575f * LOG2E;
        const float if0 = exp2f(-(float)(2 * sub) * (13.287712379549449f / 16.f)), if1 = exp2f(-(float)(2 * sub + 1) * (13.287712379549449f / 16.f));
        f32x4 gq0 = *(const f32x4*)(g_qk_q + sub * 8), gq1 = *(const f32x4*)(g_qk_q + sub * 8 + 4); const f32x2 gqa = *(const f32x2*)(g_qk_q + 64 + 2 * sub), gqb = *(const f32x2*)(g_qk_q + 80 + 2 * sub);
        f32x4 gk0 = *(const f32x4*)(g_qk_k + sub * 8), gk1 = *(const f32x4*)(g_qk_k + sub * 8 + 4); const f32x2 gka = *(const f32x2*)(g_qk_k + 64 + 2 * sub), gkb = *(const f32x2*)(g_qk_k + 80 + 2 * sub);
        for (int gi = gw; gi < NTOK / 4; gi += NGW) {
            u32x4 A[4][2]; unsigned B1[4][2], B2[4][2]; float posf[4];
#pragma unroll
            for (int t = 0; t < 4; ++t) { const int m = 4 * gi + t; posf[t] = (float)positions[m];
                const bf16_t* qp = QB + (size_t)m * 768 + hd * 96; A[t][0] = *(const u32x4*)(qp + sub * 8); B1[t][0] = *(const unsigned*)(qp + 64 + 2 * sub); B2[t][0] = *(const unsigned*)(qp + 80 + 2 * sub);
                A[t][1] = *(const u32x4*)(KVRAW + (size_t)m * 1024 + hd * 128 + sub * 8); B1[t][1] = *(const unsigned*)(KPE + (size_t)m * 32 + 2 * sub); B2[t][1] = *(const unsigned*)(KPE + (size_t)m * 32 + 16 + 2 * sub); }
#pragma unroll
            for (int t = 0; t < 4; ++t) { const int m = 4 * gi + t;
                float cs[2], sn[2];
                { const float a0 = posf[t] * if0, a1 = posf[t] * if1;
                  double r0 = (double)a0 * 0.15915494309189535, r1 = (double)a1 * 0.15915494309189535; r0 -= __builtin_rint(r0); r1 -= __builtin_rint(r1);
                  cs[0] = __builtin_amdgcn_cosf((float)r0); sn[0] = __builtin_amdgcn_sinf((float)r0); cs[1] = __builtin_amdgcn_cosf((float)r1); sn[1] = __builtin_amdgcn_sinf((float)r1); }
#pragma unroll
                for (int which = 0; which < 2; ++which) {
                    const u32x4 Av = A[t][which]; const unsigned b1 = B1[t][which], b2 = B2[t][which];
                    bf16_t* dst = which ? KB + (size_t)m * 768 + hd * 96 : QB + (size_t)m * 768 + hd * 96;
                    float f[8] = {bf_lo(Av.x), bf_hi(Av.x), bf_lo(Av.y), bf_hi(Av.y), bf_lo(Av.z), bf_hi(Av.z), bf_lo(Av.w), bf_hi(Av.w)};
                    float x1[2] = {bf_lo(b1), bf_hi(b1)}, x2[2] = {bf_lo(b2), bf_hi(b2)};
                    float ss = x1[0] * x1[0] + x1[1] * x1[1] + x2[0] * x2[0] + x2[1] * x2[1];
#pragma unroll
                    for (int j = 0; j < 8; ++j) ss += f[j] * f[j];
                    ss += __shfl_xor(ss, 1); ss += __shfl_xor(ss, 2); ss += __shfl_xor(ss, 4);
                    const float rstd = rsqrtf(ss * (1.f / 96.f) + EPS);
                    const f32x4 g0 = which ? gk0 : gq0, g1 = which ? gk1 : gq1; const f32x2 ga = which ? gka : gqa, gb = which ? gkb : gqb;
                    const float sc = which ? 1.f : QSC;
                    float y[8] = {f[0] * rstd * g0.x, f[1] * rstd * g0.y, f[2] * rstd * g0.z, f[3] * rstd * g0.w, f[4] * rstd * g1.x, f[5] * rstd * g1.y, f[6] * rstd * g1.z, f[7] * rstd * g1.w};
                    const float y1a = x1[0] * rstd * ga.x, y1b = x1[1] * rstd * ga.y, y2a = x2[0] * rstd * gb.x, y2b = x2[1] * rstd * gb.y;
                    const float o1a = y1a * cs[0] - y2a * sn[0], o1b = y1b * cs[1] - y2b * sn[1], o2a = y2a * cs[0] + y1a * sn[0], o2b = y2b * cs[1] + y1b * sn[1];
                    u32x4 o; o.x = cvt_pk_bf16(y[0] * sc, y[1] * sc); o.y = cvt_pk_bf16(y[2] * sc, y[3] * sc); o.z = cvt_pk_bf16(y[4] * sc, y[5] * sc); o.w = cvt_pk_bf16(y[6] * sc, y[7] * sc);
                    *(u32x4*)(dst + sub * 8) = o; *(unsigned*)(dst + 64 + 2 * sub) = cvt_pk_bf16(o1a * sc, o1b * sc); *(unsigned*)(dst + 80 + 2 * sub) = cvt_pk_bf16(o2a * sc, o2b * sc);
                }
            }
        }
    }
#endif
    xcd_barrier(bar);

#if PH(6)
    for (int bh = vcu; bh < NB * NH; bh += G) {
        for (int rep = 0; rep < DUP(0); ++rep) for (int qb = 0; qb < 8; ++qb) mla_unit(lds, QB, KB, KVRAW, OMLA, bh >> 3, bh & 7, qb);
        for (int rep = 0; rep < DUP(1); ++rep) for (int qb = 0; qb < 8; ++qb) sb_unit(lds, SBQ, OSB, bh >> 3, bh & 7, qb);
    }
#endif
    xcd_barrier(bar);

#if PH(8)
    for (int rep = 0; rep < DUP(6); ++rep) {
    { pg8::DenseOrder S; S.init(OMLA, WOM, NTOK, 1024, 512, G, bx); EpiMerge<false> E{MERGED, SGA, M8}; pg8::gemm_phase<false>(lds, 512, S, E); }
    { pg8::DenseOrder S; S.init(OSB, WOS, NTOK, 1024, 512, G, bx); EpiMerge<true> E{MERGED, SGB, M8}; pg8::gemm_phase<false>(lds, 512, S, E); } }
#endif
    xcd_barrier(bar);

#if PH(9)
    { pg8::DenseOrder S; S.init(M8, WOUT8, NTOK, 1024, 512, G, bx); EpiWout E{x, out, MOD, WDESCALE}; pg8::gemm_phase_f8<false>(lds, 512, S, E); }
#endif
    xcd_barrier(bar);

#if PH(10)
    {
        constexpr int I_GU = 16 * 64, I_DN = 16 * 32;
        for (int rep = 0; rep < DUP(2); ++rep) for (int it = gw; it < NE * (I_GU + I_DN); it += NGW) {
            if (it < NE * I_GU) { const int e = it / I_GU, q = it % I_GU, kb = q / 64, nb = q % 64, n0 = 32 * nb; const int g = n0 >> 10, jj = n0 & 1023;
                transpose_item_f8(w_gate_up + (size_t)e * 1024 * 2048, 1024, 2048, WGU + (size_t)e * 2048 * 1024, 64 * kb, n0, 256 * (jj >> 7) + 128 * g + (jj & 127), WSCALE, scr, lane); }
            else { const int r2 = it - NE * I_GU, e = r2 / I_DN, q = r2 % I_DN, kb = q / 32, nb = q % 32;
                transpose_item_f8(w_down + (size_t)e * 1024 * 1024, 1024, 1024, WDN + (size_t)e * 1024 * 1024, 64 * kb, 32 * nb, 32 * nb, WSCALE, scr, lane); }
        }
        __syncthreads();
        {
            const int r = lane & 31, hh = lane >> 5;
            constexpr int TP = 1026;
            LAS float* tile = (LAS float*)lds;
            float areg[64];
#pragma unroll
            for (int mm = 0; mm < 64; ++mm) areg[mm] = w_router[(size_t)(128 * wave + 4 * (mm >> 1) + 2 * hh + (mm & 1)) * 32 + r];
            const float br = b_router[r];
            for (int tt = vcu; tt < NTOK / 32; tt += G) {
                { f32x4 v[4][4];
#pragma unroll
                  for (int rr = 0; rr < 4; ++rr) { const f32x4* xr = (const f32x4*)(out + (size_t)(32 * tt + 4 * wave + rr) * 1024) + lane;
#pragma unroll
                      for (int j = 0; j < 4; ++j) v[rr][j] = xr[64 * j]; }
                  const float* mb = MOD + (size_t)((32 * tt) >> 11) * 6144;
                  f32x4 gsc[4], shv[4];
#pragma unroll
                  for (int j = 0; j < 4; ++j) { const int col = 4 * lane + 256 * j; gsc[j] = *(const f32x4*)(g_norm2 + col) * (*(const f32x4*)(mb + 4096 + col) + 1.f); shv[j] = *(const f32x4*)(mb + 3072 + col); }
#pragma unroll
                  for (int rr = 0; rr < 4; ++rr) { float ss = 0.f; const int row = 4 * wave + rr;
#pragma unroll
                      for (int j = 0; j < 4; ++j) ss += (v[rr][j].x * v[rr][j].x + v[rr][j].y * v[rr][j].y) + (v[rr][j].z * v[rr][j].z + v[rr][j].w * v[rr][j].w);
                      const float rstd = rsqrtf(wave_sum(ss) * (1.f / 1024.f) + EPS);
#pragma unroll
                      for (int j = 0; j < 4; ++j) { const int col = 4 * lane + 256 * j; const f32x4 y = (v[rr][j] * rstd) * gsc[j] + shv[j];
                          *(unsigned*)(H2 + (size_t)(32 * tt + row) * 1024 + col) = pk4_fp8(y.x, y.y, y.z, y.w);
                          *(LAS f32x2*)(tile + row * TP + col) = (f32x2){y.x, y.y}; *(LAS f32x2*)(tile + row * TP + col + 2) = (f32x2){y.z, y.w}; } } }
                __syncthreads();
                f32x16 acc;
#pragma unroll
                for (int i = 0; i < 16; ++i) acc[i] = 0.f;
#pragma unroll
                for (int sg = 0; sg < 32; ++sg) { const f32x2 hv = *(const LAS f32x2*)(tile + r * TP + 128 * wave + 4 * sg + 2 * hh);
                    acc = __builtin_amdgcn_mfma_f32_32x32x2f32(areg[2 * sg], hv.x, acc, 0, 0, 0); acc = __builtin_amdgcn_mfma_f32_32x32x2f32(areg[2 * sg + 1], hv.y, acc, 0, 0, 0); }
                __syncthreads();
#pragma unroll
                for (int i = 0; i < 16; ++i) tile[wave * 1024 + i * 64 + lane] = acc[i];
                __syncthreads();
                { const int e = r, he = (e >> 2) & 1, ie = (e & 3) + 4 * (e >> 3);
#pragma unroll
                  for (int rr = 0; rr < 4; ++rr) { const int row = 4 * wave + rr; float v = br;
#pragma unroll
                      for (int w2 = 0; w2 < 8; ++w2) v += tile[w2 * 1024 + ie * 64 + row + 32 * he];
                      float tv[4]; int te[4];
#pragma unroll
                      for (int k = 0; k < 4; ++k) { float bv = v; int bi = e;
#pragma unroll
                          for (int off = 16; off >= 1; off >>= 1) { const float ov = __shfl_xor(bv, off); const int oi = __shfl_xor(bi, off); if (ov > bv || (ov == bv && oi < bi)) { bv = ov; bi = oi; } }
                          tv[k] = bv; te[k] = bi; if (e == bi) v = -INFINITY; }
                      const float e1 = __expf(tv[1] - tv[0]), e2 = __expf(tv[2] - tv[0]), e3 = __expf(tv[3] - tv[0]); const float inv = 1.f / (1.f + e1 + e2 + e3);
                      if (lane < 4) { const int k = lane; const int ek = k == 0 ? te[0] : k == 1 ? te[1] : k == 2 ? te[2] : te[3]; const float wk = (k == 0 ? 1.f : k == 1 ? e1 : k == 2 ? e2 : e3) * inv;
                          const unsigned slot = atomicAdd(ctl + CW_CNT + (k * 32 + ek) * 16, 1u);
                          TOKL[(size_t)(k * 32 + ek) * LISTCAP + slot] = 32 * tt + row; WLST[(size_t)(k * 32 + ek) * LISTCAP + slot] = wk; } } }
                __syncthreads();
            }
        }
    }
#endif
    xcd_barrier(bar);

#if PH(11)
    {
        LAS int* rbase = (LAS int*)(lds + LDSCTL_OFF + LC_RBASE); LAS int* tbase = (LAS int*)(lds + LDSCTL_OFF + LC_TBASE); LAS int* nearr = (LAS int*)(lds + LDSCTL_OFF + LC_NE); LAS int* tilee = (LAS int*)(lds + LDSCTL_OFF + LC_TILEE);
        { int tid = threadIdx.x; asm volatile("" : "+v"(tid));
          if (tid < 4 * NE) nearr[tid] = (int)ctl[CW_CNT + tid * 16];
          __syncthreads();
          if (tid < 4) { int a = 0;
#pragma nounroll
              for (int e = 0; e < NE; ++e) { tbase[tid * 33 + e] = a; a += (nearr[tid * 32 + e] + 255) >> 8; } tbase[tid * 33 + NE] = a; }
          __syncthreads();
          if (tid == 0) { int a = 0;
#pragma nounroll
              for (int k = 0; k < 4; ++k) { rbase[k] = a; a += tbase[k * 33 + NE]; } rbase[4] = a; }
          for (int q = tid; q < 4 * MAXTILES; q += 512) { const int k = q / MAXTILES, T = q % MAXTILES;
              if (T < tbase[k * 33 + NE]) { int e = 0;
#pragma nounroll
                  while (e < NE - 1 && tbase[k * 33 + e + 1] <= T) ++e;
                  tilee[k * MAXTILES + T] = e; } }
          __syncthreads(); }
        const MoeTabs tb{rbase, tbase, nearr, tilee};
        { MoeOrderGU S{(const char*)H2, (const char*)WGU, TOKL, G, vcu, tb};
          EpiGateUp E{HID, b_gate_up};
          pg8::gemm_phase_f8<true>(lds, 512, S, E); }
        xcd_barrier(bar);
        bf16_t* Y0 = MERGED; bf16_t* Y1 = (bf16_t*)(ws + WS_SGA); bf16_t* Y2 = (bf16_t*)(ws + WS_SGB);
        for (int ph = 0; ph < 2; ++ph) {
            { MoeOrderDN S{(const char*)HID, (const char*)WDN, G, vcu, ph == 0 ? 0 : 3, ph == 0 ? 3 : 4, tb};
              EpiDown E{out, Y0, Y1, Y2, b_down, MOD, TOKL, WLST};
              pg8::gemm_phase_f8<false>(lds, 512, S, E); }
            if (ph == 0) xcd_barrier(bar);
        }
    }
#endif
}

extern "C" void kernel_launch(void* const* d_in, const int* in_sizes, int n_in, void* d_out, int out_size, void* d_ws, size_t ws_size, hipStream_t stream) {
    static int grid = 0;
    if (grid == 0) {
        if (n_in != 23 || in_sizes[0] != NTOK * DM || out_size != NTOK * DM || ws_size < WS_END) { fprintf(stderr, "kernel_launch: unexpected shapes (n_in %d, in0 %d, out %d, ws %zu); nothing launched\n", n_in, n_in > 0 ? in_sizes[0] : -1, out_size, ws_size); grid = -1; return; }
        int dev = 0, cus = 0, per_cu = 0;
        if (hipGetDevice(&dev) != hipSuccess || hipDeviceGetAttribute(&cus, hipDeviceAttributeMultiprocessorCount, dev) != hipSuccess) { grid = -1; return; }
        if (hipFuncSetAttribute((const void*)fwd_kernel, hipFuncAttributeMaxDynamicSharedMemorySize, LDS_BYTES) != hipSuccess) { fprintf(stderr, "kernel_launch: hipFuncSetAttribute failed\n"); grid = -1; return; }
        if (hipOccupancyMaxActiveBlocksPerMultiprocessor(&per_cu, (const void*)fwd_kernel, 512, LDS_BYTES) != hipSuccess || per_cu < 1) fprintf(stderr, "kernel_launch: occupancy query reports %d\n", per_cu);
        (void)hipGetLastError();
        grid = cus;
    }
    if (grid < 0) return;
    if (hipMemsetAsync((char*)d_ws + WS_CTL, 0, CTL_ZERO_BYTES, stream) != hipSuccess) return;
    Args a{};
    for (int i = 0; i < 23; ++i) a.in[i] = d_in[i];
    a.out = (float*)d_out; a.ws = (unsigned char*)d_ws;
    hipLaunchKernelGGL(fwd_kernel, dim3(grid), dim3(512), LDS_BYTES, stream, a);
}
```

```cpp
#include <hip/hip_runtime.h>
#include <cstdio>
#include <cstdint>

#define LAS __attribute__((address_space(3)))
#define GAS __attribute__((address_space(1)))
typedef unsigned short bf16_t;
typedef short bf16x8 __attribute__((ext_vector_type(8)));
typedef short s16x4 __attribute__((ext_vector_type(4)));
typedef float f32x2 __attribute__((ext_vector_type(2)));
typedef float f32x4 __attribute__((ext_vector_type(4)));
typedef float f32x16 __attribute__((ext_vector_type(16)));
typedef unsigned u32x2 __attribute__((ext_vector_type(2)));
typedef unsigned u32x4 __attribute__((ext_vector_type(4)));
typedef int v8i __attribute__((ext_vector_type(8)));
typedef unsigned u32x8 __attribute__((ext_vector_type(8)));

constexpr int NB = 32, SEQ = 2048, DM = 1024, NTOK = NB * SEQ;
constexpr int QLORA = 384, KVLORA = 256, ROPE = 32, NOPE = 64, VD = 64, QKD = 96, NH = 8;
constexpr int SBD = 64;
constexpr int NE = 32, TOPK = 4, DE = 1024;
constexpr int DIN = 4256, DINP = 4352;
constexpr float EPS = 1e-6f;
constexpr float LOG2E = 1.4426950408889634f;
constexpr int LISTCAP = NTOK;
constexpr int MAXTILES = NTOK / 256 + NE;

constexpr size_t MiB = 1u << 20;
constexpr size_t WS_CTL = 0, CTL_ZERO_BYTES = 1 * MiB;
constexpr size_t WS_WIN = 1 * MiB;
constexpr size_t WS_WUQ = 10 * MiB;
constexpr size_t WS_WUKV = 11 * MiB;
constexpr size_t WS_WOM = 12 * MiB;
constexpr size_t WS_WOS = 13 * MiB;
constexpr size_t WS_WOUT = 14 * MiB;
constexpr size_t WS_MOD = 16 * MiB;
constexpr size_t WS_ROWSS = 20 * MiB;
constexpr size_t WS_WIN8 = 18 * MiB;
constexpr size_t WS_H = 32 * MiB;
constexpr size_t WS_KVRAW = WS_H, WS_MERGED = WS_H;
constexpr size_t WS_SGA = 160 * MiB;
constexpr size_t WS_H2 = WS_SGA;
constexpr size_t WS_SGB = 288 * MiB;
constexpr size_t WS_WGU = WS_SGB;
constexpr size_t WS_SB = 416 * MiB;
constexpr size_t WS_WDN = 416 * MiB;
constexpr size_t WS_TOKL = 480 * MiB;
constexpr size_t WS_WL = 512 * MiB;
constexpr size_t WS_HID = 544 * MiB;
constexpr size_t WS_QL = 608 * MiB;
constexpr size_t WS_M8 = 608 * MiB;
constexpr size_t WS_KVL = 656 * MiB;
constexpr size_t WS_KPE = 688 * MiB;
constexpr size_t WS_Q = 692 * MiB;
constexpr size_t WS_K = 788 * MiB;
constexpr size_t WS_OMLA = 884 * MiB;
constexpr size_t WS_H8 = WS_OMLA;
constexpr size_t WS_OSB = 948 * MiB;
constexpr size_t WS_END = 1012 * MiB;
static_assert(WS_HID + (size_t)4 * MAXTILES * 256 * 1024 <= WS_END, "hid (fp8, all four rounds)");
constexpr int CW_BAR = 4096;
constexpr int CW_CNT = 16384;

constexpr int RING_BYTES = 131072;
constexpr int LDSCTL_OFF = RING_BYTES + 1024;
constexpr int LC_BARST = 0;
constexpr int LC_RBASE = 32;
constexpr int LC_TBASE = 64;
constexpr int LC_NE = 640;
constexpr int LC_TILEE = 1152;
constexpr int LDS_BYTES = 147456;
static_assert(LC_TILEE + 4 * MAXTILES * 4 <= LDS_BYTES - LDSCTL_OFF, "lds ctl");

__device__ __forceinline__ unsigned cvt_pk_bf16(float lo, float hi) { unsigned r; asm volatile("v_cvt_pk_bf16_f32 %0, %1, %2" : "=v"(r) : "v"(lo), "v"(hi)); return r; }
__device__ __forceinline__ float bf_lo(unsigned u) { return __builtin_bit_cast(float, u << 16); }
__device__ __forceinline__ float bf_hi(unsigned u) { return __builtin_bit_cast(float, u & 0xffff0000u); }
__device__ __forceinline__ float fast_sigmoid(float x) { return __builtin_amdgcn_rcpf(1.f + __builtin_amdgcn_exp2f(-x * LOG2E)); }

namespace pg8 {
constexpr int BM = 256, BK = 64, HALF = 128, HTB = HALF * BK * 2, STAGE_BYTES = 8 * HTB, NXCD = 8, WGM = 8;
__host__ __device__ __forceinline__ int lds_byte(int r, int c) { const int st = (r >> 4) * 2 + (c >> 5), rr = r & 15, cc = c & 31, ob = rr * 64 + cc * 2; return st * 1024 + (ob ^ (((ob >> 9) & 1) << 5)); }
__host__ __device__ __forceinline__ void stage_rc(int b, int& R, int& C) { const int st = b / 1024, sb = b % 1024, swz = sb ^ (((sb >> 9) & 1) << 5); R = (st >> 1) * 16 + swz / 64; C = (st & 1) * 32 + (swz % 64) / 2; }
__host__ __device__ __forceinline__ int perm32(int rho) { const int n = rho >> 4, i = rho & 15; return 8 * (i >> 2) + 4 * n + (i & 3); }

struct Unit { int pm, pn, e, j0, ne, kk; };

struct DenseOrder {
    const char* A; const char* Bt; int K; int nM, nN, nwg, G, c;
    __device__ void init(const void* A_, const void* Bt_, int M, int N, int K_, int G_, int c_) { A = (const char*)A_; Bt = (const char*)Bt_; K = K_; nM = M / BM; nN = N / BM; nwg = nM * nN; G = G_; c = c_; }
    __device__ __forceinline__ bool next(int i, Unit& u) const {
        const long L = (long)i * G + c; if (L >= nwg) return false;
        int wgid = (int)L; { const int q = nwg / NXCD, r = nwg % NXCD, xcd = wgid % NXCD, off = wgid / NXCD; wgid = (xcd < r ? xcd * (q + 1) : r * (q + 1) + (xcd - r) * q) + off; }
        const int nig = WGM * nN, gid = wgid / nig, fm = gid * WGM, gsz = (nM - fm) < WGM ? (nM - fm) : WGM;
        u.pm = fm + ((wgid % nig) % gsz); u.pn = (wgid % nig) / gsz; u.e = 0; u.j0 = 0; u.ne = 0; u.kk = 0; return true;
    }
    __device__ __forceinline__ const char* a_base(const Unit& u) const { return A + (size_t)u.pm * (size_t)(BM * 2) * K; }
    __device__ __forceinline__ const char* b_base(const Unit& u) const { return Bt + (size_t)u.pn * (size_t)(BM * 2) * K; }
    __device__ __forceinline__ unsigned row_of(const Unit&, int) const { return 0u; }
};

template <bool GATHER, class Epi, class Sched>
__device__ __forceinline__ void gemm_phase(LAS unsigned char* lds, const int K, const Sched& S, const Epi& E, const int stg = 0) {
    int tid_ = threadIdx.x; asm volatile("" : "+v"(tid_));
    const int tid = tid_, wid = __builtin_amdgcn_readfirstlane(tid >> 6), lane = tid & 63, wr = wid >> 2, wc = wid & 3, fr = lane & 15, fq = lane >> 4;
    const int nt = K / BK;
    int RA[2]; unsigned cofA[2], voffB[2];
#pragma unroll
    for (int i = 0; i < 2; ++i) { int R, C; stage_rc(tid * 16 + i * 8192, R, C); const int Rb = (R & ~31) + perm32(R & 31);
        RA[i] = R; cofA[i] = (unsigned)C * 2u; voffB[i] = (unsigned)(Rb * K + C) * 2u; }
    const size_t kstep = (size_t)(BK * 2);
    const size_t hstep = (size_t)HALF * K * 2;
    const unsigned ldsw = (unsigned)wid * 1024u;
    const int aoff = lds_byte(wr * 64 + fr, fq * 8), boff = lds_byte(wc * 32 + fr, fq * 8);
#define PG8_SA(b, h) (((b) * 2 + (h)) * HTB)
#define PG8_SB(b, h) ((4 + (b) * 2 + (h)) * HTB)
#define PG8_STAGE(bufoff, gbase, voff) do { _Pragma("unroll") for (int _i = 0; _i < 2; ++_i) \
        __builtin_amdgcn_global_load_lds((const unsigned*)((const char*)(gbase) + (voff)[_i]), (LAS unsigned*)(lds + (bufoff) + ldsw + _i * 8192), 16, 0, 0); } while (0)
#define PG8_LDA(dst, b, h) do { _Pragma("unroll") for (int m = 0; m < 4; ++m) _Pragma("unroll") for (int k = 0; k < 2; ++k) dst[m][k] = *(const LAS bf16x8*)(lds + PG8_SA(b, h) + aoff + m * 2048 + k * 1024); } while (0)
#define PG8_LDB(dst, b, h) do { _Pragma("unroll") for (int n = 0; n < 2; ++n) _Pragma("unroll") for (int k = 0; k < 2; ++k) dst[n][k] = *(const LAS bf16x8*)(lds + PG8_SB(b, h) + boff + n * 2048 + k * 1024); } while (0)
#define PG8_MMA(ai, bj, At, Bt) do { __builtin_amdgcn_s_setprio(1); _Pragma("unroll") for (int m = 0; m < 4; ++m) _Pragma("unroll") for (int n = 0; n < 2; ++n) _Pragma("unroll") for (int k = 0; k < 2; ++k) \
        acc[ai][bj][m][n] = __builtin_amdgcn_mfma_f32_16x16x32_bf16(Bt[n][k], At[m][k], acc[ai][bj][m][n], 0, 0, 0); __builtin_amdgcn_s_setprio(0); } while (0)
#define PG8_WAIT_V(n) asm volatile("s_waitcnt vmcnt(" #n ")" ::: "memory")
#define PG8_WAIT_L(n) asm volatile("s_waitcnt lgkmcnt(" #n ")" ::: "memory")
#define PG8_BAR __builtin_amdgcn_s_barrier()
#define PG8_SCHED __builtin_amdgcn_sched_barrier(0)
#define PG8_AOFFS(dst, u) do { _Pragma("unroll") for (int _h = 0; _h < 2; ++_h) _Pragma("unroll") for (int _i = 0; _i < 2; ++_i) { \
        const unsigned _row = GATHER ? S.row_of(u, _h * HALF + RA[_i]) : (unsigned)(_h * HALF + RA[_i]); dst[_h][_i] = _row * (unsigned)(K * 2) + cofA[_i]; } } while (0)
    if (stg > 0 && ((blockIdx.x >> 3) & 1)) {
        const unsigned long long t0 = __builtin_amdgcn_s_memrealtime();
        while (__builtin_amdgcn_s_memrealtime() - t0 < (unsigned long long)stg) __builtin_amdgcn_s_sleep(8); }
    Unit cur, nxt; int ui = 0;
    if (!S.next(0, cur)) return;
    f32x4 acc[2][2][4][2];
#pragma unroll
    for (int a = 0; a < 2; ++a)
#pragma unroll
        for (int b = 0; b < 2; ++b)
#pragma unroll
            for (int m = 0; m < 4; ++m)
#pragma unroll
                for (int n = 0; n < 2; ++n) acc[a][b][m][n] = (f32x4){0.f, 0.f, 0.f, 0.f};
    bf16x8 At[4][2], B0[2][2], B1[2][2];
    unsigned oc[2][2], on[2][2];
    PG8_AOFFS(oc, cur);
    const char* cA = S.a_base(cur); const char* cB = S.b_base(cur);
    PG8_STAGE(PG8_SB(0, 0), cB, voffB); PG8_STAGE(PG8_SB(0, 1), cB + hstep, voffB); PG8_STAGE(PG8_SA(0, 0), cA, oc[0]); PG8_STAGE(PG8_SA(0, 1), cA, oc[1]);
    if (wr == 1) PG8_BAR;
    PG8_WAIT_V(2); PG8_BAR;
    PG8_STAGE(PG8_SB(1, 0), cB + kstep, voffB); PG8_STAGE(PG8_SA(1, 0), cA + kstep, oc[0]); PG8_STAGE(PG8_SB(1, 1), cB + hstep + kstep, voffB);
    PG8_WAIT_V(6); PG8_BAR;
    for (;;) {
        const bool has_next = S.next(ui + 1, nxt);
        const char* nA = has_next ? S.a_base(nxt) : cA; const char* nB = has_next ? S.b_base(nxt) : cB;
        if constexpr (GATHER) { if (has_next) { PG8_AOFFS(on, nxt);
            _Pragma("unroll") for (int _h = 0; _h < 2; ++_h) _Pragma("unroll") for (int _i = 0; _i < 2; ++_i) asm volatile("" : "+v"(on[_h][_i]));
          } else {
#pragma unroll
            for (int _h = 0; _h < 2; ++_h)
#pragma unroll
                for (int _i = 0; _i < 2; ++_i) on[_h][_i] = oc[_h][_i]; } }
#pragma nounroll
        for (int t = 0; t < nt; t += 2) {
            const bool last = (t == nt - 2);
            const char* a1 = cA + (size_t)(t + 1) * kstep;
            const char* a2 = last ? nA : cA + (size_t)(t + 2) * kstep; const char* b2 = last ? nB : cB + (size_t)(t + 2) * kstep;
            const char* a3 = a2 + kstep; const char* b3 = b2 + kstep;
            unsigned o2[2][2];
#pragma unroll
            for (int _h = 0; _h < 2; ++_h)
#pragma unroll
                for (int _i = 0; _i < 2; ++_i) o2[_h][_i] = (GATHER && last) ? on[_h][_i] : oc[_h][_i];
            PG8_LDB(B0, 0, 0); PG8_LDB(B1, 0, 1); PG8_SCHED; PG8_LDA(At, 0, 0); PG8_STAGE(PG8_SA(1, 1), a1, oc[1]);
            PG8_WAIT_V(8); PG8_WAIT_L(0); PG8_BAR; PG8_MMA(0, 0, At, B0); PG8_MMA(0, 1, At, B1); PG8_BAR; PG8_SCHED;
            PG8_LDA(At, 0, 1); PG8_STAGE(PG8_SB(0, 0), b2, voffB); PG8_STAGE(PG8_SB(0, 1), b2 + hstep, voffB); PG8_STAGE(PG8_SA(0, 0), a2, o2[0]);
            PG8_WAIT_V(8); PG8_WAIT_L(0); PG8_BAR; PG8_MMA(1, 0, At, B0); PG8_MMA(1, 1, At, B1); PG8_BAR; PG8_SCHED;
            PG8_LDB(B0, 1, 0); PG8_LDB(B1, 1, 1); PG8_SCHED; PG8_LDA(At, 1, 0); PG8_STAGE(PG8_SA(0, 1), a2, o2[1]);
            PG8_WAIT_V(8); PG8_WAIT_L(0); PG8_BAR; PG8_MMA(0, 0, At, B0); PG8_MMA(0, 1, At, B1); PG8_BAR; PG8_SCHED;
            PG8_LDA(At, 1, 1); PG8_STAGE(PG8_SB(1, 0), b3, voffB); PG8_STAGE(PG8_SB(1, 1), b3 + hstep, voffB); PG8_STAGE(PG8_SA(1, 0), a3, o2[0]);
            PG8_WAIT_V(8); PG8_WAIT_L(0); PG8_BAR; PG8_MMA(1, 0, At, B0); PG8_MMA(1, 1, At, B1); PG8_BAR; PG8_SCHED;
        }
        if (wr == 0) PG8_BAR;
        E(acc, cur, wr, wc, fr, fq);
        if (!has_next) break;
#pragma unroll
        for (int a = 0; a < 2; ++a)
#pragma unroll
            for (int b = 0; b < 2; ++b)
#pragma unroll
                for (int m = 0; m < 4; ++m)
#pragma unroll
                    for (int n = 0; n < 2; ++n) acc[a][b][m][n] = (f32x4){0.f, 0.f, 0.f, 0.f};
        cur = nxt; cA = nA; cB = nB; ++ui;
        if constexpr (GATHER) {
#pragma unroll
        for (int _h = 0; _h < 2; ++_h)
#pragma unroll
            for (int _i = 0; _i < 2; ++_i) oc[_h][_i] = on[_h][_i]; }
        if (wr == 1) PG8_BAR;
    }
    PG8_WAIT_V(0);
    PG8_BAR;
#undef PG8_SA
#undef PG8_SB
#undef PG8_STAGE
#undef PG8_LDA
#undef PG8_LDB
#undef PG8_MMA
#undef PG8_WAIT_V
#undef PG8_WAIT_L
#undef PG8_BAR
#undef PG8_SCHED
#undef PG8_AOFFS
}
template <bool GATHER, class Epi, class Sched>
__device__ __forceinline__ void gemm_phase_f8(LAS unsigned char* lds, const int K, const Sched& S, const Epi& E, const int stg = 0) {
    int tid_ = threadIdx.x; asm volatile("" : "+v"(tid_));
    const int tid = tid_, wid = __builtin_amdgcn_readfirstlane(tid >> 6), lane = tid & 63, wr = wid >> 2, wc = wid & 3, fr = lane & 15, fq = lane >> 4;
    const int nt = K / BK;
    int RA[2]; unsigned cofA[2], voffB[2];
#pragma unroll
    for (int i = 0; i < 2; ++i) { int R, C; stage_rc(tid * 16 + i * 8192, R, C); const int Rb = (R & ~31) + perm32(R & 31);
        RA[i] = R; cofA[i] = (unsigned)C * 2u; voffB[i] = (unsigned)(Rb * K + C) * 2u; }
    const size_t kstep = (size_t)(BK * 2);
    const size_t hstep = (size_t)HALF * K * 2;
    const unsigned ldsw = (unsigned)wid * 1024u;
    const int aoff = lds_byte(wr * 64 + fr, 16 * (fq & 1)) + (fq >> 1) * 1024, boff = lds_byte(wc * 32 + fr, 16 * (fq & 1)) + (fq >> 1) * 1024;
#define PG8_SA(b, h) (((b) * 2 + (h)) * HTB)
#define PG8_SB(b, h) ((4 + (b) * 2 + (h)) * HTB)
#define PG8_STAGE(bufoff, gbase, voff) do { _Pragma("unroll") for (int _i = 0; _i < 2; ++_i) \
        __builtin_amdgcn_global_load_lds((const unsigned*)((const char*)(gbase) + (voff)[_i]), (LAS unsigned*)(lds + (bufoff) + ldsw + _i * 8192), 16, 0, 0); } while (0)
#define PG8_LD32(p_) __builtin_shufflevector(*(const LAS u32x4*)(p_), *(const LAS u32x4*)((p_) + 16), 0, 1, 2, 3, 4, 5, 6, 7)
#define PG8_LDA(dst, b, h) do { _Pragma("unroll") for (int m = 0; m < 4; ++m) dst[m] = PG8_LD32(lds + PG8_SA(b, h) + aoff + m * 2048); } while (0)
#define PG8_LDB(dst, b, h) do { _Pragma("unroll") for (int n = 0; n < 2; ++n) dst[n] = PG8_LD32(lds + PG8_SB(b, h) + boff + n * 2048); } while (0)
#define PG8_F8(fr_) ((v8i){(int)fr_[0][0], (int)fr_[0][1], (int)fr_[0][2], (int)fr_[0][3], (int)fr_[1][0], (int)fr_[1][1], (int)fr_[1][2], (int)fr_[1][3]})
#define PG8_MMA(ai, bj, At, Bt) do { __builtin_amdgcn_s_setprio(1); _Pragma("unroll") for (int m = 0; m < 4; ++m) _Pragma("unroll") for (int n = 0; n < 2; ++n) \
        asm volatile("v_mfma_scale_f32_16x16x128_f8f6f4 %0, %1, %2, %0, %3, %3 op_sel_hi:[0,0,0]" : "+v"(acc[ai][bj][m][n]) : "v"(Bt[n]), "v"(At[m]), "v"(one_scale)); __builtin_amdgcn_s_setprio(0); } while (0)
#define PG8_WAIT_V(n) asm volatile("s_waitcnt vmcnt(" #n ")" ::: "memory")
#define PG8_WAIT_L(n) asm volatile("s_waitcnt lgkmcnt(" #n ")" ::: "memory")
#define PG8_BAR __builtin_amdgcn_s_barrier()
#define PG8_SCHED __builtin_amdgcn_sched_barrier(0)
#define PG8_AOFFS(dst, u) do { _Pragma("unroll") for (int _h = 0; _h < 2; ++_h) _Pragma("unroll") for (int _i = 0; _i < 2; ++_i) { \
        const unsigned _row = GATHER ? S.row_of(u, _h * HALF + RA[_i]) : (unsigned)(_h * HALF + RA[_i]); dst[_h][_i] = _row * (unsigned)(K * 2) + cofA[_i]; } } while (0)
    if (stg > 0 && ((blockIdx.x >> 3) & 1)) {
        const unsigned long long t0 = __builtin_amdgcn_s_memrealtime();
        while (__builtin_amdgcn_s_memrealtime() - t0 < (unsigned long long)stg) __builtin_amdgcn_s_sleep(8); }
    Unit cur, nxt; int ui = 0;
    if (!S.next(0, cur)) return;
    f32x4 acc[2][2][4][2];
#pragma unroll
    for (int a = 0; a < 2; ++a)
#pragma unroll
        for (int b = 0; b < 2; ++b)
#pragma unroll
            for (int m = 0; m < 4; ++m)
#pragma unroll
                for (int n = 0; n < 2; ++n) { acc[a][b][m][n] = (f32x4){0.f, 0.f, 0.f, 0.f}; asm volatile("" : "+v"(acc[a][b][m][n])); }
    u32x8 At[4], B0[2], B1[2];
    int one_scale = 0x7f7f7f7f; asm volatile("" : "+v"(one_scale));
    unsigned oc[2][2], on[2][2];
    PG8_AOFFS(oc, cur);
    const char* cA = S.a_base(cur); const char* cB = S.b_base(cur);
    PG8_STAGE(PG8_SB(0, 0), cB, voffB); PG8_STAGE(PG8_SB(0, 1), cB + hstep, voffB); PG8_STAGE(PG8_SA(0, 0), cA, oc[0]); PG8_STAGE(PG8_SA(0, 1), cA, oc[1]);
    if (wr == 1) PG8_BAR;
    PG8_WAIT_V(2); PG8_BAR;
    PG8_STAGE(PG8_SB(1, 0), cB + kstep, voffB); PG8_STAGE(PG8_SA(1, 0), cA + kstep, oc[0]); PG8_STAGE(PG8_SB(1, 1), cB + hstep + kstep, voffB);
    PG8_WAIT_V(6); PG8_BAR;
    Unit nn; bool has_next = S.next(1, nxt);
    if constexpr (GATHER) { if (has_next) { PG8_AOFFS(on, nxt);
            _Pragma("unroll") for (int _h = 0; _h < 2; ++_h) _Pragma("unroll") for (int _i = 0; _i < 2; ++_i) asm volatile("" : "+v"(on[_h][_i]));
          } else {
#pragma unroll
            for (int _h = 0; _h < 2; ++_h)
#pragma unroll
                for (int _i = 0; _i < 2; ++_i) on[_h][_i] = oc[_h][_i]; } }
    for (;;) {
        const char* nA = has_next ? S.a_base(nxt) : cA; const char* nB = has_next ? S.b_base(nxt) : cB;
#pragma nounroll
        for (int t = 0; t < nt; t += 2) {
            const bool last = (t == nt - 2);
            const char* a1 = cA + (size_t)(t + 1) * kstep;
            const char* a2 = last ? nA : cA + (size_t)(t + 2) * kstep; const char* b2 = last ? nB : cB + (size_t)(t + 2) * kstep;
            const char* a3 = a2 + kstep; const char* b3 = b2 + kstep;
            unsigned o2[2][2];
#pragma unroll
            for (int _h = 0; _h < 2; ++_h)
#pragma unroll
                for (int _i = 0; _i < 2; ++_i) o2[_h][_i] = (GATHER && last) ? on[_h][_i] : oc[_h][_i];
            PG8_LDB(B0, 0, 0); PG8_LDB(B1, 0, 1); PG8_SCHED; PG8_LDA(At, 0, 0); PG8_STAGE(PG8_SA(1, 1), a1, oc[1]);
            PG8_WAIT_V(8); PG8_WAIT_L(0); PG8_BAR; PG8_MMA(0, 0, At, B0); PG8_MMA(0, 1, At, B1); PG8_BAR; PG8_SCHED;
            PG8_LDA(At, 0, 1); PG8_STAGE(PG8_SB(0, 0), b2, voffB); PG8_STAGE(PG8_SB(0, 1), b2 + hstep, voffB); PG8_STAGE(PG8_SA(0, 0), a2, o2[0]);
            PG8_WAIT_V(8); PG8_WAIT_L(0); PG8_BAR; PG8_MMA(1, 0, At, B0); PG8_MMA(1, 1, At, B1); PG8_BAR; PG8_SCHED;
            PG8_LDB(B0, 1, 0); PG8_LDB(B1, 1, 1); PG8_SCHED; PG8_LDA(At, 1, 0); PG8_STAGE(PG8_SA(0, 1), a2, o2[1]);
            PG8_WAIT_V(8); PG8_WAIT_L(0); PG8_BAR; PG8_MMA(0, 0, At, B0); PG8_MMA(0, 1, At, B1); PG8_BAR; PG8_SCHED;
            PG8_LDA(At, 1, 1); PG8_STAGE(PG8_SB(1, 0), b3, voffB); PG8_STAGE(PG8_SB(1, 1), b3 + hstep, voffB); PG8_STAGE(PG8_SA(1, 0), a3, o2[0]);
            PG8_WAIT_V(8); PG8_WAIT_L(0); PG8_BAR; PG8_MMA(1, 0, At, B0); PG8_MMA(1, 1, At, B1); PG8_BAR; PG8_SCHED;
        }
        asm volatile("s_nop 15\n\ts_nop 15" ::: "memory");
        if (wr == 0) PG8_BAR;
        const bool has_nn = has_next && S.next(ui + 2, nn);
        unsigned onn[2][2];
        if constexpr (GATHER) { if (has_nn) { PG8_AOFFS(onn, nn); } else {
#pragma unroll
            for (int _h = 0; _h < 2; ++_h)
#pragma unroll
                for (int _i = 0; _i < 2; ++_i) onn[_h][_i] = on[_h][_i]; } }
        E(acc, cur, wr, wc, fr, fq);
        if (!has_next) break;
#pragma unroll
        for (int a = 0; a < 2; ++a)
#pragma unroll
            for (int b = 0; b < 2; ++b)
#pragma unroll
                for (int m = 0; m < 4; ++m)
#pragma unroll
                    for (int n = 0; n < 2; ++n) { acc[a][b][m][n] = (f32x4){0.f, 0.f, 0.f, 0.f}; asm volatile("" : "+v"(acc[a][b][m][n])); }
        cur = nxt; cA = nA; cB = nB; ++ui; nxt = nn; has_next = has_nn;
        if constexpr (GATHER) {
#pragma unroll
        for (int _h = 0; _h < 2; ++_h)
#pragma unroll
            for (int _i = 0; _i < 2; ++_i) { oc[_h][_i] = on[_h][_i]; asm volatile("" : "+v"(onn[_h][_i])); on[_h][_i] = onn[_h][_i]; } }
        if (wr == 1) PG8_BAR;
    }
    PG8_WAIT_V(0);
    PG8_BAR;
#undef PG8_SA
#undef PG8_SB
#undef PG8_STAGE
#undef PG8_LDA
#undef PG8_LDB
#undef PG8_MMA
#undef PG8_WAIT_V
#undef PG8_WAIT_L
#undef PG8_BAR
#undef PG8_SCHED
#undef PG8_AOFFS
#undef PG8_F8
}
}
#define XB_TMO      128
#define XB_XCNT(j)  (256  + 64 * (j))
#define XB_XSUB(j)  (1280 + 64 * (j))
#define XB_XGEN(j)  (2304 + 64 * (j))
#define XB_TOP      3328
#define XB_TOPGEN   3392
#define XCD_BAR_WORDS 3456
#define XB_SPIN_CAP (1u << 18)

__device__ __forceinline__ unsigned xb_ld(unsigned* p)              { return __hip_atomic_load(p, __ATOMIC_RELAXED, __HIP_MEMORY_SCOPE_AGENT); }
__device__ __forceinline__ unsigned xb_add(unsigned* p, unsigned v) { return __hip_atomic_fetch_add(p, v, __ATOMIC_RELAXED, __HIP_MEMORY_SCOPE_AGENT); }
__device__ __forceinline__ unsigned xb_xcc_id() { return (unsigned)__builtin_amdgcn_s_getreg((3 << 11) | 20) & 0xFu; }
#define XB_SPIN(cond, bar) do { unsigned _sp = 0; while (cond) { __builtin_amdgcn_s_sleep(1); \
    if ((++_sp & 255u) == 0u) { if (xb_ld(&(bar)[XB_TMO])) break; if (_sp > XB_SPIN_CAP) { atomicAdd(&(bar)[XB_TMO], 1u); break; } } } } while (0)

struct XcdBarrier {
    unsigned* bar; unsigned x;
    volatile LAS unsigned* st;
};

__device__ __forceinline__ XcdBarrier xcd_barrier_post(unsigned* bar, volatile LAS unsigned* st) {
    XcdBarrier b; b.bar = bar; b.x = xb_xcc_id(); b.st = st;
    if (threadIdx.x == 0) (void)xb_add(&bar[XB_XCNT(b.x)], 1u);
    return b;
}
__device__ __forceinline__ void xcd_barrier_complete(unsigned* bar, unsigned x, unsigned& nloc, unsigned& nx) {
    const unsigned G = gridDim.x * gridDim.y * gridDim.z;
    unsigned sum, cnt, mine, sp = 0u;
    for (;;) {
        sum = 0u; cnt = 0u; mine = 0u;
#pragma unroll
        for (unsigned j = 0; j < 16; ++j) { const unsigned c = xb_ld(&bar[XB_XCNT(j)]); sum += c; cnt += (c > 0u) ? 1u : 0u; mine = (j == x) ? c : mine; }
        if (sum == G) break;
        __builtin_amdgcn_s_sleep(1);
        if ((++sp & 255u) == 0u) { if (xb_ld(&bar[XB_TMO])) break; if (sp > XB_SPIN_CAP) { atomicAdd(&bar[XB_TMO], 1u); break; } }
    }
    nloc = mine > 0u ? mine : 1u; nx = cnt > 0u ? cnt : 1u;
}

__device__ __forceinline__ void xcd_barrier(const XcdBarrier& b) {
    asm volatile("s_waitcnt vmcnt(0)" ::: "memory");
    __syncthreads();
    if (threadIdx.x == 0) {
        unsigned* bar = b.bar;
        __builtin_amdgcn_s_waitcnt(0);
        unsigned nloc = b.st[0], nx = b.st[1];
        if (nloc == 0u) { xcd_barrier_complete(bar, b.x, nloc, nx); b.st[0] = nloc; b.st[1] = nx; }
        const unsigned old = xb_add(&bar[XB_XSUB(b.x)], 1u);
        const unsigned gen = old / nloc;
        if (old + 1u == (gen + 1u) * nloc) {
            __builtin_amdgcn_fence(__ATOMIC_RELEASE, "agent");
            asm volatile("s_waitcnt vmcnt(0)" ::: "memory");
            const unsigned og = xb_add(&bar[XB_TOP], 1u);
            const unsigned tg = og / nx;
            if (og + 1u == (tg + 1u) * nx) xb_add(&bar[XB_TOPGEN], 1u);
            else XB_SPIN(xb_ld(&bar[XB_TOPGEN]) == tg, bar);
            __builtin_amdgcn_fence(__ATOMIC_ACQUIRE, "agent");
            xb_add(&bar[XB_XGEN(b.x)], 1u);
            asm volatile("s_waitcnt vmcnt(0)" ::: "memory");
        } else {
            XB_SPIN(xb_ld(&bar[XB_XGEN(b.x)]) == gen, bar);
            __builtin_amdgcn_fence(__ATOMIC_ACQUIRE, "agent");
            asm volatile("s_waitcnt vmcnt(0)" ::: "memory");
        }
    }
    __syncthreads();
}

#define LDS_WAIT() asm volatile("s_waitcnt lgkmcnt(0)" ::: "memory")
#define VM_WAIT() asm volatile("s_waitcnt vmcnt(0)" ::: "memory")
#define MFMA32(a, b, c) __builtin_amdgcn_mfma_f32_32x32x16_bf16((a), (b), (c), 0, 0, 0)
__device__ __forceinline__ float wave_sum(float v) {
#pragma unroll
    for (int o = 1; o < 64; o <<= 1) v += __shfl_xor(v, o);
    return v;
}
__device__ __forceinline__ int crow(int i, int hh) { return (i & 3) + 8 * (i >> 2) + 4 * hh; }
__device__ __forceinline__ bf16x8 pack8(float a0, float a1, float a2, float a3, float a4, float a5, float a6, float a7) {
    u32x4 p; p.x = cvt_pk_bf16(a0, a1); p.y = cvt_pk_bf16(a2, a3); p.z = cvt_pk_bf16(a4, a5); p.w = cvt_pk_bf16(a6, a7);
    return __builtin_bit_cast(bf16x8, p);
}

struct Ctx {
    LAS unsigned char* lds;
    int tid, lane, wave, vcu, G;
};

__device__ __forceinline__ void transpose_item(const float* W, int K, int N, bf16_t* WT, int k0, int n0, int drow0, LAS float* scr, int lane, const float* kgain = nullptr) {
#pragma unroll 8
    for (int i = 0; i < 32; ++i) { const int kk = 2 * i + (lane >> 5); float wv = W[(size_t)(k0 + kk) * N + n0 + (lane & 31)]; if (kgain) wv *= kgain[k0 + kk]; scr[kk * 33 + (lane & 31)] = wv; }
    LDS_WAIT(); asm volatile("" ::: "memory");
    const int c = lane & 7;
#pragma unroll
    for (int j = 0; j < 4; ++j) { const int n = (lane >> 3) + 8 * j; const LAS float* s = scr + (8 * c) * 33 + n;
        u32x4 o; o.x = cvt_pk_bf16(s[0 * 33], s[1 * 33]); o.y = cvt_pk_bf16(s[2 * 33], s[3 * 33]); o.z = cvt_pk_bf16(s[4 * 33], s[5 * 33]); o.w = cvt_pk_bf16(s[6 * 33], s[7 * 33]);
        *(GAS u32x4*)(WT + (size_t)(drow0 + n) * K + k0 + 8 * c) = o; }
    LDS_WAIT(); asm volatile("" ::: "memory");
}

__device__ __forceinline__ unsigned pk4_fp8(float a, float b, float c, float d) { int p = __builtin_amdgcn_cvt_pk_fp8_f32(a, b, 0, false); p = __builtin_amdgcn_cvt_pk_fp8_f32(c, d, p, true); return (unsigned)p; }
__device__ __forceinline__ void transpose_item_f8(const float* W, int K, int N, unsigned char* WT, int k0, int n0, int drow0, float scl, LAS float* scr, int lane) {
#pragma unroll 8
    for (int i = 0; i < 32; ++i) { const int kk = 2 * i + (lane >> 5); scr[kk * 33 + (lane & 31)] = W[(size_t)(k0 + kk) * N + n0 + (lane & 31)]; }
    LDS_WAIT(); asm volatile("" ::: "memory");
    const int c = lane & 7;
#pragma unroll
    for (int j = 0; j < 4; ++j) { const int n = (lane >> 3) + 8 * j; const LAS float* s = scr + (8 * c) * 33 + n;
        u32x2 o; o.x = pk4_fp8(s[0 * 33] * scl, s[1 * 33] * scl, s[2 * 33] * scl, s[3 * 33] * scl); o.y = pk4_fp8(s[4 * 33] * scl, s[5 * 33] * scl, s[6 * 33] * scl, s[7 * 33] * scl);
        *(GAS u32x2*)(WT + (size_t)(drow0 + n) * K + k0 + 8 * c) = o; }
    LDS_WAIT(); asm volatile("" ::: "memory");
}

#ifdef NT_STORES
#define ST_NT(p_, v_) __builtin_nontemporal_store((v_), (p_))
#else
#define ST_NT(p_, v_) (*(p_) = (v_))
#endif
constexpr float WSCALE = 32.f, WDESCALE = 1.f / 32.f;
typedef const f32x4 (&AccRef)[2][2][4][2];

struct EpiNull { __device__ __forceinline__ void operator()(AccRef acc, const pg8::Unit& u, int wr, int wc, int fr, int fq) const {
        float s = 0.f;
#pragma unroll
        for (int ai = 0; ai < 2; ++ai)
#pragma unroll
            for (int bj = 0; bj < 2; ++bj)
#pragma unroll
                for (int m = 0; m < 4; ++m)
#pragma unroll
                    for (int n = 0; n < 2; ++n) s += acc[ai][bj][m][n][0] + acc[ai][bj][m][n][1] + acc[ai][bj][m][n][2] + acc[ai][bj][m][n][3];
        asm volatile("" :: "v"(s)); } };
struct EpiStore {
    bf16_t* O; int ldc; const float* SS; float inv_n;
    __device__ __forceinline__ void operator()(AccRef acc, const pg8::Unit& u, int wr, int wc, int fr, int fq) const {
        const int row0 = u.pm * 256 + wr * 64 + fr, col0 = u.pn * 256 + wc * 32 + 8 * fq;
#pragma unroll
        for (int ai = 0; ai < 2; ++ai)
#pragma unroll
            for (int m = 0; m < 4; ++m) { bf16_t* rowp = O + (size_t)(row0 + ai * 128 + m * 16) * ldc + col0;
                const float rs = rsqrtf(SS[(size_t)(row0 + ai * 128 + m * 16) * 2] * inv_n + EPS);
#pragma unroll
                for (int bj = 0; bj < 2; ++bj) { const f32x4 v0 = acc[ai][bj][m][0] * rs, v1 = acc[ai][bj][m][1] * rs;
                    u32x4 w; w.x = cvt_pk_bf16(v0[0], v0[1]); w.y = cvt_pk_bf16(v0[2], v0[3]); w.z = cvt_pk_bf16(v1[0], v1[1]); w.w = cvt_pk_bf16(v1[2], v1[3]);
                    ST_NT((u32x4*)(rowp + bj * 128), w); } }
    }
};

struct EpiProj {
    bf16_t *QL, *KVL, *KPE, *SB, *SGA, *SGB; int cbase; float dsc; float* ROWSS;
    __device__ __forceinline__ void operator()(AccRef acc, const pg8::Unit& u, int wr, int wc, int fr, int fq) const {
        const int row0 = u.pm * 256 + wr * 64 + fr;
#pragma unroll
        for (int bj = 0; bj < 2; ++bj) {
            const int cg = cbase + u.pn * 256 + bj * 128 + wc * 32;
            bf16_t* base; int ld, co; bool sig = false; int lat = -1;
            if (cg < 384) { base = QL; ld = 384; co = cg; lat = 0; }
            else if (cg < 640) { base = KVL; ld = 256; co = cg - 384; lat = 1; }
            else if (cg < 672) { base = KPE; ld = 32; co = cg - 640; }
            else if (cg < 768) { continue; }
            else if (cg < 2304) { base = SB; ld = 1536; co = cg - 768; }
            else if (cg < 3328) { base = SGA; ld = 1024; co = cg - 2304; sig = true; }
            else { base = SGB; ld = 1024; co = cg - 3328; sig = true; }
#pragma unroll
            for (int ai = 0; ai < 2; ++ai)
#pragma unroll
                for (int m = 0; m < 4; ++m) { f32x4 v0 = acc[ai][bj][m][0], v1 = acc[ai][bj][m][1];
                    if (sig) {
                        int q0 = 0, q1 = 0;
#pragma unroll
                        for (int j = 0; j < 4; ++j) { q0 = __builtin_amdgcn_cvt_pk_u8_f32(fast_sigmoid(v0[j] * dsc) * 255.f, j, q0); q1 = __builtin_amdgcn_cvt_pk_u8_f32(fast_sigmoid(v1[j] * dsc) * 255.f, j, q1); }
                        u32x2 w8; w8.x = (unsigned)q0; w8.y = (unsigned)q1;
                        ST_NT((u32x2*)((unsigned char*)base + (size_t)(row0 + ai * 128 + m * 16) * 1024 + co + 8 * fq), w8); continue; }
                    u32x4 w; w.x = cvt_pk_bf16(v0[0], v0[1]); w.y = cvt_pk_bf16(v0[2], v0[3]); w.z = cvt_pk_bf16(v1[0], v1[1]); w.w = cvt_pk_bf16(v1[2], v1[3]);
                    ST_NT((u32x4*)(base + (size_t)(row0 + ai * 128 + m * 16) * ld + co + 8 * fq), w);
                    if (lat >= 0) {
                        float ss = bf_lo(w.x) * bf_lo(w.x) + bf_hi(w.x) * bf_hi(w.x) + bf_lo(w.y) * bf_lo(w.y) + bf_hi(w.y) * bf_hi(w.y) + bf_lo(w.z) * bf_lo(w.z) + bf_hi(w.z) * bf_hi(w.z) + bf_lo(w.w) * bf_lo(w.w) + bf_hi(w.w) * bf_hi(w.w);
                        ss += __shfl_xor(ss, 16); ss += __shfl_xor(ss, 32);
                        if (fq == 0) atomicAdd(ROWSS + (size_t)(row0 + ai * 128 + m * 16) * 2 + lat, ss); } }
        }
    }
};

template <bool SECOND> struct EpiMerge {
    bf16_t* MG; const bf16_t* SG; unsigned char* M8;
    __device__ __forceinline__ void operator()(AccRef acc, const pg8::Unit& u, int wr, int wc, int fr, int fq) const {
        const int row0 = u.pm * 256 + wr * 64 + fr, col0 = u.pn * 256 + wc * 32 + 8 * fq;
#pragma unroll
        for (int ai = 0; ai < 2; ++ai)
#pragma unroll
            for (int m = 0; m < 4; ++m) { const size_t ro = (size_t)(row0 + ai * 128 + m * 16) * 1024 + col0;
#pragma unroll
                for (int bj = 0; bj < 2; ++bj) { const f32x4 v0 = acc[ai][bj][m][0], v1 = acc[ai][bj][m][1];
                    const u32x2 g = *(const u32x2*)((const unsigned char*)SG + ro + bj * 128);
                    constexpr float I255 = 1.f / 255.f;
                    float r0 = (float)(g.x & 0xffu) * I255 * v0[0], r1 = (float)((g.x >> 8) & 0xffu) * I255 * v0[1], r2 = (float)((g.x >> 16) & 0xffu) * I255 * v0[2], r3 = (float)(g.x >> 24) * I255 * v0[3];
                    float r4 = (float)(g.y & 0xffu) * I255 * v1[0], r5 = (float)((g.y >> 8) & 0xffu) * I255 * v1[1], r6 = (float)((g.y >> 16) & 0xffu) * I255 * v1[2], r7 = (float)(g.y >> 24) * I255 * v1[3];
                    if (SECOND) { const u32x4 p = *(const u32x4*)(MG + ro + bj * 128);
                        r0 += bf_lo(p.x); r1 += bf_hi(p.x); r2 += bf_lo(p.y); r3 += bf_hi(p.y); r4 += bf_lo(p.z); r5 += bf_hi(p.z); r6 += bf_lo(p.w); r7 += bf_hi(p.w); }
                    if (SECOND) { u32x2 w; w.x = pk4_fp8(r0, r1, r2, r3); w.y = pk4_fp8(r4, r5, r6, r7); ST_NT((u32x2*)(M8 + ro + bj * 128), w); }
                    else { u32x4 w; w.x = cvt_pk_bf16(r0, r1); w.y = cvt_pk_bf16(r2, r3); w.z = cvt_pk_bf16(r4, r5); w.w = cvt_pk_bf16(r6, r7);
                        ST_NT((u32x4*)(MG + ro + bj * 128), w); } } }
    }
};

struct EpiWout {
    const float* X; float* OUT; const float* MOD; float dsc;
    __device__ __forceinline__ void operator()(AccRef acc, const pg8::Unit& u, int wr, int wc, int fr, int fq) const {
        const int row0 = u.pm * 256 + wr * 64 + fr, col0 = u.pn * 256 + wc * 32 + 8 * fq;
        const float* ga = MOD + (size_t)(u.pm >> 3) * 6144 + 2048 + col0;
        f32x4 g[2][2];
#pragma unroll
        for (int bj = 0; bj < 2; ++bj)
#pragma unroll
            for (int n = 0; n < 2; ++n) g[bj][n] = *(const f32x4*)(ga + bj * 128 + 4 * n) * dsc;
#pragma unroll
        for (int ai = 0; ai < 2; ++ai)
#pragma unroll
            for (int m = 0; m < 4; ++m) { const size_t ro = (size_t)(row0 + ai * 128 + m * 16) * 1024 + col0;
#pragma unroll
                for (int bj = 0; bj < 2; ++bj)
#pragma unroll
                    for (int n = 0; n < 2; ++n) { const f32x4 xv = *(const f32x4*)(X + ro + bj * 128 + 4 * n);
                        *(f32x4*)(OUT + ro + bj * 128 + 4 * n) = xv + g[bj][n] * acc[ai][bj][m][n]; } }
    }
};

struct EpiGateUp {
    unsigned char* HID; const float* BGU;
    __device__ __forceinline__ void operator()(AccRef acc, const pg8::Unit& u, int wr, int wc, int fr, int fq) const {
        const int row0 = u.pm * 256 + wr * 64 + fr, hc = u.pn * 128 + wc * 32 + 8 * fq;
        const float* bg = BGU + (size_t)u.e * 2048 + hc;
        f32x4 bgate[2], bup[2];
#pragma unroll
        for (int n = 0; n < 2; ++n) { bgate[n] = *(const f32x4*)(bg + 4 * n); bup[n] = *(const f32x4*)(bg + 1024 + 4 * n); }
#pragma unroll
        for (int ai = 0; ai < 2; ++ai)
#pragma unroll
            for (int m = 0; m < 4; ++m) { float r[8];
#pragma unroll
                for (int n = 0; n < 2; ++n) { const f32x4 gv = acc[ai][0][m][n] * WDESCALE + bgate[n], uv = acc[ai][1][m][n] * WDESCALE + bup[n];
#pragma unroll
                    for (int j = 0; j < 4; ++j) { const float g = __builtin_fminf(gv[j], 7.f); const float up = __builtin_fminf(__builtin_fmaxf(uv[j], -7.f), 7.f);
                        r[4 * n + j] = (up + 1.f) * (g * fast_sigmoid(1.702f * g)); } }
                u32x2 w; w.x = pk4_fp8(r[0], r[1], r[2], r[3]); w.y = pk4_fp8(r[4], r[5], r[6], r[7]);
                ST_NT((u32x2*)(HID + (size_t)(row0 + ai * 128 + m * 16) * 1024 + hc), w); asm volatile("" ::: "memory"); }
    }
};

struct EpiDown {
    float* OUT; bf16_t* Y0; bf16_t* Y1; bf16_t* Y2; const float* BDN; const float* MOD; const int* TOKL; const float* WL;
    __device__ __forceinline__ void operator()(AccRef acc, const pg8::Unit& u, int wr, int wc, int fr, int fq) const {
        const int col0 = u.pn * 256 + wc * 32 + 8 * fq;
        const float* bd = BDN + (size_t)u.e * 1024 + col0;
        f32x4 b4[2][2];
#pragma unroll
        for (int bj = 0; bj < 2; ++bj)
#pragma unroll
            for (int n = 0; n < 2; ++n) b4[bj][n] = *(const f32x4*)(bd + bj * 128 + 4 * n);
        const int* tl = TOKL + (size_t)(u.kk * 32 + u.e) * LISTCAP; const float* wl = WL + (size_t)(u.kk * 32 + u.e) * LISTCAP;
        bf16_t* Yk = Y0 + (size_t)u.kk * (size_t)(Y1 - Y0);
#pragma unroll
        for (int ai = 0; ai < 2; ++ai)
#pragma unroll
            for (int m = 0; m < 4; ++m) { const int slot = u.j0 + ai * 128 + wr * 64 + m * 16 + fr;
                if (slot < u.ne) { const int tok = tl[slot]; const float wgt = wl[slot];
                    const float* ga = MOD + (size_t)(tok >> 11) * 6144 + 5120 + col0; const size_t ro = (size_t)tok * 1024 + col0;
#pragma unroll
                    for (int bj = 0; bj < 2; ++bj) {
                        f32x4 v0 = *(const f32x4*)(ga + bj * 128) * ((acc[ai][bj][m][0] * WDESCALE + b4[bj][0]) * wgt), v1 = *(const f32x4*)(ga + bj * 128 + 4) * ((acc[ai][bj][m][1] * WDESCALE + b4[bj][1]) * wgt);
                        if (u.kk == 3) {
                            const u32x4 p = *(const u32x4*)(Y0 + ro + bj * 128), q = *(const u32x4*)(Y1 + ro + bj * 128), s = *(const u32x4*)(Y2 + ro + bj * 128);
                            v0[0] += bf_lo(p.x) + bf_lo(q.x) + bf_lo(s.x); v0[1] += bf_hi(p.x) + bf_hi(q.x) + bf_hi(s.x); v0[2] += bf_lo(p.y) + bf_lo(q.y) + bf_lo(s.y); v0[3] += bf_hi(p.y) + bf_hi(q.y) + bf_hi(s.y);
                            v1[0] += bf_lo(p.z) + bf_lo(q.z) + bf_lo(s.z); v1[1] += bf_hi(p.z) + bf_hi(q.z) + bf_hi(s.z); v1[2] += bf_lo(p.w) + bf_lo(q.w) + bf_lo(s.w); v1[3] += bf_hi(p.w) + bf_hi(q.w) + bf_hi(s.w);
                            float* op = OUT + ro + bj * 128;
                            *(f32x4*)op = *(const f32x4*)op + v0; *(f32x4*)(op + 4) = *(const f32x4*)(op + 4) + v1; }
                        else { u32x4 w; w.x = cvt_pk_bf16(v0[0], v0[1]); w.y = cvt_pk_bf16(v0[2], v0[3]); w.z = cvt_pk_bf16(v1[0], v1[1]); w.w = cvt_pk_bf16(v1[2], v1[3]); ST_NT((u32x4*)(Yk + ro + bj * 128), w); } } }
                asm volatile("" ::: "memory"); }
    }
};

struct MoeTabs { const LAS int* rbase; const LAS int* tbase; const LAS int* nearr; const LAS int* tilee; };
struct MoeOrderGU {
    const char* A; const char* Bt; const int* lists; int G, c; MoeTabs tb;
    __device__ __forceinline__ bool next(int i, pg8::Unit& u) const {
        const int L = i * G + c, TT = L >> 3; const int total = __builtin_amdgcn_readfirstlane(tb.rbase[4]);
        if (TT >= total) return false;
        int k = 0;
#pragma unroll
        for (int q = 1; q < 4; ++q) k += (TT >= __builtin_amdgcn_readfirstlane(tb.rbase[q])) ? 1 : 0;
        const int T = TT - __builtin_amdgcn_readfirstlane(tb.rbase[k]);
        const int e = __builtin_amdgcn_readfirstlane(tb.tilee[k * MAXTILES + T]);
        u.pm = TT; u.pn = L & 7; u.e = e; u.kk = k; u.j0 = (T - __builtin_amdgcn_readfirstlane(tb.tbase[k * 33 + e])) * 256; u.ne = __builtin_amdgcn_readfirstlane(tb.nearr[k * 32 + e]); return true;
    }
    __device__ __forceinline__ const char* a_base(const pg8::Unit&) const { return A; }
    __device__ __forceinline__ const char* b_base(const pg8::Unit& u) const { return Bt + (size_t)u.e * (size_t)(2048 * 1024) + (size_t)u.pn * (size_t)(256 * 1024); }
    __device__ __forceinline__ unsigned row_of(const pg8::Unit& u, int r) const { const int slot = u.j0 + r; return slot < u.ne ? (unsigned)lists[(size_t)(u.kk * 32 + u.e) * LISTCAP + slot] : 0u; }
};
struct MoeOrderDN {
    const char* A; const char* Bt; int G, c, k0, k1; MoeTabs tb;
    __device__ __forceinline__ bool next(int i, pg8::Unit& u) const {
        const int L = i * G + c; const int r0 = __builtin_amdgcn_readfirstlane(tb.rbase[k0]), r1 = __builtin_amdgcn_readfirstlane(tb.rbase[k1]);
        const int TT = r0 + (L >> 2);
        if (TT >= r1) return false;
        int k = 0;
#pragma unroll
        for (int q = 1; q < 4; ++q) k += (TT >= __builtin_amdgcn_readfirstlane(tb.rbase[q])) ? 1 : 0;
        const int T = TT - __builtin_amdgcn_readfirstlane(tb.rbase[k]);
        const int e = __builtin_amdgcn_readfirstlane(tb.tilee[k * MAXTILES + T]);
        u.pm = TT; u.pn = L & 3; u.e = e; u.kk = k; u.j0 = (T - __builtin_amdgcn_readfirstlane(tb.tbase[k * 33 + e])) * 256; u.ne = __builtin_amdgcn_readfirstlane(tb.nearr[k * 32 + e]); return true;
    }
    __device__ __forceinline__ const char* a_base(const pg8::Unit& u) const { return A + (size_t)u.pm * (size_t)(256 * 1024); }
    __device__ __forceinline__ const char* b_base(const pg8::Unit& u) const { return Bt + (size_t)u.e * (size_t)(1024 * 1024) + (size_t)u.pn * (size_t)(256 * 1024); }
    __device__ __forceinline__ unsigned row_of(const pg8::Unit&, int) const { return 0u; }
};

constexpr int ATT_KBYTES = 12 * 1024;
constexpr int ATT_VPITCH = 136;
constexpr int ATT_VBYTES = 64 * ATT_VPITCH;
constexpr int ATT_BUF = ATT_KBYTES + ATT_VBYTES;
constexpr int ATT_WS = 2 * ATT_BUF;
static_assert(ATT_WS + 8 * 256 + 64 <= RING_BYTES, "attention LDS");

__device__ __forceinline__ void mla_unit(LAS unsigned char* lds, const bf16_t* Q, const bf16_t* Kb, const bf16_t* KV, bf16_t* O, int b, int h, int qb) {
    const int tid = threadIdx.x, lane = tid & 63, r = lane & 31, hh = lane >> 5; const int wid = __builtin_amdgcn_readfirstlane(tid >> 6);
    const size_t rowbase = (size_t)b * SEQ; const int q0 = qb * 256, qw = q0 + 32 * wid;
    const int cq = qw >> 6, NT = (q0 >> 6) + 4;
    LAS float* wsf = (LAS float*)(lds + ATT_WS) + wid * 64;
    bf16x8 qf[6];
    { const bf16_t* qp = Q + (rowbase + qw + r) * 768 + h * 96 + hh * 8;
#pragma unroll
      for (int s = 0; s < 6; ++s) qf[s] = *(const bf16x8*)(qp + 16 * s); }
    const int lkv = tid & 63, lc = tid >> 6;
    const bf16_t* kg0 = Kb + (rowbase + lkv) * 768 + h * 96 + lc * 8;
    const bf16_t* vg = KV + (rowbase + lkv) * 1024 + h * 128 + 64 + lc * 8;
    u32x4 ka0, ka1 = (u32x4){0u, 0u, 0u, 0u}, va;
#define ATT_LOAD(t, K0, K1, V) do { K0 = *(const u32x4*)(kg0 + (size_t)(t) * 64 * 768); if (tid < 256) K1 = *(const u32x4*)(kg0 + (size_t)(t) * 64 * 768 + 64); V = *(const u32x4*)(vg + (size_t)(t) * 64 * 1024); } while (0)
#define ATT_STORE(bufi, K0, K1, V) do { LAS unsigned char* kb_ = lds + (bufi) * ATT_BUF; *(LAS u32x4*)(kb_ + tid * 16) = K0; if (tid < 256) *(LAS u32x4*)(kb_ + 8192 + tid * 16) = K1; \
        LAS unsigned char* vb_ = kb_ + ATT_KBYTES + (lc * 8) * ATT_VPITCH + lkv * 2; \
        _Pragma("unroll") for (int j_ = 0; j_ < 8; ++j_) *(LAS unsigned short*)(vb_ + j_ * ATT_VPITCH) = (unsigned short)(V[j_ >> 1] >> (16 * (j_ & 1))); } while (0)
    ATT_LOAD(0, ka0, ka1, va); ATT_STORE(0, ka0, ka1, va); __syncthreads();
    float mref = 0.f, l_run = 0.f;
    f32x16 o0, o1, negm;
#pragma unroll
    for (int i = 0; i < 16; ++i) { o0[i] = 0.f; o1[i] = 0.f; negm[i] = 0.f; }
#define MLA_ITER(t_, BUFI, K0, K1, V) do { const int t = (t_); \
        if (t + 1 < NT) ATT_LOAD(t + 1, K0, K1, V); \
        if (t <= cq) { \
            const LAS unsigned char* kb = lds + (BUFI) * ATT_BUF; const LAS unsigned char* vb = kb + ATT_KBYTES; \
            f32x16 p0, p1; \
        _Pragma("unroll") \
            for (int s = 0; s < 6; ++s) { const bf16x8 a0 = *(const LAS bf16x8*)(kb + (2 * s + hh) * 1024 + r * 16), a1 = *(const LAS bf16x8*)(kb + (2 * s + hh) * 1024 + (r + 32) * 16); \
                if (s == 0) { p0 = MFMA32(a0, qf[0], negm); p1 = MFMA32(a1, qf[0], negm); } else { p0 = MFMA32(a0, qf[s], p0); p1 = MFMA32(a1, qf[s], p1); } } \
            float d = p0[0]; \
        _Pragma("unroll") \
            for (int i = 0; i < 16; ++i) { d = __builtin_fmaxf(d, p0[i]); d = __builtin_fmaxf(d, p1[i]); } \
            d = __builtin_fmaxf(d, __shfl_xor(d, 32)); \
            if (t == 0) { mref = d; \
        _Pragma("unroll") \
                for (int i = 0; i < 16; ++i) { p0[i] -= d; p1[i] -= d; negm[i] = -d; } \
            } else if (__any(d > 8.f)) { \
                const float delta = __builtin_fmaxf(d, 0.f), alpha = __builtin_amdgcn_exp2f(-delta); mref += delta; l_run *= alpha; \
        _Pragma("unroll") \
                for (int i = 0; i < 16; ++i) { p0[i] -= delta; p1[i] -= delta; negm[i] = -mref; } \
                if (hh == 0) wsf[r] = alpha; \
                LDS_WAIT(); \
        _Pragma("unroll") \
                for (int g = 0; g < 4; ++g) { const f32x4 al = *(const LAS f32x4*)(wsf + 8 * g + 4 * hh); \
        _Pragma("unroll") \
                    for (int e = 0; e < 4; ++e) { o0[4 * g + e] *= al[e]; o1[4 * g + e] *= al[e]; } } \
                LDS_WAIT(); \
            } \
            float rs = 0.f; \
        _Pragma("unroll") \
            for (int i = 0; i < 16; ++i) { p0[i] = __builtin_amdgcn_exp2f(p0[i]); p1[i] = __builtin_amdgcn_exp2f(p1[i]); rs += p0[i] + p1[i]; } \
            l_run += rs; \
        _Pragma("unroll") \
            for (int half = 0; half < 2; ++half) \
        _Pragma("unroll") \
                for (int s2 = 0; s2 < 2; ++s2) { \
                    const f32x16& P = half ? p1 : p0; \
                    const bf16x8 pa = pack8(P[8 * s2], P[8 * s2 + 1], P[8 * s2 + 2], P[8 * s2 + 3], P[8 * s2 + 4], P[8 * s2 + 5], P[8 * s2 + 6], P[8 * s2 + 7]); \
                    const int kvo = (32 * half + 16 * s2 + 4 * hh) * 2; \
                    { const s16x4 lo = *(const LAS s16x4*)(vb + r * ATT_VPITCH + kvo), hi = *(const LAS s16x4*)(vb + r * ATT_VPITCH + kvo + 16); \
                      const bf16x8 vf = __builtin_shufflevector(lo, hi, 0, 1, 2, 3, 4, 5, 6, 7); o0 = MFMA32(pa, vf, o0); } \
                    { const s16x4 lo = *(const LAS s16x4*)(vb + (r + 32) * ATT_VPITCH + kvo), hi = *(const LAS s16x4*)(vb + (r + 32) * ATT_VPITCH + kvo + 16); \
                      const bf16x8 vf = __builtin_shufflevector(lo, hi, 0, 1, 2, 3, 4, 5, 6, 7); o1 = MFMA32(pa, vf, o1); } \
                } \
        } \
        if (t + 1 < NT) ATT_STORE((BUFI) ^ 1, K0, K1, V); \
        __syncthreads(); } while (0)
    for (int t2 = 0; t2 < NT; t2 += 2) {
        MLA_ITER(t2, 0, ka0, ka1, va);
        MLA_ITER(t2 + 1, 1, ka0, ka1, va);
    }
#undef MLA_ITER
    const float l_tot = l_run + __shfl_xor(l_run, 32);
    if (hh == 0) wsf[r] = 1.f / l_tot;
    LDS_WAIT();
#pragma unroll
    for (int g = 0; g < 4; ++g) { const f32x4 rl = *(const LAS f32x4*)(wsf + 8 * g + 4 * hh);
#pragma unroll
        for (int e = 0; e < 4; ++e) { const int i = 4 * g + e; bf16_t* op = O + (rowbase + qw + crow(i, hh)) * 512 + h * 64 + r;
            op[0] = (bf16_t)(cvt_pk_bf16(o0[i] * rl[e], 0.f) & 0xffffu); op[32] = (bf16_t)(cvt_pk_bf16(o1[i] * rl[e], 0.f) & 0xffffu); } }
    LDS_WAIT();
#undef ATT_LOAD
#undef ATT_STORE
}

#ifndef SBTHR
#define SBTHR 136.f
#endif
typedef short v4i16_t __attribute__((ext_vector_type(4)));
__device__ __forceinline__ s16x4 lds_tr16(const LAS unsigned char* p) { return __builtin_bit_cast(s16x4, __builtin_amdgcn_ds_read_tr16_b64_v4i16((LAS v4i16_t*)p)); }
constexpr int SBW_VBYTES = 4096;
constexpr int SBW_KCH = 528;
constexpr int SBW_BYTES = 8 * SBW_KCH + SBW_VBYTES;
static_assert(8 * SBW_BYTES <= RING_BYTES, "per-wave stick-breaking LDS");
__device__ __forceinline__ void sb_wave(LAS unsigned char* wl, const bf16_t* SBQ, bf16_t* O, int b, int h, int qblk) {
    int lane_ = threadIdx.x & 63; asm volatile("" : "+v"(lane_));
    const int lane = lane_, r = lane & 31, hh = lane >> 5;
    const size_t rowbase = (size_t)b * SEQ; const int qw = 32 * qblk;
    constexpr float C2 = 0.125f * LOG2E;
    bf16x8 qf[4];
    { const bf16_t* qp = SBQ + (rowbase + qw + r) * 1536 + h * 64 + hh * 8;
#pragma unroll
      for (int s = 0; s < 4; ++s) qf[s] = *(const bf16x8*)(qp + 16 * s); }
    const int lrow = lane >> 3, lch = lane & 7;
    const bf16_t* kg = SBQ + (rowbase + lrow) * 1536 + 512 + h * 64 + lch * 8;
    const bf16_t* vg = SBQ + (rowbase + lrow) * 1536 + 1024 + h * 64 + lch * 8;
    LAS unsigned char* Kl = wl; LAS unsigned char* Vt = wl + 8 * SBW_KCH;
    u32x4 kr[4], vr[4], kr2[4], vr2[4];
#define SBW_LOAD(kv0_, KR, VR) do { _Pragma("unroll") for (int i_ = 0; i_ < 4; ++i_) { KR[i_] = *(const u32x4*)(kg + (size_t)((kv0_) + 8 * i_) * 1536); VR[i_] = *(const u32x4*)(vg + (size_t)((kv0_) + 8 * i_) * 1536); } } while (0)
    SBW_LOAD(qw, kr, vr); if (qw >= 32) SBW_LOAD(qw - 32, kr2, vr2);
    float carry = 0.f;
    f32x16 o0, o1;
#pragma unroll
    for (int i = 0; i < 16; ++i) { o0[i] = 0.f; o1[i] = 0.f; }
    bool done = false;
#define SBW_STEP(kv_, KR, VR) do { const int kvh0 = (kv_); \
        _Pragma("unroll") \
        for (int i = 0; i < 4; ++i) { *(LAS u32x4*)(Kl + lch * SBW_KCH + (8 * i + lrow) * 16) = KR[i]; \
            *(LAS u32x4*)(Vt + (lch >> 2) * 2048 + (8 * i + lrow) * 64 + (lch & 3) * 16) = VR[i]; } \
        if (kvh0 >= 64) SBW_LOAD(kvh0 - 64, KR, VR); \
        LDS_WAIT(); \
        f32x16 x; \
        _Pragma("unroll") \
        for (int i = 0; i < 16; ++i) x[i] = 0.f; \
        _Pragma("unroll") \
        for (int s = 0; s < 4; ++s) { const bf16x8 a0 = *(const LAS bf16x8*)(Kl + (2 * s + hh) * SBW_KCH + r * 16); x = MFMA32(a0, qf[s], x); } \
        const bool diag = (kvh0 == qw); \
        float sp[16], z[16]; \
        _Pragma("unroll") \
        for (int i = 0; i < 16; ++i) { const float z2 = x[i] * C2; const float lg = __builtin_amdgcn_logf(1.f + __builtin_amdgcn_exp2f(__builtin_fminf(z2, 64.f))); \
            const float s_ = __builtin_fmaxf(lg, z2); \
            sp[i] = (!diag || crow(i, hh) < r) ? s_ : 0.f; z[i] = z2; } \
        float G[4], Gp[4]; \
        _Pragma("unroll") \
        for (int g = 0; g < 4; ++g) { G[g] = (sp[4 * g] + sp[4 * g + 1]) + (sp[4 * g + 2] + sp[4 * g + 3]); \
            const auto rr = __builtin_amdgcn_permlane32_swap(__float_as_uint(G[g]), __float_as_uint(G[g]), false, false); \
            Gp[g] = __uint_as_float(hh ? rr[0] : rr[1]); } \
        float tail[4]; tail[3] = 0.f; tail[2] = G[3] + Gp[3]; tail[1] = tail[2] + (G[2] + Gp[2]); tail[0] = tail[1] + (G[1] + Gp[1]); const float total = tail[0] + (G[0] + Gp[0]); \
        float a[16]; \
        _Pragma("unroll") \
        for (int g = 0; g < 4; ++g) { const float base = carry + tail[g] + (hh == 0 ? Gp[g] : 0.f); \
            const float s3 = base + sp[4 * g + 3], s2_ = s3 + sp[4 * g + 2], s1 = s2_ + sp[4 * g + 1], s0 = s1 + sp[4 * g]; \
            a[4 * g + 3] = __builtin_amdgcn_exp2f(z[4 * g + 3] - s3); a[4 * g + 2] = __builtin_amdgcn_exp2f(z[4 * g + 2] - s2_); a[4 * g + 1] = __builtin_amdgcn_exp2f(z[4 * g + 1] - s1); a[4 * g] = __builtin_amdgcn_exp2f(z[4 * g] - s0); } \
        if (diag) { \
        _Pragma("unroll") \
            for (int i = 0; i < 16; ++i) a[i] = (crow(i, hh) < r) ? a[i] : 0.f; } \
        carry += total; \
        _Pragma("unroll") \
        for (int s2 = 0; s2 < 2; ++s2) { \
            const bf16x8 pa = pack8(a[8 * s2], a[8 * s2 + 1], a[8 * s2 + 2], a[8 * s2 + 3], a[8 * s2 + 4], a[8 * s2 + 5], a[8 * s2 + 6], a[8 * s2 + 7]); \
            const LAS unsigned char* vp = Vt + (16 * s2 + 4 * hh + ((lane & 15) >> 2)) * 64 + 32 * ((lane >> 4) & 1) + 8 * (lane & 3); \
            { const s16x4 lo = lds_tr16(vp), hi = lds_tr16(vp + 8 * 64); \
              const bf16x8 vf = __builtin_shufflevector(lo, hi, 0, 1, 2, 3, 4, 5, 6, 7); o0 = MFMA32(pa, vf, o0); } \
            { const s16x4 lo = lds_tr16(vp + 2048), hi = lds_tr16(vp + 2048 + 8 * 64); \
              const bf16x8 vf = __builtin_shufflevector(lo, hi, 0, 1, 2, 3, 4, 5, 6, 7); o1 = MFMA32(pa, vf, o1); } } \
        asm volatile("" ::: "memory"); \
        done = __all(carry > SBTHR) != 0; } while (0)
    for (int kv = qw; kv >= 0; kv -= 64) {
        SBW_STEP(kv, kr, vr); if (done) break;
        if (kv >= 32) { SBW_STEP(kv - 32, kr2, vr2); if (done) break; }
    }
#undef SBW_STEP
#undef SBW_LOAD
#pragma unroll
    for (int i = 0; i < 16; ++i) { bf16_t* op = O + (rowbase + qw + crow(i, hh)) * 512 + h * 64 + r;
        op[0] = (bf16_t)(cvt_pk_bf16(o0[i], 0.f) & 0xffffu); op[32] = (bf16_t)(cvt_pk_bf16(o1[i], 0.f) & 0xffffu); }
}

__device__ __forceinline__ void sb_unit(LAS unsigned char* lds, const bf16_t* SBQ, bf16_t* O, int b, int h, int qb) {
    const int tid = threadIdx.x, lane = tid & 63, r = lane & 31, hh = lane >> 5; const int wid = __builtin_amdgcn_readfirstlane(tid >> 6);
    const size_t rowbase = (size_t)b * SEQ; const int q0 = qb * 256, qw = q0 + 32 * wid;
    const int NT = (q0 >> 6) + 4;
    constexpr float C2 = 0.125f * LOG2E;
    bf16x8 qf[4];
    { const bf16_t* qp = SBQ + (rowbase + qw + r) * 1536 + h * 64 + hh * 8;
#pragma unroll
      for (int s = 0; s < 4; ++s) qf[s] = *(const bf16x8*)(qp + 16 * s); }
    const int lkv = tid & 63, lc = tid >> 6;
    const bf16_t* kg0 = SBQ + (rowbase + lkv) * 1536 + 512 + h * 64 + lc * 8;
    const bf16_t* vg = SBQ + (rowbase + lkv) * 1536 + 1024 + h * 64 + lc * 8;
    u32x4 ka0, va, kb0, vb2;
#define ATT_LOAD(t, K0, V) do { K0 = *(const u32x4*)(kg0 + (size_t)(t) * 64 * 1536); V = *(const u32x4*)(vg + (size_t)(t) * 64 * 1536); } while (0)
#define ATT_STORE(bufi, K0, V) do { LAS unsigned char* kb_ = lds + (bufi) * ATT_BUF; *(LAS u32x4*)(kb_ + tid * 16) = K0; \
        LAS unsigned char* vb_ = kb_ + ATT_KBYTES + (lc * 8) * ATT_VPITCH + lkv * 2; \
        _Pragma("unroll") for (int j_ = 0; j_ < 8; ++j_) *(LAS unsigned short*)(vb_ + j_ * ATT_VPITCH) = (unsigned short)(V[j_ >> 1] >> (16 * (j_ & 1))); } while (0)
    LAS unsigned* dflag = (LAS unsigned*)(lds + ATT_WS + 8 * 256);
    ATT_LOAD(NT - 1, ka0, va); ATT_STORE(0, ka0, va); __syncthreads();
    ATT_LOAD(NT - 2, kb0, vb2); ATT_LOAD(NT - 3, ka0, va);
    float carry = 0.f; bool wdone = false;
    f32x16 o0, o1;
#pragma unroll
    for (int i = 0; i < 16; ++i) { o0[i] = 0.f; o1[i] = 0.f; }
#define SB_SUB(X, kvh0, kvl) do { const bool diag_ = ((kvh0) == qw); float lk_[16], z_[16]; \
        _Pragma("unroll") for (int i = 0; i < 16; ++i) { const float z2 = X[i] * C2; const float ex = __builtin_amdgcn_exp2f(z2); float sp = __builtin_amdgcn_logf(1.f + ex); sp = z2 > 64.f ? z2 : sp; \
            const bool valid = !diag_ || (crow(i, hh) < r); lk_[i] = valid ? -sp : 0.f; z_[i] = z2; } \
        float G_[4], Gp_[4]; \
        _Pragma("unroll") for (int g = 0; g < 4; ++g) { G_[g] = (lk_[4 * g] + lk_[4 * g + 1]) + (lk_[4 * g + 2] + lk_[4 * g + 3]); Gp_[g] = __shfl_xor(G_[g], 32); } \
        float tail_[4]; tail_[3] = 0.f; tail_[2] = G_[3] + Gp_[3]; tail_[1] = tail_[2] + (G_[2] + Gp_[2]); tail_[0] = tail_[1] + (G_[1] + Gp_[1]); const float total_ = tail_[0] + (G_[0] + Gp_[0]); \
        float a_[16]; \
        _Pragma("unroll") for (int g = 0; g < 4; ++g) { const float base_ = carry + tail_[g] + (hh == 0 ? Gp_[g] : 0.f); \
            const float s3 = base_ + lk_[4 * g + 3], s2_ = s3 + lk_[4 * g + 2], s1 = s2_ + lk_[4 * g + 1], s0 = s1 + lk_[4 * g]; \
            a_[4 * g + 3] = __builtin_amdgcn_exp2f(z_[4 * g + 3] + s3); a_[4 * g + 2] = __builtin_amdgcn_exp2f(z_[4 * g + 2] + s2_); a_[4 * g + 1] = __builtin_amdgcn_exp2f(z_[4 * g + 1] + s1); a_[4 * g] = __builtin_amdgcn_exp2f(z_[4 * g] + s0); } \
        if (diag_) { _Pragma("unroll") for (int i = 0; i < 16; ++i) a_[i] = (crow(i, hh) < r) ? a_[i] : 0.f; } \
        carry += total_; \
        _Pragma("unroll") for (int s2 = 0; s2 < 2; ++s2) { \
            const bf16x8 pa = pack8(a_[8 * s2], a_[8 * s2 + 1], a_[8 * s2 + 2], a_[8 * s2 + 3], a_[8 * s2 + 4], a_[8 * s2 + 5], a_[8 * s2 + 6], a_[8 * s2 + 7]); \
            const int kvo = ((kvl) + 16 * s2 + 4 * hh) * 2; \
            { const s16x4 lo = *(const LAS s16x4*)(vb + r * ATT_VPITCH + kvo), hi = *(const LAS s16x4*)(vb + r * ATT_VPITCH + kvo + 16); \
              const bf16x8 vf = __builtin_shufflevector(lo, hi, 0, 1, 2, 3, 4, 5, 6, 7); o0 = MFMA32(pa, vf, o0); } \
            { const s16x4 lo = *(const LAS s16x4*)(vb + (r + 32) * ATT_VPITCH + kvo), hi = *(const LAS s16x4*)(vb + (r + 32) * ATT_VPITCH + kvo + 16); \
              const bf16x8 vf = __builtin_shufflevector(lo, hi, 0, 1, 2, 3, 4, 5, 6, 7); o1 = MFMA32(pa, vf, o1); } } } while (0)
    bool alldone = false;
#define SB_ITER(it_, BUFI, K0, V) do { const int it = (it_), t = NT - 1 - it, kv0 = 64 * t; \
        if (kv0 <= qw && !wdone) { \
            const LAS unsigned char* kb = lds + (BUFI) * ATT_BUF; const LAS unsigned char* vb = kb + ATT_KBYTES; \
            const bool upper = (kv0 + 32 <= qw); \
            f32x16 p0, p1; \
        _Pragma("unroll") \
            for (int i = 0; i < 16; ++i) { p0[i] = 0.f; p1[i] = 0.f; } \
        _Pragma("unroll") \
            for (int s = 0; s < 4; ++s) { const bf16x8 a0 = *(const LAS bf16x8*)(kb + (2 * s + hh) * 1024 + r * 16); p0 = MFMA32(a0, qf[s], p0); } \
            if (upper) { \
        _Pragma("unroll") \
                for (int s = 0; s < 4; ++s) { const bf16x8 a1 = *(const LAS bf16x8*)(kb + (2 * s + hh) * 1024 + (r + 32) * 16); p1 = MFMA32(a1, qf[s], p1); } \
                SB_SUB(p1, kv0 + 32, 32); \
            } \
            SB_SUB(p0, kv0, 0); \
            wdone = __all(carry < -170.f) != 0; \
        } \
        if (lane == 0) dflag[(BUFI) * 8 + wid] = wdone ? 1u : 0u; \
        if (t > 0) ATT_STORE((BUFI) ^ 1, K0, V); \
        if (t > 2) ATT_LOAD(t - 3, K0, V); \
        __syncthreads(); \
        { const u32x4 f0 = *(const LAS u32x4*)(dflag + (BUFI) * 8), f1 = *(const LAS u32x4*)(dflag + (BUFI) * 8 + 4); \
          alldone = (f0.x & f0.y & f0.z & f0.w & f1.x & f1.y & f1.z & f1.w) != 0u; } } while (0)
    for (int i2 = 0; i2 < NT; i2 += 2) {
        SB_ITER(i2, 0, kb0, vb2); if (alldone) break;
        SB_ITER(i2 + 1, 1, ka0, va); if (alldone) break;
    }
#undef SB_ITER
    __syncthreads();
#pragma unroll
    for (int i = 0; i < 16; ++i) { bf16_t* op = O + (rowbase + qw + crow(i, hh)) * 512 + h * 64 + r;
        op[0] = (bf16_t)(cvt_pk_bf16(o0[i], 0.f) & 0xffffu); op[32] = (bf16_t)(cvt_pk_bf16(o1[i], 0.f) & 0xffffu); }
#undef SB_SUB
#undef ATT_LOAD
#undef ATT_STORE
}

#ifndef PHMASK
#define PHMASK 0xFFFF
#endif
#define PH(n) ((PHMASK >> (n)) & 1)
#ifndef STG_P2
#define STG_P2 0
#endif
#ifndef STG_GU
#define STG_GU 0
#endif
#ifndef DUPMASK
#define DUPMASK 0
#endif
#define DUP(n) (1 + ((DUPMASK >> (n)) & 1))
struct Args { const void* in[23]; float* out; unsigned char* ws; };

__global__ void __launch_bounds__(512, 2) fwd_kernel(Args args) {
    extern __shared__ __attribute__((aligned(16))) unsigned char lds_raw[];
    LAS unsigned char* lds = (LAS unsigned char*)lds_raw;
    const int tid = threadIdx.x, lane = tid & 63, wave = __builtin_amdgcn_readfirstlane(tid >> 6);
    const int G = gridDim.x; const int bx = blockIdx.x; const int vcu = (G % 8 == 0) ? (bx % 8) * (G / 8) + bx / 8 : bx;
    const int gw = vcu * 8 + wave, NGW = G * 8;
    unsigned char* ws = args.ws;
    unsigned* ctl = (unsigned*)(ws + WS_CTL);
    const float* x = (const float*)args.in[0]; const float* cvec = (const float*)args.in[1]; const int* positions = (const int*)args.in[2];
    const float* w_ada = (const float*)args.in[3]; const float* b_ada = (const float*)args.in[4]; const float* g_norm1 = (const float*)args.in[5];
    const float* w_in = (const float*)args.in[6]; const float* g_q_lat = (const float*)args.in[7]; const float* w_uq = (const float*)args.in[8];
    const float* g_kv_lat = (const float*)args.in[9]; const float* w_ukv = (const float*)args.in[10]; const float* g_qk_q = (const float*)args.in[11];
    const float* g_qk_k = (const float*)args.in[12]; const float* w_o_mla = (const float*)args.in[13]; const float* w_o_sb = (const float*)args.in[14];
    const float* w_out = (const float*)args.in[15]; const float* g_norm2 = (const float*)args.in[16]; const float* w_router = (const float*)args.in[17];
    const float* b_router = (const float*)args.in[18]; const float* w_gate_up = (const float*)args.in[19]; const float* b_gate_up = (const float*)args.in[20];
    const float* w_down = (const float*)args.in[21]; const float* b_down = (const float*)args.in[22];
    float* out = args.out;
    bf16_t* WIN = (bf16_t*)(ws + WS_WIN); bf16_t* WUQ = (bf16_t*)(ws + WS_WUQ); bf16_t* WUKV = (bf16_t*)(ws + WS_WUKV); bf16_t* WOM = (bf16_t*)(ws + WS_WOM);
    bf16_t* WOS = (bf16_t*)(ws + WS_WOS); bf16_t* WOUT = (bf16_t*)(ws + WS_WOUT); float* MOD = (float*)(ws + WS_MOD);
    float* ROWSS = (float*)(ws + WS_ROWSS); unsigned char* WIN8 = ws + WS_WIN8; unsigned char* H8 = ws + WS_H8; unsigned char* M8 = ws + WS_M8; unsigned char* WOUT8 = ws + WS_WOUT;
    bf16_t* HB = (bf16_t*)(ws + WS_H); bf16_t* KVRAW = (bf16_t*)(ws + WS_KVRAW); bf16_t* MERGED = (bf16_t*)(ws + WS_MERGED);
    bf16_t* SGA = (bf16_t*)(ws + WS_SGA); bf16_t* SGB = (bf16_t*)(ws + WS_SGB); unsigned char* H2 = ws + WS_H2;
    unsigned char* WGU = ws + WS_WGU; unsigned char* WDN = ws + WS_WDN; bf16_t* SBQ = (bf16_t*)(ws + WS_SB);
    int* TOKL = (int*)(ws + WS_TOKL); float* WLST = (float*)(ws + WS_WL); unsigned char* HID = ws + WS_HID;
    bf16_t* QL = (bf16_t*)(ws + WS_QL); bf16_t* KVL = (bf16_t*)(ws + WS_KVL); bf16_t* KPE = (bf16_t*)(ws + WS_KPE);
    bf16_t* QB = (bf16_t*)(ws + WS_Q); bf16_t* KB = (bf16_t*)(ws + WS_K); bf16_t* OMLA = (bf16_t*)(ws + WS_OMLA); bf16_t* OSB = (bf16_t*)(ws + WS_OSB);

    for (int u = tid; u < (LDS_BYTES - LDSCTL_OFF) / 4; u += 512) ((LAS unsigned*)(lds + LDSCTL_OFF))[u] = 0u;
    __syncthreads();
    XcdBarrier bar = xcd_barrier_post(ctl + CW_BAR, (volatile LAS unsigned*)(lds + LDSCTL_OFF + LC_BARST));
    LAS float* scr = (LAS float*)(lds + wave * 16384);

#if PH(0)
    {
        constexpr int I_IN = 16 * 133, I_UQ = 6 * 24, I_UKV = 4 * 32, I_OM = 8 * 32, I_OS = 8 * 32, I_OUT = 16 * 32;
        constexpr int NIT = I_IN + I_UQ + I_UKV + I_OM + I_OS + I_OUT;
        for (int it = gw; it < NIT; it += NGW) {
            int q = it;
            if (q < I_IN) { const int kb = q / 133, nb = q % 133, n0 = 32 * nb;
                if (nb < 69) transpose_item(w_in, 1024, DIN, WIN, 64 * kb, n0, n0 < 672 ? n0 : n0 + 96, scr, lane);
                else transpose_item_f8(w_in, 1024, DIN, WIN8, 64 * kb, n0, n0 - 2208, WSCALE, scr, lane);
                continue; } q -= I_IN;
            if (q < I_UQ) { const int kb = q / 24, nb = q % 24; transpose_item(w_uq, 384, 768, WUQ, 64 * kb, 32 * nb, 32 * nb, scr, lane, g_q_lat); continue; } q -= I_UQ;
            if (q < I_UKV) { const int kb = q / 32, nb = q % 32; transpose_item(w_ukv, 256, 1024, WUKV, 64 * kb, 32 * nb, 32 * nb, scr, lane, g_kv_lat); continue; } q -= I_UKV;
            if (q < I_OM) { const int kb = q / 32, nb = q % 32; transpose_item(w_o_mla, 512, 1024, WOM, 64 * kb, 32 * nb, 32 * nb, scr, lane); continue; } q -= I_OM;
            if (q < I_OS) { const int kb = q / 32, nb = q % 32; transpose_item(w_o_sb, 512, 1024, WOS, 64 * kb, 32 * nb, 32 * nb, scr, lane); continue; } q -= I_OS;
            { const int kb = q / 32, nb = q % 32; transpose_item_f8(w_out, 1024, 1024, WOUT8, 64 * kb, 32 * nb, 32 * nb, WSCALE, scr, lane); }
        }
        for (int i = vcu * 512 + tid; i < NTOK * 2 / 4; i += G * 512) ((f32x4*)ROWSS)[i] = (f32x4){0.f, 0.f, 0.f, 0.f};
        for (int i = vcu * 512 + tid; i < 96 * 1024 * 2 / 16; i += G * 512) ((u32x4*)(WIN + 672 * 1024))[i] = (u32x4){0u, 0u, 0u, 0u};
        __syncthreads();
        for (int it = vcu; it < 6144 / 64; it += G) {
            for (int idx = lane; idx < 32 * 128; idx += 64) { const int b = idx >> 7, kk = idx & 127; const float cv = cvec[b * 1024 + 128 * wave + kk]; scr[idx] = cv / (1.f + __expf(-cv)); }
            LDS_WAIT(); asm volatile("" ::: "memory");
            float acc[32];
#pragma unroll
            for (int b = 0; b < 32; ++b) acc[b] = 0.f;
            const float* wp = w_ada + (size_t)(128 * wave) * 6144 + 64 * it + lane;
            float wc[8];
#pragma unroll
            for (int j = 0; j < 8; ++j) wc[j] = wp[(size_t)j * 6144];
#pragma nounroll
            for (int k8 = 0; k8 < 16; ++k8) {
                float wn[8];
                const int kn = k8 < 15 ? k8 + 1 : k8;
#pragma unroll
                for (int j = 0; j < 8; ++j) wn[j] = wp[(size_t)(8 * kn + j) * 6144];
#pragma unroll
                for (int j4 = 0; j4 < 2; ++j4) {
#pragma unroll
                    for (int b = 0; b < 32; ++b) { const f32x4 s = *(const LAS f32x4*)(scr + b * 128 + 8 * k8 + 4 * j4); acc[b] += s.x * wc[4 * j4] + s.y * wc[4 * j4 + 1] + s.z * wc[4 * j4 + 2] + s.w * wc[4 * j4 + 3];
                        if ((b & 7) == 7) asm volatile("" ::: "memory"); } }
#pragma unroll
                for (int j = 0; j < 8; ++j) wc[j] = wn[j];
            }
            LDS_WAIT(); asm volatile("" ::: "memory");
#pragma unroll
            for (int b = 0; b < 32; ++b) scr[b * 64 + lane] = acc[b];
            __syncthreads();
#pragma unroll
            for (int bb = 0; bb < 4; ++bb) { const int b = 4 * wave + bb; float s = 0.f;
#pragma unroll
                for (int w2 = 0; w2 < 8; ++w2) s += ((const LAS float*)(lds + w2 * 16384))[b * 64 + lane];
                MOD[b * 6144 + 64 * it + lane] = s + b_ada[64 * it + lane]; }
            __syncthreads();
        }
    }
#endif
    xcd_barrier(bar);

#if PH(1)
    for (int gi = gw; gi < NTOK / 4; gi += NGW) {
        f32x4 v[4][4];
#pragma unroll
        for (int rr = 0; rr < 4; ++rr) { const f32x4* xr = (const f32x4*)(x + (size_t)(4 * gi + rr) * 1024) + lane;
#pragma unroll
            for (int j = 0; j < 4; ++j) v[rr][j] = xr[64 * j]; }
        const int b = (4 * gi) >> 11;
        const float* mb = MOD + (size_t)b * 6144;
        f32x4 gsc[4], shv[4];
#pragma unroll
        for (int j = 0; j < 4; ++j) { const int col = 4 * lane + 256 * j; gsc[j] = *(const f32x4*)(g_norm1 + col) * (*(const f32x4*)(mb + 1024 + col) + 1.f); shv[j] = *(const f32x4*)(mb + col); }
#pragma unroll
        for (int rr = 0; rr < 4; ++rr) { float ss = 0.f;
#pragma unroll
            for (int j = 0; j < 4; ++j) ss += (v[rr][j].x * v[rr][j].x + v[rr][j].y * v[rr][j].y) + (v[rr][j].z * v[rr][j].z + v[rr][j].w * v[rr][j].w);
            const float rstd = rsqrtf(wave_sum(ss) * (1.f / 1024.f) + EPS);
#pragma unroll
            for (int j = 0; j < 4; ++j) { const int col = 4 * lane + 256 * j; const f32x4 y = (v[rr][j] * rstd) * gsc[j] + shv[j];
                u32x2 o; o.x = cvt_pk_bf16(y.x, y.y); o.y = cvt_pk_bf16(y.z, y.w);
                *(u32x2*)(HB + (size_t)(4 * gi + rr) * 1024 + col) = o;
                *(unsigned*)(H8 + (size_t)(4 * gi + rr) * 1024 + col) = pk4_fp8(y.x, y.y, y.z, y.w); } }
    }
#endif
    xcd_barrier(bar);

#if PH(2)
    { pg8::DenseOrder S; S.init(HB, WIN, NTOK, 2304, 1024, G, bx);
      EpiProj E{QL, KVL, KPE, SBQ, SGA, SGB, 0, 1.f, ROWSS};
      pg8::gemm_phase<false>(lds, 1024, S, E, STG_P2); }
    { pg8::DenseOrder S; S.init(H8, WIN8, NTOK, 2048, 512, G, bx);
      EpiProj E{QL, KVL, KPE, SBQ, SGA, SGB, 2304, WDESCALE, ROWSS};
      pg8::gemm_phase_f8<false>(lds, 512, S, E); }
#endif
    xcd_barrier(bar);

#if PH(4)
    for (int rep = 0; rep < DUP(5); ++rep) {
    { pg8::DenseOrder S; S.init(QL, WUQ, NTOK, 768, 384, G, bx); EpiStore E{QB, 768, ROWSS, 1.f / 384.f}; pg8::gemm_phase<false>(lds, 384, S, E); }
    { pg8::DenseOrder S; S.init(KVL, WUKV, NTOK, 1024, 256, G, bx); EpiStore E{KVRAW, 1024, ROWSS + 1, 1.f / 256.f}; pg8::gemm_phase<false>(lds, 256, S, E); } }
#endif
    xcd_barrier(bar);

#if PH(5)
    {
        const int hd = lane >> 3, sub = lane & 7;
        const float QSC = 0.10206207261596575f * LOG2E;
        const float if0 = exp2f(-(float)(2 * sub) * (13.287712379549449f / 16.f)), if1 = exp2f(-(float)(2 * sub + 1) * (13.287712379549449f / 16.f));
        f32x4 gq0 = *(const f32x4*)(g_qk_q + sub * 8), gq1 = *(const f32x4*)(g_qk_q + sub * 8 + 4); const f32x2 gqa = *(const f32x2*)(g_qk_q + 64 + 2 * sub), gqb = *(const f32x2*)(g_qk_q + 80 + 2 * sub);
        f32x4 gk0 = *(const f32x4*)(g_qk_k + sub * 8), gk1 = *(const f32x4*)(g_qk_k + sub * 8 + 4); const f32x2 gka = *(const f32x2*)(g_qk_k + 64 + 2 * sub), gkb = *(const f32x2*)(g_qk_k + 80 + 2 * sub);
        for (int gi = gw; gi < NTOK / 4; gi += NGW) {
            u32x4 A[4][2]; unsigned B1[4][2], B2[4][2]; float posf[4];
#pragma unroll
            for (int t = 0; t < 4; ++t) { const int m = 4 * gi + t; posf[t] = (float)positions[m];
                const bf16_t* qp = QB + (size_t)m * 768 + hd * 96; A[t][0] = *(const u32x4*)(qp + sub * 8); B1[t][0] = *(const unsigned*)(qp + 64 + 2 * sub); B2[t][0] = *(const unsigned*)(qp + 80 + 2 * sub);
                A[t][1] = *(const u32x4*)(KVRAW + (size_t)m * 1024 + hd * 128 + sub * 8); B1[t][1] = *(const unsigned*)(KPE + (size_t)m * 32 + 2 * sub); B2[t][1] = *(const unsigned*)(KPE + (size_t)m * 32 + 16 + 2 * sub); }
#pragma unroll
            for (int t = 0; t < 4; ++t) { const int m = 4 * gi + t;
                float cs[2], sn[2];
                { const float a0 = posf[t] * if0, a1 = posf[t] * if1;
                  double r0 = (double)a0 * 0.15915494309189535, r1 = (double)a1 * 0.15915494309189535; r0 -= __builtin_rint(r0); r1 -= __builtin_rint(r1);
                  cs[0] = __builtin_amdgcn_cosf((float)r0); sn[0] = __builtin_amdgcn_sinf((float)r0); cs[1] = __builtin_amdgcn_cosf((float)r1); sn[1] = __builtin_amdgcn_sinf((float)r1); }
#pragma unroll
                for (int which = 0; which < 2; ++which) {
                    const u32x4 Av = A[t][which]; const unsigned b1 = B1[t][which], b2 = B2[t][which];
                    bf16_t* dst = which ? KB + (size_t)m * 768 + hd * 96 : QB + (size_t)m * 768 + hd * 96;
                    float f[8] = {bf_lo(Av.x), bf_hi(Av.x), bf_lo(Av.y), bf_hi(Av.y), bf_lo(Av.z), bf_hi(Av.z), bf_lo(Av.w), bf_hi(Av.w)};
                    float x1[2] = {bf_lo(b1), bf_hi(b1)}, x2[2] = {bf_lo(b2), bf_hi(b2)};
                    float ss = x1[0] * x1[0] + x1[1] * x1[1] + x2[0] * x2[0] + x2[1] * x2[1];
#pragma unroll
                    for (int j = 0; j < 8; ++j) ss += f[j] * f[j];
                    ss += __shfl_xor(ss, 1); ss += __shfl_xor(ss, 2); ss += __shfl_xor(ss, 4);
                    const float rstd = rsqrtf(ss * (1.f / 96.f) + EPS);
                    const f32x4 g0 = which ? gk0 : gq0, g1 = which ? gk1 : gq1; const f32x2 ga = which ? gka : gqa, gb = which ? gkb : gqb;
                    const float sc = which ? 1.f : QSC;
                    float y[8] = {f[0] * rstd * g0.x, f[1] * rstd * g0.y, f[2] * rstd * g0.z, f[3] * rstd * g0.w, f[4] * rstd * g1.x, f[5] * rstd * g1.y, f[6] * rstd * g1.z, f[7] * rstd * g1.w};
                    const float y1a = x1[0] * rstd * ga.x, y1b = x1[1] * rstd * ga.y, y2a = x2[0] * rstd * gb.x, y2b = x2[1] * rstd * gb.y;
                    const float o1a = y1a * cs[0] - y2a * sn[0], o1b = y1b * cs[1] - y2b * sn[1], o2a = y2a * cs[0] + y1a * sn[0], o2b = y2b * cs[1] + y1b * sn[1];
                    u32x4 o; o.x = cvt_pk_bf16(y[0] * sc, y[1] * sc); o.y = cvt_pk_bf16(y[2] * sc, y[3] * sc); o.z = cvt_pk_bf16(y[4] * sc, y[5] * sc); o.w = cvt_pk_bf16(y[6] * sc, y[7] * sc);
                    *(u32x4*)(dst + sub * 8) = o; *(unsigned*)(dst + 64 + 2 * sub) = cvt_pk_bf16(o1a * sc, o1b * sc); *(unsigned*)(dst + 80 + 2 * sub) = cvt_pk_bf16(o2a * sc, o2b * sc);
                }
            }
        }
    }
#endif
    xcd_barrier(bar);

#if PH(6)
    for (int bh = vcu; bh < NB * NH; bh += G) {
        for (int rep = 0; rep < DUP(0); ++rep) for (int qb = 0; qb < 8; ++qb) mla_unit(lds, QB, KB, KVRAW, OMLA, bh >> 3, bh & 7, qb);
        __syncthreads();
        for (int rep = 0; rep < DUP(1); ++rep) for (int qi = 0; qi < 8; ++qi) sb_wave(lds + wave * SBW_BYTES, SBQ, OSB, bh >> 3, bh & 7, 8 * qi + wave);
        __syncthreads();
    }
#endif
    xcd_barrier(bar);

#if PH(8)
    for (int rep = 0; rep < DUP(6); ++rep) {
    { pg8::DenseOrder S; S.init(OMLA, WOM, NTOK, 1024, 512, G, bx); EpiMerge<false> E{MERGED, SGA, M8}; pg8::gemm_phase<false>(lds, 512, S, E); }
    { pg8::DenseOrder S; S.init(OSB, WOS, NTOK, 1024, 512, G, bx); EpiMerge<true> E{MERGED, SGB, M8}; pg8::gemm_phase<false>(lds, 512, S, E); } }
#endif
    xcd_barrier(bar);

#if PH(9)
    { pg8::DenseOrder S; S.init(M8, WOUT8, NTOK, 1024, 512, G, bx); EpiWout E{x, out, MOD, WDESCALE}; pg8::gemm_phase_f8<false>(lds, 512, S, E); }
#endif
    xcd_barrier(bar);

#if PH(10)
    {
        constexpr int I_GU = 16 * 64, I_DN = 16 * 32;
        for (int rep = 0; rep < DUP(2); ++rep) for (int it = gw; it < NE * (I_GU + I_DN); it += NGW) {
            if (it < NE * I_GU) { const int e = it / I_GU, q = it % I_GU, kb = q / 64, nb = q % 64, n0 = 32 * nb; const int g = n0 >> 10, jj = n0 & 1023;
                transpose_item_f8(w_gate_up + (size_t)e * 1024 * 2048, 1024, 2048, WGU + (size_t)e * 2048 * 1024, 64 * kb, n0, 256 * (jj >> 7) + 128 * g + (jj & 127), WSCALE, scr, lane); }
            else { const int r2 = it - NE * I_GU, e = r2 / I_DN, q = r2 % I_DN, kb = q / 32, nb = q % 32;
                transpose_item_f8(w_down + (size_t)e * 1024 * 1024, 1024, 1024, WDN + (size_t)e * 1024 * 1024, 64 * kb, 32 * nb, 32 * nb, WSCALE, scr, lane); }
        }
        __syncthreads();
        {
            const int r = lane & 31, hh = lane >> 5;
            constexpr int TP = 1026;
            LAS float* tile = (LAS float*)lds;
            float areg[64];
#pragma unroll
            for (int mm = 0; mm < 64; ++mm) areg[mm] = w_router[(size_t)(128 * wave + 4 * (mm >> 1) + 2 * hh + (mm & 1)) * 32 + r];
            const float br = b_router[r];
            for (int tt = vcu; tt < NTOK / 32; tt += G) {
                { f32x4 v[4][4];
#pragma unroll
                  for (int rr = 0; rr < 4; ++rr) { const f32x4* xr = (const f32x4*)(out + (size_t)(32 * tt + 4 * wave + rr) * 1024) + lane;
#pragma unroll
                      for (int j = 0; j < 4; ++j) v[rr][j] = xr[64 * j]; }
                  const float* mb = MOD + (size_t)((32 * tt) >> 11) * 6144;
                  f32x4 gsc[4], shv[4];
#pragma unroll
                  for (int j = 0; j < 4; ++j) { const int col = 4 * lane + 256 * j; gsc[j] = *(const f32x4*)(g_norm2 + col) * (*(const f32x4*)(mb + 4096 + col) + 1.f); shv[j] = *(const f32x4*)(mb + 3072 + col); }
#pragma unroll
                  for (int rr = 0; rr < 4; ++rr) { float ss = 0.f; const int row = 4 * wave + rr;
#pragma unroll
                      for (int j = 0; j < 4; ++j) ss += (v[rr][j].x * v[rr][j].x + v[rr][j].y * v[rr][j].y) + (v[rr][j].z * v[rr][j].z + v[rr][j].w * v[rr][j].w);
                      const float rstd = rsqrtf(wave_sum(ss) * (1.f / 1024.f) + EPS);
#pragma unroll
                      for (int j = 0; j < 4; ++j) { const int col = 4 * lane + 256 * j; const f32x4 y = (v[rr][j] * rstd) * gsc[j] + shv[j];
                          *(unsigned*)(H2 + (size_t)(32 * tt + row) * 1024 + col) = pk4_fp8(y.x, y.y, y.z, y.w);
                          *(LAS f32x2*)(tile + row * TP + col) = (f32x2){y.x, y.y}; *(LAS f32x2*)(tile + row * TP + col + 2) = (f32x2){y.z, y.w}; } } }
                __syncthreads();
                f32x16 acc;
#pragma unroll
                for (int i = 0; i < 16; ++i) acc[i] = 0.f;
#pragma unroll
                for (int sg = 0; sg < 32; ++sg) { const f32x2 hv = *(const LAS f32x2*)(tile + r * TP + 128 * wave + 4 * sg + 2 * hh);
                    acc = __builtin_amdgcn_mfma_f32_32x32x2f32(areg[2 * sg], hv.x, acc, 0, 0, 0); acc = __builtin_amdgcn_mfma_f32_32x32x2f32(areg[2 * sg + 1], hv.y, acc, 0, 0, 0); }
                __syncthreads();
#pragma unroll
                for (int i = 0; i < 16; ++i) tile[wave * 1024 + i * 64 + lane] = acc[i];
                __syncthreads();
                { const int e = r, he = (e >> 2) & 1, ie = (e & 3) + 4 * (e >> 3);
#pragma unroll
                  for (int rr = 0; rr < 4; ++rr) { const int row = 4 * wave + rr; float v = br;
#pragma unroll
                      for (int w2 = 0; w2 < 8; ++w2) v += tile[w2 * 1024 + ie * 64 + row + 32 * he];
                      float tv[4]; int te[4];
#pragma unroll
                      for (int k = 0; k < 4; ++k) { float bv = v; int bi = e;
#pragma unroll
                          for (int off = 16; off >= 1; off >>= 1) { const float ov = __shfl_xor(bv, off); const int oi = __shfl_xor(bi, off); if (ov > bv || (ov == bv && oi < bi)) { bv = ov; bi = oi; } }
                          tv[k] = bv; te[k] = bi; if (e == bi) v = -INFINITY; }
                      const float e1 = __expf(tv[1] - tv[0]), e2 = __expf(tv[2] - tv[0]), e3 = __expf(tv[3] - tv[0]); const float inv = 1.f / (1.f + e1 + e2 + e3);
                      if (lane < 4) { const int k = lane; const int ek = k == 0 ? te[0] : k == 1 ? te[1] : k == 2 ? te[2] : te[3]; const float wk = (k == 0 ? 1.f : k == 1 ? e1 : k == 2 ? e2 : e3) * inv;
                          const unsigned slot = atomicAdd(ctl + CW_CNT + (k * 32 + ek) * 16, 1u);
                          TOKL[(size_t)(k * 32 + ek) * LISTCAP + slot] = 32 * tt + row; WLST[(size_t)(k * 32 + ek) * LISTCAP + slot] = wk; } } }
                __syncthreads();
            }
        }
    }
#endif
    xcd_barrier(bar);

#if PH(11)
    {
        LAS int* rbase = (LAS int*)(lds + LDSCTL_OFF + LC_RBASE); LAS int* tbase = (LAS int*)(lds + LDSCTL_OFF + LC_TBASE); LAS int* nearr = (LAS int*)(lds + LDSCTL_OFF + LC_NE); LAS int* tilee = (LAS int*)(lds + LDSCTL_OFF + LC_TILEE);
        { int tid = threadIdx.x; asm volatile("" : "+v"(tid));
          if (tid < 4 * NE) nearr[tid] = (int)ctl[CW_CNT + tid * 16];
          __syncthreads();
          if (tid < 4) { int a = 0;
#pragma nounroll
              for (int e = 0; e < NE; ++e) { tbase[tid * 33 + e] = a; a += (nearr[tid * 32 + e] + 255) >> 8; } tbase[tid * 33 + NE] = a; }
          __syncthreads();
          if (tid == 0) { int a = 0;
#pragma nounroll
              for (int k = 0; k < 4; ++k) { rbase[k] = a; a += tbase[k * 33 + NE]; } rbase[4] = a; }
          for (int q = tid; q < 4 * MAXTILES; q += 512) { const int k = q / MAXTILES, T = q % MAXTILES;
              if (T < tbase[k * 33 + NE]) { int e = 0;
#pragma nounroll
                  while (e < NE - 1 && tbase[k * 33 + e + 1] <= T) ++e;
                  tilee[k * MAXTILES + T] = e; } }
          __syncthreads(); }
        const MoeTabs tb{rbase, tbase, nearr, tilee};
        { MoeOrderGU S{(const char*)H2, (const char*)WGU, TOKL, G, vcu, tb};
          EpiGateUp E{HID, b_gate_up};
          pg8::gemm_phase_f8<true>(lds, 512, S, E, STG_GU);
#ifdef GU_DUP
          pg8::gemm_phase_f8<true>(lds, 512, S, E, 0);
#endif
#ifdef GU_NULL
          { EpiNull EN; pg8::gemm_phase_f8<true>(lds, 512, S, EN, 0); }
#endif
        }
        xcd_barrier(bar);
        bf16_t* Y0 = MERGED; bf16_t* Y1 = (bf16_t*)(ws + WS_SGA); bf16_t* Y2 = (bf16_t*)(ws + WS_SGB);
        for (int ph = 0; ph < 2; ++ph) {
            { MoeOrderDN S{(const char*)HID, (const char*)WDN, G, vcu, ph == 0 ? 0 : 3, ph == 0 ? 3 : 4, tb};
              EpiDown E{out, Y0, Y1, Y2, b_down, MOD, TOKL, WLST};
              pg8::gemm_phase_f8<false>(lds, 512, S, E); }
            if (ph == 0) xcd_barrier(bar);
        }
    }
#endif
}

extern "C" void kernel_launch(void* const* d_in, const int* in_sizes, int n_in, void* d_out, int out_size, void* d_ws, size_t ws_size, hipStream_t stream) {
    static int grid = 0;
    if (grid == 0) {
        if (n_in != 23 || in_sizes[0] != NTOK * DM || out_size != NTOK * DM || ws_size < WS_END) { fprintf(stderr, "kernel_launch: unexpected shapes (n_in %d, in0 %d, out %d, ws %zu); nothing launched\n", n_in, n_in > 0 ? in_sizes[0] : -1, out_size, ws_size); grid = -1; return; }
        int dev = 0, cus = 0, per_cu = 0;
        if (hipGetDevice(&dev) != hipSuccess || hipDeviceGetAttribute(&cus, hipDeviceAttributeMultiprocessorCount, dev) != hipSuccess) { grid = -1; return; }
        if (hipFuncSetAttribute((const void*)fwd_kernel, hipFuncAttributeMaxDynamicSharedMemorySize, LDS_BYTES) != hipSuccess) { fprintf(stderr, "kernel_launch: hipFuncSetAttribute failed\n"); grid = -1; return; }
        if (hipOccupancyMaxActiveBlocksPerMultiprocessor(&per_cu, (const void*)fwd_kernel, 512, LDS_BYTES) != hipSuccess || per_cu < 1) fprintf(stderr, "kernel_launch: occupancy query reports %d\n", per_cu);
        (void)hipGetLastError();
        grid = cus;
    }
    if (grid < 0) return;
    if (hipMemsetAsync((char*)d_ws + WS_CTL, 0, CTL_ZERO_BYTES, stream) != hipSuccess) return;
    Args a{};
    for (int i = 0; i < 23; ++i) a.in[i] = d_in[i];
    a.out = (float*)d_out; a.ws = (unsigned char*)d_ws;
    hipLaunchKernelGGL(fwd_kernel, dim3(grid), dim3(512), LDS_BYTES, stream, a);
}
```

```cpp
#include <hip/hip_runtime.h>
#include <cstdio>
#include <cstdint>

#define LAS __attribute__((address_space(3)))
#define GAS __attribute__((address_space(1)))
typedef unsigned short bf16_t;
typedef short bf16x8 __attribute__((ext_vector_type(8)));
typedef short s16x4 __attribute__((ext_vector_type(4)));
typedef float f32x2 __attribute__((ext_vector_type(2)));
typedef float f32x4 __attribute__((ext_vector_type(4)));
typedef float f32x16 __attribute__((ext_vector_type(16)));
typedef unsigned u32x2 __attribute__((ext_vector_type(2)));
typedef unsigned u32x4 __attribute__((ext_vector_type(4)));
typedef int v8i __attribute__((ext_vector_type(8)));
typedef unsigned u32x8 __attribute__((ext_vector_type(8)));

constexpr int NB = 32, SEQ = 2048, DM = 1024, NTOK = NB * SEQ;
constexpr int QLORA = 384, KVLORA = 256, ROPE = 32, NOPE = 64, VD = 64, QKD = 96, NH = 8;
constexpr int SBD = 64;
constexpr int NE = 32, TOPK = 4, DE = 1024;
constexpr int DIN = 4256, DINP = 4352;
constexpr float EPS = 1e-6f;
constexpr float LOG2E = 1.4426950408889634f;
constexpr int LISTCAP = NTOK;
constexpr int MAXTILES = NTOK / 256 + NE;

constexpr size_t MiB = 1u << 20;
constexpr size_t WS_CTL = 0, CTL_ZERO_BYTES = 1 * MiB;
constexpr size_t WS_WIN = 1 * MiB;
constexpr size_t WS_WUQ = 10 * MiB;
constexpr size_t WS_WUKV = 11 * MiB;
constexpr size_t WS_WOM = 12 * MiB;
constexpr size_t WS_WOS = 13 * MiB;
constexpr size_t WS_WOUT = 14 * MiB;
constexpr size_t WS_MOD = 16 * MiB;
constexpr size_t WS_ROWSS = 20 * MiB;
constexpr size_t WS_WIN8 = 18 * MiB;
constexpr size_t WS_H = 32 * MiB;
constexpr size_t WS_KVRAW = WS_H, WS_MERGED = WS_H;
constexpr size_t WS_SGA = 160 * MiB;
constexpr size_t WS_H2 = WS_SGA;
constexpr size_t WS_SGB = 288 * MiB;
constexpr size_t WS_WGU = WS_SGB;
constexpr size_t WS_SB = 416 * MiB;
constexpr size_t WS_WDN = 416 * MiB;
constexpr size_t WS_TOKL = 480 * MiB;
constexpr size_t WS_WL = 512 * MiB;
constexpr size_t WS_HID = 544 * MiB;
constexpr size_t WS_QL = 608 * MiB;
constexpr size_t WS_M8 = 608 * MiB;
constexpr size_t WS_KVL = 656 * MiB;
constexpr size_t WS_KPE = 688 * MiB;
constexpr size_t WS_Q = 692 * MiB;
constexpr size_t WS_K = 788 * MiB;
constexpr size_t WS_OMLA = 884 * MiB;
constexpr size_t WS_H8 = WS_OMLA;
constexpr size_t WS_OSB = 948 * MiB;
constexpr size_t WS_END = 1012 * MiB;
static_assert(WS_HID + (size_t)4 * MAXTILES * 256 * 1024 <= WS_END, "hid (fp8, all four rounds)");
constexpr int CW_BAR = 4096;
constexpr int CW_CNT = 16384;

constexpr int RING_BYTES = 131072;
constexpr int LDSCTL_OFF = RING_BYTES + 1024;
constexpr int LC_BARST = 0;
constexpr int LC_RBASE = 32;
constexpr int LC_TBASE = 64;
constexpr int LC_NE = 640;
constexpr int LC_TILEE = 1152;
constexpr int LDS_BYTES = 147456;
static_assert(LC_TILEE + 4 * MAXTILES * 4 <= LDS_BYTES - LDSCTL_OFF, "lds ctl");

__device__ __forceinline__ unsigned cvt_pk_bf16(float lo, float hi) { unsigned r; asm volatile("v_cvt_pk_bf16_f32 %0, %1, %2" : "=v"(r) : "v"(lo), "v"(hi)); return r; }
__device__ __forceinline__ float bf_lo(unsigned u) { return __builtin_bit_cast(float, u << 16); }
__device__ __forceinline__ float bf_hi(unsigned u) { return __builtin_bit_cast(float, u & 0xffff0000u); }
__device__ __forceinline__ float fast_sigmoid(float x) { return __builtin_amdgcn_rcpf(1.f + __builtin_amdgcn_exp2f(-x * LOG2E)); }

namespace pg8 {
constexpr int BM = 256, BK = 64, HALF = 128, HTB = HALF * BK * 2, STAGE_BYTES = 8 * HTB, NXCD = 8, WGM = 8;
__host__ __device__ __forceinline__ int lds_byte(int r, int c) { const int st = (r >> 4) * 2 + (c >> 5), rr = r & 15, cc = c & 31, ob = rr * 64 + cc * 2; return st * 1024 + (ob ^ (((ob >> 9) & 1) << 5)); }
__host__ __device__ __forceinline__ void stage_rc(int b, int& R, int& C) { const int st = b / 1024, sb = b % 1024, swz = sb ^ (((sb >> 9) & 1) << 5); R = (st >> 1) * 16 + swz / 64; C = (st & 1) * 32 + (swz % 64) / 2; }
__host__ __device__ __forceinline__ int perm32(int rho) { const int n = rho >> 4, i = rho & 15; return 8 * (i >> 2) + 4 * n + (i & 3); }

struct Unit { int pm, pn, e, j0, ne, kk; };

struct DenseOrder {
    const char* A; const char* Bt; int K; int nM, nN, nwg, G, c;
    __device__ void init(const void* A_, const void* Bt_, int M, int N, int K_, int G_, int c_) { A = (const char*)A_; Bt = (const char*)Bt_; K = K_; nM = M / BM; nN = N / BM; nwg = nM * nN; G = G_; c = c_; }
    __device__ __forceinline__ bool next(int i, Unit& u) const {
        const long L = (long)i * G + c; if (L >= nwg) return false;
        int wgid = (int)L; { const int q = nwg / NXCD, r = nwg % NXCD, xcd = wgid % NXCD, off = wgid / NXCD; wgid = (xcd < r ? xcd * (q + 1) : r * (q + 1) + (xcd - r) * q) + off; }
        const int nig = WGM * nN, gid = wgid / nig, fm = gid * WGM, gsz = (nM - fm) < WGM ? (nM - fm) : WGM;
        u.pm = fm + ((wgid % nig) % gsz); u.pn = (wgid % nig) / gsz; u.e = 0; u.j0 = 0; u.ne = 0; u.kk = 0; return true;
    }
    __device__ __forceinline__ const char* a_base(const Unit& u) const { return A + (size_t)u.pm * (size_t)(BM * 2) * K; }
    __device__ __forceinline__ const char* b_base(const Unit& u) const { return Bt + (size_t)u.pn * (size_t)(BM * 2) * K; }
    __device__ __forceinline__ unsigned row_of(const Unit&, int) const { return 0u; }
};

template <bool GATHER, class Epi, class Sched>
__device__ __forceinline__ void gemm_phase(LAS unsigned char* lds, const int K, const Sched& S, const Epi& E, const int stg = 0) {
    int tid_ = threadIdx.x; asm volatile("" : "+v"(tid_));
    const int tid = tid_, wid = __builtin_amdgcn_readfirstlane(tid >> 6), lane = tid & 63, wr = wid >> 2, wc = wid & 3, fr = lane & 15, fq = lane >> 4;
    const int nt = K / BK;
    int RA[2]; unsigned cofA[2], voffB[2];
#pragma unroll
    for (int i = 0; i < 2; ++i) { int R, C; stage_rc(tid * 16 + i * 8192, R, C); const int Rb = (R & ~31) + perm32(R & 31);
        RA[i] = R; cofA[i] = (unsigned)C * 2u; voffB[i] = (unsigned)(Rb * K + C) * 2u; }
    const size_t kstep = (size_t)(BK * 2);
    const size_t hstep = (size_t)HALF * K * 2;
    const unsigned ldsw = (unsigned)wid * 1024u;
    const int aoff = lds_byte(wr * 64 + fr, fq * 8), boff = lds_byte(wc * 32 + fr, fq * 8);
#define PG8_SA(b, h) (((b) * 2 + (h)) * HTB)
#define PG8_SB(b, h) ((4 + (b) * 2 + (h)) * HTB)
#define PG8_STAGE(bufoff, gbase, voff) do { _Pragma("unroll") for (int _i = 0; _i < 2; ++_i) \
        __builtin_amdgcn_global_load_lds((const unsigned*)((const char*)(gbase) + (voff)[_i]), (LAS unsigned*)(lds + (bufoff) + ldsw + _i * 8192), 16, 0, 0); } while (0)
#define PG8_LDA(dst, b, h) do { _Pragma("unroll") for (int m = 0; m < 4; ++m) _Pragma("unroll") for (int k = 0; k < 2; ++k) dst[m][k] = *(const LAS bf16x8*)(lds + PG8_SA(b, h) + aoff + m * 2048 + k * 1024); } while (0)
#define PG8_LDB(dst, b, h) do { _Pragma("unroll") for (int n = 0; n < 2; ++n) _Pragma("unroll") for (int k = 0; k < 2; ++k) dst[n][k] = *(const LAS bf16x8*)(lds + PG8_SB(b, h) + boff + n * 2048 + k * 1024); } while (0)
#define PG8_MMA(ai, bj, At, Bt) do { __builtin_amdgcn_s_setprio(1); _Pragma("unroll") for (int m = 0; m < 4; ++m) _Pragma("unroll") for (int n = 0; n < 2; ++n) _Pragma("unroll") for (int k = 0; k < 2; ++k) \
        acc[ai][bj][m][n] = __builtin_amdgcn_mfma_f32_16x16x32_bf16(Bt[n][k], At[m][k], acc[ai][bj][m][n], 0, 0, 0); __builtin_amdgcn_s_setprio(0); } while (0)
#define PG8_WAIT_V(n) asm volatile("s_waitcnt vmcnt(" #n ")" ::: "memory")
#define PG8_WAIT_L(n) asm volatile("s_waitcnt lgkmcnt(" #n ")" ::: "memory")
#define PG8_BAR __builtin_amdgcn_s_barrier()
#define PG8_SCHED __builtin_amdgcn_sched_barrier(0)
#define PG8_AOFFS(dst, u) do { _Pragma("unroll") for (int _h = 0; _h < 2; ++_h) _Pragma("unroll") for (int _i = 0; _i < 2; ++_i) { \
        const unsigned _row = GATHER ? S.row_of(u, _h * HALF + RA[_i]) : (unsigned)(_h * HALF + RA[_i]); dst[_h][_i] = _row * (unsigned)(K * 2) + cofA[_i]; } } while (0)
    if (stg > 0 && ((blockIdx.x >> 3) & 1)) {
        const unsigned long long t0 = __builtin_amdgcn_s_memrealtime();
        while (__builtin_amdgcn_s_memrealtime() - t0 < (unsigned long long)stg) __builtin_amdgcn_s_sleep(8); }
    Unit cur, nxt; int ui = 0;
    if (!S.next(0, cur)) return;
    f32x4 acc[2][2][4][2];
#pragma unroll
    for (int a = 0; a < 2; ++a)
#pragma unroll
        for (int b = 0; b < 2; ++b)
#pragma unroll
            for (int m = 0; m < 4; ++m)
#pragma unroll
                for (int n = 0; n < 2; ++n) acc[a][b][m][n] = (f32x4){0.f, 0.f, 0.f, 0.f};
    bf16x8 At[4][2], B0[2][2], B1[2][2];
    unsigned oc[2][2], on[2][2];
    PG8_AOFFS(oc, cur);
    const char* cA = S.a_base(cur); const char* cB = S.b_base(cur);
    PG8_STAGE(PG8_SB(0, 0), cB, voffB); PG8_STAGE(PG8_SB(0, 1), cB + hstep, voffB); PG8_STAGE(PG8_SA(0, 0), cA, oc[0]); PG8_STAGE(PG8_SA(0, 1), cA, oc[1]);
    if (wr == 1) PG8_BAR;
    PG8_WAIT_V(2); PG8_BAR;
    PG8_STAGE(PG8_SB(1, 0), cB + kstep, voffB); PG8_STAGE(PG8_SA(1, 0), cA + kstep, oc[0]); PG8_STAGE(PG8_SB(1, 1), cB + hstep + kstep, voffB);
    PG8_WAIT_V(6); PG8_BAR;
    for (;;) {
        const bool has_next = S.next(ui + 1, nxt);
        const char* nA = has_next ? S.a_base(nxt) : cA; const char* nB = has_next ? S.b_base(nxt) : cB;
        if constexpr (GATHER) { if (has_next) { PG8_AOFFS(on, nxt);
            _Pragma("unroll") for (int _h = 0; _h < 2; ++_h) _Pragma("unroll") for (int _i = 0; _i < 2; ++_i) asm volatile("" : "+v"(on[_h][_i]));
          } else {
#pragma unroll
            for (int _h = 0; _h < 2; ++_h)
#pragma unroll
                for (int _i = 0; _i < 2; ++_i) on[_h][_i] = oc[_h][_i]; } }
#pragma nounroll
        for (int t = 0; t < nt; t += 2) {
            const bool last = (t == nt - 2);
            const char* a1 = cA + (size_t)(t + 1) * kstep;
            const char* a2 = last ? nA : cA + (size_t)(t + 2) * kstep; const char* b2 = last ? nB : cB + (size_t)(t + 2) * kstep;
            const char* a3 = a2 + kstep; const char* b3 = b2 + kstep;
            unsigned o2[2][2];
#pragma unroll
            for (int _h = 0; _h < 2; ++_h)
#pragma unroll
                for (int _i = 0; _i < 2; ++_i) o2[_h][_i] = (GATHER && last) ? on[_h][_i] : oc[_h][_i];
            PG8_LDB(B0, 0, 0); PG8_LDB(B1, 0, 1); PG8_SCHED; PG8_LDA(At, 0, 0); PG8_STAGE(PG8_SA(1, 1), a1, oc[1]);
            PG8_WAIT_V(8); PG8_WAIT_L(0); PG8_BAR; PG8_MMA(0, 0, At, B0); PG8_MMA(0, 1, At, B1); PG8_BAR; PG8_SCHED;
            PG8_LDA(At, 0, 1); PG8_STAGE(PG8_SB(0, 0), b2, voffB); PG8_STAGE(PG8_SB(0, 1), b2 + hstep, voffB); PG8_STAGE(PG8_SA(0, 0), a2, o2[0]);
            PG8_WAIT_V(8); PG8_WAIT_L(0); PG8_BAR; PG8_MMA(1, 0, At, B0); PG8_MMA(1, 1, At, B1); PG8_BAR; PG8_SCHED;
            PG8_LDB(B0, 1, 0); PG8_LDB(B1, 1, 1); PG8_SCHED; PG8_LDA(At, 1, 0); PG8_STAGE(PG8_SA(0, 1), a2, o2[1]);
            PG8_WAIT_V(8); PG8_WAIT_L(0); PG8_BAR; PG8_MMA(0, 0, At, B0); PG8_MMA(0, 1, At, B1); PG8_BAR; PG8_SCHED;
            PG8_LDA(At, 1, 1); PG8_STAGE(PG8_SB(1, 0), b3, voffB); PG8_STAGE(PG8_SB(1, 1), b3 + hstep, voffB); PG8_STAGE(PG8_SA(1, 0), a3, o2[0]);
            PG8_WAIT_V(8); PG8_WAIT_L(0); PG8_BAR; PG8_MMA(1, 0, At, B0); PG8_MMA(1, 1, At, B1); PG8_BAR; PG8_SCHED;
        }
        if (wr == 0) PG8_BAR;
        E(acc, cur, wr, wc, fr, fq);
        if (!has_next) break;
#pragma unroll
        for (int a = 0; a < 2; ++a)
#pragma unroll
            for (int b = 0; b < 2; ++b)
#pragma unroll
                for (int m = 0; m < 4; ++m)
#pragma unroll
                    for (int n = 0; n < 2; ++n) acc[a][b][m][n] = (f32x4){0.f, 0.f, 0.f, 0.f};
        cur = nxt; cA = nA; cB = nB; ++ui;
        if constexpr (GATHER) {
#pragma unroll
        for (int _h = 0; _h < 2; ++_h)
#pragma unroll
            for (int _i = 0; _i < 2; ++_i) oc[_h][_i] = on[_h][_i]; }
        if (wr == 1) PG8_BAR;
    }
    PG8_WAIT_V(0);
    PG8_BAR;
#undef PG8_SA
#undef PG8_SB
#undef PG8_STAGE
#undef PG8_LDA
#undef PG8_LDB
#undef PG8_MMA
#undef PG8_WAIT_V
#undef PG8_WAIT_L
#undef PG8_BAR
#undef PG8_SCHED
#undef PG8_AOFFS
}
template <bool GATHER, class Epi, class Sched>
__device__ __forceinline__ void gemm_phase_f8(LAS unsigned char* lds, const int K, const Sched& S, const Epi& E, const int stg = 0) {
    int tid_ = threadIdx.x; asm volatile("" : "+v"(tid_));
    const int tid = tid_, wid = __builtin_amdgcn_readfirstlane(tid >> 6), lane = tid & 63, wr = wid >> 2, wc = wid & 3, fr = lane & 15, fq = lane >> 4;
    const int nt = K / BK;
    int RA[2]; unsigned cofA[2], voffB[2];
#pragma unroll
    for (int i = 0; i < 2; ++i) { int R, C; stage_rc(tid * 16 + i * 8192, R, C); const int Rb = (R & ~31) + perm32(R & 31);
        RA[i] = R; cofA[i] = (unsigned)C * 2u; voffB[i] = (unsigned)(Rb * K + C) * 2u; }
    const size_t kstep = (size_t)(BK * 2);
    const size_t hstep = (size_t)HALF * K * 2;
    const unsigned ldsw = (unsigned)wid * 1024u;
    const int aoff = lds_byte(wr * 64 + fr, 16 * (fq & 1)) + (fq >> 1) * 1024, boff = lds_byte(wc * 32 + fr, 16 * (fq & 1)) + (fq >> 1) * 1024;
#define PG8_SA(b, h) (((b) * 2 + (h)) * HTB)
#define PG8_SB(b, h) ((4 + (b) * 2 + (h)) * HTB)
#define PG8_STAGE(bufoff, gbase, voff) do { _Pragma("unroll") for (int _i = 0; _i < 2; ++_i) \
        __builtin_amdgcn_global_load_lds((const unsigned*)((const char*)(gbase) + (voff)[_i]), (LAS unsigned*)(lds + (bufoff) + ldsw + _i * 8192), 16, 0, 0); } while (0)
#define PG8_LD32(p_) __builtin_shufflevector(*(const LAS u32x4*)(p_), *(const LAS u32x4*)((p_) + 16), 0, 1, 2, 3, 4, 5, 6, 7)
#define PG8_LDA(dst, b, h) do { _Pragma("unroll") for (int m = 0; m < 4; ++m) dst[m] = PG8_LD32(lds + PG8_SA(b, h) + aoff + m * 2048); } while (0)
#define PG8_LDB(dst, b, h) do { _Pragma("unroll") for (int n = 0; n < 2; ++n) dst[n] = PG8_LD32(lds + PG8_SB(b, h) + boff + n * 2048); } while (0)
#define PG8_F8(fr_) ((v8i){(int)fr_[0][0], (int)fr_[0][1], (int)fr_[0][2], (int)fr_[0][3], (int)fr_[1][0], (int)fr_[1][1], (int)fr_[1][2], (int)fr_[1][3]})
#define PG8_MMA(ai, bj, At, Bt) do { __builtin_amdgcn_s_setprio(1); _Pragma("unroll") for (int m = 0; m < 4; ++m) _Pragma("unroll") for (int n = 0; n < 2; ++n) \
        asm volatile("v_mfma_scale_f32_16x16x128_f8f6f4 %0, %1, %2, %0, %3, %3 op_sel_hi:[0,0,0]" : "+v"(acc[ai][bj][m][n]) : "v"(Bt[n]), "v"(At[m]), "v"(one_scale)); __builtin_amdgcn_s_setprio(0); } while (0)
#define PG8_WAIT_V(n) asm volatile("s_waitcnt vmcnt(" #n ")" ::: "memory")
#define PG8_WAIT_L(n) asm volatile("s_waitcnt lgkmcnt(" #n ")" ::: "memory")
#define PG8_BAR __builtin_amdgcn_s_barrier()
#define PG8_SCHED __builtin_amdgcn_sched_barrier(0)
#define PG8_AOFFS(dst, u) do { _Pragma("unroll") for (int _h = 0; _h < 2; ++_h) _Pragma("unroll") for (int _i = 0; _i < 2; ++_i) { \
        const unsigned _row = GATHER ? S.row_of(u, _h * HALF + RA[_i]) : (unsigned)(_h * HALF + RA[_i]); dst[_h][_i] = _row * (unsigned)(K * 2) + cofA[_i]; } } while (0)
    if (stg > 0 && ((blockIdx.x >> 3) & 1)) {
        const unsigned long long t0 = __builtin_amdgcn_s_memrealtime();
        while (__builtin_amdgcn_s_memrealtime() - t0 < (unsigned long long)stg) __builtin_amdgcn_s_sleep(8); }
    Unit cur, nxt; int ui = 0;
    if (!S.next(0, cur)) return;
    f32x4 acc[2][2][4][2];
#pragma unroll
    for (int a = 0; a < 2; ++a)
#pragma unroll
        for (int b = 0; b < 2; ++b)
#pragma unroll
            for (int m = 0; m < 4; ++m)
#pragma unroll
                for (int n = 0; n < 2; ++n) { acc[a][b][m][n] = (f32x4){0.f, 0.f, 0.f, 0.f}; asm volatile("" : "+v"(acc[a][b][m][n])); }
    u32x8 At[4], B0[2], B1[2];
    int one_scale = 0x7f7f7f7f; asm volatile("" : "+v"(one_scale));
    unsigned oc[2][2], on[2][2];
    PG8_AOFFS(oc, cur);
    const char* cA = S.a_base(cur); const char* cB = S.b_base(cur);
    PG8_STAGE(PG8_SB(0, 0), cB, voffB); PG8_STAGE(PG8_SB(0, 1), cB + hstep, voffB); PG8_STAGE(PG8_SA(0, 0), cA, oc[0]); PG8_STAGE(PG8_SA(0, 1), cA, oc[1]);
    if (wr == 1) PG8_BAR;
    PG8_WAIT_V(2); PG8_BAR;
    PG8_STAGE(PG8_SB(1, 0), cB + kstep, voffB); PG8_STAGE(PG8_SA(1, 0), cA + kstep, oc[0]); PG8_STAGE(PG8_SB(1, 1), cB + hstep + kstep, voffB);
    PG8_WAIT_V(6); PG8_BAR;
    Unit nn; bool has_next = S.next(1, nxt);
    if constexpr (GATHER) { if (has_next) { PG8_AOFFS(on, nxt);
            _Pragma("unroll") for (int _h = 0; _h < 2; ++_h) _Pragma("unroll") for (int _i = 0; _i < 2; ++_i) asm volatile("" : "+v"(on[_h][_i]));
          } else {
#pragma unroll
            for (int _h = 0; _h < 2; ++_h)
#pragma unroll
                for (int _i = 0; _i < 2; ++_i) on[_h][_i] = oc[_h][_i]; } }
    for (;;) {
        const char* nA = has_next ? S.a_base(nxt) : cA; const char* nB = has_next ? S.b_base(nxt) : cB;
#pragma nounroll
        for (int t = 0; t < nt; t += 2) {
            const bool last = (t == nt - 2);
            const char* a1 = cA + (size_t)(t + 1) * kstep;
            const char* a2 = last ? nA : cA + (size_t)(t + 2) * kstep; const char* b2 = last ? nB : cB + (size_t)(t + 2) * kstep;
            const char* a3 = a2 + kstep; const char* b3 = b2 + kstep;
            unsigned o2[2][2];
#pragma unroll
            for (int _h = 0; _h < 2; ++_h)
#pragma unroll
                for (int _i = 0; _i < 2; ++_i) o2[_h][_i] = (GATHER && last) ? on[_h][_i] : oc[_h][_i];
            PG8_LDB(B0, 0, 0); PG8_LDB(B1, 0, 1); PG8_SCHED; PG8_LDA(At, 0, 0); PG8_STAGE(PG8_SA(1, 1), a1, oc[1]);
            PG8_WAIT_V(8); PG8_WAIT_L(0); PG8_BAR; PG8_MMA(0, 0, At, B0); PG8_MMA(0, 1, At, B1); PG8_BAR; PG8_SCHED;
            PG8_LDA(At, 0, 1); PG8_STAGE(PG8_SB(0, 0), b2, voffB); PG8_STAGE(PG8_SB(0, 1), b2 + hstep, voffB); PG8_STAGE(PG8_SA(0, 0), a2, o2[0]);
            PG8_WAIT_V(8); PG8_WAIT_L(0); PG8_BAR; PG8_MMA(1, 0, At, B0); PG8_MMA(1, 1, At, B1); PG8_BAR; PG8_SCHED;
            PG8_LDB(B0, 1, 0); PG8_LDB(B1, 1, 1); PG8_SCHED; PG8_LDA(At, 1, 0); PG8_STAGE(PG8_SA(0, 1), a2, o2[1]);
            PG8_WAIT_V(8); PG8_WAIT_L(0); PG8_BAR; PG8_MMA(0, 0, At, B0); PG8_MMA(0, 1, At, B1); PG8_BAR; PG8_SCHED;
            PG8_LDA(At, 1, 1); PG8_STAGE(PG8_SB(1, 0), b3, voffB); PG8_STAGE(PG8_SB(1, 1), b3 + hstep, voffB); PG8_STAGE(PG8_SA(1, 0), a3, o2[0]);
            PG8_WAIT_V(8); PG8_WAIT_L(0); PG8_BAR; PG8_MMA(1, 0, At, B0); PG8_MMA(1, 1, At, B1); PG8_BAR; PG8_SCHED;
        }
        asm volatile("s_nop 15\n\ts_nop 15" ::: "memory");
        if (wr == 0) PG8_BAR;
        const bool has_nn = has_next && S.next(ui + 2, nn);
        unsigned onn[2][2];
        if constexpr (GATHER) { if (has_nn) { PG8_AOFFS(onn, nn); } else {
#pragma unroll
            for (int _h = 0; _h < 2; ++_h)
#pragma unroll
                for (int _i = 0; _i < 2; ++_i) onn[_h][_i] = on[_h][_i]; } }
        E(acc, cur, wr, wc, fr, fq);
        if (!has_next) break;
#pragma unroll
        for (int a = 0; a < 2; ++a)
#pragma unroll
            for (int b = 0; b < 2; ++b)
#pragma unroll
                for (int m = 0; m < 4; ++m)
#pragma unroll
                    for (int n = 0; n < 2; ++n) { acc[a][b][m][n] = (f32x4){0.f, 0.f, 0.f, 0.f}; asm volatile("" : "+v"(acc[a][b][m][n])); }
        cur = nxt; cA = nA; cB = nB; ++ui; nxt = nn; has_next = has_nn;
        if constexpr (GATHER) {
#pragma unroll
        for (int _h = 0; _h < 2; ++_h)
#pragma unroll
            for (int _i = 0; _i < 2; ++_i) { oc[_h][_i] = on[_h][_i]; asm volatile("" : "+v"(onn[_h][_i])); on[_h][_i] = onn[_h][_i]; } }
        if (wr == 1) PG8_BAR;
    }
    PG8_WAIT_V(0);
    PG8_BAR;
#undef PG8_SA
#undef PG8_SB
#undef PG8_STAGE
#undef PG8_LDA
#undef PG8_LDB
#undef PG8_MMA
#undef PG8_WAIT_V
#undef PG8_WAIT_L
#undef PG8_BAR
#undef PG8_SCHED
#undef PG8_AOFFS
#undef PG8_F8
}
}
#define XB_TMO      128
#define XB_XCNT(j)  (256  + 64 * (j))
#define XB_XSUB(j)  (1280 + 64 * (j))
#define XB_XGEN(j)  (2304 + 64 * (j))
#define XB_TOP      3328
#define XB_TOPGEN   3392
#define XCD_BAR_WORDS 3456
#define XB_SPIN_CAP (1u << 18)

__device__ __forceinline__ unsigned xb_ld(unsigned* p)              { return __hip_atomic_load(p, __ATOMIC_RELAXED, __HIP_MEMORY_SCOPE_AGENT); }
__device__ __forceinline__ unsigned xb_add(unsigned* p, unsigned v) { return __hip_atomic_fetch_add(p, v, __ATOMIC_RELAXED, __HIP_MEMORY_SCOPE_AGENT); }
__device__ __forceinline__ unsigned xb_xcc_id() { return (unsigned)__builtin_amdgcn_s_getreg((3 << 11) | 20) & 0xFu; }
#define XB_SPIN(cond, bar) do { unsigned _sp = 0; while (cond) { __builtin_amdgcn_s_sleep(1); \
    if ((++_sp & 255u) == 0u) { if (xb_ld(&(bar)[XB_TMO])) break; if (_sp > XB_SPIN_CAP) { atomicAdd(&(bar)[XB_TMO], 1u); break; } } } } while (0)

struct XcdBarrier {
    unsigned* bar; unsigned x;
    volatile LAS unsigned* st;
};

__device__ __forceinline__ XcdBarrier xcd_barrier_post(unsigned* bar, volatile LAS unsigned* st) {
    XcdBarrier b; b.bar = bar; b.x = xb_xcc_id(); b.st = st;
    if (threadIdx.x == 0) (void)xb_add(&bar[XB_XCNT(b.x)], 1u);
    return b;
}
__device__ __forceinline__ void xcd_barrier_complete(unsigned* bar, unsigned x, unsigned& nloc, unsigned& nx) {
    const unsigned G = gridDim.x * gridDim.y * gridDim.z;
    unsigned sum, cnt, mine, sp = 0u;
    for (;;) {
        sum = 0u; cnt = 0u; mine = 0u;
#pragma unroll
        for (unsigned j = 0; j < 16; ++j) { const unsigned c = xb_ld(&bar[XB_XCNT(j)]); sum += c; cnt += (c > 0u) ? 1u : 0u; mine = (j == x) ? c : mine; }
        if (sum == G) break;
        __builtin_amdgcn_s_sleep(1);
        if ((++sp & 255u) == 0u) { if (xb_ld(&bar[XB_TMO])) break; if (sp > XB_SPIN_CAP) { atomicAdd(&bar[XB_TMO], 1u); break; } }
    }
    nloc = mine > 0u ? mine : 1u; nx = cnt > 0u ? cnt : 1u;
}

__device__ __forceinline__ void xcd_barrier(const XcdBarrier& b) {
    asm volatile("s_waitcnt vmcnt(0)" ::: "memory");
    __syncthreads();
    if (threadIdx.x == 0) {
        unsigned* bar = b.bar;
        __builtin_amdgcn_s_waitcnt(0);
        unsigned nloc = b.st[0], nx = b.st[1];
        if (nloc == 0u) { xcd_barrier_complete(bar, b.x, nloc, nx); b.st[0] = nloc; b.st[1] = nx; }
        const unsigned old = xb_add(&bar[XB_XSUB(b.x)], 1u);
        const unsigned gen = old / nloc;
        if (old + 1u == (gen + 1u) * nloc) {
            __builtin_amdgcn_fence(__ATOMIC_RELEASE, "agent");
            asm volatile("s_waitcnt vmcnt(0)" ::: "memory");
            const unsigned og = xb_add(&bar[XB_TOP], 1u);
            const unsigned tg = og / nx;
            if (og + 1u == (tg + 1u) * nx) xb_add(&bar[XB_TOPGEN], 1u);
            else XB_SPIN(xb_ld(&bar[XB_TOPGEN]) == tg, bar);
            __builtin_amdgcn_fence(__ATOMIC_ACQUIRE, "agent");
            xb_add(&bar[XB_XGEN(b.x)], 1u);
            asm volatile("s_waitcnt vmcnt(0)" ::: "memory");
        } else {
            XB_SPIN(xb_ld(&bar[XB_XGEN(b.x)]) == gen, bar);
            __builtin_amdgcn_fence(__ATOMIC_ACQUIRE, "agent");
            asm volatile("s_waitcnt vmcnt(0)" ::: "memory");
        }
    }
    __syncthreads();
}

#define LDS_WAIT() asm volatile("s_waitcnt lgkmcnt(0)" ::: "memory")
#define VM_WAIT() asm volatile("s_waitcnt vmcnt(0)" ::: "memory")
#define MFMA32(a, b, c) __builtin_amdgcn_mfma_f32_32x32x16_bf16((a), (b), (c), 0, 0, 0)
__device__ __forceinline__ float wave_sum(float v) {
#pragma unroll
    for (int o = 1; o < 64; o <<= 1) v += __shfl_xor(v, o);
    return v;
}
__device__ __forceinline__ int crow(int i, int hh) { return (i & 3) + 8 * (i >> 2) + 4 * hh; }
__device__ __forceinline__ bf16x8 pack8(float a0, float a1, float a2, float a3, float a4, float a5, float a6, float a7) {
    u32x4 p; p.x = cvt_pk_bf16(a0, a1); p.y = cvt_pk_bf16(a2, a3); p.z = cvt_pk_bf16(a4, a5); p.w = cvt_pk_bf16(a6, a7);
    return __builtin_bit_cast(bf16x8, p);
}

struct Ctx {
    LAS unsigned char* lds;
    int tid, lane, wave, vcu, G;
};

__device__ __forceinline__ void transpose_item(const float* W, int K, int N, bf16_t* WT, int k0, int n0, int drow0, LAS float* scr, int lane, const float* kgain = nullptr) {
#pragma unroll 8
    for (int i = 0; i < 32; ++i) { const int kk = 2 * i + (lane >> 5); float wv = W[(size_t)(k0 + kk) * N + n0 + (lane & 31)]; if (kgain) wv *= kgain[k0 + kk]; scr[kk * 33 + (lane & 31)] = wv; }
    LDS_WAIT(); asm volatile("" ::: "memory");
    const int c = lane & 7;
#pragma unroll
    for (int j = 0; j < 4; ++j) { const int n = (lane >> 3) + 8 * j; const LAS float* s = scr + (8 * c) * 33 + n;
        u32x4 o; o.x = cvt_pk_bf16(s[0 * 33], s[1 * 33]); o.y = cvt_pk_bf16(s[2 * 33], s[3 * 33]); o.z = cvt_pk_bf16(s[4 * 33], s[5 * 33]); o.w = cvt_pk_bf16(s[6 * 33], s[7 * 33]);
        *(GAS u32x4*)(WT + (size_t)(drow0 + n) * K + k0 + 8 * c) = o; }
    LDS_WAIT(); asm volatile("" ::: "memory");
}

__device__ __forceinline__ unsigned pk4_fp8(float a, float b, float c, float d) { int p = __builtin_amdgcn_cvt_pk_fp8_f32(a, b, 0, false); p = __builtin_amdgcn_cvt_pk_fp8_f32(c, d, p, true); return (unsigned)p; }
__device__ __forceinline__ void transpose_item_f8(const float* W, int K, int N, unsigned char* WT, int k0, int n0, int drow0, float scl, LAS float* scr, int lane) {
#pragma unroll 8
    for (int i = 0; i < 32; ++i) { const int kk = 2 * i + (lane >> 5); scr[kk * 33 + (lane & 31)] = W[(size_t)(k0 + kk) * N + n0 + (lane & 31)]; }
    LDS_WAIT(); asm volatile("" ::: "memory");
    const int c = lane & 7;
#pragma unroll
    for (int j = 0; j < 4; ++j) { const int n = (lane >> 3) + 8 * j; const LAS float* s = scr + (8 * c) * 33 + n;
        u32x2 o; o.x = pk4_fp8(s[0 * 33] * scl, s[1 * 33] * scl, s[2 * 33] * scl, s[3 * 33] * scl); o.y = pk4_fp8(s[4 * 33] * scl, s[5 * 33] * scl, s[6 * 33] * scl, s[7 * 33] * scl);
        *(GAS u32x2*)(WT + (size_t)(drow0 + n) * K + k0 + 8 * c) = o; }
    LDS_WAIT(); asm volatile("" ::: "memory");
}

#ifdef NT_STORES
#define ST_NT(p_, v_) __builtin_nontemporal_store((v_), (p_))
#else
#define ST_NT(p_, v_) (*(p_) = (v_))
#endif
constexpr float WSCALE = 32.f, WDESCALE = 1.f / 32.f;
typedef const f32x4 (&AccRef)[2][2][4][2];

struct EpiNull { __device__ __forceinline__ void operator()(AccRef acc, const pg8::Unit& u, int wr, int wc, int fr, int fq) const {
        float s = 0.f;
#pragma unroll
        for (int ai = 0; ai < 2; ++ai)
#pragma unroll
            for (int bj = 0; bj < 2; ++bj)
#pragma unroll
                for (int m = 0; m < 4; ++m)
#pragma unroll
                    for (int n = 0; n < 2; ++n) s += acc[ai][bj][m][n][0] + acc[ai][bj][m][n][1] + acc[ai][bj][m][n][2] + acc[ai][bj][m][n][3];
        asm volatile("" :: "v"(s)); } };
struct EpiStore {
    bf16_t* O; int ldc; const float* SS; float inv_n;
    __device__ __forceinline__ void operator()(AccRef acc, const pg8::Unit& u, int wr, int wc, int fr, int fq) const {
        const int row0 = u.pm * 256 + wr * 64 + fr, col0 = u.pn * 256 + wc * 32 + 8 * fq;
#pragma unroll
        for (int ai = 0; ai < 2; ++ai)
#pragma unroll
            for (int m = 0; m < 4; ++m) { bf16_t* rowp = O + (size_t)(row0 + ai * 128 + m * 16) * ldc + col0;
                const float rs = rsqrtf(SS[(size_t)(row0 + ai * 128 + m * 16) * 2] * inv_n + EPS);
#pragma unroll
                for (int bj = 0; bj < 2; ++bj) { const f32x4 v0 = acc[ai][bj][m][0] * rs, v1 = acc[ai][bj][m][1] * rs;
                    u32x4 w; w.x = cvt_pk_bf16(v0[0], v0[1]); w.y = cvt_pk_bf16(v0[2], v0[3]); w.z = cvt_pk_bf16(v1[0], v1[1]); w.w = cvt_pk_bf16(v1[2], v1[3]);
                    ST_NT((u32x4*)(rowp + bj * 128), w); } }
    }
};

struct EpiProj {
    bf16_t *QL, *KVL, *KPE, *SB, *SGA, *SGB; int cbase; float dsc; float* ROWSS;
    __device__ __forceinline__ void operator()(AccRef acc, const pg8::Unit& u, int wr, int wc, int fr, int fq) const {
        const int row0 = u.pm * 256 + wr * 64 + fr;
#pragma unroll
        for (int bj = 0; bj < 2; ++bj) {
            const int cg = cbase + u.pn * 256 + bj * 128 + wc * 32;
            bf16_t* base; int ld, co; bool sig = false; int lat = -1;
            if (cg < 384) { base = QL; ld = 384; co = cg; lat = 0; }
            else if (cg < 640) { base = KVL; ld = 256; co = cg - 384; lat = 1; }
            else if (cg < 672) { base = KPE; ld = 32; co = cg - 640; }
            else if (cg < 768) { continue; }
            else if (cg < 2304) { base = SB; ld = 1536; co = cg - 768; }
            else if (cg < 3328) { base = SGA; ld = 1024; co = cg - 2304; sig = true; }
            else { base = SGB; ld = 1024; co = cg - 3328; sig = true; }
#pragma unroll
            for (int ai = 0; ai < 2; ++ai)
#pragma unroll
                for (int m = 0; m < 4; ++m) { f32x4 v0 = acc[ai][bj][m][0], v1 = acc[ai][bj][m][1];
                    if (sig) {
                        int q0 = 0, q1 = 0;
#pragma unroll
                        for (int j = 0; j < 4; ++j) { q0 = __builtin_amdgcn_cvt_pk_u8_f32(fast_sigmoid(v0[j] * dsc) * 255.f, j, q0); q1 = __builtin_amdgcn_cvt_pk_u8_f32(fast_sigmoid(v1[j] * dsc) * 255.f, j, q1); }
                        u32x2 w8; w8.x = (unsigned)q0; w8.y = (unsigned)q1;
                        ST_NT((u32x2*)((unsigned char*)base + (size_t)(row0 + ai * 128 + m * 16) * 1024 + co + 8 * fq), w8); continue; }
                    u32x4 w; w.x = cvt_pk_bf16(v0[0], v0[1]); w.y = cvt_pk_bf16(v0[2], v0[3]); w.z = cvt_pk_bf16(v1[0], v1[1]); w.w = cvt_pk_bf16(v1[2], v1[3]);
                    ST_NT((u32x4*)(base + (size_t)(row0 + ai * 128 + m * 16) * ld + co + 8 * fq), w);
                    if (lat >= 0) {
                        float ss = bf_lo(w.x) * bf_lo(w.x) + bf_hi(w.x) * bf_hi(w.x) + bf_lo(w.y) * bf_lo(w.y) + bf_hi(w.y) * bf_hi(w.y) + bf_lo(w.z) * bf_lo(w.z) + bf_hi(w.z) * bf_hi(w.z) + bf_lo(w.w) * bf_lo(w.w) + bf_hi(w.w) * bf_hi(w.w);
                        ss += __shfl_xor(ss, 16); ss += __shfl_xor(ss, 32);
                        if (fq == 0) atomicAdd(ROWSS + (size_t)(row0 + ai * 128 + m * 16) * 2 + lat, ss); } }
        }
    }
};

template <bool SECOND> struct EpiMerge {
    bf16_t* MG; const bf16_t* SG; unsigned char* M8;
    __device__ __forceinline__ void operator()(AccRef acc, const pg8::Unit& u, int wr, int wc, int fr, int fq) const {
        const int row0 = u.pm * 256 + wr * 64 + fr, col0 = u.pn * 256 + wc * 32 + 8 * fq;
#pragma unroll
        for (int ai = 0; ai < 2; ++ai)
#pragma unroll
            for (int m = 0; m < 4; ++m) { const size_t ro = (size_t)(row0 + ai * 128 + m * 16) * 1024 + col0;
#pragma unroll
                for (int bj = 0; bj < 2; ++bj) { const f32x4 v0 = acc[ai][bj][m][0], v1 = acc[ai][bj][m][1];
                    const u32x2 g = *(const u32x2*)((const unsigned char*)SG + ro + bj * 128);
                    constexpr float I255 = 1.f / 255.f;
                    float r0 = (float)(g.x & 0xffu) * I255 * v0[0], r1 = (float)((g.x >> 8) & 0xffu) * I255 * v0[1], r2 = (float)((g.x >> 16) & 0xffu) * I255 * v0[2], r3 = (float)(g.x >> 24) * I255 * v0[3];
                    float r4 = (float)(g.y & 0xffu) * I255 * v1[0], r5 = (float)((g.y >> 8) & 0xffu) * I255 * v1[1], r6 = (float)((g.y >> 16) & 0xffu) * I255 * v1[2], r7 = (float)(g.y >> 24) * I255 * v1[3];
                    if (SECOND) { const u32x4 p = *(const u32x4*)(MG + ro + bj * 128);
                        r0 += bf_lo(p.x); r1 += bf_hi(p.x); r2 += bf_lo(p.y); r3 += bf_hi(p.y); r4 += bf_lo(p.z); r5 += bf_hi(p.z); r6 += bf_lo(p.w); r7 += bf_hi(p.w); }
                    if (SECOND) { u32x2 w; w.x = pk4_fp8(r0, r1, r2, r3); w.y = pk4_fp8(r4, r5, r6, r7); ST_NT((u32x2*)(M8 + ro + bj * 128), w); }
                    else { u32x4 w; w.x = cvt_pk_bf16(r0, r1); w.y = cvt_pk_bf16(r2, r3); w.z = cvt_pk_bf16(r4, r5); w.w = cvt_pk_bf16(r6, r7);
                        ST_NT((u32x4*)(MG + ro + bj * 128), w); } } }
    }
};

struct EpiWout {
    const float* X; float* OUT; const float* MOD; float dsc;
    __device__ __forceinline__ void operator()(AccRef acc, const pg8::Unit& u, int wr, int wc, int fr, int fq) const {
        const int row0 = u.pm * 256 + wr * 64 + fr, col0 = u.pn * 256 + wc * 32 + 8 * fq;
        const float* ga = MOD + (size_t)(u.pm >> 3) * 6144 + 2048 + col0;
        f32x4 g[2][2];
#pragma unroll
        for (int bj = 0; bj < 2; ++bj)
#pragma unroll
            for (int n = 0; n < 2; ++n) g[bj][n] = *(const f32x4*)(ga + bj * 128 + 4 * n) * dsc;
#pragma unroll
        for (int ai = 0; ai < 2; ++ai)
#pragma unroll
            for (int m = 0; m < 4; ++m) { const size_t ro = (size_t)(row0 + ai * 128 + m * 16) * 1024 + col0;
#pragma unroll
                for (int bj = 0; bj < 2; ++bj)
#pragma unroll
                    for (int n = 0; n < 2; ++n) { const f32x4 xv = *(const f32x4*)(X + ro + bj * 128 + 4 * n);
                        *(f32x4*)(OUT + ro + bj * 128 + 4 * n) = xv + g[bj][n] * acc[ai][bj][m][n]; } }
    }
};

struct EpiGateUp {
    unsigned char* HID; const float* BGU;
    __device__ __forceinline__ void operator()(AccRef acc, const pg8::Unit& u, int wr, int wc, int fr, int fq) const {
        const int row0 = u.pm * 256 + wr * 64 + fr, hc = u.pn * 128 + wc * 32 + 8 * fq;
        const float* bg = BGU + (size_t)u.e * 2048 + hc;
        f32x4 bgate[2], bup[2];
#pragma unroll
        for (int n = 0; n < 2; ++n) { bgate[n] = *(const f32x4*)(bg + 4 * n); bup[n] = *(const f32x4*)(bg + 1024 + 4 * n); }
#pragma unroll
        for (int ai = 0; ai < 2; ++ai)
#pragma unroll
            for (int m = 0; m < 4; ++m) { float r[8];
#pragma unroll
                for (int n = 0; n < 2; ++n) { const f32x4 gv = acc[ai][0][m][n] * WDESCALE + bgate[n], uv = acc[ai][1][m][n] * WDESCALE + bup[n];
#pragma unroll
                    for (int j = 0; j < 4; ++j) { const float g = __builtin_fminf(gv[j], 7.f); const float up = __builtin_fminf(__builtin_fmaxf(uv[j], -7.f), 7.f);
                        r[4 * n + j] = (up + 1.f) * (g * fast_sigmoid(1.702f * g)); } }
                u32x2 w; w.x = pk4_fp8(r[0], r[1], r[2], r[3]); w.y = pk4_fp8(r[4], r[5], r[6], r[7]);
                ST_NT((u32x2*)(HID + (size_t)(row0 + ai * 128 + m * 16) * 1024 + hc), w); asm volatile("" ::: "memory"); }
    }
};

struct EpiDown {
    float* OUT; bf16_t* Y0; bf16_t* Y1; bf16_t* Y2; const float* BDN; const float* MOD; const int* TOKL; const float* WL;
    __device__ __forceinline__ void operator()(AccRef acc, const pg8::Unit& u, int wr, int wc, int fr, int fq) const {
        const int col0 = u.pn * 256 + wc * 32 + 8 * fq;
        const float* bd = BDN + (size_t)u.e * 1024 + col0;
        f32x4 b4[2][2];
#pragma unroll
        for (int bj = 0; bj < 2; ++bj)
#pragma unroll
            for (int n = 0; n < 2; ++n) b4[bj][n] = *(const f32x4*)(bd + bj * 128 + 4 * n);
        const int* tl = TOKL + (size_t)(u.kk * 32 + u.e) * LISTCAP; const float* wl = WL + (size_t)(u.kk * 32 + u.e) * LISTCAP;
        bf16_t* Yk = Y0 + (size_t)u.kk * (size_t)(Y1 - Y0);
#pragma unroll
        for (int ai = 0; ai < 2; ++ai)
#pragma unroll
            for (int m = 0; m < 4; ++m) { const int slot = u.j0 + ai * 128 + wr * 64 + m * 16 + fr;
                if (slot < u.ne) { const int tok = tl[slot]; const float wgt = wl[slot];
                    const float* ga = MOD + (size_t)(tok >> 11) * 6144 + 5120 + col0; const size_t ro = (size_t)tok * 1024 + col0;
#pragma unroll
                    for (int bj = 0; bj < 2; ++bj) {
                        f32x4 v0 = *(const f32x4*)(ga + bj * 128) * ((acc[ai][bj][m][0] * WDESCALE + b4[bj][0]) * wgt), v1 = *(const f32x4*)(ga + bj * 128 + 4) * ((acc[ai][bj][m][1] * WDESCALE + b4[bj][1]) * wgt);
                        if (u.kk == 3) {
                            const u32x4 p = *(const u32x4*)(Y0 + ro + bj * 128), q = *(const u32x4*)(Y1 + ro + bj * 128), s = *(const u32x4*)(Y2 + ro + bj * 128);
                            v0[0] += bf_lo(p.x) + bf_lo(q.x) + bf_lo(s.x); v0[1] += bf_hi(p.x) + bf_hi(q.x) + bf_hi(s.x); v0[2] += bf_lo(p.y) + bf_lo(q.y) + bf_lo(s.y); v0[3] += bf_hi(p.y) + bf_hi(q.y) + bf_hi(s.y);
                            v1[0] += bf_lo(p.z) + bf_lo(q.z) + bf_lo(s.z); v1[1] += bf_hi(p.z) + bf_hi(q.z) + bf_hi(s.z); v1[2] += bf_lo(p.w) + bf_lo(q.w) + bf_lo(s.w); v1[3] += bf_hi(p.w) + bf_hi(q.w) + bf_hi(s.w);
                            float* op = OUT + ro + bj * 128;
                            *(f32x4*)op = *(const f32x4*)op + v0; *(f32x4*)(op + 4) = *(const f32x4*)(op + 4) + v1; }
                        else { u32x4 w; w.x = cvt_pk_bf16(v0[0], v0[1]); w.y = cvt_pk_bf16(v0[2], v0[3]); w.z = cvt_pk_bf16(v1[0], v1[1]); w.w = cvt_pk_bf16(v1[2], v1[3]); ST_NT((u32x4*)(Yk + ro + bj * 128), w); } } }
                asm volatile("" ::: "memory"); }
    }
};

struct MoeTabs { const LAS int* rbase; const LAS int* tbase; const LAS int* nearr; const LAS int* tilee; };
struct MoeOrderGU {
    const char* A; const char* Bt; const int* lists; int G, c; MoeTabs tb;
    __device__ __forceinline__ bool next(int i, pg8::Unit& u) const {
        const int L = i * G + c, TT = L >> 3; const int total = __builtin_amdgcn_readfirstlane(tb.rbase[4]);
        if (TT >= total) return false;
        int k = 0;
#pragma unroll
        for (int q = 1; q < 4; ++q) k += (TT >= __builtin_amdgcn_readfirstlane(tb.rbase[q])) ? 1 : 0;
        const int T = TT - __builtin_amdgcn_readfirstlane(tb.rbase[k]);
        const int e = __builtin_amdgcn_readfirstlane(tb.tilee[k * MAXTILES + T]);
        u.pm = TT; u.pn = L & 7; u.e = e; u.kk = k; u.j0 = (T - __builtin_amdgcn_readfirstlane(tb.tbase[k * 33 + e])) * 256; u.ne = __builtin_amdgcn_readfirstlane(tb.nearr[k * 32 + e]); return true;
    }
    __device__ __forceinline__ const char* a_base(const pg8::Unit&) const { return A; }
    __device__ __forceinline__ const char* b_base(const pg8::Unit& u) const { return Bt + (size_t)u.e * (size_t)(2048 * 1024) + (size_t)u.pn * (size_t)(256 * 1024); }
    __device__ __forceinline__ unsigned row_of(const pg8::Unit& u, int r) const { const int slot = u.j0 + r; return slot < u.ne ? (unsigned)lists[(size_t)(u.kk * 32 + u.e) * LISTCAP + slot] : 0u; }
};
struct MoeOrderDN {
    const char* A; const char* Bt; int G, c, k0, k1; MoeTabs tb;
    __device__ __forceinline__ bool next(int i, pg8::Unit& u) const {
        const int L = i * G + c; const int r0 = __builtin_amdgcn_readfirstlane(tb.rbase[k0]), r1 = __builtin_amdgcn_readfirstlane(tb.rbase[k1]);
        const int TT = r0 + (L >> 2);
        if (TT >= r1) return false;
        int k = 0;
#pragma unroll
        for (int q = 1; q < 4; ++q) k += (TT >= __builtin_amdgcn_readfirstlane(tb.rbase[q])) ? 1 : 0;
        const int T = TT - __builtin_amdgcn_readfirstlane(tb.rbase[k]);
        const int e = __builtin_amdgcn_readfirstlane(tb.tilee[k * MAXTILES + T]);
        u.pm = TT; u.pn = L & 3; u.e = e; u.kk = k; u.j0 = (T - __builtin_amdgcn_readfirstlane(tb.tbase[k * 33 + e])) * 256; u.ne = __builtin_amdgcn_readfirstlane(tb.nearr[k * 32 + e]); return true;
    }
    __device__ __forceinline__ const char* a_base(const pg8::Unit& u) const { return A + (size_t)u.pm * (size_t)(256 * 1024); }
    __device__ __forceinline__ const char* b_base(const pg8::Unit& u) const { return Bt + (size_t)u.e * (size_t)(1024 * 1024) + (size_t)u.pn * (size_t)(256 * 1024); }
    __device__ __forceinline__ unsigned row_of(const pg8::Unit&, int) const { return 0u; }
};

constexpr int ATT_KBYTES = 12 * 1024;
constexpr int ATT_VPITCH = 136;
constexpr int ATT_VBYTES = 64 * ATT_VPITCH;
constexpr int ATT_BUF = ATT_KBYTES + ATT_VBYTES;
constexpr int ATT_WS = 2 * ATT_BUF;
static_assert(ATT_WS + 8 * 256 + 64 <= RING_BYTES, "attention LDS");

typedef short v4i16_t __attribute__((ext_vector_type(4)));
__device__ __forceinline__ s16x4 lds_tr16(const LAS unsigned char* p) { return __builtin_bit_cast(s16x4, __builtin_amdgcn_ds_read_tr16_b64_v4i16((LAS v4i16_t*)p)); }
constexpr int M2_KCH = 1040;
constexpr int M2_KB = 12 * M2_KCH;
constexpr int M2_VB = 8192;
constexpr int M2_BUF = M2_KB + M2_VB;
constexpr int M2_WS = 2 * M2_BUF;
static_assert(M2_WS + 8 * 256 <= RING_BYTES && M2_KB % 16 == 0, "MLA LDS");
__device__ __forceinline__ void mla_unit2(LAS unsigned char* lds, const bf16_t* Q, const bf16_t* Kb, const bf16_t* KV, bf16_t* O, int b, int h, int u2) {
    int tid_ = threadIdx.x; asm volatile("" : "+v"(tid_));
    const int tid = tid_, lane = tid & 63, r = lane & 31, hh = lane >> 5; const int wid = __builtin_amdgcn_readfirstlane(tid >> 6);
    const size_t rowbase = (size_t)b * SEQ; const int q0 = u2 * 512;
    const int qwA = q0 + 32 * wid, qwB = q0 + 256 + 32 * (7 - wid);
    const int cqA = qwA >> 6, cqB = qwB >> 6, NT = (q0 >> 6) + 8;
    LAS float* wsfA = (LAS float*)(lds + M2_WS) + wid * 64; LAS float* wsfB = wsfA + 32;
    bf16x8 qfA[6], qfB[6];
    { const bf16_t* qp = Q + (rowbase + qwA + r) * 768 + h * 96 + hh * 8; const bf16_t* qp2 = Q + (rowbase + qwB + r) * 768 + h * 96 + hh * 8;
#pragma unroll
      for (int s = 0; s < 6; ++s) { qfA[s] = *(const bf16x8*)(qp + 16 * s); qfB[s] = *(const bf16x8*)(qp2 + 16 * s); } }
    const int kr0_ = tid / 12, kc0_ = tid % 12, kr1_ = (tid + 512) / 12, kc1_ = (tid + 512) % 12;
    const bf16_t* kg0 = Kb + (rowbase + kr0_) * 768 + h * 96 + kc0_ * 8;
    const bf16_t* kg1 = Kb + (rowbase + kr1_) * 768 + h * 96 + kc1_ * 8;
    const bf16_t* vg = KV + (rowbase + (tid >> 3)) * 1024 + h * 128 + 64 + (tid & 7) * 8;
    const int kd0 = kc0_ * M2_KCH + kr0_ * 16, kd1 = kc1_ * M2_KCH + kr1_ * 16, vd = ((tid & 7) >> 2) * 4096 + (tid >> 3) * 64 + (tid & 3) * 16;
    u32x4 k0r, k1r = (u32x4){0u, 0u, 0u, 0u}, v0r;
#define M2_LOAD(t) do { k0r = *(const u32x4*)(kg0 + (size_t)(t) * 64 * 768); if (tid < 256) k1r = *(const u32x4*)(kg1 + (size_t)(t) * 64 * 768); v0r = *(const u32x4*)(vg + (size_t)(t) * 64 * 1024); } while (0)
#define M2_STORE(bufi) do { LAS unsigned char* kb_ = lds + (bufi) * M2_BUF; *(LAS u32x4*)(kb_ + kd0) = k0r; if (tid < 256) *(LAS u32x4*)(kb_ + kd1) = k1r; *(LAS u32x4*)(kb_ + M2_KB + vd) = v0r; } while (0)
    M2_LOAD(0); M2_STORE(0); __syncthreads();
    float mrefA = 0.f, lA = 0.f, mrefB = 0.f, lB = 0.f;
    f32x16 oA0, oA1, oB0, oB1;
#pragma unroll
    for (int i = 0; i < 16; ++i) { oA0[i] = 0.f; oA1[i] = 0.f; oB0[i] = 0.f; oB1[i] = 0.f; }
    const int vlane = ((lane & 15) >> 2) * 64 + 32 * ((lane >> 4) & 1) + 8 * (lane & 3);
#define M2_SOFT_PV(P0, P1, MREF, LRUN, O0, O1, WSF) do { \
        float d = P0[0]; \
        _Pragma("unroll") for (int i = 0; i < 16; ++i) { d = __builtin_fmaxf(d, P0[i]); d = __builtin_fmaxf(d, P1[i]); } \
        { const auto rr = __builtin_amdgcn_permlane32_swap(__float_as_uint(d), __float_as_uint(d), false, false); d = __builtin_fmaxf(__uint_as_float(rr[0]), __uint_as_float(rr[1])); } \
        d -= MREF; \
        if (t == 0) { MREF += d; } \
        else if (__any(d > 8.f)) { const float delta = __builtin_fmaxf(d, 0.f), alpha = __builtin_amdgcn_exp2f(-delta); MREF += delta; LRUN *= alpha; \
            if (hh == 0) WSF[r] = alpha; \
            LDS_WAIT(); \
            _Pragma("unroll") for (int g = 0; g < 4; ++g) { const f32x4 al = *(const LAS f32x4*)(WSF + 8 * g + 4 * hh); \
                _Pragma("unroll") for (int e = 0; e < 4; ++e) { O0[4 * g + e] *= al[e]; O1[4 * g + e] *= al[e]; } } \
            LDS_WAIT(); } \
        float rs = 0.f; \
        _Pragma("unroll") for (int i = 0; i < 16; ++i) { P0[i] = __builtin_amdgcn_exp2f(P0[i] - MREF); P1[i] = __builtin_amdgcn_exp2f(P1[i] - MREF); rs += P0[i] + P1[i]; } \
        LRUN += rs; \
        _Pragma("unroll") for (int half = 0; half < 2; ++half) \
            _Pragma("unroll") for (int s2 = 0; s2 < 2; ++s2) { \
                const f32x16& P = half ? P1 : P0; \
                const bf16x8 pa = pack8(P[8 * s2], P[8 * s2 + 1], P[8 * s2 + 2], P[8 * s2 + 3], P[8 * s2 + 4], P[8 * s2 + 5], P[8 * s2 + 6], P[8 * s2 + 7]); \
                const LAS unsigned char* vp = vb + (32 * half + 16 * s2 + 4 * hh) * 64 + vlane; \
                { const s16x4 lo = lds_tr16(vp), hi = lds_tr16(vp + 8 * 64); const bf16x8 vf = __builtin_shufflevector(lo, hi, 0, 1, 2, 3, 4, 5, 6, 7); O0 = MFMA32(pa, vf, O0); } \
                { const s16x4 lo = lds_tr16(vp + 4096), hi = lds_tr16(vp + 4096 + 8 * 64); const bf16x8 vf = __builtin_shufflevector(lo, hi, 0, 1, 2, 3, 4, 5, 6, 7); O1 = MFMA32(pa, vf, O1); } } \
    } while (0)
    for (int t = 0; t < NT; ++t) {
        const int buf = t & 1;
        if (t + 1 < NT) M2_LOAD(t + 1);
        const LAS unsigned char* kb = lds + buf * M2_BUF; const LAS unsigned char* vb = kb + M2_KB;
        const bool doA = (t <= cqA), doB = (t <= cqB);
        if (doA && doB) {
            f32x16 a0p, a1p, b0p, b1p;
#pragma unroll
            for (int i = 0; i < 16; ++i) { a0p[i] = 0.f; a1p[i] = 0.f; b0p[i] = 0.f; b1p[i] = 0.f; }
#pragma unroll
            for (int s = 0; s < 6; ++s) { const bf16x8 k0 = *(const LAS bf16x8*)(kb + (2 * s + hh) * M2_KCH + r * 16), k1 = *(const LAS bf16x8*)(kb + (2 * s + hh) * M2_KCH + (r + 32) * 16);
                a0p = MFMA32(k0, qfA[s], a0p); a1p = MFMA32(k1, qfA[s], a1p); b0p = MFMA32(k0, qfB[s], b0p); b1p = MFMA32(k1, qfB[s], b1p); }
            M2_SOFT_PV(a0p, a1p, mrefA, lA, oA0, oA1, wsfA);
            M2_SOFT_PV(b0p, b1p, mrefB, lB, oB0, oB1, wsfB);
        } else if (doB) {
            f32x16 b0p, b1p;
#pragma unroll
            for (int i = 0; i < 16; ++i) { b0p[i] = 0.f; b1p[i] = 0.f; }
#pragma unroll
            for (int s = 0; s < 6; ++s) { const bf16x8 k0 = *(const LAS bf16x8*)(kb + (2 * s + hh) * M2_KCH + r * 16), k1 = *(const LAS bf16x8*)(kb + (2 * s + hh) * M2_KCH + (r + 32) * 16);
                b0p = MFMA32(k0, qfB[s], b0p); b1p = MFMA32(k1, qfB[s], b1p); }
            M2_SOFT_PV(b0p, b1p, mrefB, lB, oB0, oB1, wsfB);
        }
        if (t + 1 < NT) M2_STORE(buf ^ 1);
        __syncthreads();
    }
#undef M2_SOFT_PV
#undef M2_LOAD
#undef M2_STORE
#define M2_OUT(QW, LRUN, O0, O1, WSF) do { \
        float lt = LRUN; { const auto rr = __builtin_amdgcn_permlane32_swap(__float_as_uint(lt), __float_as_uint(lt), false, false); lt = __uint_as_float(rr[0]) + __uint_as_float(rr[1]); } \
        if (hh == 0) WSF[r] = 1.f / lt; \
        LDS_WAIT(); \
        _Pragma("unroll") for (int g = 0; g < 4; ++g) { const f32x4 rl = *(const LAS f32x4*)(WSF + 8 * g + 4 * hh); \
            _Pragma("unroll") for (int e = 0; e < 4; ++e) { const int i = 4 * g + e; bf16_t* op = O + (rowbase + (QW) + crow(i, hh)) * 512 + h * 64 + r; \
                op[0] = (bf16_t)(cvt_pk_bf16(O0[i] * rl[e], 0.f) & 0xffffu); op[32] = (bf16_t)(cvt_pk_bf16(O1[i] * rl[e], 0.f) & 0xffffu); } } \
        LDS_WAIT(); } while (0)
    M2_OUT(qwA, lA, oA0, oA1, wsfA);
    M2_OUT(qwB, lB, oB0, oB1, wsfB);
#undef M2_OUT
}

__device__ __forceinline__ void mla_unit(LAS unsigned char* lds, const bf16_t* Q, const bf16_t* Kb, const bf16_t* KV, bf16_t* O, int b, int h, int qb) {
    const int tid = threadIdx.x, lane = tid & 63, r = lane & 31, hh = lane >> 5; const int wid = __builtin_amdgcn_readfirstlane(tid >> 6);
    const size_t rowbase = (size_t)b * SEQ; const int q0 = qb * 256, qw = q0 + 32 * wid;
    const int cq = qw >> 6, NT = (q0 >> 6) + 4;
    LAS float* wsf = (LAS float*)(lds + ATT_WS) + wid * 64;
    bf16x8 qf[6];
    { const bf16_t* qp = Q + (rowbase + qw + r) * 768 + h * 96 + hh * 8;
#pragma unroll
      for (int s = 0; s < 6; ++s) qf[s] = *(const bf16x8*)(qp + 16 * s); }
    const int lkv = tid & 63, lc = tid >> 6;
    const bf16_t* kg0 = Kb + (rowbase + lkv) * 768 + h * 96 + lc * 8;
    const bf16_t* vg = KV + (rowbase + lkv) * 1024 + h * 128 + 64 + lc * 8;
    u32x4 ka0, ka1 = (u32x4){0u, 0u, 0u, 0u}, va;
#define ATT_LOAD(t, K0, K1, V) do { K0 = *(const u32x4*)(kg0 + (size_t)(t) * 64 * 768); if (tid < 256) K1 = *(const u32x4*)(kg0 + (size_t)(t) * 64 * 768 + 64); V = *(const u32x4*)(vg + (size_t)(t) * 64 * 1024); } while (0)
#define ATT_STORE(bufi, K0, K1, V) do { LAS unsigned char* kb_ = lds + (bufi) * ATT_BUF; *(LAS u32x4*)(kb_ + tid * 16) = K0; if (tid < 256) *(LAS u32x4*)(kb_ + 8192 + tid * 16) = K1; \
        LAS unsigned char* vb_ = kb_ + ATT_KBYTES + (lc * 8) * ATT_VPITCH + lkv * 2; \
        _Pragma("unroll") for (int j_ = 0; j_ < 8; ++j_) *(LAS unsigned short*)(vb_ + j_ * ATT_VPITCH) = (unsigned short)(V[j_ >> 1] >> (16 * (j_ & 1))); } while (0)
    ATT_LOAD(0, ka0, ka1, va); ATT_STORE(0, ka0, ka1, va); __syncthreads();
    float mref = 0.f, l_run = 0.f;
    f32x16 o0, o1, negm;
#pragma unroll
    for (int i = 0; i < 16; ++i) { o0[i] = 0.f; o1[i] = 0.f; negm[i] = 0.f; }
#define MLA_ITER(t_, BUFI, K0, K1, V) do { const int t = (t_); \
        if (t + 1 < NT) ATT_LOAD(t + 1, K0, K1, V); \
        if (t <= cq) { \
            const LAS unsigned char* kb = lds + (BUFI) * ATT_BUF; const LAS unsigned char* vb = kb + ATT_KBYTES; \
            f32x16 p0, p1; \
        _Pragma("unroll") \
            for (int s = 0; s < 6; ++s) { const bf16x8 a0 = *(const LAS bf16x8*)(kb + (2 * s + hh) * 1024 + r * 16), a1 = *(const LAS bf16x8*)(kb + (2 * s + hh) * 1024 + (r + 32) * 16); \
                if (s == 0) { p0 = MFMA32(a0, qf[0], negm); p1 = MFMA32(a1, qf[0], negm); } else { p0 = MFMA32(a0, qf[s], p0); p1 = MFMA32(a1, qf[s], p1); } } \
            float d = p0[0]; \
        _Pragma("unroll") \
            for (int i = 0; i < 16; ++i) { d = __builtin_fmaxf(d, p0[i]); d = __builtin_fmaxf(d, p1[i]); } \
            d = __builtin_fmaxf(d, __shfl_xor(d, 32)); \
            if (t == 0) { mref = d; \
        _Pragma("unroll") \
                for (int i = 0; i < 16; ++i) { p0[i] -= d; p1[i] -= d; negm[i] = -d; } \
            } else if (__any(d > 8.f)) { \
                const float delta = __builtin_fmaxf(d, 0.f), alpha = __builtin_amdgcn_exp2f(-delta); mref += delta; l_run *= alpha; \
        _Pragma("unroll") \
                for (int i = 0; i < 16; ++i) { p0[i] -= delta; p1[i] -= delta; negm[i] = -mref; } \
                if (hh == 0) wsf[r] = alpha; \
                LDS_WAIT(); \
        _Pragma("unroll") \
                for (int g = 0; g < 4; ++g) { const f32x4 al = *(const LAS f32x4*)(wsf + 8 * g + 4 * hh); \
        _Pragma("unroll") \
                    for (int e = 0; e < 4; ++e) { o0[4 * g + e] *= al[e]; o1[4 * g + e] *= al[e]; } } \
                LDS_WAIT(); \
            } \
            float rs = 0.f; \
        _Pragma("unroll") \
            for (int i = 0; i < 16; ++i) { p0[i] = __builtin_amdgcn_exp2f(p0[i]); p1[i] = __builtin_amdgcn_exp2f(p1[i]); rs += p0[i] + p1[i]; } \
            l_run += rs; \
        _Pragma("unroll") \
            for (int half = 0; half < 2; ++half) \
        _Pragma("unroll") \
                for (int s2 = 0; s2 < 2; ++s2) { \
                    const f32x16& P = half ? p1 : p0; \
                    const bf16x8 pa = pack8(P[8 * s2], P[8 * s2 + 1], P[8 * s2 + 2], P[8 * s2 + 3], P[8 * s2 + 4], P[8 * s2 + 5], P[8 * s2 + 6], P[8 * s2 + 7]); \
                    const int kvo = (32 * half + 16 * s2 + 4 * hh) * 2; \
                    { const s16x4 lo = *(const LAS s16x4*)(vb + r * ATT_VPITCH + kvo), hi = *(const LAS s16x4*)(vb + r * ATT_VPITCH + kvo + 16); \
                      const bf16x8 vf = __builtin_shufflevector(lo, hi, 0, 1, 2, 3, 4, 5, 6, 7); o0 = MFMA32(pa, vf, o0); } \
                    { const s16x4 lo = *(const LAS s16x4*)(vb + (r + 32) * ATT_VPITCH + kvo), hi = *(const LAS s16x4*)(vb + (r + 32) * ATT_VPITCH + kvo + 16); \
                      const bf16x8 vf = __builtin_shufflevector(lo, hi, 0, 1, 2, 3, 4, 5, 6, 7); o1 = MFMA32(pa, vf, o1); } \
                } \
        } \
        if (t + 1 < NT) ATT_STORE((BUFI) ^ 1, K0, K1, V); \
        __syncthreads(); } while (0)
    for (int t2 = 0; t2 < NT; t2 += 2) {
        MLA_ITER(t2, 0, ka0, ka1, va);
        MLA_ITER(t2 + 1, 1, ka0, ka1, va);
    }
#undef MLA_ITER
    const float l_tot = l_run + __shfl_xor(l_run, 32);
    if (hh == 0) wsf[r] = 1.f / l_tot;
    LDS_WAIT();
#pragma unroll
    for (int g = 0; g < 4; ++g) { const f32x4 rl = *(const LAS f32x4*)(wsf + 8 * g + 4 * hh);
#pragma unroll
        for (int e = 0; e < 4; ++e) { const int i = 4 * g + e; bf16_t* op = O + (rowbase + qw + crow(i, hh)) * 512 + h * 64 + r;
            op[0] = (bf16_t)(cvt_pk_bf16(o0[i] * rl[e], 0.f) & 0xffffu); op[32] = (bf16_t)(cvt_pk_bf16(o1[i] * rl[e], 0.f) & 0xffffu); } }
    LDS_WAIT();
#undef ATT_LOAD
#undef ATT_STORE
}

#ifndef SBTHR
#define SBTHR 136.f
#endif
constexpr int SBW_VBYTES = 4096;
constexpr int SBW_KCH = 528;
constexpr int SBW_BYTES = 8 * SBW_KCH + SBW_VBYTES;
static_assert(8 * SBW_BYTES <= RING_BYTES, "per-wave stick-breaking LDS");
__device__ __forceinline__ void sb_wave(LAS unsigned char* wl, const bf16_t* SBQ, bf16_t* O, int b, int h, int qblk) {
    int lane_ = threadIdx.x & 63; asm volatile("" : "+v"(lane_));
    const int lane = lane_, r = lane & 31, hh = lane >> 5;
    const size_t rowbase = (size_t)b * SEQ; const int qw = 32 * qblk;
    constexpr float C2 = 0.125f * LOG2E;
    bf16x8 qf[4];
    { const bf16_t* qp = SBQ + (rowbase + qw + r) * 1536 + h * 64 + hh * 8;
#pragma unroll
      for (int s = 0; s < 4; ++s) qf[s] = *(const bf16x8*)(qp + 16 * s); }
    const int lrow = lane >> 3, lch = lane & 7;
    const bf16_t* kg = SBQ + (rowbase + lrow) * 1536 + 512 + h * 64 + lch * 8;
    const bf16_t* vg = SBQ + (rowbase + lrow) * 1536 + 1024 + h * 64 + lch * 8;
    LAS unsigned char* Kl = wl; LAS unsigned char* Vt = wl + 8 * SBW_KCH;
    u32x4 kr[4], vr[4], kr2[4], vr2[4];
#define SBW_LOAD(kv0_, KR, VR) do { _Pragma("unroll") for (int i_ = 0; i_ < 4; ++i_) { KR[i_] = *(const u32x4*)(kg + (size_t)((kv0_) + 8 * i_) * 1536); VR[i_] = *(const u32x4*)(vg + (size_t)((kv0_) + 8 * i_) * 1536); } } while (0)
    SBW_LOAD(qw, kr, vr); if (qw >= 32) SBW_LOAD(qw - 32, kr2, vr2);
    float carry = 0.f;
    f32x16 o0, o1;
#pragma unroll
    for (int i = 0; i < 16; ++i) { o0[i] = 0.f; o1[i] = 0.f; }
    bool done = false;
#define SBW_STEP(kv_, KR, VR) do { const int kvh0 = (kv_); \
        _Pragma("unroll") \
        for (int i = 0; i < 4; ++i) { *(LAS u32x4*)(Kl + lch * SBW_KCH + (8 * i + lrow) * 16) = KR[i]; \
            *(LAS u32x4*)(Vt + (lch >> 2) * 2048 + (8 * i + lrow) * 64 + (lch & 3) * 16) = VR[i]; } \
        if (kvh0 >= 64) SBW_LOAD(kvh0 - 64, KR, VR); \
        LDS_WAIT(); \
        f32x16 x; \
        _Pragma("unroll") \
        for (int i = 0; i < 16; ++i) x[i] = 0.f; \
        _Pragma("unroll") \
        for (int s = 0; s < 4; ++s) { const bf16x8 a0 = *(const LAS bf16x8*)(Kl + (2 * s + hh) * SBW_KCH + r * 16); x = MFMA32(a0, qf[s], x); } \
        const bool diag = (kvh0 == qw); \
        float sp[16], z[16]; \
        _Pragma("unroll") \
        for (int i = 0; i < 16; ++i) { const float z2 = x[i] * C2; const float lg = __builtin_amdgcn_logf(1.f + __builtin_amdgcn_exp2f(__builtin_fminf(z2, 64.f))); \
            const float s_ = __builtin_fmaxf(lg, z2); \
            sp[i] = (!diag || crow(i, hh) < r) ? s_ : 0.f; z[i] = z2; } \
        float G[4], Gp[4]; \
        _Pragma("unroll") \
        for (int g = 0; g < 4; ++g) { G[g] = (sp[4 * g] + sp[4 * g + 1]) + (sp[4 * g + 2] + sp[4 * g + 3]); \
            const auto rr = __builtin_amdgcn_permlane32_swap(__float_as_uint(G[g]), __float_as_uint(G[g]), false, false); \
            Gp[g] = __uint_as_float(hh ? rr[0] : rr[1]); } \
        float tail[4]; tail[3] = 0.f; tail[2] = G[3] + Gp[3]; tail[1] = tail[2] + (G[2] + Gp[2]); tail[0] = tail[1] + (G[1] + Gp[1]); const float total = tail[0] + (G[0] + Gp[0]); \
        float a[16]; \
        _Pragma("unroll") \
        for (int g = 0; g < 4; ++g) { const float base = carry + tail[g] + (hh == 0 ? Gp[g] : 0.f); \
            const float s3 = base + sp[4 * g + 3], s2_ = s3 + sp[4 * g + 2], s1 = s2_ + sp[4 * g + 1], s0 = s1 + sp[4 * g]; \
            a[4 * g + 3] = __builtin_amdgcn_exp2f(z[4 * g + 3] - s3); a[4 * g + 2] = __builtin_amdgcn_exp2f(z[4 * g + 2] - s2_); a[4 * g + 1] = __builtin_amdgcn_exp2f(z[4 * g + 1] - s1); a[4 * g] = __builtin_amdgcn_exp2f(z[4 * g] - s0); } \
        if (diag) { \
        _Pragma("unroll") \
            for (int i = 0; i < 16; ++i) a[i] = (crow(i, hh) < r) ? a[i] : 0.f; } \
        carry += total; \
        _Pragma("unroll") \
        for (int s2 = 0; s2 < 2; ++s2) { \
            const bf16x8 pa = pack8(a[8 * s2], a[8 * s2 + 1], a[8 * s2 + 2], a[8 * s2 + 3], a[8 * s2 + 4], a[8 * s2 + 5], a[8 * s2 + 6], a[8 * s2 + 7]); \
            const LAS unsigned char* vp = Vt + (16 * s2 + 4 * hh + ((lane & 15) >> 2)) * 64 + 32 * ((lane >> 4) & 1) + 8 * (lane & 3); \
            { const s16x4 lo = lds_tr16(vp), hi = lds_tr16(vp + 8 * 64); \
              const bf16x8 vf = __builtin_shufflevector(lo, hi, 0, 1, 2, 3, 4, 5, 6, 7); o0 = MFMA32(pa, vf, o0); } \
            { const s16x4 lo = lds_tr16(vp + 2048), hi = lds_tr16(vp + 2048 + 8 * 64); \
              const bf16x8 vf = __builtin_shufflevector(lo, hi, 0, 1, 2, 3, 4, 5, 6, 7); o1 = MFMA32(pa, vf, o1); } } \
        asm volatile("" ::: "memory"); \
        done = __all(carry > SBTHR) != 0; } while (0)
    for (int kv = qw; kv >= 0; kv -= 64) {
        SBW_STEP(kv, kr, vr); if (done) break;
        if (kv >= 32) { SBW_STEP(kv - 32, kr2, vr2); if (done) break; }
    }
#undef SBW_STEP
#undef SBW_LOAD
#pragma unroll
    for (int i = 0; i < 16; ++i) { bf16_t* op = O + (rowbase + qw + crow(i, hh)) * 512 + h * 64 + r;
        op[0] = (bf16_t)(cvt_pk_bf16(o0[i], 0.f) & 0xffffu); op[32] = (bf16_t)(cvt_pk_bf16(o1[i], 0.f) & 0xffffu); }
}

__device__ __forceinline__ void sb_unit(LAS unsigned char* lds, const bf16_t* SBQ, bf16_t* O, int b, int h, int qb) {
    const int tid = threadIdx.x, lane = tid & 63, r = lane & 31, hh = lane >> 5; const int wid = __builtin_amdgcn_readfirstlane(tid >> 6);
    const size_t rowbase = (size_t)b * SEQ; const int q0 = qb * 256, qw = q0 + 32 * wid;
    const int NT = (q0 >> 6) + 4;
    constexpr float C2 = 0.125f * LOG2E;
    bf16x8 qf[4];
    { const bf16_t* qp = SBQ + (rowbase + qw + r) * 1536 + h * 64 + hh * 8;
#pragma unroll
      for (int s = 0; s < 4; ++s) qf[s] = *(const bf16x8*)(qp + 16 * s); }
    const int lkv = tid & 63, lc = tid >> 6;
    const bf16_t* kg0 = SBQ + (rowbase + lkv) * 1536 + 512 + h * 64 + lc * 8;
    const bf16_t* vg = SBQ + (rowbase + lkv) * 1536 + 1024 + h * 64 + lc * 8;
    u32x4 ka0, va, kb0, vb2;
#define ATT_LOAD(t, K0, V) do { K0 = *(const u32x4*)(kg0 + (size_t)(t) * 64 * 1536); V = *(const u32x4*)(vg + (size_t)(t) * 64 * 1536); } while (0)
#define ATT_STORE(bufi, K0, V) do { LAS unsigned char* kb_ = lds + (bufi) * ATT_BUF; *(LAS u32x4*)(kb_ + tid * 16) = K0; \
        LAS unsigned char* vb_ = kb_ + ATT_KBYTES + (lc * 8) * ATT_VPITCH + lkv * 2; \
        _Pragma("unroll") for (int j_ = 0; j_ < 8; ++j_) *(LAS unsigned short*)(vb_ + j_ * ATT_VPITCH) = (unsigned short)(V[j_ >> 1] >> (16 * (j_ & 1))); } while (0)
    LAS unsigned* dflag = (LAS unsigned*)(lds + ATT_WS + 8 * 256);
    ATT_LOAD(NT - 1, ka0, va); ATT_STORE(0, ka0, va); __syncthreads();
    ATT_LOAD(NT - 2, kb0, vb2); ATT_LOAD(NT - 3, ka0, va);
    float carry = 0.f; bool wdone = false;
    f32x16 o0, o1;
#pragma unroll
    for (int i = 0; i < 16; ++i) { o0[i] = 0.f; o1[i] = 0.f; }
#define SB_SUB(X, kvh0, kvl) do { const bool diag_ = ((kvh0) == qw); float lk_[16], z_[16]; \
        _Pragma("unroll") for (int i = 0; i < 16; ++i) { const float z2 = X[i] * C2; const float ex = __builtin_amdgcn_exp2f(z2); float sp = __builtin_amdgcn_logf(1.f + ex); sp = z2 > 64.f ? z2 : sp; \
            const bool valid = !diag_ || (crow(i, hh) < r); lk_[i] = valid ? -sp : 0.f; z_[i] = z2; } \
        float G_[4], Gp_[4]; \
        _Pragma("unroll") for (int g = 0; g < 4; ++g) { G_[g] = (lk_[4 * g] + lk_[4 * g + 1]) + (lk_[4 * g + 2] + lk_[4 * g + 3]); Gp_[g] = __shfl_xor(G_[g], 32); } \
        float tail_[4]; tail_[3] = 0.f; tail_[2] = G_[3] + Gp_[3]; tail_[1] = tail_[2] + (G_[2] + Gp_[2]); tail_[0] = tail_[1] + (G_[1] + Gp_[1]); const float total_ = tail_[0] + (G_[0] + Gp_[0]); \
        float a_[16]; \
        _Pragma("unroll") for (int g = 0; g < 4; ++g) { const float base_ = carry + tail_[g] + (hh == 0 ? Gp_[g] : 0.f); \
            const float s3 = base_ + lk_[4 * g + 3], s2_ = s3 + lk_[4 * g + 2], s1 = s2_ + lk_[4 * g + 1], s0 = s1 + lk_[4 * g]; \
            a_[4 * g + 3] = __builtin_amdgcn_exp2f(z_[4 * g + 3] + s3); a_[4 * g + 2] = __builtin_amdgcn_exp2f(z_[4 * g + 2] + s2_); a_[4 * g + 1] = __builtin_amdgcn_exp2f(z_[4 * g + 1] + s1); a_[4 * g] = __builtin_amdgcn_exp2f(z_[4 * g] + s0); } \
        if (diag_) { _Pragma("unroll") for (int i = 0; i < 16; ++i) a_[i] = (crow(i, hh) < r) ? a_[i] : 0.f; } \
        carry += total_; \
        _Pragma("unroll") for (int s2 = 0; s2 < 2; ++s2) { \
            const bf16x8 pa = pack8(a_[8 * s2], a_[8 * s2 + 1], a_[8 * s2 + 2], a_[8 * s2 + 3], a_[8 * s2 + 4], a_[8 * s2 + 5], a_[8 * s2 + 6], a_[8 * s2 + 7]); \
            const int kvo = ((kvl) + 16 * s2 + 4 * hh) * 2; \
            { const s16x4 lo = *(const LAS s16x4*)(vb + r * ATT_VPITCH + kvo), hi = *(const LAS s16x4*)(vb + r * ATT_VPITCH + kvo + 16); \
              const bf16x8 vf = __builtin_shufflevector(lo, hi, 0, 1, 2, 3, 4, 5, 6, 7); o0 = MFMA32(pa, vf, o0); } \
            { const s16x4 lo = *(const LAS s16x4*)(vb + (r + 32) * ATT_VPITCH + kvo), hi = *(const LAS s16x4*)(vb + (r + 32) * ATT_VPITCH + kvo + 16); \
              const bf16x8 vf = __builtin_shufflevector(lo, hi, 0, 1, 2, 3, 4, 5, 6, 7); o1 = MFMA32(pa, vf, o1); } } } while (0)
    bool alldone = false;
#define SB_ITER(it_, BUFI, K0, V) do { const int it = (it_), t = NT - 1 - it, kv0 = 64 * t; \
        if (kv0 <= qw && !wdone) { \
            const LAS unsigned char* kb = lds + (BUFI) * ATT_BUF; const LAS unsigned char* vb = kb + ATT_KBYTES; \
            const bool upper = (kv0 + 32 <= qw); \
            f32x16 p0, p1; \
        _Pragma("unroll") \
            for (int i = 0; i < 16; ++i) { p0[i] = 0.f; p1[i] = 0.f; } \
        _Pragma("unroll") \
            for (int s = 0; s < 4; ++s) { const bf16x8 a0 = *(const LAS bf16x8*)(kb + (2 * s + hh) * 1024 + r * 16); p0 = MFMA32(a0, qf[s], p0); } \
            if (upper) { \
        _Pragma("unroll") \
                for (int s = 0; s < 4; ++s) { const bf16x8 a1 = *(const LAS bf16x8*)(kb + (2 * s + hh) * 1024 + (r + 32) * 16); p1 = MFMA32(a1, qf[s], p1); } \
                SB_SUB(p1, kv0 + 32, 32); \
            } \
            SB_SUB(p0, kv0, 0); \
            wdone = __all(carry < -170.f) != 0; \
        } \
        if (lane == 0) dflag[(BUFI) * 8 + wid] = wdone ? 1u : 0u; \
        if (t > 0) ATT_STORE((BUFI) ^ 1, K0, V); \
        if (t > 2) ATT_LOAD(t - 3, K0, V); \
        __syncthreads(); \
        { const u32x4 f0 = *(const LAS u32x4*)(dflag + (BUFI) * 8), f1 = *(const LAS u32x4*)(dflag + (BUFI) * 8 + 4); \
          alldone = (f0.x & f0.y & f0.z & f0.w & f1.x & f1.y & f1.z & f1.w) != 0u; } } while (0)
    for (int i2 = 0; i2 < NT; i2 += 2) {
        SB_ITER(i2, 0, kb0, vb2); if (alldone) break;
        SB_ITER(i2 + 1, 1, ka0, va); if (alldone) break;
    }
#undef SB_ITER
    __syncthreads();
#pragma unroll
    for (int i = 0; i < 16; ++i) { bf16_t* op = O + (rowbase + qw + crow(i, hh)) * 512 + h * 64 + r;
        op[0] = (bf16_t)(cvt_pk_bf16(o0[i], 0.f) & 0xffffu); op[32] = (bf16_t)(cvt_pk_bf16(o1[i], 0.f) & 0xffffu); }
#undef SB_SUB
#undef ATT_LOAD
#undef ATT_STORE
}

#ifndef PHMASK
#define PHMASK 0xFFFF
#endif
#define PH(n) ((PHMASK >> (n)) & 1)
#ifndef STG_P2
#define STG_P2 0
#endif
#ifndef STG_GU
#define STG_GU 0
#endif
#ifndef DUPMASK
#define DUPMASK 0
#endif
#define DUP(n) (1 + ((DUPMASK >> (n)) & 1))
struct Args { const void* in[23]; float* out; unsigned char* ws; };

__global__ void __launch_bounds__(512, 2) fwd_kernel(Args args) {
    extern __shared__ __attribute__((aligned(16))) unsigned char lds_raw[];
    LAS unsigned char* lds = (LAS unsigned char*)lds_raw;
    const int tid = threadIdx.x, lane = tid & 63, wave = __builtin_amdgcn_readfirstlane(tid >> 6);
    const int G = gridDim.x; const int bx = blockIdx.x; const int vcu = (G % 8 == 0) ? (bx % 8) * (G / 8) + bx / 8 : bx;
    const int gw = vcu * 8 + wave, NGW = G * 8;
    unsigned char* ws = args.ws;
    unsigned* ctl = (unsigned*)(ws + WS_CTL);
    const float* x = (const float*)args.in[0]; const float* cvec = (const float*)args.in[1]; const int* positions = (const int*)args.in[2];
    const float* w_ada = (const float*)args.in[3]; const float* b_ada = (const float*)args.in[4]; const float* g_norm1 = (const float*)args.in[5];
    const float* w_in = (const float*)args.in[6]; const float* g_q_lat = (const float*)args.in[7]; const float* w_uq = (const float*)args.in[8];
    const float* g_kv_lat = (const float*)args.in[9]; const float* w_ukv = (const float*)args.in[10]; const float* g_qk_q = (const float*)args.in[11];
    const float* g_qk_k = (const float*)args.in[12]; const float* w_o_mla = (const float*)args.in[13]; const float* w_o_sb = (const float*)args.in[14];
    const float* w_out = (const float*)args.in[15]; const float* g_norm2 = (const float*)args.in[16]; const float* w_router = (const float*)args.in[17];
    const float* b_router = (const float*)args.in[18]; const float* w_gate_up = (const float*)args.in[19]; const float* b_gate_up = (const float*)args.in[20];
    const float* w_down = (const float*)args.in[21]; const float* b_down = (const float*)args.in[22];
    float* out = args.out;
    bf16_t* WIN = (bf16_t*)(ws + WS_WIN); bf16_t* WUQ = (bf16_t*)(ws + WS_WUQ); bf16_t* WUKV = (bf16_t*)(ws + WS_WUKV); bf16_t* WOM = (bf16_t*)(ws + WS_WOM);
    bf16_t* WOS = (bf16_t*)(ws + WS_WOS); bf16_t* WOUT = (bf16_t*)(ws + WS_WOUT); float* MOD = (float*)(ws + WS_MOD);
    float* ROWSS = (float*)(ws + WS_ROWSS); unsigned char* WIN8 = ws + WS_WIN8; unsigned char* H8 = ws + WS_H8; unsigned char* M8 = ws + WS_M8; unsigned char* WOUT8 = ws + WS_WOUT;
    bf16_t* HB = (bf16_t*)(ws + WS_H); bf16_t* KVRAW = (bf16_t*)(ws + WS_KVRAW); bf16_t* MERGED = (bf16_t*)(ws + WS_MERGED);
    bf16_t* SGA = (bf16_t*)(ws + WS_SGA); bf16_t* SGB = (bf16_t*)(ws + WS_SGB); unsigned char* H2 = ws + WS_H2;
    unsigned char* WGU = ws + WS_WGU; unsigned char* WDN = ws + WS_WDN; bf16_t* SBQ = (bf16_t*)(ws + WS_SB);
    int* TOKL = (int*)(ws + WS_TOKL); float* WLST = (float*)(ws + WS_WL); unsigned char* HID = ws + WS_HID;
    bf16_t* QL = (bf16_t*)(ws + WS_QL); bf16_t* KVL = (bf16_t*)(ws + WS_KVL); bf16_t* KPE = (bf16_t*)(ws + WS_KPE);
    bf16_t* QB = (bf16_t*)(ws + WS_Q); bf16_t* KB = (bf16_t*)(ws + WS_K); bf16_t* OMLA = (bf16_t*)(ws + WS_OMLA); bf16_t* OSB = (bf16_t*)(ws + WS_OSB);

    for (int u = tid; u < (LDS_BYTES - LDSCTL_OFF) / 4; u += 512) ((LAS unsigned*)(lds + LDSCTL_OFF))[u] = 0u;
    __syncthreads();
    XcdBarrier bar = xcd_barrier_post(ctl + CW_BAR, (volatile LAS unsigned*)(lds + LDSCTL_OFF + LC_BARST));
    LAS float* scr = (LAS float*)(lds + wave * 16384);

#if PH(0)
    {
        constexpr int I_IN = 16 * 133, I_UQ = 6 * 24, I_UKV = 4 * 32, I_OM = 8 * 32, I_OS = 8 * 32, I_OUT = 16 * 32;
        constexpr int NIT = I_IN + I_UQ + I_UKV + I_OM + I_OS + I_OUT;
        for (int it = gw; it < NIT; it += NGW) {
            int q = it;
            if (q < I_IN) { const int kb = q / 133, nb = q % 133, n0 = 32 * nb;
                if (nb < 69) transpose_item(w_in, 1024, DIN, WIN, 64 * kb, n0, n0 < 672 ? n0 : n0 + 96, scr, lane);
                else transpose_item_f8(w_in, 1024, DIN, WIN8, 64 * kb, n0, n0 - 2208, WSCALE, scr, lane);
                continue; } q -= I_IN;
            if (q < I_UQ) { const int kb = q / 24, nb = q % 24; transpose_item(w_uq, 384, 768, WUQ, 64 * kb, 32 * nb, 32 * nb, scr, lane, g_q_lat); continue; } q -= I_UQ;
            if (q < I_UKV) { const int kb = q / 32, nb = q % 32; transpose_item(w_ukv, 256, 1024, WUKV, 64 * kb, 32 * nb, 32 * nb, scr, lane, g_kv_lat); continue; } q -= I_UKV;
            if (q < I_OM) { const int kb = q / 32, nb = q % 32; transpose_item(w_o_mla, 512, 1024, WOM, 64 * kb, 32 * nb, 32 * nb, scr, lane); continue; } q -= I_OM;
            if (q < I_OS) { const int kb = q / 32, nb = q % 32; transpose_item(w_o_sb, 512, 1024, WOS, 64 * kb, 32 * nb, 32 * nb, scr, lane); continue; } q -= I_OS;
            { const int kb = q / 32, nb = q % 32; transpose_item_f8(w_out, 1024, 1024, WOUT8, 64 * kb, 32 * nb, 32 * nb, WSCALE, scr, lane); }
        }
        for (int i = vcu * 512 + tid; i < NTOK * 2 / 4; i += G * 512) ((f32x4*)ROWSS)[i] = (f32x4){0.f, 0.f, 0.f, 0.f};
        for (int i = vcu * 512 + tid; i < 96 * 1024 * 2 / 16; i += G * 512) ((u32x4*)(WIN + 672 * 1024))[i] = (u32x4){0u, 0u, 0u, 0u};
        __syncthreads();
        for (int it = vcu; it < 6144 / 64; it += G) {
            for (int idx = lane; idx < 32 * 128; idx += 64) { const int b = idx >> 7, kk = idx & 127; const float cv = cvec[b * 1024 + 128 * wave + kk]; scr[idx] = cv / (1.f + __expf(-cv)); }
            LDS_WAIT(); asm volatile("" ::: "memory");
            float acc[32];
#pragma unroll
            for (int b = 0; b < 32; ++b) acc[b] = 0.f;
            const float* wp = w_ada + (size_t)(128 * wave) * 6144 + 64 * it + lane;
            float wc[8];
#pragma unroll
            for (int j = 0; j < 8; ++j) wc[j] = wp[(size_t)j * 6144];
#pragma nounroll
            for (int k8 = 0; k8 < 16; ++k8) {
                float wn[8];
                const int kn = k8 < 15 ? k8 + 1 : k8;
#pragma unroll
                for (int j = 0; j < 8; ++j) wn[j] = wp[(size_t)(8 * kn + j) * 6144];
#pragma unroll
                for (int j4 = 0; j4 < 2; ++j4) {
#pragma unroll
                    for (int b = 0; b < 32; ++b) { const f32x4 s = *(const LAS f32x4*)(scr + b * 128 + 8 * k8 + 4 * j4); acc[b] += s.x * wc[4 * j4] + s.y * wc[4 * j4 + 1] + s.z * wc[4 * j4 + 2] + s.w * wc[4 * j4 + 3];
                        if ((b & 7) == 7) asm volatile("" ::: "memory"); } }
#pragma unroll
                for (int j = 0; j < 8; ++j) wc[j] = wn[j];
            }
            LDS_WAIT(); asm volatile("" ::: "memory");
#pragma unroll
            for (int b = 0; b < 32; ++b) scr[b * 64 + lane] = acc[b];
            __syncthreads();
#pragma unroll
            for (int bb = 0; bb < 4; ++bb) { const int b = 4 * wave + bb; float s = 0.f;
#pragma unroll
                for (int w2 = 0; w2 < 8; ++w2) s += ((const LAS float*)(lds + w2 * 16384))[b * 64 + lane];
                MOD[b * 6144 + 64 * it + lane] = s + b_ada[64 * it + lane]; }
            __syncthreads();
        }
    }
#endif
    xcd_barrier(bar);

#if PH(1)
    for (int gi = gw; gi < NTOK / 4; gi += NGW) {
        f32x4 v[4][4];
#pragma unroll
        for (int rr = 0; rr < 4; ++rr) { const f32x4* xr = (const f32x4*)(x + (size_t)(4 * gi + rr) * 1024) + lane;
#pragma unroll
            for (int j = 0; j < 4; ++j) v[rr][j] = xr[64 * j]; }
        const int b = (4 * gi) >> 11;
        const float* mb = MOD + (size_t)b * 6144;
        f32x4 gsc[4], shv[4];
#pragma unroll
        for (int j = 0; j < 4; ++j) { const int col = 4 * lane + 256 * j; gsc[j] = *(const f32x4*)(g_norm1 + col) * (*(const f32x4*)(mb + 1024 + col) + 1.f); shv[j] = *(const f32x4*)(mb + col); }
#pragma unroll
        for (int rr = 0; rr < 4; ++rr) { float ss = 0.f;
#pragma unroll
            for (int j = 0; j < 4; ++j) ss += (v[rr][j].x * v[rr][j].x + v[rr][j].y * v[rr][j].y) + (v[rr][j].z * v[rr][j].z + v[rr][j].w * v[rr][j].w);
            const float rstd = rsqrtf(wave_sum(ss) * (1.f / 1024.f) + EPS);
#pragma unroll
            for (int j = 0; j < 4; ++j) { const int col = 4 * lane + 256 * j; const f32x4 y = (v[rr][j] * rstd) * gsc[j] + shv[j];
                u32x2 o; o.x = cvt_pk_bf16(y.x, y.y); o.y = cvt_pk_bf16(y.z, y.w);
                *(u32x2*)(HB + (size_t)(4 * gi + rr) * 1024 + col) = o;
                *(unsigned*)(H8 + (size_t)(4 * gi + rr) * 1024 + col) = pk4_fp8(y.x, y.y, y.z, y.w); } }
    }
#endif
    xcd_barrier(bar);

#if PH(2)
    { pg8::DenseOrder S; S.init(HB, WIN, NTOK, 2304, 1024, G, bx);
      EpiProj E{QL, KVL, KPE, SBQ, SGA, SGB, 0, 1.f, ROWSS};
      pg8::gemm_phase<false>(lds, 1024, S, E, STG_P2); }
    { pg8::DenseOrder S; S.init(H8, WIN8, NTOK, 2048, 512, G, bx);
      EpiProj E{QL, KVL, KPE, SBQ, SGA, SGB, 2304, WDESCALE, ROWSS};
      pg8::gemm_phase_f8<false>(lds, 512, S, E); }
#endif
    xcd_barrier(bar);

#if PH(4)
    for (int rep = 0; rep < DUP(5); ++rep) {
    { pg8::DenseOrder S; S.init(QL, WUQ, NTOK, 768, 384, G, bx); EpiStore E{QB, 768, ROWSS, 1.f / 384.f}; pg8::gemm_phase<false>(lds, 384, S, E); }
    { pg8::DenseOrder S; S.init(KVL, WUKV, NTOK, 1024, 256, G, bx); EpiStore E{KVRAW, 1024, ROWSS + 1, 1.f / 256.f}; pg8::gemm_phase<false>(lds, 256, S, E); } }
#endif
    xcd_barrier(bar);

#if PH(5)
    {
        const int hd = lane >> 3, sub = lane & 7;
        const float QSC = 0.10206207261596575f * LOG2E;
        const float if0 = exp2f(-(float)(2 * sub) * (13.287712379549449f / 16.f)), if1 = exp2f(-(float)(2 * sub + 1) * (13.287712379549449f / 16.f));
        f32x4 gq0 = *(const f32x4*)(g_qk_q + sub * 8), gq1 = *(const f32x4*)(g_qk_q + sub * 8 + 4); const f32x2 gqa = *(const f32x2*)(g_qk_q + 64 + 2 * sub), gqb = *(const f32x2*)(g_qk_q + 80 + 2 * sub);
        f32x4 gk0 = *(const f32x4*)(g_qk_k + sub * 8), gk1 = *(const f32x4*)(g_qk_k + sub * 8 + 4); const f32x2 gka = *(const f32x2*)(g_qk_k + 64 + 2 * sub), gkb = *(const f32x2*)(g_qk_k + 80 + 2 * sub);
        for (int gi = gw; gi < NTOK / 4; gi += NGW) {
            u32x4 A[4][2]; unsigned B1[4][2], B2[4][2]; float posf[4];
#pragma unroll
            for (int t = 0; t < 4; ++t) { const int m = 4 * gi + t; posf[t] = (float)positions[m];
                const bf16_t* qp = QB + (size_t)m * 768 + hd * 96; A[t][0] = *(const u32x4*)(qp + sub * 8); B1[t][0] = *(const unsigned*)(qp + 64 + 2 * sub); B2[t][0] = *(const unsigned*)(qp + 80 + 2 * sub);
                A[t][1] = *(const u32x4*)(KVRAW + (size_t)m * 1024 + hd * 128 + sub * 8); B1[t][1] = *(const unsigned*)(KPE + (size_t)m * 32 + 2 * sub); B2[t][1] = *(const unsigned*)(KPE + (size_t)m * 32 + 16 + 2 * sub); }
#pragma unroll
            for (int t = 0; t < 4; ++t) { const int m = 4 * gi + t;
                float cs[2], sn[2];
                { const float a0 = posf[t] * if0, a1 = posf[t] * if1;
                  double r0 = (double)a0 * 0.15915494309189535, r1 = (double)a1 * 0.15915494309189535; r0 -= __builtin_rint(r0); r1 -= __builtin_rint(r1);
                  cs[0] = __builtin_amdgcn_cosf((float)r0); sn[0] = __builtin_amdgcn_sinf((float)r0); cs[1] = __builtin_amdgcn_cosf((float)r1); sn[1] = __builtin_amdgcn_sinf((float)r1); }
#pragma unroll
                for (int which = 0; which < 2; ++which) {
                    const u32x4 Av = A[t][which]; const unsigned b1 = B1[t][which], b2 = B2[t][which];
                    bf16_t* dst = which ? KB + (size_t)m * 768 + hd * 96 : QB + (size_t)m * 768 + hd * 96;
                    float f[8] = {bf_lo(Av.x), bf_hi(Av.x), bf_lo(Av.y), bf_hi(Av.y), bf_lo(Av.z), bf_hi(Av.z), bf_lo(Av.w), bf_hi(Av.w)};
                    float x1[2] = {bf_lo(b1), bf_hi(b1)}, x2[2] = {bf_lo(b2), bf_hi(b2)};
                    float ss = x1[0] * x1[0] + x1[1] * x1[1] + x2[0] * x2[0] + x2[1] * x2[1];
#pragma unroll
                    for (int j = 0; j < 8; ++j) ss += f[j] * f[j];
                    ss += __shfl_xor(ss, 1); ss += __shfl_xor(ss, 2); ss += __shfl_xor(ss, 4);
                    const float rstd = rsqrtf(ss * (1.f / 96.f) + EPS);
                    const f32x4 g0 = which ? gk0 : gq0, g1 = which ? gk1 : gq1; const f32x2 ga = which ? gka : gqa, gb = which ? gkb : gqb;
                    const float sc = which ? 1.f : QSC;
                    float y[8] = {f[0] * rstd * g0.x, f[1] * rstd * g0.y, f[2] * rstd * g0.z, f[3] * rstd * g0.w, f[4] * rstd * g1.x, f[5] * rstd * g1.y, f[6] * rstd * g1.z, f[7] * rstd * g1.w};
                    const float y1a = x1[0] * rstd * ga.x, y1b = x1[1] * rstd * ga.y, y2a = x2[0] * rstd * gb.x, y2b = x2[1] * rstd * gb.y;
                    const float o1a = y1a * cs[0] - y2a * sn[0], o1b = y1b * cs[1] - y2b * sn[1], o2a = y2a * cs[0] + y1a * sn[0], o2b = y2b * cs[1] + y1b * sn[1];
                    u32x4 o; o.x = cvt_pk_bf16(y[0] * sc, y[1] * sc); o.y = cvt_pk_bf16(y[2] * sc, y[3] * sc); o.z = cvt_pk_bf16(y[4] * sc, y[5] * sc); o.w = cvt_pk_bf16(y[6] * sc, y[7] * sc);
                    *(u32x4*)(dst + sub * 8) = o; *(unsigned*)(dst + 64 + 2 * sub) = cvt_pk_bf16(o1a * sc, o1b * sc); *(unsigned*)(dst + 80 + 2 * sub) = cvt_pk_bf16(o2a * sc, o2b * sc);
                }
            }
        }
    }
#endif
    xcd_barrier(bar);

#if PH(6)
    for (int bh = vcu; bh < NB * NH; bh += G) {
        for (int rep = 0; rep < DUP(0); ++rep) for (int u2 = 0; u2 < 4; ++u2) mla_unit2(lds, QB, KB, KVRAW, OMLA, bh >> 3, bh & 7, u2);
        __syncthreads();
        for (int rep = 0; rep < DUP(1); ++rep) for (int qi = 0; qi < 8; ++qi) sb_wave(lds + wave * SBW_BYTES, SBQ, OSB, bh >> 3, bh & 7, 8 * qi + wave);
        __syncthreads();
    }
#endif
    xcd_barrier(bar);

#if PH(8)
    for (int rep = 0; rep < DUP(6); ++rep) {
    { pg8::DenseOrder S; S.init(OMLA, WOM, NTOK, 1024, 512, G, bx); EpiMerge<false> E{MERGED, SGA, M8}; pg8::gemm_phase<false>(lds, 512, S, E); }
    { pg8::DenseOrder S; S.init(OSB, WOS, NTOK, 1024, 512, G, bx); EpiMerge<true> E{MERGED, SGB, M8}; pg8::gemm_phase<false>(lds, 512, S, E); } }
#endif
    xcd_barrier(bar);

#if PH(9)
    { pg8::DenseOrder S; S.init(M8, WOUT8, NTOK, 1024, 512, G, bx); EpiWout E{x, out, MOD, WDESCALE}; pg8::gemm_phase_f8<false>(lds, 512, S, E); }
#endif
    xcd_barrier(bar);

#if PH(10)
    {
        constexpr int I_GU = 16 * 64, I_DN = 16 * 32;
        for (int rep = 0; rep < DUP(2); ++rep) for (int it = gw; it < NE * (I_GU + I_DN); it += NGW) {
            if (it < NE * I_GU) { const int e = it / I_GU, q = it % I_GU, kb = q / 64, nb = q % 64, n0 = 32 * nb; const int g = n0 >> 10, jj = n0 & 1023;
                transpose_item_f8(w_gate_up + (size_t)e * 1024 * 2048, 1024, 2048, WGU + (size_t)e * 2048 * 1024, 64 * kb, n0, 256 * (jj >> 7) + 128 * g + (jj & 127), WSCALE, scr, lane); }
            else { const int r2 = it - NE * I_GU, e = r2 / I_DN, q = r2 % I_DN, kb = q / 32, nb = q % 32;
                transpose_item_f8(w_down + (size_t)e * 1024 * 1024, 1024, 1024, WDN + (size_t)e * 1024 * 1024, 64 * kb, 32 * nb, 32 * nb, WSCALE, scr, lane); }
        }
        __syncthreads();
        {
            const int r = lane & 31, hh = lane >> 5;
            constexpr int TP = 1026;
            LAS float* tile = (LAS float*)lds;
            float areg[64];
#pragma unroll
            for (int mm = 0; mm < 64; ++mm) areg[mm] = w_router[(size_t)(128 * wave + 4 * (mm >> 1) + 2 * hh + (mm & 1)) * 32 + r];
            const float br = b_router[r];
            for (int tt = vcu; tt < NTOK / 32; tt += G) {
                { f32x4 v[4][4];
#pragma unroll
                  for (int rr = 0; rr < 4; ++rr) { const f32x4* xr = (const f32x4*)(out + (size_t)(32 * tt + 4 * wave + rr) * 1024) + lane;
#pragma unroll
                      for (int j = 0; j < 4; ++j) v[rr][j] = xr[64 * j]; }
                  const float* mb = MOD + (size_t)((32 * tt) >> 11) * 6144;
                  f32x4 gsc[4], shv[4];
#pragma unroll
                  for (int j = 0; j < 4; ++j) { const int col = 4 * lane + 256 * j; gsc[j] = *(const f32x4*)(g_norm2 + col) * (*(const f32x4*)(mb + 4096 + col) + 1.f); shv[j] = *(const f32x4*)(mb + 3072 + col); }
#pragma unroll
                  for (int rr = 0; rr < 4; ++rr) { float ss = 0.f; const int row = 4 * wave + rr;
#pragma unroll
                      for (int j = 0; j < 4; ++j) ss += (v[rr][j].x * v[rr][j].x + v[rr][j].y * v[rr][j].y) + (v[rr][j].z * v[rr][j].z + v[rr][j].w * v[rr][j].w);
                      const float rstd = rsqrtf(wave_sum(ss) * (1.f / 1024.f) + EPS);
#pragma unroll
                      for (int j = 0; j < 4; ++j) { const int col = 4 * lane + 256 * j; const f32x4 y = (v[rr][j] * rstd) * gsc[j] + shv[j];
                          *(unsigned*)(H2 + (size_t)(32 * tt + row) * 1024 + col) = pk4_fp8(y.x, y.y, y.z, y.w);
                          *(LAS f32x2*)(tile + row * TP + col) = (f32x2){y.x, y.y}; *(LAS f32x2*)(tile + row * TP + col + 2) = (f32x2){y.z, y.w}; } } }
                __syncthreads();
                f32x16 acc;
#pragma unroll
                for (int i = 0; i < 16; ++i) acc[i] = 0.f;
#pragma unroll
                for (int sg = 0; sg < 32; ++sg) { const f32x2 hv = *(const LAS f32x2*)(tile + r * TP + 128 * wave + 4 * sg + 2 * hh);
                    acc = __builtin_amdgcn_mfma_f32_32x32x2f32(areg[2 * sg], hv.x, acc, 0, 0, 0); acc = __builtin_amdgcn_mfma_f32_32x32x2f32(areg[2 * sg + 1], hv.y, acc, 0, 0, 0); }
                __syncthreads();
#pragma unroll
                for (int i = 0; i < 16; ++i) tile[wave * 1024 + i * 64 + lane] = acc[i];
                __syncthreads();
                { const int e = r, he = (e >> 2) & 1, ie = (e & 3) + 4 * (e >> 3);
#pragma unroll
                  for (int rr = 0; rr < 4; ++rr) { const int row = 4 * wave + rr; float v = br;
#pragma unroll
                      for (int w2 = 0; w2 < 8; ++w2) v += tile[w2 * 1024 + ie * 64 + row + 32 * he];
                      float tv[4]; int te[4];
#pragma unroll
                      for (int k = 0; k < 4; ++k) { float bv = v; int bi = e;
#pragma unroll
                          for (int off = 16; off >= 1; off >>= 1) { const float ov = __shfl_xor(bv, off); const int oi = __shfl_xor(bi, off); if (ov > bv || (ov == bv && oi < bi)) { bv = ov; bi = oi; } }
                          tv[k] = bv; te[k] = bi; if (e == bi) v = -INFINITY; }
                      const float e1 = __expf(tv[1] - tv[0]), e2 = __expf(tv[2] - tv[0]), e3 = __expf(tv[3] - tv[0]); const float inv = 1.f / (1.f + e1 + e2 + e3);
                      if (lane < 4) { const int k = lane; const int ek = k == 0 ? te[0] : k == 1 ? te[1] : k == 2 ? te[2] : te[3]; const float wk = (k == 0 ? 1.f : k == 1 ? e1 : k == 2 ? e2 : e3) * inv;
                          const unsigned slot = atomicAdd(ctl + CW_CNT + (k * 32 + ek) * 16, 1u);
                          TOKL[(size_t)(k * 32 + ek) * LISTCAP + slot] = 32 * tt + row; WLST[(size_t)(k * 32 + ek) * LISTCAP + slot] = wk; } } }
                __syncthreads();
            }
        }
    }
#endif
    xcd_barrier(bar);

#if PH(11)
    {
        LAS int* rbase = (LAS int*)(lds + LDSCTL_OFF + LC_RBASE); LAS int* tbase = (LAS int*)(lds + LDSCTL_OFF + LC_TBASE); LAS int* nearr = (LAS int*)(lds + LDSCTL_OFF + LC_NE); LAS int* tilee = (LAS int*)(lds + LDSCTL_OFF + LC_TILEE);
        { int tid = threadIdx.x; asm volatile("" : "+v"(tid));
          if (tid < 4 * NE) nearr[tid] = (int)ctl[CW_CNT + tid * 16];
          __syncthreads();
          if (tid < 4) { int a = 0;
#pragma nounroll
              for (int e = 0; e < NE; ++e) { tbase[tid * 33 + e] = a; a += (nearr[tid * 32 + e] + 255) >> 8; } tbase[tid * 33 + NE] = a; }
          __syncthreads();
          if (tid == 0) { int a = 0;
#pragma nounroll
              for (int k = 0; k < 4; ++k) { rbase[k] = a; a += tbase[k * 33 + NE]; } rbase[4] = a; }
          for (int q = tid; q < 4 * MAXTILES; q += 512) { const int k = q / MAXTILES, T = q % MAXTILES;
              if (T < tbase[k * 33 + NE]) { int e = 0;
#pragma nounroll
                  while (e < NE - 1 && tbase[k * 33 + e + 1] <= T) ++e;
                  tilee[k * MAXTILES + T] = e; } }
          __syncthreads(); }
        const MoeTabs tb{rbase, tbase, nearr, tilee};
        { MoeOrderGU S{(const char*)H2, (const char*)WGU, TOKL, G, vcu, tb};
          EpiGateUp E{HID, b_gate_up};
          pg8::gemm_phase_f8<true>(lds, 512, S, E, STG_GU);
#ifdef GU_DUP
          pg8::gemm_phase_f8<true>(lds, 512, S, E, 0);
#endif
#ifdef GU_NULL
          { EpiNull EN; pg8::gemm_phase_f8<true>(lds, 512, S, EN, 0); }
#endif
        }
        xcd_barrier(bar);
        bf16_t* Y0 = MERGED; bf16_t* Y1 = (bf16_t*)(ws + WS_SGA); bf16_t* Y2 = (bf16_t*)(ws + WS_SGB);
        for (int ph = 0; ph < 2; ++ph) {
            { MoeOrderDN S{(const char*)HID, (const char*)WDN, G, vcu, ph == 0 ? 0 : 3, ph == 0 ? 3 : 4, tb};
              EpiDown E{out, Y0, Y1, Y2, b_down, MOD, TOKL, WLST};
              pg8::gemm_phase_f8<false>(lds, 512, S, E); }
            if (ph == 0) xcd_barrier(bar);
        }
    }
#endif
}

extern "C" void kernel_launch(void* const* d_in, const int* in_sizes, int n_in, void* d_out, int out_size, void* d_ws, size_t ws_size, hipStream_t stream) {
    static int grid = 0;
    if (grid == 0) {
        if (n_in != 23 || in_sizes[0] != NTOK * DM || out_size != NTOK * DM || ws_size < WS_END) { fprintf(stderr, "kernel_launch: unexpected shapes (n_in %d, in0 %d, out %d, ws %zu); nothing launched\n", n_in, n_in > 0 ? in_sizes[0] : -1, out_size, ws_size); grid = -1; return; }
        int dev = 0, cus = 0, per_cu = 0;
        if (hipGetDevice(&dev) != hipSuccess || hipDeviceGetAttribute(&cus, hipDeviceAttributeMultiprocessorCount, dev) != hipSuccess) { grid = -1; return; }
        if (hipFuncSetAttribute((const void*)fwd_kernel, hipFuncAttributeMaxDynamicSharedMemorySize, LDS_BYTES) != hipSuccess) { fprintf(stderr, "kernel_launch: hipFuncSetAttribute failed\n"); grid = -1; return; }
        if (hipOccupancyMaxActiveBlocksPerMultiprocessor(&per_cu, (const void*)fwd_kernel, 512, LDS_BYTES) != hipSuccess || per_cu < 1) fprintf(stderr, "kernel_launch: occupancy query reports %d\n", per_cu);
        (void)hipGetLastError();
        grid = cus;
    }
    if (grid < 0) return;
    if (hipMemsetAsync((char*)d_ws + WS_CTL, 0, CTL_ZERO_BYTES, stream) != hipSuccess) return;
    Args a{};
    for (int i = 0; i < 23; ++i) a.in[i] = d_in[i];
    a.out = (float*)d_out; a.ws = (unsigned char*)d_ws;
    hipLaunchKernelGGL(fwd_kernel, dim3(grid), dim3(512), LDS_BYTES, stream, a);
}
```
